# Optimizing an MI355X kernel written in HIP

```python
import jax, jax.numpy as jnp
from jax import lax
import numpy as np

D_MODEL = 1024
BATCH = 4
SEQ = 8192
DEPTH = 4

MEM_LEN = 256

POOL_W = D_MODEL // 4
NSA_W = D_MODEL // 4
SGU_W = D_MODEL // 4
CONV_W = D_MODEL - POOL_W - NSA_W - SGU_W
D_MIX = POOL_W + NSA_W + SGU_W + CONV_W

POOL_GROUPS = 4
POOL_WINDOWS = (2, 4, 8, 16)
POOL_GW = POOL_W // POOL_GROUPS

NSA_HEADS = 4
NSA_DH = NSA_W // NSA_HEADS
CMP_BLOCK = 32
CMP_STRIDE = 16
CMP_HIDDEN = 256
SEL_BLOCK = 64
SEL_TOPK = 16
WINDOW = 512
Q_BLOCK = 128
FORCE_SCORE = 1e4

SGU_GROUPS = 4
SGU_GW = SGU_W // SGU_GROUPS
SGU_CHUNK = 128

CONV_WIDTH = 31

X_HEADS = 4
X_DH = D_MODEL // X_HEADS

D_FF = 2816
N_EXPERTS = 8
TOP_K = 2
D_FF_EXPERT = 3584
MOE_BLOCK = 512
N_DENSE = (DEPTH + 1) // 2
N_MOE = DEPTH // 2

ALPHA = (2 * DEPTH) ** 0.25
BETA = (8 * DEPTH) ** -0.25
LN_EPS = 1e-5
NEG_INF = -1e30

IN_SPLITS = (POOL_W, NSA_W, 6 * NSA_DH, 3 * NSA_HEADS, 2 * SGU_W, 2 * CONV_W)
D_IN = sum(IN_SPLITS)
IN_OFFSETS = tuple(sum(IN_SPLITS[:i + 1]) for i in range(len(IN_SPLITS) - 1))

kernel_name = "hybrid_pool_nsa_sgu_conv_moe_trunk"


def layer_norm(x, g, b):
    xf = x.astype(jnp.float32)
    mu = jnp.mean(xf, axis=-1, keepdims=True)
    var = jnp.mean(jnp.square(xf - mu), axis=-1, keepdims=True)
    y = (xf - mu) * lax.rsqrt(var + LN_EPS)
    return (y * g.astype(jnp.float32) + b.astype(jnp.float32)).astype(x.dtype)


def masked_softmax(s, mask):
    p = jax.nn.softmax(jnp.where(mask, s, NEG_INF), axis=-1)
    return jnp.where(mask, p, 0.0)


def pool_mixer(a, w, scale):
    b, t, _ = a.shape
    af = a.astype(jnp.float32).reshape(b, t, POOL_GROUPS, POOL_GW)
    cs = jnp.cumsum(af, axis=1)
    pos = jnp.arange(t)
    outs = []
    for g, win in enumerate(POOL_WINDOWS):
        c = cs[:, :, g]
        prev = jnp.pad(c, ((0, 0), (win, 0), (0, 0)))[:, :t]
        cnt = jnp.minimum(pos + 1, win).astype(jnp.float32)[None, :, None]
        outs.append((c - prev) / cnt - af[:, :, g])
    d = jnp.stack(outs, axis=2).astype(a.dtype)
    y = jnp.einsum('btgc,gcd->btgd', d, w).reshape(b, t, POOL_W)
    return y * scale


def compress_kv(raw, pe, w1, w2):
    b, t, dk = raw.shape
    n_chunk = t // CMP_STRIDE
    per = CMP_BLOCK // CMP_STRIDE
    nc = n_chunk - per + 1
    c = raw.reshape(b, n_chunk, CMP_STRIDE, dk)
    blocks = jnp.concatenate([c[:, p:p + nc] for p in range(per)], axis=2) + pe
    h = jax.nn.gelu(blocks.reshape(b, nc, CMP_BLOCK * dk) @ w1)
    return h @ w2


def nsa_mixer(q, kv, gate_logits, pe_k, wk1, wk2, pe_v, wv1, wv2):
    b, t, _ = q.shape
    qh = q.reshape(b, t, NSA_HEADS, NSA_DH)
    k_cmp, v_cmp, k_sel, v_sel, k_win, v_win = jnp.split(kv, 6, axis=-1)
    kc = compress_kv(k_cmp, pe_k, wk1, wk2)
    vc = compress_kv(v_cmp, pe_v, wv1, wv2)
    nc = kc.shape[1]
    ns = t // SEL_BLOCK
    n_sel = min(SEL_TOPK, ns)
    ks_blocks = k_sel.reshape(b, ns, SEL_BLOCK, NSA_DH)
    vs_blocks = v_sel.reshape(b, ns, SEL_BLOCK, NSA_DH)
    kw_pad = jnp.pad(k_win, ((0, 0), (WINDOW, 0), (0, 0)))
    vw_pad = jnp.pad(v_win, ((0, 0), (WINDOW, 0), (0, 0)))
    gates = jax.nn.sigmoid(gate_logits.astype(jnp.float32)).reshape(b, t, NSA_HEADS, 3)
    scale = NSA_DH ** -0.5
    cmp_end = jnp.arange(nc) * CMP_STRIDE + CMP_BLOCK - 1
    sel_ids = jnp.arange(ns)
    ratio = SEL_BLOCK // CMP_STRIDE
    lead = CMP_BLOCK // CMP_STRIDE - 1
    tail = ratio * ns - nc

    def query_block(i):
        q0 = i * Q_BLOCK
        tq = q0 + jnp.arange(Q_BLOCK)
        qb = lax.dynamic_slice_in_dim(qh, q0, Q_BLOCK, axis=1)
        s = jnp.einsum('bqhd,bnd->bhqn', qb, kc).astype(jnp.float32) * scale
        p_c = masked_softmax(s, cmp_end[None, :] <= tq[:, None])
        o_c = jnp.einsum('bhqn,bnd->bqhd', p_c.astype(vc.dtype), vc)
        imp = jnp.pad(p_c.sum(axis=1), ((0, 0), (0, 0), (lead, tail)))
        imp_sel = imp[..., :ratio * ns].reshape(b, Q_BLOCK, ns, ratio).sum(-1)
        for p in range(lead):
            imp_sel = imp_sel + imp[..., ratio + p:ratio + p + ratio * ns:ratio]
        cur = tq // SEL_BLOCK
        valid = sel_ids[None, :] <= cur[:, None]
        forced = ((sel_ids[None, :] == 0) | (sel_ids[None, :] == cur[:, None])
                  | (sel_ids[None, :] == cur[:, None] - 1))
        score = jnp.where(valid, imp_sel + FORCE_SCORE * forced, -1.0)
        top_s, idx = lax.top_k(score, n_sel)
        ks = jax.vmap(lambda kb, ib: kb[ib])(ks_blocks, idx)
        vs = jax.vmap(lambda vb, ib: vb[ib])(vs_blocks, idx)
        kpos = idx[..., None] * SEL_BLOCK + jnp.arange(SEL_BLOCK)
        m_s = (top_s >= 0.0)[..., None] & (kpos <= tq[None, :, None, None])
        s = jnp.einsum('bqhd,bqnkd->bhqnk', qb, ks).astype(jnp.float32) * scale
        s = s.reshape(b, NSA_HEADS, Q_BLOCK, n_sel * SEL_BLOCK)
        m_s = m_s.reshape(b, 1, Q_BLOCK, n_sel * SEL_BLOCK)
        p_s = masked_softmax(s, m_s).reshape(b, NSA_HEADS, Q_BLOCK, n_sel, SEL_BLOCK)
        o_s = jnp.einsum('bhqnk,bqnkd->bqhd', p_s.astype(vs.dtype), vs)
        kw = lax.dynamic_slice_in_dim(kw_pad, q0, WINDOW + Q_BLOCK, axis=1)
        vw = lax.dynamic_slice_in_dim(vw_pad, q0, WINDOW + Q_BLOCK, axis=1)
        spos = q0 - WINDOW + jnp.arange(WINDOW + Q_BLOCK)
        m_w = ((spos[None, :] >= 0) & (spos[None, :] <= tq[:, None])
               & (spos[None, :] > tq[:, None] - WINDOW))
        s = jnp.einsum('bqhd,bkd->bhqk', qb, kw).astype(jnp.float32) * scale
        p_w = masked_softmax(s, m_w)
        o_w = jnp.einsum('bhqk,bkd->bqhd', p_w.astype(vw.dtype), vw)
        g = lax.dynamic_slice_in_dim(gates, q0, Q_BLOCK, axis=1)
        o = g[..., 0:1] * o_c + g[..., 1:2] * o_s + g[..., 2:3] * o_w
        return o.astype(qh.dtype)

    out = lax.map(query_block, jnp.arange(t // Q_BLOCK))
    return out.transpose(1, 0, 2, 3, 4).reshape(b, t, NSA_W)


def sgu_mixer(uv, ln_g, ln_b, w_s, b_s):
    b, t, _ = uv.shape
    u, v = jnp.split(jax.nn.gelu(uv), 2, axis=-1)
    v = layer_norm(v, ln_g, ln_b)
    v = v.reshape(b, t // SGU_CHUNK, SGU_CHUNK, SGU_GROUPS, SGU_GW)
    causal = jnp.tril(jnp.ones((SGU_CHUNK, SGU_CHUNK), dtype=bool))
    w = jnp.where(causal, w_s, 0.0)
    mix = jnp.einsum('gij,bnjgc->bnigc', w, v) + b_s.T[None, None, :, :, None]
    return u * mix.reshape(b, t, SGU_W)


def conv_mixer(ag, w_dw, b_dw, ln_g, ln_b, w_pw):
    a, g = jnp.split(ag, 2, axis=-1)
    h = a * jax.nn.sigmoid(g)
    h = lax.conv_general_dilated(
        h, w_dw[:, None, :], window_strides=(1,), padding=[(CONV_WIDTH - 1, 0)],
        dimension_numbers=("NWC", "WIO", "NWC"), feature_group_count=CONV_W) + b_dw
    h = jax.nn.silu(layer_norm(h, ln_g, ln_b))
    return h @ w_pw


def hybrid_mixer(h, w_in, pool_w, pool_scale, pe_k, wk1, wk2, pe_v, wv1, wv2,
                 sgu_ln_g, sgu_ln_b, sgu_w, sgu_b, conv_w, conv_b, conv_ln_g,
                 conv_ln_b, conv_pw, w_out):
    z = h @ w_in
    a, q, kv, gl, uv, ag = jnp.split(z, IN_OFFSETS, axis=-1)
    y = jnp.concatenate([
        pool_mixer(a, pool_w, pool_scale),
        nsa_mixer(q, kv, gl, pe_k, wk1, wk2, pe_v, wv1, wv2),
        sgu_mixer(uv, sgu_ln_g, sgu_ln_b, sgu_w, sgu_b),
        conv_mixer(ag, conv_w, conv_b, conv_ln_g, conv_ln_b, conv_pw),
    ], axis=-1)
    return y @ w_out


def memory_cross_attention(h, mem, wq, wkv, wo):
    b, t, d = h.shape
    q = (h @ wq).reshape(b, t, X_HEADS, X_DH)
    k, v = jnp.split(mem @ wkv, 2, axis=-1)
    k = k.reshape(b, -1, X_HEADS, X_DH)
    v = v.reshape(b, -1, X_HEADS, X_DH)
    s = jnp.einsum('bthd,bmhd->bhtm', q, k).astype(jnp.float32) * (X_DH ** -0.5)
    p = jax.nn.softmax(s, axis=-1)
    o = jnp.einsum('bhtm,bmhd->bthd', p.astype(v.dtype), v).reshape(b, t, d)
    return o @ wo


def swiglu(h, w13, w2):
    g, u = jnp.split(h @ w13, 2, axis=-1)
    return (jax.nn.silu(g) * u) @ w2


def moe_swiglu(h, router_w, w13, w2):
    n, d = h.shape
    logits = (h @ router_w).astype(jnp.float32)
    top_v, top_e = lax.top_k(logits, TOP_K)
    gate = jax.nn.softmax(top_v, axis=-1)
    flat_e = top_e.reshape(-1)
    flat_tok = jnp.arange(n * TOP_K, dtype=jnp.int32) // TOP_K
    order = jnp.argsort(flat_e)
    se = flat_e[order]
    counts = jnp.bincount(flat_e, length=N_EXPERTS)
    start = jnp.cumsum(counts) - counts
    pcounts = (counts + MOE_BLOCK - 1) // MOE_BLOCK * MOE_BLOCK
    pend = jnp.cumsum(pcounts)
    pstart = pend - pcounts
    dest = pstart[se] + jnp.arange(n * TOP_K) - start[se]
    m_pad = -(-(n * TOP_K) // MOE_BLOCK) * MOE_BLOCK + N_EXPERTS * MOE_BLOCK
    tok = jnp.full((m_pad,), n, jnp.int32).at[dest].set(flat_tok[order])
    gw = jnp.zeros((m_pad,), jnp.float32).at[dest].set(gate.reshape(-1)[order])
    n_blk = m_pad // MOE_BLOCK
    blk_e = jnp.minimum(jnp.searchsorted(pend, jnp.arange(n_blk) * MOE_BLOCK, side='right'),
                        N_EXPERTS - 1)
    h_pad = jnp.concatenate([h, jnp.zeros((1, d), h.dtype)], axis=0)

    def expert_block(args):
        tb, e = args
        g, u = jnp.split(h_pad[tb] @ w13[e], 2, axis=-1)
        return (jax.nn.silu(g) * u) @ w2[e]

    y = lax.map(expert_block, (tok.reshape(n_blk, MOE_BLOCK), blk_e))
    y = y.reshape(m_pad, d) * gw[:, None].astype(h.dtype)
    return jax.ops.segment_sum(y, tok, num_segments=n + 1)[:n]


def setup_inputs(seed: int = 0) -> dict:
    key = jax.random.key(seed)
    ks = iter(jax.random.split(key, 48))
    f32 = jnp.float32
    L, ND, NM, dk = DEPTH, N_DENSE, N_MOE, NSA_DH

    def nrm(shape, scale):
        return jax.random.normal(next(ks), shape, f32) * scale

    def gain(shape):
        return 1.0 + nrm(shape, 0.05)

    def bias(shape):
        return nrm(shape, 0.02)

    return {
        "x": nrm((BATCH, SEQ, D_MODEL), 1.0),
        "mem": nrm((BATCH, MEM_LEN, D_MODEL), 1.0),
        "w_in": nrm((L, D_MODEL, D_IN), D_MODEL ** -0.5),
        "pool_w": nrm((L, POOL_GROUPS, POOL_GW, POOL_GW), POOL_GW ** -0.5),
        "pool_scale": 1.0 + nrm((L, POOL_W), 0.1),
        "cmp_pe_k": nrm((L, CMP_BLOCK, dk), 0.1),
        "cmp_k_w1": nrm((L, CMP_BLOCK * dk, CMP_HIDDEN), (CMP_BLOCK * dk) ** -0.5),
        "cmp_k_w2": nrm((L, CMP_HIDDEN, dk), CMP_HIDDEN ** -0.5),
        "cmp_pe_v": nrm((L, CMP_BLOCK, dk), 0.1),
        "cmp_v_w1": nrm((L, CMP_BLOCK * dk, CMP_HIDDEN), (CMP_BLOCK * dk) ** -0.5),
        "cmp_v_w2": nrm((L, CMP_HIDDEN, dk), CMP_HIDDEN ** -0.5),
        "sgu_ln_g": gain((L, SGU_W)),
        "sgu_ln_b": bias((L, SGU_W)),
        "sgu_w": nrm((L, SGU_GROUPS, SGU_CHUNK, SGU_CHUNK), SGU_CHUNK ** -0.5),
        "sgu_b": 1.0 + nrm((L, SGU_GROUPS, SGU_CHUNK), 0.1),
        "conv_w": nrm((L, CONV_WIDTH, CONV_W), CONV_WIDTH ** -0.5),
        "conv_b": bias((L, CONV_W)),
        "conv_ln_g": gain((L, CONV_W)),
        "conv_ln_b": bias((L, CONV_W)),
        "conv_pw": nrm((L, CONV_W, CONV_W), CONV_W ** -0.5),
        "w_out": nrm((L, D_MIX, D_MODEL), BETA * D_MIX ** -0.5),
        "ln1_g": gain((L, D_MODEL)),
        "ln1_b": bias((L, D_MODEL)),
        "xq_w": nrm((L, D_MODEL, D_MODEL), D_MODEL ** -0.5),
        "xkv_w": nrm((L, D_MODEL, 2 * D_MODEL), D_MODEL ** -0.5),
        "xo_w": nrm((L, D_MODEL, D_MODEL), BETA * D_MODEL ** -0.5),
        "ln2_g": gain((L, D_MODEL)),
        "ln2_b": bias((L, D_MODEL)),
        "ffn_w13": nrm((ND, D_MODEL, 2 * D_FF), D_MODEL ** -0.5),
        "ffn_w2": nrm((ND, D_FF, D_MODEL), BETA * D_FF ** -0.5),
        "router_w": nrm((NM, D_MODEL, N_EXPERTS), D_MODEL ** -0.5),
        "exp_w13": nrm((NM, N_EXPERTS, D_MODEL, 2 * D_FF_EXPERT), D_MODEL ** -0.5),
        "exp_w2": nrm((NM, N_EXPERTS, D_FF_EXPERT, D_MODEL), BETA * D_FF_EXPERT ** -0.5),
        "ln3_g": gain((L, D_MODEL)),
        "ln3_b": bias((L, D_MODEL)),
    }


def reference(x, mem, w_in, pool_w, pool_scale, cmp_pe_k, cmp_k_w1, cmp_k_w2,
              cmp_pe_v, cmp_v_w1, cmp_v_w2, sgu_ln_g, sgu_ln_b, sgu_w, sgu_b,
              conv_w, conv_b, conv_ln_g, conv_ln_b, conv_pw, w_out, ln1_g, ln1_b,
              xq_w, xkv_w, xo_w, ln2_g, ln2_b, ffn_w13, ffn_w2, router_w,
              exp_w13, exp_w2, ln3_g, ln3_b):
    b, t, d = x.shape
    for l in range(DEPTH):
        mix = hybrid_mixer(x, w_in[l], pool_w[l], pool_scale[l], cmp_pe_k[l],
                           cmp_k_w1[l], cmp_k_w2[l], cmp_pe_v[l], cmp_v_w1[l],
                           cmp_v_w2[l], sgu_ln_g[l], sgu_ln_b[l], sgu_w[l], sgu_b[l],
                           conv_w[l], conv_b[l], conv_ln_g[l], conv_ln_b[l],
                           conv_pw[l], w_out[l])
        x = layer_norm(ALPHA * x + mix, ln1_g[l], ln1_b[l])
        xa = memory_cross_attention(x, mem, xq_w[l], xkv_w[l], xo_w[l])
        x = layer_norm(ALPHA * x + xa, ln2_g[l], ln2_b[l])
        if l % 2 == 0:
            f = swiglu(x, ffn_w13[l // 2], ffn_w2[l // 2])
        else:
            f = moe_swiglu(x.reshape(b * t, d), router_w[l // 2], exp_w13[l // 2],
                           exp_w2[l // 2]).reshape(b, t, d)
        x = layer_norm(ALPHA * x + f, ln3_g[l], ln3_b[l])
    return x
```

```cpp
#include <hip/hip_runtime.h>
#include <cstdio>
#include <cstdint>

#define GAS __attribute__((address_space(1)))
#define LAS __attribute__((address_space(3)))
typedef unsigned short bf16;
typedef short bf16x8 __attribute__((ext_vector_type(8)));
typedef short bf16x4 __attribute__((ext_vector_type(4)));
typedef float f32x4 __attribute__((ext_vector_type(4)));
typedef float f32x2 __attribute__((ext_vector_type(2)));
typedef unsigned u32x4 __attribute__((ext_vector_type(4)));
typedef unsigned u32x2 __attribute__((ext_vector_type(2)));

constexpr int D = 1024, NB = 4, T = 8192, NL = 4, MEM = 256, M = NB * T;
constexpr int DIN = 1932, DINP = 2048;
constexpr int C_POOL = 0, C_Q = 256, C_KCMP = 512, C_VCMP = 576, C_KSEL = 640, C_VSEL = 704, C_KWIN = 768, C_VWIN = 832, C_GATE = 896, C_U = 908, C_V = 1164, C_CA = 1420, C_CG = 1676;
constexpr int FF = 2816, NE = 8, FE = 3584;
constexpr int NCMP = 511;
constexpr float ALPHA = 1.6817928305074292f;
constexpr float LN_EPS = 1e-5f;
constexpr int MOE_ROWS = 2 * M + NE * 256;
constexpr int NWAVES = 8, NTHREADS = 512;

constexpr size_t al256(size_t x) { return (x + 255) & ~(size_t)255; }
constexpr size_t MiB = 1u << 20;
constexpr size_t WS_CTL = 0, CTL_ZERO_BYTES = 64 * 1024;
constexpr size_t WS_HIST = 1 * MiB;
constexpr size_t WS_META = WS_HIST + 8192;
constexpr size_t WS_TOKINFO = WS_META + 256;
constexpr size_t WS_TOKG = WS_TOKINFO + (size_t)2 * M * 4;
constexpr size_t WS_TOKPOS = WS_TOKG + (size_t)2 * M * 4;
constexpr size_t WS_KC = WS_TOKPOS + (size_t)2 * M * 4;
constexpr size_t WS_VC = WS_KC + (size_t)NB * 512 * 64 * 2;
constexpr size_t WS_PEB = WS_VC + (size_t)NB * 512 * 64 * 2;
constexpr size_t WS_POOLWT = WS_PEB + (size_t)NL * 2 * 256 * 4;
constexpr size_t WS_SGUW = WS_POOLWT + (size_t)NL * 4 * 64 * 64 * 2;
constexpr size_t WS_PWT = WS_SGUW + (size_t)NL * 4 * 128 * 128 * 2;
constexpr size_t WS_CW2T = WS_PWT + (size_t)NL * 256 * 256 * 2;
constexpr size_t WS_CW1T = WS_CW2T + (size_t)NL * 2 * 64 * 256 * 2;
constexpr size_t WS_MEMB = WS_CW1T + (size_t)NL * 2 * 256 * 2048 * 2;
constexpr size_t WS_KMEM = WS_MEMB + (size_t)1024 * 1024 * 2;
constexpr size_t WS_VTMEM = WS_KMEM + (size_t)NL * 1024 * 1024 * 2;
constexpr size_t WS_SMALL_END = WS_VTMEM + (size_t)NL * 4096 * 256 * 2;
constexpr size_t WS_WINT = 32 * MiB;
static_assert(WS_SMALL_END <= WS_WINT, "small region");
constexpr size_t WS_WOUTT = WS_WINT + (size_t)NL * DINP * D * 2;
constexpr size_t WS_XQT = WS_WOUTT + (size_t)NL * D * D * 2;
constexpr size_t WS_XKVT = WS_XQT + (size_t)NL * D * D * 2;
constexpr size_t WS_XOT = WS_XKVT + (size_t)NL * 2 * D * D * 2;
constexpr size_t WS_W13T = WS_XOT + (size_t)NL * D * D * 2;
constexpr size_t WS_W2T = WS_W13T + (size_t)2 * 2 * FF * D * 2;
constexpr size_t WS_E13T = WS_W2T + (size_t)2 * D * FF * 2;
constexpr size_t WS_E2T = WS_E13T + (size_t)16 * 2 * FE * D * 2;
constexpr size_t WS_XB = WS_E2T + (size_t)16 * D * FE * 2;
constexpr size_t WS_VBUF = WS_XB + (size_t)M * D * 2;
constexpr size_t WS_Z = WS_VBUF + (size_t)M * D * 4;
constexpr size_t WS_Y = WS_Z + (size_t)M * DINP * 2;
constexpr size_t WS_Q = WS_Y + (size_t)M * D * 2;
constexpr size_t WS_H = WS_Q + (size_t)M * D * 2;
constexpr size_t WS_END = WS_H + (size_t)MOE_ROWS * FE * 2;
static_assert((size_t)MOE_ROWS * D * 4 <= WS_H - WS_VBUF, "FS overlay");
static_assert((size_t)MOE_ROWS * D * 2 <= WS_Q - WS_Z, "XG overlay");

constexpr int SCR_BYTES = 153600;
constexpr int LDSCTL_OFF = SCR_BYTES;
constexpr int LDS_BYTES = 155648;

__device__ __forceinline__ float bf2f(unsigned v) { return __uint_as_float(v << 16); }
__device__ __forceinline__ unsigned f2bf(float f) { unsigned u = __builtin_bit_cast(unsigned, f); return (u + 0x7fffu + ((u >> 16) & 1u)) >> 16; }
__device__ __forceinline__ unsigned pk2(float lo, float hi) { return f2bf(lo) | (f2bf(hi) << 16); }
__device__ __forceinline__ float lo16(unsigned w) { return __uint_as_float(w << 16); }
__device__ __forceinline__ float hi16(unsigned w) { return __uint_as_float(w & 0xffff0000u); }
__device__ __forceinline__ float sigmoidf_(float x) { return 1.0f / (1.0f + __expf(-x)); }
__device__ __forceinline__ float siluf_(float x) { return x / (1.0f + __expf(-x)); }
__device__ __forceinline__ float gelu_tanh(float x) { const float u = 0.7978845608028654f * (x + 0.044715f * x * x * x); return x / (1.0f + __expf(-2.0f * u)); }
__device__ __forceinline__ float wave_sum(float v) {
#pragma unroll
    for (int o = 1; o < 64; o <<= 1) v += __shfl_xor(v, o);
    return v;
}
__device__ __forceinline__ float wave_max(float v) {
#pragma unroll
    for (int o = 1; o < 64; o <<= 1) v = fmaxf(v, __shfl_xor(v, o));
    return v;
}
__device__ __forceinline__ f32x4 mfma16(bf16x8 a, bf16x8 b, f32x4 c) { return __builtin_amdgcn_mfma_f32_16x16x32_bf16(a, b, c, 0, 0, 0); }
typedef __bf16 bf16x2_t __attribute__((ext_vector_type(2)));
__device__ __forceinline__ float dot2bf(unsigned a, unsigned b, float c) { return __builtin_amdgcn_fdot2_f32_bf16(__builtin_bit_cast(bf16x2_t, a), __builtin_bit_cast(bf16x2_t, b), c, false); }
#define LDS_WAIT() asm volatile("s_waitcnt lgkmcnt(0)" ::: "memory")

namespace pg8 {
#define PG8_LAS __attribute__((address_space(3)))
typedef unsigned short bf16_t;
typedef short bf16x8 __attribute__((ext_vector_type(8)));
typedef float f32x4 __attribute__((ext_vector_type(4)));
typedef unsigned u32x4 __attribute__((ext_vector_type(4)));
constexpr int BM = 256, BK = 64, HALF = 128, HTB = HALF * BK * 2  , STAGE_BYTES = 8 * HTB, NXCD = 8, WGM = 8;

__host__ __device__ __forceinline__ int lds_byte(int r, int c) { const int st = (r >> 4) * 2 + (c >> 5), rr = r & 15, cc = c & 31, ob = rr * 64 + cc * 2; return st * 1024 + (ob ^ (((ob >> 9) & 1) << 5)); }
__host__ __device__ __forceinline__ void stage_rc(int b, int& R, int& C) { const int st = b / 1024, sb = b % 1024, swz = sb ^ (((sb >> 9) & 1) << 5); R = (st >> 1) * 16 + swz / 64; C = (st & 1) * 32 + (swz % 64) / 2; }
__host__ __device__ __forceinline__ int perm32(int rho) { const int n = rho >> 4, i = rho & 15; return 8 * (i >> 2) + 4 * n + (i & 3); }

struct Unit { int pm, pn; };
struct Gemm { const bf16_t* A; const bf16_t* Bt; int M, N, K; };

struct StaticOrder {
    int nM, nN, nwg, G, c;
    __host__ __device__ void init(int M, int N, int G_, int c_) { nM = M / BM; nN = N / BM; nwg = nM * nN; G = G_; c = c_; }
    __host__ __device__ bool next(int i, Unit& u) const {
        const long L = (long)i * G + c; if (L >= nwg) return false;
        int wgid = (int)L; { const int q = nwg / NXCD, r = nwg % NXCD, xcd = wgid % NXCD, off = wgid / NXCD; wgid = (xcd < r ? xcd * (q + 1) : r * (q + 1) + (xcd - r) * q) + off; }
        const int nig = WGM * nN, gid = wgid / nig, fm = gid * WGM, gsz = (nM - fm) < WGM ? (nM - fm) : WGM;
        u.pm = fm + ((wgid % nig) % gsz); u.pn = (wgid % nig) / gsz; return true;
    }
    __device__ __forceinline__ void a_ready(const Unit&) const {}
    __device__ __forceinline__ void done(const Unit&) const {}
    __device__ __forceinline__ const char* bbase(const Gemm& g, const Unit&) const { return (const char*)g.Bt; }
};

template <class Epi, class Sched, bool ALIGN_EPI = false, bool SP2 = false>
__device__ __forceinline__ void gemm_phase(PG8_LAS unsigned char* lds, const Gemm g, const Sched& S, const Epi& E) {
    int tid_l = threadIdx.x; asm volatile("" : "+v"(tid_l));
    const int tid = tid_l, wid = __builtin_amdgcn_readfirstlane(tid >> 6), lane = tid & 63, wr = wid >> 2, wc = wid & 3, fr = lane & 15, fq = lane >> 4;
    const int K = g.K, nt = K / BK;
    unsigned voffA[2], voffB[2];
#pragma unroll
    for (int i = 0; i < 2; ++i) { int R, C; stage_rc(tid * 16 + i * 8192, R, C); const int Rb = Epi::PERM ? ((R & ~31) + perm32(R & 31)) : R;
        voffA[i] = (unsigned)(R * K + C) * 2u; voffB[i] = (unsigned)(Rb * K + C) * 2u; }
    const size_t kstep = (size_t)(BK * 2);
    const size_t hstep = (size_t)HALF * K * 2;
    const size_t tstep = 2 * hstep;
    const unsigned ldsw = (unsigned)wid * 1024u;
    const int aoff = lds_byte(wr * 64 + fr, fq * 8), boff = lds_byte(wc * 32 + fr, fq * 8);
#define PG8_SA(b, h) (((b) * 2 + (h)) * HTB)
#define PG8_SB(b, h) ((4 + (b) * 2 + (h)) * HTB)
#define PG8_STAGE(bufoff, gbase, voff) do { _Pragma("unroll") for (int _i = 0; _i < 2; ++_i) \
        __builtin_amdgcn_global_load_lds((const unsigned*)((const char*)(gbase) + (voff)[_i]), (PG8_LAS unsigned*)(lds + (bufoff) + ldsw + _i * 8192), 16, 0, 0); } while (0)
#define PG8_LDA(dst, b, h) do { _Pragma("unroll") for (int m = 0; m < 4; ++m) _Pragma("unroll") for (int k = 0; k < 2; ++k) dst[m][k] = *(const PG8_LAS bf16x8*)(lds + PG8_SA(b, h) + aoff + m * 2048 + k * 1024); } while (0)
#define PG8_LDB(dst, b, h) do { _Pragma("unroll") for (int n = 0; n < 2; ++n) _Pragma("unroll") for (int k = 0; k < 2; ++k) dst[n][k] = *(const PG8_LAS bf16x8*)(lds + PG8_SB(b, h) + boff + n * 2048 + k * 1024); } while (0)
#define PG8_MMA(ai, bj, At, Bt) do { __builtin_amdgcn_s_setprio(1); _Pragma("unroll") for (int m = 0; m < 4; ++m) _Pragma("unroll") for (int n = 0; n < 2; ++n) _Pragma("unroll") for (int k = 0; k < 2; ++k) \
        acc[ai][bj][m][n] = __builtin_amdgcn_mfma_f32_16x16x32_bf16(Bt[n][k], At[m][k], acc[ai][bj][m][n], 0, 0, 0); __builtin_amdgcn_s_setprio(0); } while (0)
#define PG8_WAIT_V(n) asm volatile("s_waitcnt vmcnt(" #n ")" ::: "memory")
#define PG8_WAIT_L(n) asm volatile("s_waitcnt lgkmcnt(" #n ")" ::: "memory")
#define PG8_BAR __builtin_amdgcn_s_barrier()
#define PG8_SCHED __builtin_amdgcn_sched_barrier(0)
    Unit cur, nxt; int ui = 0;
    if (!S.next(0, cur)) return;
    f32x4 acc[2][2][4][2];
#pragma unroll
    for (int a = 0; a < 2; ++a)
#pragma unroll
        for (int b = 0; b < 2; ++b)
#pragma unroll
            for (int m = 0; m < 4; ++m)
#pragma unroll
                for (int n = 0; n < 2; ++n) acc[a][b][m][n] = (f32x4){0.f, 0.f, 0.f, 0.f};
    bf16x8 At[4][2], B0[2][2], B1[2][2];
    const char* cA = (const char*)g.A + (size_t)cur.pm * tstep; const char* cB = S.bbase(g, cur) + (size_t)cur.pn * tstep;
    S.a_ready(cur);
    if constexpr (SP2) {
        PG8_STAGE(PG8_SB(0, 0), cB, voffB); PG8_STAGE(PG8_SB(0, 1), cB + hstep, voffB); PG8_STAGE(PG8_SA(0, 0), cA, voffA); PG8_STAGE(PG8_SA(0, 1), cA + hstep, voffA);
        if (wr == 1) PG8_BAR;
        PG8_WAIT_V(2); PG8_BAR;
        PG8_STAGE(PG8_SB(1, 0), cB + kstep, voffB); PG8_STAGE(PG8_SA(1, 0), cA + kstep, voffA); PG8_STAGE(PG8_SB(1, 1), cB + hstep + kstep, voffB);
        PG8_WAIT_V(6); PG8_BAR;
    } else {
        PG8_STAGE(PG8_SB(0, 0), cB, voffB); PG8_STAGE(PG8_SA(0, 0), cA, voffA); PG8_STAGE(PG8_SB(0, 1), cB + hstep, voffB); PG8_STAGE(PG8_SA(0, 1), cA + hstep, voffA);
        if (wr == 1) PG8_BAR;
        PG8_WAIT_V(4); PG8_BAR;
        PG8_STAGE(PG8_SB(1, 0), cB + kstep, voffB); PG8_STAGE(PG8_SA(1, 0), cA + kstep, voffA); PG8_STAGE(PG8_SB(1, 1), cB + hstep + kstep, voffB);
        PG8_WAIT_V(6); PG8_BAR;
    }
    for (;;) {
        const bool has_next = S.next(ui + 1, nxt);
        const char* nA = has_next ? (const char*)g.A + (size_t)nxt.pm * tstep : cA; const char* nB = has_next ? S.bbase(g, nxt) + (size_t)nxt.pn * tstep : cB;
        for (int t = 0; t < nt; t += 2) {
            const bool last = (t == nt - 2);
            const char* a1 = cA + (size_t)(t + 1) * kstep;
            const char* a2 = last ? nA : cA + (size_t)(t + 2) * kstep; const char* b2 = last ? nB : cB + (size_t)(t + 2) * kstep;
            const char* a3 = a2 + kstep; const char* b3 = b2 + kstep;
            if (last && has_next) S.a_ready(nxt);
            if constexpr (SP2) {
            PG8_LDB(B0, 0, 0); PG8_LDB(B1, 0, 1); PG8_SCHED; PG8_LDA(At, 0, 0); PG8_STAGE(PG8_SA(1, 1), a1 + hstep, voffA);
            PG8_WAIT_V(8); PG8_WAIT_L(0); PG8_BAR; PG8_MMA(0, 0, At, B0); PG8_MMA(0, 1, At, B1); PG8_BAR; PG8_SCHED;
            PG8_LDA(At, 0, 1); PG8_STAGE(PG8_SB(0, 0), b2, voffB); PG8_STAGE(PG8_SB(0, 1), b2 + hstep, voffB); PG8_STAGE(PG8_SA(0, 0), a2, voffA);
            PG8_WAIT_V(8); PG8_WAIT_L(0); PG8_BAR; PG8_MMA(1, 0, At, B0); PG8_MMA(1, 1, At, B1); PG8_BAR; PG8_SCHED;
            PG8_LDB(B0, 1, 0); PG8_LDB(B1, 1, 1); PG8_SCHED; PG8_LDA(At, 1, 0); PG8_STAGE(PG8_SA(0, 1), a2 + hstep, voffA);
            PG8_WAIT_V(8); PG8_WAIT_L(0); PG8_BAR; PG8_MMA(0, 0, At, B0); PG8_MMA(0, 1, At, B1); PG8_BAR; PG8_SCHED;
            PG8_LDA(At, 1, 1); PG8_STAGE(PG8_SB(1, 0), b3, voffB); PG8_STAGE(PG8_SB(1, 1), b3 + hstep, voffB); PG8_STAGE(PG8_SA(1, 0), a3, voffA);
            PG8_WAIT_V(8); PG8_WAIT_L(0); PG8_BAR; PG8_MMA(1, 0, At, B0); PG8_MMA(1, 1, At, B1); PG8_BAR; PG8_SCHED;
            } else {
            PG8_LDB(B0, 0, 0); PG8_SCHED; PG8_LDA(At, 0, 0); PG8_STAGE(PG8_SA(1, 1), a1 + hstep, voffA);
            PG8_WAIT_L(8); PG8_BAR; PG8_WAIT_L(0); PG8_MMA(0, 0, At, B0); PG8_BAR; PG8_SCHED;
            PG8_LDB(B1, 0, 1); PG8_STAGE(PG8_SB(0, 0), b2, voffB);
            PG8_BAR; PG8_WAIT_L(0); PG8_MMA(0, 1, At, B1); PG8_BAR;
            PG8_LDA(At, 0, 1); PG8_STAGE(PG8_SA(0, 0), a2, voffA);
            PG8_BAR; PG8_WAIT_L(0); PG8_MMA(1, 0, At, B0); PG8_BAR; PG8_SCHED;
            PG8_STAGE(PG8_SB(0, 1), b2 + hstep, voffB);
            PG8_WAIT_V(6); PG8_BAR; PG8_MMA(1, 1, At, B1); PG8_BAR;
            PG8_LDB(B0, 1, 0); PG8_SCHED; PG8_LDA(At, 1, 0); PG8_STAGE(PG8_SA(0, 1), a2 + hstep, voffA);
            PG8_WAIT_L(8); PG8_BAR; PG8_WAIT_L(0); PG8_MMA(0, 0, At, B0); PG8_BAR; PG8_SCHED;
            PG8_LDB(B1, 1, 1); PG8_STAGE(PG8_SB(1, 0), b3, voffB);
            PG8_BAR; PG8_WAIT_L(0); PG8_MMA(0, 1, At, B1); PG8_BAR;
            PG8_LDA(At, 1, 1); PG8_STAGE(PG8_SA(1, 0), a3, voffA);
            PG8_BAR; PG8_WAIT_L(0); PG8_MMA(1, 0, At, B0); PG8_BAR; PG8_SCHED;
            PG8_STAGE(PG8_SB(1, 1), b3 + hstep, voffB);
            PG8_WAIT_V(6); PG8_BAR; PG8_MMA(1, 1, At, B1); PG8_BAR;
            }
        }
        if constexpr (ALIGN_EPI) { if (wr == 0) PG8_BAR; }
        if constexpr (!Epi::AFTER_DRAIN) { E(acc, cur, wr, wc, fr, fq); S.done(cur); }
        if (!has_next) break;
#pragma unroll
        for (int a = 0; a < 2; ++a)
#pragma unroll
            for (int b = 0; b < 2; ++b)
#pragma unroll
                for (int m = 0; m < 4; ++m)
#pragma unroll
                    for (int n = 0; n < 2; ++n) acc[a][b][m][n] = (f32x4){0.f, 0.f, 0.f, 0.f};
        cur = nxt; cA = nA; cB = nB; ++ui;
        if constexpr (ALIGN_EPI) { if (wr == 1) PG8_BAR; }
    }
    PG8_WAIT_V(0);
    if constexpr (!ALIGN_EPI) { if (wr == 0) PG8_BAR; }
    PG8_BAR;
    if constexpr (Epi::AFTER_DRAIN) { E.fused(acc, cur, wr, wc, fr, fq, lds, wid, lane); S.done(cur); }
#undef PG8_SA
#undef PG8_SB
#undef PG8_STAGE
#undef PG8_LDA
#undef PG8_LDB
#undef PG8_MMA
#undef PG8_WAIT_V
#undef PG8_WAIT_L
#undef PG8_BAR
#undef PG8_SCHED
}
}

namespace pg8 {
__device__ __forceinline__ unsigned cvt_pk_bf16(float lo, float hi) { unsigned r; asm volatile("v_cvt_pk_bf16_f32 %0, %1, %2" : "=v"(r) : "v"(lo), "v"(hi)); return r; }

struct EpiBf16 {
    static constexpr bool PERM = true, AFTER_DRAIN = false;
    bf16_t* O; int ldc;
    __device__ __forceinline__ void operator()(const f32x4 (&acc)[2][2][4][2], const Unit& u, int wr, int wc, int fr, int fq) const {
        const int row0 = u.pm * BM + wr * 64 + fr; const int col0 = u.pn * BM + wc * 32 + 8 * fq;
#pragma unroll
        for (int ai = 0; ai < 2; ++ai)
#pragma unroll
            for (int m = 0; m < 4; ++m) { bf16_t* rowp = O + (size_t)(row0 + ai * HALF + m * 16) * ldc + col0;
#pragma unroll
                for (int bj = 0; bj < 2; ++bj) { const f32x4 v0 = acc[ai][bj][m][0], v1 = acc[ai][bj][m][1];
                    u32x4 w; w.x = cvt_pk_bf16(v0[0], v0[1]); w.y = cvt_pk_bf16(v0[2], v0[3]); w.z = cvt_pk_bf16(v1[0], v1[1]); w.w = cvt_pk_bf16(v1[2], v1[3]);
                    *(u32x4*)(rowp + bj * HALF) = w; } }
    }
};
struct EpiKV {
    static constexpr bool PERM = true, AFTER_DRAIN = false;
    bf16_t* Kd; bf16_t* VTd;
    __device__ __forceinline__ void operator()(const f32x4 (&acc)[2][2][4][2], const Unit& u, int wr, int wc, int fr, int fq) const {
        const int row0 = u.pm * BM + wr * 64 + fr; const int col0 = u.pn * BM + wc * 32 + 8 * fq;
#pragma unroll
        for (int ai = 0; ai < 2; ++ai)
#pragma unroll
            for (int m = 0; m < 4; ++m) { const int row = row0 + ai * HALF + m * 16;
#pragma unroll
                for (int bj = 0; bj < 2; ++bj) { const f32x4 v0 = acc[ai][bj][m][0], v1 = acc[ai][bj][m][1]; const int col = col0 + bj * HALF;
                    u32x4 w; w.x = cvt_pk_bf16(v0[0], v0[1]); w.y = cvt_pk_bf16(v0[2], v0[3]); w.z = cvt_pk_bf16(v1[0], v1[1]); w.w = cvt_pk_bf16(v1[2], v1[3]);
                    if (col < 1024) { *(u32x4*)(Kd + (size_t)row * 1024 + col) = w; }
                    else { const int c = col - 1024, b = row >> 8, mm = row & 255; bf16_t* p = VTd + ((size_t)(b * 1024 + c)) * 256 + mm;
                        p[0 * 256] = (bf16_t)(w.x & 0xffffu); p[1 * 256] = (bf16_t)(w.x >> 16); p[2 * 256] = (bf16_t)(w.y & 0xffffu); p[3 * 256] = (bf16_t)(w.y >> 16);
                        p[4 * 256] = (bf16_t)(w.z & 0xffffu); p[5 * 256] = (bf16_t)(w.z >> 16); p[6 * 256] = (bf16_t)(w.w & 0xffffu); p[7 * 256] = (bf16_t)(w.w >> 16); } } }
    }
};
struct EpiF32Res {
    static constexpr bool PERM = false, AFTER_DRAIN = false;
    float* out; const float* res; int ldc; float alpha;
    __device__ __forceinline__ void operator()(const f32x4 (&acc)[2][2][4][2], const Unit& u, int wr, int wc, int fr, int fq) const {
        const int row0 = u.pm * BM + wr * 64 + fr; const int col0 = u.pn * BM + wc * 32 + 4 * fq;
#pragma unroll
        for (int ai = 0; ai < 2; ++ai)
#pragma unroll
            for (int m = 0; m < 4; ++m) { const size_t off = (size_t)(row0 + ai * HALF + m * 16) * ldc + col0;
#pragma unroll
                for (int bj = 0; bj < 2; ++bj)
#pragma unroll
                    for (int n = 0; n < 2; ++n) { f32x4 v = acc[ai][bj][m][n]; const size_t o2 = off + bj * HALF + n * 16;
                        if (res) { const f32x4 r = *(const f32x4*)(res + o2); v = v + r * alpha; }
                        *(f32x4*)(out + o2) = v; } }
    }
};
struct EpiSwiglu {
    static constexpr bool PERM = true, AFTER_DRAIN = false;
    bf16_t* H; int ldh;
    __device__ __forceinline__ void operator()(const f32x4 (&acc)[2][2][4][2], const Unit& u, int wr, int wc, int fr, int fq) const {
        const int row0 = u.pm * BM + wr * 64 + fr; const int col0 = u.pn * BM + wc * 32 + 8 * fq;
#pragma unroll
        for (int ai = 0; ai < 2; ++ai)
#pragma unroll
            for (int m = 0; m < 4; ++m) { bf16_t* rowp = H + (size_t)(row0 + ai * HALF + m * 16) * ldh;
#pragma unroll
                for (int bj = 0; bj < 2; ++bj) { const f32x4 v0 = acc[ai][bj][m][0], v1 = acc[ai][bj][m][1];
                    const float h0 = v0[0] / (1.0f + __expf(-v0[0])) * v0[1], h1 = v0[2] / (1.0f + __expf(-v0[2])) * v0[3];
                    const float h2 = v1[0] / (1.0f + __expf(-v1[0])) * v1[1], h3 = v1[2] / (1.0f + __expf(-v1[2])) * v1[3];
                    u32x2 w; w.x = cvt_pk_bf16(h0, h1); w.y = cvt_pk_bf16(h2, h3);
                    *(u32x2*)(rowp + ((col0 + bj * HALF) >> 1)) = w; } }
    }
};
struct GroupedOrder : StaticOrder {
    int pend[8]; size_t estride;
    __device__ __forceinline__ const char* bbase(const Gemm& g, const Unit& u) const {
        int e = 0;
#pragma unroll
        for (int k = 0; k < 7; ++k) e += (u.pm >= pend[k]) ? 1 : 0;
        return (const char*)g.Bt + (size_t)e * estride;
    }
};
}
#define XB_TMO      128
#define XB_XCNT(j)  (256  + 64 * (j))
#define XB_XSUB(j)  (1280 + 64 * (j))
#define XB_XGEN(j)  (2304 + 64 * (j))
#define XB_TOP      3328
#define XB_TOPGEN   3392
#define XCD_BAR_WORDS 3456
#define XB_SPIN_CAP (1u << 18)

__device__ __forceinline__ unsigned xb_ld(unsigned* p)              { return __hip_atomic_load(p, __ATOMIC_RELAXED, __HIP_MEMORY_SCOPE_AGENT); }
__device__ __forceinline__ unsigned xb_add(unsigned* p, unsigned v) { return __hip_atomic_fetch_add(p, v, __ATOMIC_RELAXED, __HIP_MEMORY_SCOPE_AGENT); }
__device__ __forceinline__ unsigned xb_xcc_id() { return (unsigned)__builtin_amdgcn_s_getreg((3 << 11) | 20) & 0xFu; }
#define XB_SPIN(cond, bar) do { unsigned _sp = 0; while (cond) { __builtin_amdgcn_s_sleep(1); \
    if ((++_sp & 255u) == 0u) { if (xb_ld(&(bar)[XB_TMO])) break; if (_sp > XB_SPIN_CAP) { atomicAdd(&(bar)[XB_TMO], 1u); break; } } } } while (0)

struct XcdBarrier {
    unsigned* bar; unsigned x;
    volatile LAS unsigned* st;
};

__device__ __forceinline__ XcdBarrier xcd_barrier_post(unsigned* bar, volatile LAS unsigned* st) {
    XcdBarrier b; b.bar = bar; b.x = xb_xcc_id(); b.st = st;
    if (threadIdx.x == 0) (void)xb_add(&bar[XB_XCNT(b.x)], 1u);
    return b;
}
__device__ __forceinline__ void xcd_barrier_complete(unsigned* bar, unsigned x, unsigned& nloc, unsigned& nx) {
    const unsigned G = gridDim.x * gridDim.y * gridDim.z;
    unsigned sum, cnt, mine, sp = 0u;
    for (;;) {
        sum = 0u; cnt = 0u; mine = 0u;
#pragma unroll
        for (unsigned j = 0; j < 16; ++j) { const unsigned c = xb_ld(&bar[XB_XCNT(j)]); sum += c; cnt += (c > 0u) ? 1u : 0u; mine = (j == x) ? c : mine; }
        if (sum == G) break;
        __builtin_amdgcn_s_sleep(1);
        if ((++sp & 255u) == 0u) { if (xb_ld(&bar[XB_TMO])) break; if (sp > XB_SPIN_CAP) { atomicAdd(&bar[XB_TMO], 1u); break; } }
    }
    nloc = mine > 0u ? mine : 1u; nx = cnt > 0u ? cnt : 1u;
}

__device__ __forceinline__ void xcd_barrier(const XcdBarrier& b) {
    asm volatile("s_waitcnt vmcnt(0)" ::: "memory");
    __syncthreads();
    if (threadIdx.x == 0) {
        unsigned* bar = b.bar;
        __builtin_amdgcn_s_waitcnt(0);
        unsigned nloc = b.st[0], nx = b.st[1];
        if (nloc == 0u) { xcd_barrier_complete(bar, b.x, nloc, nx); b.st[0] = nloc; b.st[1] = nx; }
        const unsigned old = xb_add(&bar[XB_XSUB(b.x)], 1u);
        const unsigned gen = old / nloc;
        if (old + 1u == (gen + 1u) * nloc) {
            __builtin_amdgcn_fence(__ATOMIC_RELEASE, "agent");
            asm volatile("s_waitcnt vmcnt(0)" ::: "memory");
            const unsigned og = xb_add(&bar[XB_TOP], 1u);
            const unsigned tg = og / nx;
            if (og + 1u == (tg + 1u) * nx) xb_add(&bar[XB_TOPGEN], 1u);
            else XB_SPIN(xb_ld(&bar[XB_TOPGEN]) == tg, bar);
            __builtin_amdgcn_fence(__ATOMIC_ACQUIRE, "agent");
            xb_add(&bar[XB_XGEN(b.x)], 1u);
            asm volatile("s_waitcnt vmcnt(0)" ::: "memory");
        } else {
            XB_SPIN(xb_ld(&bar[XB_XGEN(b.x)]) == gen, bar);
            __builtin_amdgcn_fence(__ATOMIC_ACQUIRE, "agent");
            asm volatile("s_waitcnt vmcnt(0)" ::: "memory");
        }
    }
    __syncthreads();
}

struct Params { const float* in[35]; float* out; unsigned char* ws; int ph_lo, ph_hi; };
enum { I_X = 0, I_MEM, I_WIN, I_POOLW, I_POOLS, I_PEK, I_KW1, I_KW2, I_PEV, I_VW1, I_VW2, I_SLNG, I_SLNB, I_SGUW, I_SGUB, I_CONVW, I_CONVB, I_CLNG, I_CLNB, I_CONVPW,
       I_WOUT, I_LN1G, I_LN1B, I_XQ, I_XKV, I_XO, I_LN2G, I_LN2B, I_W13, I_W2, I_ROUTER, I_E13, I_E2, I_LN3G, I_LN3B };

struct Ctx {
    const float* in[35];
    float* X;
    bf16 *XB, *Z, *Y, *Q, *H, *XG, *KC, *VC, *MEMB, *KMEM, *VTMEM;
    bf16 *WINT, *WOUTT, *XQT, *XKVT, *XOT, *W13T, *W2T, *E13T, *E2T, *CW1T, *CW2T, *PWT, *POOLWT, *SGUWB;
    float *VBUF, *FS, *PEB, *TOKG;
    int *HIST, *META, *TOKPOS; unsigned* TOKINFO;
    int tid, lane, wid, bid, G;
};

struct MatDesc { const float* src; bf16* dst; int K, N, Npad, split; };
__device__ __forceinline__ void get_mat(const Ctx& C, int id, MatDesc& d) {
    d.split = 0;
    if (id < 56) {
        const int l = id / 14, k = id % 14;
        if (k == 0)      { d.src = C.in[I_WIN] + (size_t)l * D * DIN;  d.dst = C.WINT + (size_t)l * DINP * D;  d.K = D; d.N = DIN; d.Npad = DINP; }
        else if (k == 1) { d.src = C.in[I_WOUT] + (size_t)l * D * D;   d.dst = C.WOUTT + (size_t)l * D * D;    d.K = D; d.N = D; d.Npad = D; }
        else if (k == 2) { d.src = C.in[I_XQ] + (size_t)l * D * D;     d.dst = C.XQT + (size_t)l * D * D;      d.K = D; d.N = D; d.Npad = D; }
        else if (k == 3) { d.src = C.in[I_XKV] + (size_t)l * D * 2 * D; d.dst = C.XKVT + (size_t)l * 2 * D * D; d.K = D; d.N = 2 * D; d.Npad = 2 * D; }
        else if (k == 4) { d.src = C.in[I_XO] + (size_t)l * D * D;     d.dst = C.XOT + (size_t)l * D * D;      d.K = D; d.N = D; d.Npad = D; }
        else if (k == 5) { d.src = C.in[I_KW1] + (size_t)l * 2048 * 256; d.dst = C.CW1T + (size_t)(l * 2 + 0) * 256 * 2048; d.K = 2048; d.N = 256; d.Npad = 256; }
        else if (k == 6) { d.src = C.in[I_VW1] + (size_t)l * 2048 * 256; d.dst = C.CW1T + (size_t)(l * 2 + 1) * 256 * 2048; d.K = 2048; d.N = 256; d.Npad = 256; }
        else if (k == 7) { d.src = C.in[I_KW2] + (size_t)l * 256 * 64; d.dst = C.CW2T + (size_t)(l * 2 + 0) * 64 * 256; d.K = 256; d.N = 64; d.Npad = 64; }
        else if (k == 8) { d.src = C.in[I_VW2] + (size_t)l * 256 * 64; d.dst = C.CW2T + (size_t)(l * 2 + 1) * 64 * 256; d.K = 256; d.N = 64; d.Npad = 64; }
        else if (k == 9) { d.src = C.in[I_CONVPW] + (size_t)l * 256 * 256; d.dst = C.PWT + (size_t)l * 256 * 256; d.K = 256; d.N = 256; d.Npad = 256; }
        else { const int g = k - 10; d.src = C.in[I_POOLW] + (size_t)(l * 4 + g) * 64 * 64; d.dst = C.POOLWT + (size_t)(l * 4 + g) * 64 * 64; d.K = 64; d.N = 64; d.Npad = 64; }
    } else if (id < 60) {
        const int i = (id - 56) >> 1, w = (id - 56) & 1;
        if (w == 0) { d.src = C.in[I_W13] + (size_t)i * D * 2 * FF; d.dst = C.W13T + (size_t)i * 2 * FF * D; d.K = D; d.N = 2 * FF; d.Npad = 2 * FF; d.split = FF; }
        else        { d.src = C.in[I_W2] + (size_t)i * FF * D;      d.dst = C.W2T + (size_t)i * D * FF;      d.K = FF; d.N = D; d.Npad = D; }
    } else {
        const int j = id - 60, ie = j >> 1, w = j & 1;
        if (w == 0) { d.src = C.in[I_E13] + (size_t)ie * D * 2 * FE; d.dst = C.E13T + (size_t)ie * 2 * FE * D; d.K = D; d.N = 2 * FE; d.Npad = 2 * FE; d.split = FE; }
        else        { d.src = C.in[I_E2] + (size_t)ie * FE * D;      d.dst = C.E2T + (size_t)ie * D * FE;      d.K = FE; d.N = D; d.Npad = D; }
    }
}
__device__ __forceinline__ void transpose_item(const MatDesc& d, LAS float* scr, int item, int lane) {
    const int nblk = d.Npad / 32, kb = item / nblk, nb = item % nblk, k0 = 64 * kb, n0 = 32 * nb;
    const int ncol = n0 + (lane & 31); const bool ok = ncol < d.N;
#pragma unroll 8
    for (int i = 0; i < 32; ++i) { const int kk = 2 * i + (lane >> 5); scr[kk * 33 + (lane & 31)] = ok ? d.src[(size_t)(k0 + kk) * d.N + ncol] : 0.f; }
    LDS_WAIT();
    const int c = lane & 7;
#pragma unroll
    for (int j = 0; j < 4; ++j) { const int n = (lane >> 3) + 8 * j; const LAS float* s = scr + (8 * c) * 33 + n;
        u32x4 o; o.x = pk2(s[0 * 33], s[1 * 33]); o.y = pk2(s[2 * 33], s[3 * 33]); o.z = pk2(s[4 * 33], s[5 * 33]); o.w = pk2(s[6 * 33], s[7 * 33]);
        const int ng = n0 + n; const int drow = d.split ? (ng < d.split ? 2 * ng : 2 * (ng - d.split) + 1) : ng;
        *(u32x4*)(d.dst + (size_t)drow * d.K + k0 + 8 * c) = o; }
    LDS_WAIT();
}
__device__ __forceinline__ void p0_prologue(const Ctx& C, LAS unsigned char* lds) {
    LAS float* scr = (LAS float*)(lds + C.wid * 8704);
    const int gw = C.bid * NWAVES + C.wid, NGW = C.G * NWAVES;
    int start = 0;
    for (int id = 0; id < 92; ++id) {
        MatDesc d; get_mat(C, id, d);
        const int ntiles = (d.K / 64) * (d.Npad / 32);
        int first = gw - start; if (first < 0) first += NGW;
        for (int it = first; it < ntiles; it += NGW) transpose_item(d, scr, it, C.lane);
        start = (start + ntiles) % NGW;
    }
    const int gt = C.bid * NTHREADS + C.tid, NGT = C.G * NTHREADS;
    { const f32x4* xs = (const f32x4*)C.in[I_X]; u32x4* xd = (u32x4*)C.XB;
      for (int i = gt; i < M * D / 8; i += NGT) { const f32x4 a = xs[2 * i], b = xs[2 * i + 1]; u32x4 o; o.x = pk2(a[0], a[1]); o.y = pk2(a[2], a[3]); o.z = pk2(b[0], b[1]); o.w = pk2(b[2], b[3]); xd[i] = o; } }
    { const f32x4* xs = (const f32x4*)C.in[I_MEM]; u32x4* xd = (u32x4*)C.MEMB;
      for (int i = gt; i < NB * MEM * D / 8; i += NGT) { const f32x4 a = xs[2 * i], b = xs[2 * i + 1]; u32x4 o; o.x = pk2(a[0], a[1]); o.y = pk2(a[2], a[3]); o.z = pk2(b[0], b[1]); o.w = pk2(b[2], b[3]); xd[i] = o; } }
    { const f32x4* ws = (const f32x4*)C.in[I_SGUW]; u32x4* wd = (u32x4*)C.SGUWB;
      for (int i = gt; i < NL * 4 * 128 * 128 / 8; i += NGT) { const int j0 = (i & 15) * 8, ii = (i >> 4) & 127; const f32x4 a = ws[2 * i], b = ws[2 * i + 1];
          float v[8] = {a[0], a[1], a[2], a[3], b[0], b[1], b[2], b[3]};
#pragma unroll
          for (int e = 0; e < 8; ++e) v[e] = (j0 + e <= ii) ? v[e] : 0.f;
          u32x4 o; o.x = pk2(v[0], v[1]); o.y = pk2(v[2], v[3]); o.z = pk2(v[4], v[5]); o.w = pk2(v[6], v[7]); wd[i] = o; } }
    for (int o = gw; o < NL * 2 * 256; o += NGW) { const int n = o & 255, kv = (o >> 8) & 1, l = o >> 9;
        const float* pe = C.in[kv ? I_PEV : I_PEK] + (size_t)l * 2048; const float* w1 = C.in[kv ? I_VW1 : I_KW1] + (size_t)l * 2048 * 256;
        float s = 0.f;
        for (int k = C.lane; k < 2048; k += 64) s += pe[k] * w1[(size_t)k * 256 + n];
        s = wave_sum(s); if (C.lane == 0) C.PEB[o] = s; }
}

__device__ __forceinline__ void ln_phase(const Ctx& C, const float* src, const float* gam, const float* bet, int mode, const float* router, LAS unsigned char* lds) {
    LAS float* rwT = (LAS float*)lds;
    LAS int* te = (LAS int*)(lds + 32768);
    LAS float* tgl = (LAS float*)(lds + 32768 + 1024);
    if (router) { for (int i = C.tid; i < 8192; i += NTHREADS) rwT[(i & 7) * 1024 + (i >> 3)] = router[i]; __syncthreads(); }
    f32x4 g4[4], b4[4];
#pragma unroll
    for (int j = 0; j < 4; ++j) { g4[j] = *(const f32x4*)(gam + 256 * j + 4 * C.lane); b4[j] = *(const f32x4*)(bet + 256 * j + 4 * C.lane); }
    for (int tile = C.bid; tile < M / 128; tile += C.G) {
        for (int i = 0; i < 16; ++i) {
            const int tl = 16 * C.wid + i; const size_t row = (size_t)tile * 128 + tl;
            f32x4 v[4];
            if (mode == 0) {
#pragma unroll
                for (int j = 0; j < 4; ++j) v[j] = *(const f32x4*)(src + row * D + 256 * j + 4 * C.lane);
            } else {
                const int p0 = C.TOKPOS[2 * row], p1 = C.TOKPOS[2 * row + 1]; const float g0 = C.TOKG[2 * row], g1 = C.TOKG[2 * row + 1];
#pragma unroll
                for (int j = 0; j < 4; ++j) { const f32x4 x = *(const f32x4*)(C.X + row * D + 256 * j + 4 * C.lane);
                    const f32x4 a = *(const f32x4*)(C.FS + (size_t)p0 * D + 256 * j + 4 * C.lane), b = *(const f32x4*)(C.FS + (size_t)p1 * D + 256 * j + 4 * C.lane);
                    v[j] = x * ALPHA + a * g0 + b * g1; }
            }
            float s = 0.f;
#pragma unroll
            for (int j = 0; j < 4; ++j) s += (v[j][0] + v[j][1]) + (v[j][2] + v[j][3]);
            const float mean = wave_sum(s) * (1.f / D); float s2 = 0.f;
#pragma unroll
            for (int j = 0; j < 4; ++j) { v[j] = v[j] - mean; s2 += (v[j][0] * v[j][0] + v[j][1] * v[j][1]) + (v[j][2] * v[j][2] + v[j][3] * v[j][3]); }
            const float rstd = 1.0f / sqrtf(wave_sum(s2) * (1.f / D) + LN_EPS);
#pragma unroll
            for (int j = 0; j < 4; ++j) { v[j] = v[j] * rstd * g4[j] + b4[j];
                *(f32x4*)(C.X + row * D + 256 * j + 4 * C.lane) = v[j];
                u32x2 o; o.x = pk2(v[j][0], v[j][1]); o.y = pk2(v[j][2], v[j][3]); *(u32x2*)(C.XB + row * D + 256 * j + 4 * C.lane) = o; }
            if (router) {
                float lg[8];
#pragma unroll
                for (int ex = 0; ex < 8; ++ex) { float a = 0.f;
#pragma unroll
                    for (int j = 0; j < 4; ++j) { const f32x4 w = *(const LAS f32x4*)(rwT + ex * 1024 + 256 * j + 4 * C.lane); a += (v[j][0] * w[0] + v[j][1] * w[1]) + (v[j][2] * w[2] + v[j][3] * w[3]); }
                    lg[ex] = wave_sum(a); }
                int e0 = 0; float l0 = lg[0];
#pragma unroll
                for (int ex = 1; ex < 8; ++ex) if (lg[ex] > l0) { l0 = lg[ex]; e0 = ex; }
                int e1 = -1; float l1 = -INFINITY;
#pragma unroll
                for (int ex = 0; ex < 8; ++ex) if (ex != e0 && lg[ex] > l1) { l1 = lg[ex]; e1 = ex; }
                const float ed = __expf(l1 - l0), ga = 1.0f / (1.0f + ed), gb = ed * ga;
                if (C.lane == 0) { te[2 * tl] = e0; te[2 * tl + 1] = e1; tgl[2 * tl] = ga; tgl[2 * tl + 1] = gb; }
            }
        }
        if (router) {
            __syncthreads();
            if (C.wid == 0) {
                int run[8];
#pragma unroll
                for (int ex = 0; ex < 8; ++ex) run[ex] = 0;
                for (int rr = 0; rr < 4; ++rr) { const int a = 64 * rr + C.lane; const int e = te[a]; int rank = 0;
#pragma unroll
                    for (int ex = 0; ex < 8; ++ex) { const unsigned long long mk = __ballot(e == ex); if (e == ex) rank = run[ex] + __popcll(mk & ((1ull << C.lane) - 1ull)); run[ex] += __popcll(mk); }
                    C.TOKINFO[(size_t)tile * 256 + a] = (unsigned)e | ((unsigned)rank << 8); C.TOKG[(size_t)tile * 256 + a] = tgl[a]; }
#pragma unroll
                for (int ex = 0; ex < 8; ++ex) if (C.lane == ex) C.HIST[tile * 8 + ex] = run[ex];
            }
            __syncthreads();
        }
    }
}

struct ConvW { f32x4 w[31]; f32x4 cb, lg, lb; };
__device__ __forceinline__ void load_convw(const Ctx& C, int l, ConvW& cw) {
#pragma unroll
    for (int k = 0; k < 31; ++k) cw.w[k] = *(const f32x4*)(C.in[I_CONVW] + ((size_t)l * 31 + k) * 256 + 4 * C.lane);
    cw.cb = *(const f32x4*)(C.in[I_CONVB] + l * 256 + 4 * C.lane); cw.lg = *(const f32x4*)(C.in[I_CLNG] + l * 256 + 4 * C.lane); cw.lb = *(const f32x4*)(C.in[I_CLNB] + l * 256 + 4 * C.lane);
}
template <int WHICH>
__device__ __forceinline__ void mixers_tile(const Ctx& C, int l, int tb, LAS unsigned char* lds, const ConvW& cw) {
    const int tid = C.tid, wid = C.wid, lane = C.lane;
    const int b = tb >> 6, t0 = (tb & 63) << 7; const size_t R0 = (size_t)b * T + t0;
    const bf16* Zb = C.Z + (size_t)b * T * DINP;
    const int m16 = lane & 15, gq = lane >> 4, row = 16 * wid + m16;
    if constexpr ((WHICH & 1) != 0) {
        LAS bf16* Dl = (LAS bf16*)lds;
        for (int it = tid; it < 128 * 32; it += NTHREADS) {
            const int tl = it >> 5, c8 = it & 31, g = c8 >> 3, w = 2 << g, t = t0 + tl, n = (t + 1 < w) ? (t + 1) : w;
            float s[8], cur[8];
#pragma unroll
            for (int e = 0; e < 8; ++e) { s[e] = 0.f; cur[e] = 0.f; }
            for (int k = 0; k < n; ++k) {
                const u32x4 v = *(const u32x4*)(Zb + (size_t)(t - k) * DINP + C_POOL + 8 * c8);
                const float f[8] = {lo16(v.x), hi16(v.x), lo16(v.y), hi16(v.y), lo16(v.z), hi16(v.z), lo16(v.w), hi16(v.w)};
#pragma unroll
                for (int e = 0; e < 8; ++e) { s[e] += f[e]; if (k == 0) cur[e] = f[e]; }
            }
            const float inv = 1.0f / (float)n;
            u32x4 o; o.x = pk2(s[0] * inv - cur[0], s[1] * inv - cur[1]); o.y = pk2(s[2] * inv - cur[2], s[3] * inv - cur[3]);
            o.z = pk2(s[4] * inv - cur[4], s[5] * inv - cur[5]); o.w = pk2(s[6] * inv - cur[6], s[7] * inv - cur[7]);
            *(LAS u32x4*)(Dl + tl * 264 + 8 * c8) = o;
        }
        __syncthreads();
#pragma unroll
        for (int g = 0; g < 4; ++g) {
            bf16x8 a[2];
#pragma unroll
            for (int s = 0; s < 2; ++s) a[s] = *(const LAS bf16x8*)(Dl + row * 264 + g * 64 + 32 * s + 8 * gq);
#pragma unroll
            for (int nt = 0; nt < 4; ++nt) {
                f32x4 acc = {0.f, 0.f, 0.f, 0.f};
#pragma unroll
                for (int s = 0; s < 2; ++s) { const bf16x8 bfr = *(const bf16x8*)(C.POOLWT + ((size_t)((l * 4 + g) * 64 + 16 * nt + m16)) * 64 + 32 * s + 8 * gq); acc = mfma16(bfr, a[s], acc); }
                const int col = g * 64 + 16 * nt + 4 * gq;
                const f32x4 sc = *(const f32x4*)(C.in[I_POOLS] + l * 256 + col);
                u32x2 o; o.x = pk2(acc[0] * sc[0], acc[1] * sc[1]); o.y = pk2(acc[2] * sc[2], acc[3] * sc[3]);
                *(u32x2*)(C.Y + (R0 + row) * D + col) = o;
            }
        }
        __syncthreads();
    }
    if constexpr ((WHICH & 2) != 0) {
        LAS bf16* VnT = (LAS bf16*)lds;
        const f32x4 lg = *(const f32x4*)(C.in[I_SLNG] + l * 256 + 4 * lane), lb = *(const f32x4*)(C.in[I_SLNB] + l * 256 + 4 * lane);
#pragma unroll 1
        for (int i = 0; i < 16; ++i) {
            const int tl = 16 * wid + i;
            const u32x2 v = *(const u32x2*)(C.Z + (R0 + tl) * DINP + C_V + 4 * lane);
            const float x0 = gelu_tanh(lo16(v.x)), x1 = gelu_tanh(hi16(v.x)), x2 = gelu_tanh(lo16(v.y)), x3 = gelu_tanh(hi16(v.y));
            const float mean = wave_sum((x0 + x1) + (x2 + x3)) * (1.f / 256.f);
            const float d0 = x0 - mean, d1 = x1 - mean, d2 = x2 - mean, d3 = x3 - mean;
            const float rstd = 1.0f / sqrtf(wave_sum((d0 * d0 + d1 * d1) + (d2 * d2 + d3 * d3)) * (1.f / 256.f) + LN_EPS);
            VnT[(4 * lane + 0) * 136 + tl] = (bf16)f2bf(d0 * rstd * lg[0] + lb[0]); VnT[(4 * lane + 1) * 136 + tl] = (bf16)f2bf(d1 * rstd * lg[1] + lb[1]);
            VnT[(4 * lane + 2) * 136 + tl] = (bf16)f2bf(d2 * rstd * lg[2] + lb[2]); VnT[(4 * lane + 3) * 136 + tl] = (bf16)f2bf(d3 * rstd * lg[3] + lb[3]);
        }
        __syncthreads();
        const int ns = (wid >> 1) + 1;
#pragma unroll
        for (int g = 0; g < 4; ++g) {
            f32x4 acc[4];
#pragma unroll
            for (int nt = 0; nt < 4; ++nt) acc[nt] = (f32x4){0.f, 0.f, 0.f, 0.f};
#pragma unroll
            for (int s = 0; s < 4; ++s) if (s < ns) {
                const bf16x8 a = *(const bf16x8*)(C.SGUWB + ((size_t)((l * 4 + g) * 128 + row)) * 128 + 32 * s + 8 * gq);
#pragma unroll
                for (int nt = 0; nt < 4; ++nt) { const bf16x8 bfr = *(const LAS bf16x8*)(VnT + (g * 64 + 16 * nt + m16) * 136 + 32 * s + 8 * gq); acc[nt] = mfma16(bfr, a, acc[nt]); }
            }
            const float bs = C.in[I_SGUB][(l * 4 + g) * 128 + row];
#pragma unroll
            for (int nt = 0; nt < 4; ++nt) {
                const int col = g * 64 + 16 * nt + 4 * gq;
                const u32x2 uu = *(const u32x2*)(C.Z + (R0 + row) * DINP + C_U + col);
                const float u0 = gelu_tanh(lo16(uu.x)), u1 = gelu_tanh(hi16(uu.x)), u2 = gelu_tanh(lo16(uu.y)), u3 = gelu_tanh(hi16(uu.y));
                u32x2 o; o.x = pk2(u0 * (acc[nt][0] + bs), u1 * (acc[nt][1] + bs)); o.y = pk2(u2 * (acc[nt][2] + bs), u3 * (acc[nt][3] + bs));
                *(u32x2*)(C.Y + (R0 + row) * D + 512 + col) = o;
            }
        }
        __syncthreads();
    }
    if constexpr ((WHICH & 4) != 0) {
        LAS bf16* Hg = (LAS bf16*)lds;
        LAS unsigned char* Hn = lds + 158 * 528;
        for (int it = tid; it < 158 * 64; it += NTHREADS) {
            const int r = it >> 6, c4 = it & 63, t = t0 - 30 + r;
            u32x2 o; o.x = 0u; o.y = 0u;
            if (t >= 0) { const bf16* zr = Zb + (size_t)t * DINP; const u32x2 a = *(const u32x2*)(zr + C_CA + 4 * c4), gg = *(const u32x2*)(zr + C_CG + 4 * c4);
                o.x = pk2(lo16(a.x) * sigmoidf_(lo16(gg.x)), hi16(a.x) * sigmoidf_(hi16(gg.x))); o.y = pk2(lo16(a.y) * sigmoidf_(lo16(gg.y)), hi16(a.y) * sigmoidf_(hi16(gg.y))); }
            *(LAS u32x2*)(Hg + r * 264 + 4 * c4) = o;
        }
        __syncthreads();
        {
            const f32x4 cb = cw.cb, lg = cw.lg, lb = cw.lb;
#pragma unroll 1
            for (int i = 0; i < 16; ++i) {
                const int tl = 16 * wid + i;
                f32x4 acc = cb;
#pragma unroll
                for (int k = 0; k < 31; ++k) {
                    const u32x2 h = *(const LAS u32x2*)(Hg + (tl + k) * 264 + 4 * lane);
                    acc[0] += cw.w[k][0] * lo16(h.x); acc[1] += cw.w[k][1] * hi16(h.x); acc[2] += cw.w[k][2] * lo16(h.y); acc[3] += cw.w[k][3] * hi16(h.y); }
                const float mean = wave_sum((acc[0] + acc[1]) + (acc[2] + acc[3])) * (1.f / 256.f);
                const float d0 = acc[0] - mean, d1 = acc[1] - mean, d2 = acc[2] - mean, d3 = acc[3] - mean;
                const float rstd = 1.0f / sqrtf(wave_sum((d0 * d0 + d1 * d1) + (d2 * d2 + d3 * d3)) * (1.f / 256.f) + LN_EPS);
                const float y0 = siluf_(d0 * rstd * lg[0] + lb[0]), y1 = siluf_(d1 * rstd * lg[1] + lb[1]), y2 = siluf_(d2 * rstd * lg[2] + lb[2]), y3 = siluf_(d3 * rstd * lg[3] + lb[3]);
                u32x2 o; o.x = pk2(y0, y1); o.y = pk2(y2, y3);
                *(LAS u32x2*)(Hn + tl * 512 + (((lane >> 1) ^ (tl & 15)) << 4) + ((lane & 1) << 3)) = o;
            }
        }
        __syncthreads();
#pragma unroll 1
        for (int nh = 0; nh < 2; ++nh) {
            f32x4 acc[8];
#pragma unroll
            for (int nt = 0; nt < 8; ++nt) acc[nt] = (f32x4){0.f, 0.f, 0.f, 0.f};
            const bf16* pw = C.PWT + ((size_t)(l * 256 + 128 * nh + m16)) * 256 + 8 * gq;
#pragma unroll 1
            for (int s = 0; s < 8; ++s) {
                const bf16x8 a = *(const LAS bf16x8*)(Hn + row * 512 + (((4 * s + gq) ^ (row & 15)) << 4));
#pragma unroll
                for (int nt = 0; nt < 8; ++nt) { const bf16x8 bfr = *(const bf16x8*)(pw + (size_t)(16 * nt) * 256 + 32 * s); acc[nt] = mfma16(bfr, a, acc[nt]); }
            }
#pragma unroll
            for (int nt = 0; nt < 8; ++nt) { u32x2 o; o.x = pk2(acc[nt][0], acc[nt][1]); o.y = pk2(acc[nt][2], acc[nt][3]); *(u32x2*)(C.Y + (R0 + row) * D + 768 + 128 * nh + 16 * nt + 4 * gq) = o; }
        }
        __syncthreads();
    }
}
__device__ __forceinline__ void compress_item(const Ctx& C, int l, int it, LAS unsigned char* lds) {
    const int wid = C.wid, lane = C.lane;
    const int rt = it >> 1, kv = it & 1, m16 = lane & 15, gq = lane >> 4;
    const int cr = 16 * rt + m16, bb = cr >> 9, n = cr & 511, nn = n < 510 ? n : 510;
    const bf16* rowbase = C.Z + ((size_t)bb * T + 16 * nn) * DINP + (kv ? C_VCMP : C_KCMP);
    const bf16* w1t = C.CW1T + (size_t)(l * 2 + kv) * 256 * 2048;
    f32x4 acc[2]; acc[0] = (f32x4){0.f, 0.f, 0.f, 0.f}; acc[1] = acc[0];
#pragma unroll 4
    for (int s = 0; s < 64; ++s) {
        const bf16x8 a = *(const bf16x8*)(rowbase + (size_t)(s >> 1) * DINP + 32 * (s & 1) + 8 * gq);
#pragma unroll
        for (int nt = 0; nt < 2; ++nt) { const bf16x8 bfr = *(const bf16x8*)(w1t + (size_t)(32 * wid + 16 * nt + m16) * 2048 + 32 * s + 8 * gq); acc[nt] = mfma16(bfr, a, acc[nt]); }
    }
    LAS bf16* Hc = (LAS bf16*)lds;
#pragma unroll
    for (int nt = 0; nt < 2; ++nt) { const int col = 32 * wid + 16 * nt + 4 * gq; const f32x4 pb = *(const f32x4*)(C.PEB + (l * 2 + kv) * 256 + col);
        u32x2 o; o.x = pk2(gelu_tanh(acc[nt][0] + pb[0]), gelu_tanh(acc[nt][1] + pb[1])); o.y = pk2(gelu_tanh(acc[nt][2] + pb[2]), gelu_tanh(acc[nt][3] + pb[3]));
        *(LAS u32x2*)(Hc + m16 * 264 + col) = o; }
    __syncthreads();
    if (wid < 4) {
        const bf16* w2t = C.CW2T + (size_t)(l * 2 + kv) * 64 * 256;
        f32x4 a2 = {0.f, 0.f, 0.f, 0.f};
#pragma unroll
        for (int s = 0; s < 8; ++s) { const bf16x8 a = *(const LAS bf16x8*)(Hc + m16 * 264 + 32 * s + 8 * gq); const bf16x8 bfr = *(const bf16x8*)(w2t + (size_t)(16 * wid + m16) * 256 + 32 * s + 8 * gq); a2 = mfma16(bfr, a, a2); }
        if (n < NCMP) { u32x2 o; o.x = pk2(a2[0], a2[1]); o.y = pk2(a2[2], a2[3]); *(u32x2*)((kv ? C.VC : C.KC) + (size_t)cr * 64 + 16 * wid + 4 * gq) = o; }
    }
    __syncthreads();
}

__device__ __forceinline__ void nsa_branch(const bf16* kb, const bf16* vb, int pitch, const LAS int* base, int nch, int vlo, int vhi, int chi,
                                           const LAS unsigned* qs, LAS float* sc, float (&o)[4], int lane) {
    float mx0 = -INFINITY, mx1 = -INFINITY, mx2 = -INFINITY, mx3 = -INFINITY;
#pragma unroll 1
    for (int i = 0; i < nch; ++i) {
        asm volatile("" ::: "memory");
        const int r = base[i] + lane; const bool valid = (r >= vlo) && (r <= vhi);
        const int rc = r < 0 ? 0 : (r > chi ? chi : r);
        const u32x4* kp = (const u32x4*)(kb + (size_t)rc * pitch);
        u32x4 kr[8];
#pragma unroll
        for (int c = 0; c < 8; ++c) kr[c] = kp[c];
        float a0 = 0.f, a1 = 0.f, a2 = 0.f, a3 = 0.f;
#pragma unroll
        for (int c = 0; c < 8; ++c) {
            const u32x4 q0 = *(const LAS u32x4*)(qs + 0 * 32 + 4 * c), q1 = *(const LAS u32x4*)(qs + 1 * 32 + 4 * c), q2 = *(const LAS u32x4*)(qs + 2 * 32 + 4 * c), q3 = *(const LAS u32x4*)(qs + 3 * 32 + 4 * c);
            a0 = dot2bf(kr[c].x, q0.x, a0); a0 = dot2bf(kr[c].y, q0.y, a0); a0 = dot2bf(kr[c].z, q0.z, a0); a0 = dot2bf(kr[c].w, q0.w, a0);
            a1 = dot2bf(kr[c].x, q1.x, a1); a1 = dot2bf(kr[c].y, q1.y, a1); a1 = dot2bf(kr[c].z, q1.z, a1); a1 = dot2bf(kr[c].w, q1.w, a1);
            a2 = dot2bf(kr[c].x, q2.x, a2); a2 = dot2bf(kr[c].y, q2.y, a2); a2 = dot2bf(kr[c].z, q2.z, a2); a2 = dot2bf(kr[c].w, q2.w, a2);
            a3 = dot2bf(kr[c].x, q3.x, a3); a3 = dot2bf(kr[c].y, q3.y, a3); a3 = dot2bf(kr[c].z, q3.z, a3); a3 = dot2bf(kr[c].w, q3.w, a3);
        }
        if (!valid) { a0 = -INFINITY; a1 = -INFINITY; a2 = -INFINITY; a3 = -INFINITY; }
        sc[0 * 1024 + 64 * i + lane] = a0; sc[1 * 1024 + 64 * i + lane] = a1; sc[2 * 1024 + 64 * i + lane] = a2; sc[3 * 1024 + 64 * i + lane] = a3;
        mx0 = fmaxf(mx0, a0); mx1 = fmaxf(mx1, a1); mx2 = fmaxf(mx2, a2); mx3 = fmaxf(mx3, a3);
    }
    mx0 = wave_max(mx0); mx1 = wave_max(mx1); mx2 = wave_max(mx2); mx3 = wave_max(mx3);
    float l0 = 0.f, l1 = 0.f, l2 = 0.f, l3 = 0.f;
    for (int i = 0; i < nch; ++i) {
        const float s0 = sc[0 * 1024 + 64 * i + lane], s1 = sc[1 * 1024 + 64 * i + lane], s2 = sc[2 * 1024 + 64 * i + lane], s3 = sc[3 * 1024 + 64 * i + lane];
        const float e0 = (s0 == -INFINITY) ? 0.f : __expf(s0 - mx0), e1 = (s1 == -INFINITY) ? 0.f : __expf(s1 - mx1), e2 = (s2 == -INFINITY) ? 0.f : __expf(s2 - mx2), e3 = (s3 == -INFINITY) ? 0.f : __expf(s3 - mx3);
        sc[0 * 1024 + 64 * i + lane] = e0; sc[1 * 1024 + 64 * i + lane] = e1; sc[2 * 1024 + 64 * i + lane] = e2; sc[3 * 1024 + 64 * i + lane] = e3;
        l0 += e0; l1 += e1; l2 += e2; l3 += e3;
    }
    l0 = wave_sum(l0); l1 = wave_sum(l1); l2 = wave_sum(l2); l3 = wave_sum(l3);
    const float i0 = l0 > 0.f ? 1.0f / l0 : 0.f, i1 = l1 > 0.f ? 1.0f / l1 : 0.f, i2 = l2 > 0.f ? 1.0f / l2 : 0.f, i3 = l3 > 0.f ? 1.0f / l3 : 0.f;
    for (int i = 0; i < nch; ++i) { sc[0 * 1024 + 64 * i + lane] *= i0; sc[1 * 1024 + 64 * i + lane] *= i1; sc[2 * 1024 + 64 * i + lane] *= i2; sc[3 * 1024 + 64 * i + lane] *= i3; }
    LDS_WAIT();
    float o0 = 0.f, o1 = 0.f, o2 = 0.f, o3 = 0.f;
    for (int i = 0; i < nch; ++i) {
        const int b0 = base[i];
        for (int j = 0; j < 64; j += 4) {
            const f32x4 p0 = *(const LAS f32x4*)(sc + 0 * 1024 + 64 * i + j), p1 = *(const LAS f32x4*)(sc + 1 * 1024 + 64 * i + j), p2 = *(const LAS f32x4*)(sc + 2 * 1024 + 64 * i + j), p3 = *(const LAS f32x4*)(sc + 3 * 1024 + 64 * i + j);
#pragma unroll
            for (int u = 0; u < 4; ++u) { int r = b0 + j + u; r = r < 0 ? 0 : (r > chi ? chi : r);
                const float vv = bf2f((unsigned)vb[(size_t)r * pitch + lane]);
                o0 += p0[u] * vv; o1 += p1[u] * vv; o2 += p2[u] * vv; o3 += p3[u] * vv; }
        }
    }
    o[0] = o0; o[1] = o1; o[2] = o2; o[3] = o3;
}
__device__ __forceinline__ void nsa_query(const Ctx& C, int b, int t, LAS unsigned char* wl  ) {
    const int lane = C.lane;
    LAS float* sc = (LAS float*)wl;
    LAS unsigned* qs = (LAS unsigned*)(wl + 16384);
    LAS int* base = (LAS int*)(wl + 16384 + 1024);
    const size_t row = (size_t)b * T + t;
    const bf16* zr = C.Z + row * DINP;
    const bf16* Zb = C.Z + (size_t)b * T * DINP;
    { const unsigned w2 = *(const unsigned*)(zr + C_Q + 2 * lane);
      const unsigned w3 = *(const unsigned*)(zr + C_Q + 128 + 2 * lane);
      qs[lane] = pk2(lo16(w2) * 0.125f, hi16(w2) * 0.125f); qs[64 + lane] = pk2(lo16(w3) * 0.125f, hi16(w3) * 0.125f); }
    const int nvalid = (t >= 31) ? ((t - 31) / 16 + 1) : 0;
    const int nchc = (nvalid + 63) >> 6;
    if (lane < 16) base[lane] = 64 * lane;
    LDS_WAIT();
    float oc[4];
    nsa_branch(C.KC + (size_t)b * 512 * 64, C.VC + (size_t)b * 512 * 64, 64, base, nchc, 0, nvalid - 1, 510, qs, sc, oc, lane);
    const int cur = t >> 6;
    float c0, c1;
    {
        float im0 = 0.f, im1 = 0.f;
#pragma unroll
        for (int rr = -1; rr <= 3; ++rr) { const int n0 = 4 * lane + rr, n1 = 4 * (lane + 64) + rr;
            if (n0 >= 0 && n0 < 64 * nchc) im0 += (sc[n0] + sc[1024 + n0]) + (sc[2048 + n0] + sc[3072 + n0]);
            if (n1 < 64 * nchc) im1 += (sc[n1] + sc[1024 + n1]) + (sc[2048 + n1] + sc[3072 + n1]); }
        const int m0 = lane, m1 = lane + 64;
        c0 = (m0 <= cur) ? (im0 + ((m0 == 0 || m0 == cur || m0 == cur - 1) ? 1e4f : 0.f)) : -1.0f;
        c1 = (m1 <= cur) ? (im1 + ((m1 == 0 || m1 == cur || m1 == cur - 1) ? 1e4f : 0.f)) : -1.0f;
    }
    LDS_WAIT();
    for (int r = 0; r < 16; ++r) {
        float bv; int bi;
        if (c0 >= c1) { bv = c0; bi = lane; } else { bv = c1; bi = lane + 64; }
#pragma unroll
        for (int off = 1; off < 64; off <<= 1) { const float ov = __shfl_xor(bv, off); const int oi = __shfl_xor(bi, off); if (ov > bv || (ov == bv && oi < bi)) { bv = ov; bi = oi; } }
        if (bi == lane) c0 = -2.0f; if (bi == lane + 64) c1 = -2.0f;
        if (lane == 0) base[r] = (bv >= 0.f) ? 64 * bi : -1000000;
    }
    LDS_WAIT();
    float os[4];
    nsa_branch(Zb + C_KSEL, Zb + C_VSEL, DINP, base, 16, 0, t, T - 1, qs, sc, os, lane);
    if (lane < 16) base[lane] = t - 511 + 64 * lane;
    LDS_WAIT();
    float ow[4];
    nsa_branch(Zb + C_KWIN, Zb + C_VWIN, DINP, base, 8, 0, t, T - 1, qs, sc, ow, lane);
#pragma unroll
    for (int h = 0; h < 4; ++h) {
        const float g0 = sigmoidf_(bf2f((unsigned)zr[C_GATE + 3 * h + 0])), g1 = sigmoidf_(bf2f((unsigned)zr[C_GATE + 3 * h + 1])), g2 = sigmoidf_(bf2f((unsigned)zr[C_GATE + 3 * h + 2]));
        C.Y[row * D + 256 + h * 64 + lane] = (bf16)f2bf(g0 * oc[h] + g1 * os[h] + g2 * ow[h]);
    }
    LDS_WAIT();
}

__device__ __forceinline__ void xattn_unit(const Ctx& C, int l, int unit, LAS unsigned char* lds) {
    const int tid = C.tid, wid = C.wid, lane = C.lane;
    const int qt = unit & 63, bh = unit >> 6, b = bh >> 2, h = bh & 3;
    const int m16 = lane & 15, gq = lane >> 4;
    const size_t qrow = (size_t)b * T + qt * 128 + 16 * wid + m16;
    bf16x8 qf[8];
#pragma unroll
    for (int s = 0; s < 8; ++s) qf[s] = *(const bf16x8*)(C.Q + qrow * D + h * 256 + 32 * s + 8 * gq);
    const bf16* ksrc = C.KMEM + ((size_t)l * 1024 + b * 256) * 1024 + h * 256;
    for (int it = tid; it < 256 * 32; it += NTHREADS) { const int key = it >> 5, c = it & 31; *(LAS u32x4*)(lds + key * 528 + c * 16) = *(const u32x4*)(ksrc + (size_t)key * 1024 + 8 * c); }
    __syncthreads();
    f32x4 sacc[16];
#pragma unroll
    for (int kt = 0; kt < 16; ++kt) { sacc[kt] = (f32x4){0.f, 0.f, 0.f, 0.f};
#pragma unroll
        for (int s = 0; s < 8; ++s) { const bf16x8 a = *(const LAS bf16x8*)(lds + (16 * kt + m16) * 528 + 64 * s + 16 * gq); sacc[kt] = mfma16(a, qf[s], sacc[kt]); } }
    float mx = -INFINITY;
#pragma unroll
    for (int kt = 0; kt < 16; ++kt) mx = fmaxf(fmaxf(mx, fmaxf(sacc[kt][0], sacc[kt][1])), fmaxf(sacc[kt][2], sacc[kt][3]));
    mx = fmaxf(mx, __shfl_xor(mx, 16)); mx = fmaxf(mx, __shfl_xor(mx, 32));
    const float scl = 0.0625f * 1.4426950408889634f;
    float sum = 0.f;
#pragma unroll
    for (int kt = 0; kt < 16; ++kt)
#pragma unroll
        for (int r = 0; r < 4; ++r) { const float e = exp2f((sacc[kt][r] - mx) * scl); sacc[kt][r] = e; sum += e; }
    sum += __shfl_xor(sum, 16); sum += __shfl_xor(sum, 32);
    const float inv = 1.0f / sum;
    bf16x8 pf[8];
#pragma unroll
    for (int s2 = 0; s2 < 8; ++s2) { u32x4 w; w.x = pk2(sacc[2 * s2][0], sacc[2 * s2][1]); w.y = pk2(sacc[2 * s2][2], sacc[2 * s2][3]); w.z = pk2(sacc[2 * s2 + 1][0], sacc[2 * s2 + 1][1]); w.w = pk2(sacc[2 * s2 + 1][2], sacc[2 * s2 + 1][3]);
        pf[s2] = __builtin_bit_cast(bf16x8, w); }
    __syncthreads();
    const bf16* vsrc = C.VTMEM + ((size_t)l * 4096 + (b * 4 + h) * 256) * 256;
    for (int it = tid; it < 256 * 32; it += NTHREADS) { const int d = it >> 5, c = it & 31; *(LAS u32x4*)(lds + d * 528 + c * 16) = *(const u32x4*)(vsrc + (size_t)d * 256 + 8 * c); }
    __syncthreads();
#pragma unroll
    for (int dt = 0; dt < 16; ++dt) {
        f32x4 oacc = {0.f, 0.f, 0.f, 0.f};
#pragma unroll
        for (int s2 = 0; s2 < 8; ++s2) { const u32x2 lo = *(const LAS u32x2*)(lds + (16 * dt + m16) * 528 + 64 * s2 + 8 * gq), hi = *(const LAS u32x2*)(lds + (16 * dt + m16) * 528 + 64 * s2 + 32 + 8 * gq);
            u32x4 w; w.x = lo.x; w.y = lo.y; w.z = hi.x; w.w = hi.y; oacc = mfma16(__builtin_bit_cast(bf16x8, w), pf[s2], oacc); }
        u32x2 o; o.x = pk2(oacc[0] * inv, oacc[1] * inv); o.y = pk2(oacc[2] * inv, oacc[3] * inv);
        *(u32x2*)(C.Y + qrow * D + h * 256 + 16 * dt + 4 * gq) = o;
    }
    __syncthreads();
}

__device__ __forceinline__ void moe_gather(const Ctx& C, LAS unsigned char* lds) {
    LAS int* sh = (LAS int*)lds;
    for (int i = C.tid; i < 2048; i += NTHREADS) sh[i] = C.HIST[i];
    __syncthreads();
    if (C.tid < 8) { int c = 0; for (int tl = 0; tl < 256; ++tl) c += sh[tl * 8 + C.tid]; sh[2048 + C.tid] = c; }
    __syncthreads();
    if (C.tid == 0) { int acc = 0; for (int ex = 0; ex < 8; ++ex) { sh[2064 + ex] = acc; acc += (sh[2048 + ex] + 255) & ~255; if (C.bid == 0) C.META[ex] = acc >> 8; } if (C.bid == 0) C.META[8] = acc >> 8; }
    __syncthreads();
    for (int tile = C.bid; tile < 256; tile += C.G) {
        if (C.tid < 8) { int c = 0; for (int tl = 0; tl < tile; ++tl) c += sh[tl * 8 + C.tid]; sh[2056 + C.tid] = c; }
        __syncthreads();
        for (int i = 0; i < 32; ++i) {
            const int a = 32 * C.wid + i; const size_t ag = (size_t)tile * 256 + a;
            const unsigned info = C.TOKINFO[ag]; const int e = info & 255u, lr = info >> 8;
            const int dest = sh[2064 + e] + sh[2056 + e] + lr;
            if (C.lane == 0) C.TOKPOS[ag] = dest;
            const u32x4* s = (const u32x4*)(C.XB + ((size_t)tile * 128 + (a >> 1)) * D); u32x4* dd = (u32x4*)(C.XG + (size_t)dest * D);
            dd[C.lane] = s[C.lane]; dd[C.lane + 64] = s[C.lane + 64];
        }
        __syncthreads();
    }
    const int gw = C.bid * NWAVES + C.wid, NGW = C.G * NWAVES;
    for (int ex = 0; ex < 8; ++ex) { const int s0 = sh[2064 + ex] + sh[2048 + ex], e0 = sh[2064 + ex] + ((sh[2048 + ex] + 255) & ~255);
        for (int r = s0 + gw; r < e0; r += NGW) { u32x4* dd = (u32x4*)(C.XG + (size_t)r * D); const u32x4 z = {0u, 0u, 0u, 0u}; dd[C.lane] = z; dd[C.lane + 64] = z; } }
}

#ifndef MK_MULTI
#define MK_MULTI 0
#endif
constexpr int PH_PER_LAYER = 13, N_PHASES = 1 + NL * PH_PER_LAYER;


__device__ __forceinline__ void mkctx(Ctx& C, const Params& P, int tid) {
    C.tid = tid; C.lane = tid & 63; C.wid = __builtin_amdgcn_readfirstlane(tid >> 6); C.bid = blockIdx.x; C.G = gridDim.x;
#pragma unroll
    for (int i = 0; i < 35; ++i) C.in[i] = P.in[i];
    unsigned char* ws = P.ws;
    C.X = P.out;
    C.XB = (bf16*)(ws + WS_XB); C.Z = (bf16*)(ws + WS_Z); C.Y = (bf16*)(ws + WS_Y); C.Q = (bf16*)(ws + WS_Q); C.H = (bf16*)(ws + WS_H); C.XG = (bf16*)(ws + WS_Z);
    C.KC = (bf16*)(ws + WS_KC); C.VC = (bf16*)(ws + WS_VC); C.MEMB = (bf16*)(ws + WS_MEMB); C.KMEM = (bf16*)(ws + WS_KMEM); C.VTMEM = (bf16*)(ws + WS_VTMEM);
    C.WINT = (bf16*)(ws + WS_WINT); C.WOUTT = (bf16*)(ws + WS_WOUTT); C.XQT = (bf16*)(ws + WS_XQT); C.XKVT = (bf16*)(ws + WS_XKVT); C.XOT = (bf16*)(ws + WS_XOT);
    C.W13T = (bf16*)(ws + WS_W13T); C.W2T = (bf16*)(ws + WS_W2T); C.E13T = (bf16*)(ws + WS_E13T); C.E2T = (bf16*)(ws + WS_E2T);
    C.CW1T = (bf16*)(ws + WS_CW1T); C.CW2T = (bf16*)(ws + WS_CW2T); C.PWT = (bf16*)(ws + WS_PWT); C.POOLWT = (bf16*)(ws + WS_POOLWT); C.SGUWB = (bf16*)(ws + WS_SGUW);
    C.VBUF = (float*)(ws + WS_VBUF); C.FS = (float*)(ws + WS_VBUF); C.PEB = (float*)(ws + WS_PEB); C.TOKG = (float*)(ws + WS_TOKG);
    C.HIST = (int*)(ws + WS_HIST); C.META = (int*)(ws + WS_META); C.TOKPOS = (int*)(ws + WS_TOKPOS); C.TOKINFO = (unsigned*)(ws + WS_TOKINFO);
}
#define MKCTX() Ctx C; { int t_ = threadIdx.x; asm volatile("" : "+v"(t_)); mkctx(C, P, t_); }

__global__ void __launch_bounds__(NTHREADS, 2) fwd_kernel(Params P) {
    extern __shared__ __attribute__((aligned(16))) unsigned char lds_raw[];
    LAS unsigned char* lds = (LAS unsigned char*)lds_raw;
    for (int u = threadIdx.x; u < (LDS_BYTES - LDSCTL_OFF) / 4; u += NTHREADS) ((LAS unsigned*)(lds + LDSCTL_OFF))[u] = 0u;
    __syncthreads();
    unsigned char* ws = P.ws;
    XcdBarrier bar; bar.bar = (unsigned*)(ws + WS_CTL); bar.x = 0; bar.st = nullptr;
#if !MK_MULTI
    bar = xcd_barrier_post((unsigned*)(ws + WS_CTL), (volatile LAS unsigned*)(lds + LDSCTL_OFF));
#endif
    const int lo = P.ph_lo, hi = P.ph_hi;
#define IN(k) (lo <= (k) && (k) < hi)
#if MK_MULTI
#define SEAM(k) do { } while (0)
#else
#define SEAM(k) do { if (IN(k) && IN((k) + 1)) xcd_barrier(bar); } while (0)
#endif
    int ph = 0;
    if (IN(ph)) { MKCTX(); p0_prologue(C, lds); }
    SEAM(ph); ++ph;

    for (int l = 0; l < NL; ++l) {
        const bool moe = (l & 1) != 0; const int li = l >> 1;
        if (IN(ph)) {
            MKCTX();
            if (l == 0) {
                for (int l2 = 0; l2 < NL; ++l2) {
                    pg8::Gemm g{C.MEMB, C.XKVT + (size_t)l2 * 2 * D * D, NB * MEM, 2 * D, D}; pg8::StaticOrder S; S.init(NB * MEM, 2 * D, C.G, (C.bid + 32 * l2) % C.G);
                    pg8::EpiKV E{C.KMEM + (size_t)l2 * 1024 * 1024, C.VTMEM + (size_t)l2 * 4096 * 256};
                    pg8::gemm_phase<pg8::EpiKV, pg8::StaticOrder, true, true>(lds, g, S, E);
                }
            }
            pg8::Gemm g{C.XB, C.WINT + (size_t)l * DINP * D, M, DINP, D}; pg8::StaticOrder S; S.init(M, DINP, C.G, C.bid);
            pg8::EpiBf16 E{C.Z, DINP};
            pg8::gemm_phase<pg8::EpiBf16, pg8::StaticOrder, true, true>(lds, g, S, E);
        }
        SEAM(ph); ++ph;
        if (IN(ph)) {
            MKCTX();
            { ConvW cw;
              for (int tb = C.bid; tb < M / 128; tb += C.G) mixers_tile<1>(C, l, tb, lds, cw);
              for (int tb = C.bid; tb < M / 128; tb += C.G) mixers_tile<2>(C, l, tb, lds, cw);
              load_convw(C, l, cw);
              for (int tb = C.bid; tb < M / 128; tb += C.G) mixers_tile<4>(C, l, tb, lds, cw); }
            for (int it = C.bid; it < 256; it += C.G) compress_item(C, l, it, lds);
        }
        SEAM(ph); ++ph;
        if (IN(ph)) {
            MKCTX();
            const int gw = C.bid * NWAVES + C.wid, NGW = C.G * NWAVES;
            for (int q = gw; q < M; q += NGW) nsa_query(C, q >> 13, q & (T - 1), lds + C.wid * 17664);
        }
        SEAM(ph); ++ph;
        if (IN(ph)) {
            MKCTX();
            pg8::Gemm g{C.Y, C.WOUTT + (size_t)l * D * D, M, D, D}; pg8::StaticOrder S; S.init(M, D, C.G, C.bid);
            pg8::EpiF32Res E{C.VBUF, (l == 0) ? C.in[I_X] : (const float*)C.X, D, ALPHA};
            pg8::gemm_phase<pg8::EpiF32Res, pg8::StaticOrder, true, true>(lds, g, S, E);
        }
        SEAM(ph); ++ph;
        if (IN(ph)) { MKCTX(); ln_phase(C, C.VBUF, C.in[I_LN1G] + l * D, C.in[I_LN1B] + l * D, 0, nullptr, lds); }
        SEAM(ph); ++ph;
        if (IN(ph)) {
            MKCTX();
            pg8::Gemm g{C.XB, C.XQT + (size_t)l * D * D, M, D, D}; pg8::StaticOrder S; S.init(M, D, C.G, C.bid);
            pg8::EpiBf16 E{C.Q, D};
            pg8::gemm_phase<pg8::EpiBf16, pg8::StaticOrder, true, true>(lds, g, S, E);
        }
        SEAM(ph); ++ph;
        if (IN(ph)) { MKCTX(); for (int u = C.bid; u < NB * 4 * 64; u += C.G) xattn_unit(C, l, u, lds); }
        SEAM(ph); ++ph;
        if (IN(ph)) {
            MKCTX();
            pg8::Gemm g{C.Y, C.XOT + (size_t)l * D * D, M, D, D}; pg8::StaticOrder S; S.init(M, D, C.G, C.bid);
            pg8::EpiF32Res E{C.VBUF, (const float*)C.X, D, ALPHA};
            pg8::gemm_phase<pg8::EpiF32Res, pg8::StaticOrder, true, true>(lds, g, S, E);
        }
        SEAM(ph); ++ph;
        if (IN(ph)) { MKCTX(); ln_phase(C, C.VBUF, C.in[I_LN2G] + l * D, C.in[I_LN2B] + l * D, 0, moe ? C.in[I_ROUTER] + (size_t)li * D * NE : nullptr, lds); }
        SEAM(ph); ++ph;
        if (IN(ph)) { if (moe) { MKCTX(); moe_gather(C, lds); } }
        SEAM(ph); ++ph;
        if (IN(ph)) {
            MKCTX();
            pg8::GroupedOrder S; int npan;
            if (moe) {
#pragma unroll
                for (int k = 0; k < 8; ++k) S.pend[k] = __builtin_amdgcn_readfirstlane(C.META[k]);
                npan = __builtin_amdgcn_readfirstlane(C.META[8]); S.estride = (size_t)2 * FE * D * 2;
            } else {
#pragma unroll
                for (int k = 0; k < 8; ++k) S.pend[k] = M / 256;
                npan = M / 256; S.estride = 0;
            }
            const int N = moe ? 2 * FE : 2 * FF;
            pg8::Gemm g{moe ? C.XG : C.XB, moe ? C.E13T + (size_t)li * NE * 2 * FE * D : C.W13T + (size_t)li * 2 * FF * D, npan * 256, N, D};
            S.init(npan * 256, N, C.G, C.bid);
            pg8::EpiSwiglu E{C.H, N / 2};
            pg8::gemm_phase<pg8::EpiSwiglu, pg8::GroupedOrder, true, true>(lds, g, S, E);
        }
        SEAM(ph); ++ph;
        if (IN(ph)) {
            MKCTX();
            pg8::GroupedOrder S; int npan;
            if (moe) {
#pragma unroll
                for (int k = 0; k < 8; ++k) S.pend[k] = __builtin_amdgcn_readfirstlane(C.META[k]);
                npan = __builtin_amdgcn_readfirstlane(C.META[8]); S.estride = (size_t)D * FE * 2;
            } else {
#pragma unroll
                for (int k = 0; k < 8; ++k) S.pend[k] = M / 256;
                npan = M / 256; S.estride = 0;
            }
            const int K = moe ? FE : FF;
            pg8::Gemm g{C.H, moe ? C.E2T + (size_t)li * NE * D * FE : C.W2T + (size_t)li * D * FF, npan * 256, D, K};
            S.init(npan * 256, D, C.G, C.bid);
            pg8::EpiF32Res E{moe ? C.FS : C.VBUF, moe ? nullptr : (const float*)C.X, D, ALPHA};
            pg8::gemm_phase<pg8::EpiF32Res, pg8::GroupedOrder, true, true>(lds, g, S, E);
        }
        SEAM(ph); ++ph;
        if (IN(ph)) { MKCTX(); ln_phase(C, C.VBUF, C.in[I_LN3G] + l * D, C.in[I_LN3B] + l * D, moe ? 1 : 0, nullptr, lds); }
        SEAM(ph); ++ph;
    }
#undef IN
#undef SEAM
}

extern "C" void kernel_launch(void* const* d_in, const int* in_sizes, int n_in, void* d_out, int out_size, void* d_ws, size_t ws_size, hipStream_t stream) {
    static int grid = 0;
    if (grid == 0) {
        if (n_in != 35 || out_size != M * D || ws_size < WS_END) { fprintf(stderr, "kernel_launch: unexpected problem (n_in %d, out %d, ws %zu < %zu)\n", n_in, out_size, ws_size, (size_t)WS_END); grid = -1; return; }
        int dev = 0, cus = 0, per_cu = 0;
        if (hipGetDevice(&dev) != hipSuccess || hipDeviceGetAttribute(&cus, hipDeviceAttributeMultiprocessorCount, dev) != hipSuccess) { grid = -1; return; }
        if (hipFuncSetAttribute((const void*)fwd_kernel, hipFuncAttributeMaxDynamicSharedMemorySize, LDS_BYTES) != hipSuccess) { fprintf(stderr, "kernel_launch: hipFuncSetAttribute failed\n"); grid = -1; return; }
        if (hipOccupancyMaxActiveBlocksPerMultiprocessor(&per_cu, (const void*)fwd_kernel, NTHREADS, LDS_BYTES) != hipSuccess || per_cu < 1) { fprintf(stderr, "kernel_launch: occupancy query says %d\n", per_cu); }
        (void)hipGetLastError();
        grid = cus;
    }
    if (grid < 0) return;
    (void)hipMemsetAsync((char*)d_ws + WS_CTL, 0, CTL_ZERO_BYTES, stream);
    Params p{};
    for (int i = 0; i < 35; ++i) p.in[i] = (const float*)d_in[i];
    p.out = (float*)d_out; p.ws = (unsigned char*)d_ws;
#if MK_MULTI
    for (int k = 0; k < N_PHASES; ++k) { p.ph_lo = k; p.ph_hi = k + 1; hipLaunchKernelGGL(fwd_kernel, dim3(grid), dim3(NTHREADS), LDS_BYTES, stream, p); }
#else
    p.ph_lo = 0; p.ph_hi = N_PHASES;
    hipLaunchKernelGGL(fwd_kernel, dim3(grid), dim3(NTHREADS), LDS_BYTES, stream, p);
#endif
}
```

```cpp
#include <hip/hip_runtime.h>
#include <cstdio>
#include <cstdint>

#define GAS __attribute__((address_space(1)))
#define LAS __attribute__((address_space(3)))
typedef unsigned short bf16;
typedef short bf16x8 __attribute__((ext_vector_type(8)));
typedef short bf16x4 __attribute__((ext_vector_type(4)));
typedef float f32x4 __attribute__((ext_vector_type(4)));
typedef float f32x2 __attribute__((ext_vector_type(2)));
typedef unsigned u32x4 __attribute__((ext_vector_type(4)));
typedef unsigned u32x2 __attribute__((ext_vector_type(2)));

constexpr int D = 1024, NB = 4, T = 8192, NL = 4, MEM = 256, M = NB * T;
constexpr int DIN = 1932, DINP = 2048;
constexpr int C_POOL = 0, C_Q = 256, C_KCMP = 512, C_VCMP = 576, C_KSEL = 640, C_VSEL = 704, C_KWIN = 768, C_VWIN = 832, C_GATE = 896, C_U = 908, C_V = 1164, C_CA = 1420, C_CG = 1676;
constexpr int FF = 2816, NE = 8, FE = 3584;
constexpr int NCMP = 511;
constexpr float ALPHA = 1.6817928305074292f;
constexpr float LN_EPS = 1e-5f;
constexpr int MOE_ROWS = 2 * M + NE * 256;
constexpr int NWAVES = 8, NTHREADS = 512;

constexpr size_t al256(size_t x) { return (x + 255) & ~(size_t)255; }
constexpr size_t MiB = 1u << 20;
constexpr size_t WS_CTL = 0, CTL_ZERO_BYTES = 64 * 1024;
constexpr size_t WS_HIST = 1 * MiB;
constexpr size_t WS_META = WS_HIST + 8192;
constexpr size_t WS_TOKINFO = WS_META + 256;
constexpr size_t WS_TOKG = WS_TOKINFO + (size_t)2 * M * 4;
constexpr size_t WS_TOKPOS = WS_TOKG + (size_t)2 * M * 4;
constexpr size_t WS_KC = WS_TOKPOS + (size_t)2 * M * 4;
constexpr size_t WS_VC = WS_KC + (size_t)NB * 512 * 64 * 2;
constexpr size_t WS_PEB = WS_VC + (size_t)NB * 512 * 64 * 2;
constexpr size_t WS_POOLWT = WS_PEB + (size_t)NL * 2 * 256 * 4;
constexpr size_t WS_SGUW = WS_POOLWT + (size_t)NL * 4 * 64 * 64 * 2;
constexpr size_t WS_PWT = WS_SGUW + (size_t)NL * 4 * 128 * 128 * 2;
constexpr size_t WS_CW2T = WS_PWT + (size_t)NL * 256 * 256 * 2;
constexpr size_t WS_CW1T = WS_CW2T + (size_t)NL * 2 * 64 * 256 * 2;
constexpr size_t WS_MEMB = WS_CW1T + (size_t)NL * 2 * 256 * 2048 * 2;
constexpr size_t WS_KMEM = WS_MEMB + (size_t)1024 * 1024 * 2;
constexpr size_t WS_VTMEM = WS_KMEM + (size_t)NL * 1024 * 1024 * 2;
constexpr size_t WS_VCT = WS_VTMEM + (size_t)NL * 4096 * 256 * 2;
constexpr size_t WS_VSELT = WS_VCT + (size_t)NB * 64 * 512 * 2;
constexpr size_t WS_VWINT = WS_VSELT + (size_t)NB * 64 * T * 2;
constexpr size_t WS_SMALL_END = WS_VWINT + (size_t)NB * 64 * T * 2;
constexpr size_t WS_WINT = 48 * MiB;
static_assert(WS_SMALL_END <= WS_WINT, "small region");
constexpr size_t WS_WOUTT = WS_WINT + (size_t)NL * DINP * D * 2;
constexpr size_t WS_XQT = WS_WOUTT + (size_t)NL * D * D * 2;
constexpr size_t WS_XKVT = WS_XQT + (size_t)NL * D * D * 2;
constexpr size_t WS_XOT = WS_XKVT + (size_t)NL * 2 * D * D * 2;
constexpr size_t WS_W13T = WS_XOT + (size_t)NL * D * D * 2;
constexpr size_t WS_W2T = WS_W13T + (size_t)2 * 2 * FF * D * 2;
constexpr size_t WS_E13T = WS_W2T + (size_t)2 * D * FF * 2;
constexpr size_t WS_E2T = WS_E13T + (size_t)16 * 2 * FE * D * 2;
constexpr size_t WS_XB = WS_E2T + (size_t)16 * D * FE * 2;
constexpr size_t WS_VBUF = WS_XB + (size_t)M * D * 2;
constexpr size_t WS_Z = WS_VBUF + (size_t)M * D * 4;
constexpr size_t WS_Y = WS_Z + (size_t)M * DINP * 2;
constexpr size_t WS_Q = WS_Y + (size_t)M * D * 2;
constexpr size_t WS_H = WS_Q + (size_t)M * D * 2;
constexpr size_t WS_END = WS_H + (size_t)MOE_ROWS * FE * 2;
static_assert((size_t)MOE_ROWS * D * 4 <= WS_H - WS_VBUF, "FS overlay");
static_assert((size_t)MOE_ROWS * D * 2 <= WS_Q - WS_Z, "XG overlay");

constexpr int SCR_BYTES = 153600;
constexpr int LDSCTL_OFF = SCR_BYTES;
constexpr int LDS_BYTES = 155648;

__device__ __forceinline__ float bf2f(unsigned v) { return __uint_as_float(v << 16); }
__device__ __forceinline__ unsigned f2bf(float f) { unsigned u = __builtin_bit_cast(unsigned, f); return (u + 0x7fffu + ((u >> 16) & 1u)) >> 16; }
__device__ __forceinline__ unsigned pk2(float lo, float hi) { return f2bf(lo) | (f2bf(hi) << 16); }
__device__ __forceinline__ float lo16(unsigned w) { return __uint_as_float(w << 16); }
__device__ __forceinline__ float hi16(unsigned w) { return __uint_as_float(w & 0xffff0000u); }
__device__ __forceinline__ float sigmoidf_(float x) { return 1.0f / (1.0f + __expf(-x)); }
__device__ __forceinline__ float siluf_(float x) { return x / (1.0f + __expf(-x)); }
__device__ __forceinline__ float gelu_tanh(float x) { const float u = 0.7978845608028654f * (x + 0.044715f * x * x * x); return x / (1.0f + __expf(-2.0f * u)); }
__device__ __forceinline__ float wave_sum(float v) {
#pragma unroll
    for (int o = 1; o < 64; o <<= 1) v += __shfl_xor(v, o);
    return v;
}
__device__ __forceinline__ float wave_max(float v) {
#pragma unroll
    for (int o = 1; o < 64; o <<= 1) v = fmaxf(v, __shfl_xor(v, o));
    return v;
}
__device__ __forceinline__ f32x4 mfma16(bf16x8 a, bf16x8 b, f32x4 c) { return __builtin_amdgcn_mfma_f32_16x16x32_bf16(a, b, c, 0, 0, 0); }
typedef __bf16 bf16x2_t __attribute__((ext_vector_type(2)));
__device__ __forceinline__ float dot2bf(unsigned a, unsigned b, float c) { return __builtin_amdgcn_fdot2_f32_bf16(__builtin_bit_cast(bf16x2_t, a), __builtin_bit_cast(bf16x2_t, b), c, false); }
#define LDS_WAIT() asm volatile("s_waitcnt lgkmcnt(0)" ::: "memory")

namespace pg8 {
#define PG8_LAS __attribute__((address_space(3)))
typedef unsigned short bf16_t;
typedef short bf16x8 __attribute__((ext_vector_type(8)));
typedef float f32x4 __attribute__((ext_vector_type(4)));
typedef unsigned u32x4 __attribute__((ext_vector_type(4)));
constexpr int BM = 256, BK = 64, HALF = 128, HTB = HALF * BK * 2  , STAGE_BYTES = 8 * HTB, NXCD = 8, WGM = 8;

__host__ __device__ __forceinline__ int lds_byte(int r, int c) { const int st = (r >> 4) * 2 + (c >> 5), rr = r & 15, cc = c & 31, ob = rr * 64 + cc * 2; return st * 1024 + (ob ^ (((ob >> 9) & 1) << 5)); }
__host__ __device__ __forceinline__ void stage_rc(int b, int& R, int& C) { const int st = b / 1024, sb = b % 1024, swz = sb ^ (((sb >> 9) & 1) << 5); R = (st >> 1) * 16 + swz / 64; C = (st & 1) * 32 + (swz % 64) / 2; }
__host__ __device__ __forceinline__ int perm32(int rho) { const int n = rho >> 4, i = rho & 15; return 8 * (i >> 2) + 4 * n + (i & 3); }

struct Unit { int pm, pn; };
struct Gemm { const bf16_t* A; const bf16_t* Bt; int M, N, K; };

struct StaticOrder {
    int nM, nN, nwg, G, c;
    __host__ __device__ void init(int M, int N, int G_, int c_) { nM = M / BM; nN = N / BM; nwg = nM * nN; G = G_; c = c_; }
    __host__ __device__ bool next(int i, Unit& u) const {
        const long L = (long)i * G + c; if (L >= nwg) return false;
        int wgid = (int)L; { const int q = nwg / NXCD, r = nwg % NXCD, xcd = wgid % NXCD, off = wgid / NXCD; wgid = (xcd < r ? xcd * (q + 1) : r * (q + 1) + (xcd - r) * q) + off; }
        const int nig = WGM * nN, gid = wgid / nig, fm = gid * WGM, gsz = (nM - fm) < WGM ? (nM - fm) : WGM;
        u.pm = fm + ((wgid % nig) % gsz); u.pn = (wgid % nig) / gsz; return true;
    }
    __device__ __forceinline__ void a_ready(const Unit&) const {}
    __device__ __forceinline__ void done(const Unit&) const {}
    __device__ __forceinline__ const char* bbase(const Gemm& g, const Unit&) const { return (const char*)g.Bt; }
};

template <class Epi, class Sched, bool ALIGN_EPI = false, bool SP2 = false>
__device__ __forceinline__ void gemm_phase(PG8_LAS unsigned char* lds, const Gemm g, const Sched& S, const Epi& E) {
    int tid_l = threadIdx.x; asm volatile("" : "+v"(tid_l));
    const int tid = tid_l, wid = __builtin_amdgcn_readfirstlane(tid >> 6), lane = tid & 63, wr = wid >> 2, wc = wid & 3, fr = lane & 15, fq = lane >> 4;
    const int K = g.K, nt = K / BK;
    unsigned voffA[2], voffB[2];
#pragma unroll
    for (int i = 0; i < 2; ++i) { int R, C; stage_rc(tid * 16 + i * 8192, R, C); const int Rb = Epi::PERM ? ((R & ~31) + perm32(R & 31)) : R;
        voffA[i] = (unsigned)(R * K + C) * 2u; voffB[i] = (unsigned)(Rb * K + C) * 2u; }
    const size_t kstep = (size_t)(BK * 2);
    const size_t hstep = (size_t)HALF * K * 2;
    const size_t tstep = 2 * hstep;
    const unsigned ldsw = (unsigned)wid * 1024u;
    const int aoff = lds_byte(wr * 64 + fr, fq * 8), boff = lds_byte(wc * 32 + fr, fq * 8);
#define PG8_SA(b, h) (((b) * 2 + (h)) * HTB)
#define PG8_SB(b, h) ((4 + (b) * 2 + (h)) * HTB)
#define PG8_STAGE(bufoff, gbase, voff) do { _Pragma("unroll") for (int _i = 0; _i < 2; ++_i) \
        __builtin_amdgcn_global_load_lds((const unsigned*)((const char*)(gbase) + (voff)[_i]), (PG8_LAS unsigned*)(lds + (bufoff) + ldsw + _i * 8192), 16, 0, 0); } while (0)
#define PG8_LDA(dst, b, h) do { _Pragma("unroll") for (int m = 0; m < 4; ++m) _Pragma("unroll") for (int k = 0; k < 2; ++k) dst[m][k] = *(const PG8_LAS bf16x8*)(lds + PG8_SA(b, h) + aoff + m * 2048 + k * 1024); } while (0)
#define PG8_LDB(dst, b, h) do { _Pragma("unroll") for (int n = 0; n < 2; ++n) _Pragma("unroll") for (int k = 0; k < 2; ++k) dst[n][k] = *(const PG8_LAS bf16x8*)(lds + PG8_SB(b, h) + boff + n * 2048 + k * 1024); } while (0)
#define PG8_MMA(ai, bj, At, Bt) do { __builtin_amdgcn_s_setprio(1); _Pragma("unroll") for (int m = 0; m < 4; ++m) _Pragma("unroll") for (int n = 0; n < 2; ++n) _Pragma("unroll") for (int k = 0; k < 2; ++k) \
        acc[ai][bj][m][n] = __builtin_amdgcn_mfma_f32_16x16x32_bf16(Bt[n][k], At[m][k], acc[ai][bj][m][n], 0, 0, 0); __builtin_amdgcn_s_setprio(0); } while (0)
#define PG8_WAIT_V(n) asm volatile("s_waitcnt vmcnt(" #n ")" ::: "memory")
#define PG8_WAIT_L(n) asm volatile("s_waitcnt lgkmcnt(" #n ")" ::: "memory")
#define PG8_BAR __builtin_amdgcn_s_barrier()
#define PG8_SCHED __builtin_amdgcn_sched_barrier(0)
    Unit cur, nxt; int ui = 0;
    if (!S.next(0, cur)) return;
    f32x4 acc[2][2][4][2];
#pragma unroll
    for (int a = 0; a < 2; ++a)
#pragma unroll
        for (int b = 0; b < 2; ++b)
#pragma unroll
            for (int m = 0; m < 4; ++m)
#pragma unroll
                for (int n = 0; n < 2; ++n) acc[a][b][m][n] = (f32x4){0.f, 0.f, 0.f, 0.f};
    bf16x8 At[4][2], B0[2][2], B1[2][2];
    const char* cA = (const char*)g.A + (size_t)cur.pm * tstep; const char* cB = S.bbase(g, cur) + (size_t)cur.pn * tstep;
    S.a_ready(cur);
    if constexpr (SP2) {
        PG8_STAGE(PG8_SB(0, 0), cB, voffB); PG8_STAGE(PG8_SB(0, 1), cB + hstep, voffB); PG8_STAGE(PG8_SA(0, 0), cA, voffA); PG8_STAGE(PG8_SA(0, 1), cA + hstep, voffA);
        if (wr == 1) PG8_BAR;
        PG8_WAIT_V(2); PG8_BAR;
        PG8_STAGE(PG8_SB(1, 0), cB + kstep, voffB); PG8_STAGE(PG8_SA(1, 0), cA + kstep, voffA); PG8_STAGE(PG8_SB(1, 1), cB + hstep + kstep, voffB);
        PG8_WAIT_V(6); PG8_BAR;
    } else {
        PG8_STAGE(PG8_SB(0, 0), cB, voffB); PG8_STAGE(PG8_SA(0, 0), cA, voffA); PG8_STAGE(PG8_SB(0, 1), cB + hstep, voffB); PG8_STAGE(PG8_SA(0, 1), cA + hstep, voffA);
        if (wr == 1) PG8_BAR;
        PG8_WAIT_V(4); PG8_BAR;
        PG8_STAGE(PG8_SB(1, 0), cB + kstep, voffB); PG8_STAGE(PG8_SA(1, 0), cA + kstep, voffA); PG8_STAGE(PG8_SB(1, 1), cB + hstep + kstep, voffB);
        PG8_WAIT_V(6); PG8_BAR;
    }
    for (;;) {
        const bool has_next = S.next(ui + 1, nxt);
        const char* nA = has_next ? (const char*)g.A + (size_t)nxt.pm * tstep : cA; const char* nB = has_next ? S.bbase(g, nxt) + (size_t)nxt.pn * tstep : cB;
        for (int t = 0; t < nt; t += 2) {
            const bool last = (t == nt - 2);
            const char* a1 = cA + (size_t)(t + 1) * kstep;
            const char* a2 = last ? nA : cA + (size_t)(t + 2) * kstep; const char* b2 = last ? nB : cB + (size_t)(t + 2) * kstep;
            const char* a3 = a2 + kstep; const char* b3 = b2 + kstep;
            if (last && has_next) S.a_ready(nxt);
            if constexpr (SP2) {
            PG8_LDB(B0, 0, 0); PG8_LDB(B1, 0, 1); PG8_SCHED; PG8_LDA(At, 0, 0); PG8_STAGE(PG8_SA(1, 1), a1 + hstep, voffA);
            PG8_WAIT_V(8); PG8_WAIT_L(0); PG8_BAR; PG8_MMA(0, 0, At, B0); PG8_MMA(0, 1, At, B1); PG8_BAR; PG8_SCHED;
            PG8_LDA(At, 0, 1); PG8_STAGE(PG8_SB(0, 0), b2, voffB); PG8_STAGE(PG8_SB(0, 1), b2 + hstep, voffB); PG8_STAGE(PG8_SA(0, 0), a2, voffA);
            PG8_WAIT_V(8); PG8_WAIT_L(0); PG8_BAR; PG8_MMA(1, 0, At, B0); PG8_MMA(1, 1, At, B1); PG8_BAR; PG8_SCHED;
            PG8_LDB(B0, 1, 0); PG8_LDB(B1, 1, 1); PG8_SCHED; PG8_LDA(At, 1, 0); PG8_STAGE(PG8_SA(0, 1), a2 + hstep, voffA);
            PG8_WAIT_V(8); PG8_WAIT_L(0); PG8_BAR; PG8_MMA(0, 0, At, B0); PG8_MMA(0, 1, At, B1); PG8_BAR; PG8_SCHED;
            PG8_LDA(At, 1, 1); PG8_STAGE(PG8_SB(1, 0), b3, voffB); PG8_STAGE(PG8_SB(1, 1), b3 + hstep, voffB); PG8_STAGE(PG8_SA(1, 0), a3, voffA);
            PG8_WAIT_V(8); PG8_WAIT_L(0); PG8_BAR; PG8_MMA(1, 0, At, B0); PG8_MMA(1, 1, At, B1); PG8_BAR; PG8_SCHED;
            } else {
            PG8_LDB(B0, 0, 0); PG8_SCHED; PG8_LDA(At, 0, 0); PG8_STAGE(PG8_SA(1, 1), a1 + hstep, voffA);
            PG8_WAIT_L(8); PG8_BAR; PG8_WAIT_L(0); PG8_MMA(0, 0, At, B0); PG8_BAR; PG8_SCHED;
            PG8_LDB(B1, 0, 1); PG8_STAGE(PG8_SB(0, 0), b2, voffB);
            PG8_BAR; PG8_WAIT_L(0); PG8_MMA(0, 1, At, B1); PG8_BAR;
            PG8_LDA(At, 0, 1); PG8_STAGE(PG8_SA(0, 0), a2, voffA);
            PG8_BAR; PG8_WAIT_L(0); PG8_MMA(1, 0, At, B0); PG8_BAR; PG8_SCHED;
            PG8_STAGE(PG8_SB(0, 1), b2 + hstep, voffB);
            PG8_WAIT_V(6); PG8_BAR; PG8_MMA(1, 1, At, B1); PG8_BAR;
            PG8_LDB(B0, 1, 0); PG8_SCHED; PG8_LDA(At, 1, 0); PG8_STAGE(PG8_SA(0, 1), a2 + hstep, voffA);
            PG8_WAIT_L(8); PG8_BAR; PG8_WAIT_L(0); PG8_MMA(0, 0, At, B0); PG8_BAR; PG8_SCHED;
            PG8_LDB(B1, 1, 1); PG8_STAGE(PG8_SB(1, 0), b3, voffB);
            PG8_BAR; PG8_WAIT_L(0); PG8_MMA(0, 1, At, B1); PG8_BAR;
            PG8_LDA(At, 1, 1); PG8_STAGE(PG8_SA(1, 0), a3, voffA);
            PG8_BAR; PG8_WAIT_L(0); PG8_MMA(1, 0, At, B0); PG8_BAR; PG8_SCHED;
            PG8_STAGE(PG8_SB(1, 1), b3 + hstep, voffB);
            PG8_WAIT_V(6); PG8_BAR; PG8_MMA(1, 1, At, B1); PG8_BAR;
            }
        }
        if constexpr (ALIGN_EPI) { if (wr == 0) PG8_BAR; }
        if constexpr (!Epi::AFTER_DRAIN) { E(acc, cur, wr, wc, fr, fq); S.done(cur); }
        if (!has_next) break;
#pragma unroll
        for (int a = 0; a < 2; ++a)
#pragma unroll
            for (int b = 0; b < 2; ++b)
#pragma unroll
                for (int m = 0; m < 4; ++m)
#pragma unroll
                    for (int n = 0; n < 2; ++n) acc[a][b][m][n] = (f32x4){0.f, 0.f, 0.f, 0.f};
        cur = nxt; cA = nA; cB = nB; ++ui;
        if constexpr (ALIGN_EPI) { if (wr == 1) PG8_BAR; }
    }
    PG8_WAIT_V(0);
    if constexpr (!ALIGN_EPI) { if (wr == 0) PG8_BAR; }
    PG8_BAR;
    if constexpr (Epi::AFTER_DRAIN) { E.fused(acc, cur, wr, wc, fr, fq, lds, wid, lane); S.done(cur); }
#undef PG8_SA
#undef PG8_SB
#undef PG8_STAGE
#undef PG8_LDA
#undef PG8_LDB
#undef PG8_MMA
#undef PG8_WAIT_V
#undef PG8_WAIT_L
#undef PG8_BAR
#undef PG8_SCHED
}
}

namespace pg8 {
__device__ __forceinline__ unsigned cvt_pk_bf16(float lo, float hi) { unsigned r; asm volatile("v_cvt_pk_bf16_f32 %0, %1, %2" : "=v"(r) : "v"(lo), "v"(hi)); return r; }

struct EpiBf16 {
    static constexpr bool PERM = true, AFTER_DRAIN = false;
    bf16_t* O; int ldc;
    __device__ __forceinline__ void operator()(const f32x4 (&acc)[2][2][4][2], const Unit& u, int wr, int wc, int fr, int fq) const {
        const int row0 = u.pm * BM + wr * 64 + fr; const int col0 = u.pn * BM + wc * 32 + 8 * fq;
#pragma unroll
        for (int ai = 0; ai < 2; ++ai)
#pragma unroll
            for (int m = 0; m < 4; ++m) { bf16_t* rowp = O + (size_t)(row0 + ai * HALF + m * 16) * ldc + col0;
#pragma unroll
                for (int bj = 0; bj < 2; ++bj) { const f32x4 v0 = acc[ai][bj][m][0], v1 = acc[ai][bj][m][1];
                    u32x4 w; w.x = cvt_pk_bf16(v0[0], v0[1]); w.y = cvt_pk_bf16(v0[2], v0[3]); w.z = cvt_pk_bf16(v1[0], v1[1]); w.w = cvt_pk_bf16(v1[2], v1[3]);
                    *(u32x4*)(rowp + bj * HALF) = w; } }
    }
};
struct EpiKV {
    static constexpr bool PERM = true, AFTER_DRAIN = false;
    bf16_t* Kd; bf16_t* VTd;
    __device__ __forceinline__ void operator()(const f32x4 (&acc)[2][2][4][2], const Unit& u, int wr, int wc, int fr, int fq) const {
        const int row0 = u.pm * BM + wr * 64 + fr; const int col0 = u.pn * BM + wc * 32 + 8 * fq;
#pragma unroll
        for (int ai = 0; ai < 2; ++ai)
#pragma unroll
            for (int m = 0; m < 4; ++m) { const int row = row0 + ai * HALF + m * 16;
#pragma unroll
                for (int bj = 0; bj < 2; ++bj) { const f32x4 v0 = acc[ai][bj][m][0], v1 = acc[ai][bj][m][1]; const int col = col0 + bj * HALF;
                    u32x4 w; w.x = cvt_pk_bf16(v0[0], v0[1]); w.y = cvt_pk_bf16(v0[2], v0[3]); w.z = cvt_pk_bf16(v1[0], v1[1]); w.w = cvt_pk_bf16(v1[2], v1[3]);
                    if (col < 1024) { *(u32x4*)(Kd + (size_t)row * 1024 + col) = w; }
                    else { const int c = col - 1024, b = row >> 8, mm = row & 255; bf16_t* p = VTd + ((size_t)(b * 1024 + c)) * 256 + mm;
                        p[0 * 256] = (bf16_t)(w.x & 0xffffu); p[1 * 256] = (bf16_t)(w.x >> 16); p[2 * 256] = (bf16_t)(w.y & 0xffffu); p[3 * 256] = (bf16_t)(w.y >> 16);
                        p[4 * 256] = (bf16_t)(w.z & 0xffffu); p[5 * 256] = (bf16_t)(w.z >> 16); p[6 * 256] = (bf16_t)(w.w & 0xffffu); p[7 * 256] = (bf16_t)(w.w >> 16); } } }
    }
};
struct EpiF32Res {
    static constexpr bool PERM = false, AFTER_DRAIN = false;
    float* out; const float* res; int ldc; float alpha;
    __device__ __forceinline__ void operator()(const f32x4 (&acc)[2][2][4][2], const Unit& u, int wr, int wc, int fr, int fq) const {
        const int row0 = u.pm * BM + wr * 64 + fr; const int col0 = u.pn * BM + wc * 32 + 4 * fq;
#pragma unroll
        for (int ai = 0; ai < 2; ++ai)
#pragma unroll
            for (int m = 0; m < 4; ++m) { const size_t off = (size_t)(row0 + ai * HALF + m * 16) * ldc + col0;
#pragma unroll
                for (int bj = 0; bj < 2; ++bj)
#pragma unroll
                    for (int n = 0; n < 2; ++n) { f32x4 v = acc[ai][bj][m][n]; const size_t o2 = off + bj * HALF + n * 16;
                        if (res) { const f32x4 r = *(const f32x4*)(res + o2); v = v + r * alpha; }
                        *(f32x4*)(out + o2) = v; } }
    }
};
struct EpiSwiglu {
    static constexpr bool PERM = true, AFTER_DRAIN = false;
    bf16_t* H; int ldh;
    __device__ __forceinline__ void operator()(const f32x4 (&acc)[2][2][4][2], const Unit& u, int wr, int wc, int fr, int fq) const {
        const int row0 = u.pm * BM + wr * 64 + fr; const int col0 = u.pn * BM + wc * 32 + 8 * fq;
#pragma unroll
        for (int ai = 0; ai < 2; ++ai)
#pragma unroll
            for (int m = 0; m < 4; ++m) { bf16_t* rowp = H + (size_t)(row0 + ai * HALF + m * 16) * ldh;
#pragma unroll
                for (int bj = 0; bj < 2; ++bj) { const f32x4 v0 = acc[ai][bj][m][0], v1 = acc[ai][bj][m][1];
                    const float h0 = v0[0] / (1.0f + __expf(-v0[0])) * v0[1], h1 = v0[2] / (1.0f + __expf(-v0[2])) * v0[3];
                    const float h2 = v1[0] / (1.0f + __expf(-v1[0])) * v1[1], h3 = v1[2] / (1.0f + __expf(-v1[2])) * v1[3];
                    u32x2 w; w.x = cvt_pk_bf16(h0, h1); w.y = cvt_pk_bf16(h2, h3);
                    *(u32x2*)(rowp + ((col0 + bj * HALF) >> 1)) = w; } }
    }
};
struct GroupedOrder : StaticOrder {
    int pend[8]; size_t estride;
    __device__ __forceinline__ const char* bbase(const Gemm& g, const Unit& u) const {
        int e = 0;
#pragma unroll
        for (int k = 0; k < 7; ++k) e += (u.pm >= pend[k]) ? 1 : 0;
        return (const char*)g.Bt + (size_t)e * estride;
    }
};
}
#define XB_TMO      128
#define XB_XCNT(j)  (256  + 64 * (j))
#define XB_XSUB(j)  (1280 + 64 * (j))
#define XB_XGEN(j)  (2304 + 64 * (j))
#define XB_TOP      3328
#define XB_TOPGEN   3392
#define XCD_BAR_WORDS 3456
#define XB_SPIN_CAP (1u << 18)

__device__ __forceinline__ unsigned xb_ld(unsigned* p)              { return __hip_atomic_load(p, __ATOMIC_RELAXED, __HIP_MEMORY_SCOPE_AGENT); }
__device__ __forceinline__ unsigned xb_add(unsigned* p, unsigned v) { return __hip_atomic_fetch_add(p, v, __ATOMIC_RELAXED, __HIP_MEMORY_SCOPE_AGENT); }
__device__ __forceinline__ unsigned xb_xcc_id() { return (unsigned)__builtin_amdgcn_s_getreg((3 << 11) | 20) & 0xFu; }
#define XB_SPIN(cond, bar) do { unsigned _sp = 0; while (cond) { __builtin_amdgcn_s_sleep(1); \
    if ((++_sp & 255u) == 0u) { if (xb_ld(&(bar)[XB_TMO])) break; if (_sp > XB_SPIN_CAP) { atomicAdd(&(bar)[XB_TMO], 1u); break; } } } } while (0)

struct XcdBarrier {
    unsigned* bar; unsigned x;
    volatile LAS unsigned* st;
};

__device__ __forceinline__ XcdBarrier xcd_barrier_post(unsigned* bar, volatile LAS unsigned* st) {
    XcdBarrier b; b.bar = bar; b.x = xb_xcc_id(); b.st = st;
    if (threadIdx.x == 0) (void)xb_add(&bar[XB_XCNT(b.x)], 1u);
    return b;
}
__device__ __forceinline__ void xcd_barrier_complete(unsigned* bar, unsigned x, unsigned& nloc, unsigned& nx) {
    const unsigned G = gridDim.x * gridDim.y * gridDim.z;
    unsigned sum, cnt, mine, sp = 0u;
    for (;;) {
        sum = 0u; cnt = 0u; mine = 0u;
#pragma unroll
        for (unsigned j = 0; j < 16; ++j) { const unsigned c = xb_ld(&bar[XB_XCNT(j)]); sum += c; cnt += (c > 0u) ? 1u : 0u; mine = (j == x) ? c : mine; }
        if (sum == G) break;
        __builtin_amdgcn_s_sleep(1);
        if ((++sp & 255u) == 0u) { if (xb_ld(&bar[XB_TMO])) break; if (sp > XB_SPIN_CAP) { atomicAdd(&bar[XB_TMO], 1u); break; } }
    }
    nloc = mine > 0u ? mine : 1u; nx = cnt > 0u ? cnt : 1u;
}

__device__ __forceinline__ void xcd_barrier(const XcdBarrier& b) {
    asm volatile("s_waitcnt vmcnt(0)" ::: "memory");
    __syncthreads();
    if (threadIdx.x == 0) {
        unsigned* bar = b.bar;
        __builtin_amdgcn_s_waitcnt(0);
        unsigned nloc = b.st[0], nx = b.st[1];
        if (nloc == 0u) { xcd_barrier_complete(bar, b.x, nloc, nx); b.st[0] = nloc; b.st[1] = nx; }
        const unsigned old = xb_add(&bar[XB_XSUB(b.x)], 1u);
        const unsigned gen = old / nloc;
        if (old + 1u == (gen + 1u) * nloc) {
            __builtin_amdgcn_fence(__ATOMIC_RELEASE, "agent");
            asm volatile("s_waitcnt vmcnt(0)" ::: "memory");
            const unsigned og = xb_add(&bar[XB_TOP], 1u);
            const unsigned tg = og / nx;
            if (og + 1u == (tg + 1u) * nx) xb_add(&bar[XB_TOPGEN], 1u);
            else XB_SPIN(xb_ld(&bar[XB_TOPGEN]) == tg, bar);
            __builtin_amdgcn_fence(__ATOMIC_ACQUIRE, "agent");
            xb_add(&bar[XB_XGEN(b.x)], 1u);
            asm volatile("s_waitcnt vmcnt(0)" ::: "memory");
        } else {
            XB_SPIN(xb_ld(&bar[XB_XGEN(b.x)]) == gen, bar);
            __builtin_amdgcn_fence(__ATOMIC_ACQUIRE, "agent");
            asm volatile("s_waitcnt vmcnt(0)" ::: "memory");
        }
    }
    __syncthreads();
}

struct Params { const float* in[35]; float* out; unsigned char* ws; int ph_lo, ph_hi, dbg, pad; };
enum { I_X = 0, I_MEM, I_WIN, I_POOLW, I_POOLS, I_PEK, I_KW1, I_KW2, I_PEV, I_VW1, I_VW2, I_SLNG, I_SLNB, I_SGUW, I_SGUB, I_CONVW, I_CONVB, I_CLNG, I_CLNB, I_CONVPW,
       I_WOUT, I_LN1G, I_LN1B, I_XQ, I_XKV, I_XO, I_LN2G, I_LN2B, I_W13, I_W2, I_ROUTER, I_E13, I_E2, I_LN3G, I_LN3B };

struct Ctx {
    const float* in[35];
    float* X;
    bf16 *XB, *Z, *Y, *Q, *H, *XG, *KC, *VC, *MEMB, *KMEM, *VTMEM, *VCT, *VSELT, *VWINT;
    bf16 *WINT, *WOUTT, *XQT, *XKVT, *XOT, *W13T, *W2T, *E13T, *E2T, *CW1T, *CW2T, *PWT, *POOLWT, *SGUWB;
    float *VBUF, *FS, *PEB, *TOKG;
    int *HIST, *META, *TOKPOS; unsigned* TOKINFO;
    int tid, lane, wid, bid, G;
};

struct MatDesc { const float* src; bf16* dst; int K, N, Npad, split; };
__device__ __forceinline__ void get_mat(const Ctx& C, int id, MatDesc& d) {
    d.split = 0;
    if (id < 56) {
        const int l = id / 14, k = id % 14;
        if (k == 0)      { d.src = C.in[I_WIN] + (size_t)l * D * DIN;  d.dst = C.WINT + (size_t)l * DINP * D;  d.K = D; d.N = DIN; d.Npad = DINP; }
        else if (k == 1) { d.src = C.in[I_WOUT] + (size_t)l * D * D;   d.dst = C.WOUTT + (size_t)l * D * D;    d.K = D; d.N = D; d.Npad = D; }
        else if (k == 2) { d.src = C.in[I_XQ] + (size_t)l * D * D;     d.dst = C.XQT + (size_t)l * D * D;      d.K = D; d.N = D; d.Npad = D; }
        else if (k == 3) { d.src = C.in[I_XKV] + (size_t)l * D * 2 * D; d.dst = C.XKVT + (size_t)l * 2 * D * D; d.K = D; d.N = 2 * D; d.Npad = 2 * D; }
        else if (k == 4) { d.src = C.in[I_XO] + (size_t)l * D * D;     d.dst = C.XOT + (size_t)l * D * D;      d.K = D; d.N = D; d.Npad = D; }
        else if (k == 5) { d.src = C.in[I_KW1] + (size_t)l * 2048 * 256; d.dst = C.CW1T + (size_t)(l * 2 + 0) * 256 * 2048; d.K = 2048; d.N = 256; d.Npad = 256; }
        else if (k == 6) { d.src = C.in[I_VW1] + (size_t)l * 2048 * 256; d.dst = C.CW1T + (size_t)(l * 2 + 1) * 256 * 2048; d.K = 2048; d.N = 256; d.Npad = 256; }
        else if (k == 7) { d.src = C.in[I_KW2] + (size_t)l * 256 * 64; d.dst = C.CW2T + (size_t)(l * 2 + 0) * 64 * 256; d.K = 256; d.N = 64; d.Npad = 64; }
        else if (k == 8) { d.src = C.in[I_VW2] + (size_t)l * 256 * 64; d.dst = C.CW2T + (size_t)(l * 2 + 1) * 64 * 256; d.K = 256; d.N = 64; d.Npad = 64; }
        else if (k == 9) { d.src = C.in[I_CONVPW] + (size_t)l * 256 * 256; d.dst = C.PWT + (size_t)l * 256 * 256; d.K = 256; d.N = 256; d.Npad = 256; }
        else { const int g = k - 10; d.src = C.in[I_POOLW] + (size_t)(l * 4 + g) * 64 * 64; d.dst = C.POOLWT + (size_t)(l * 4 + g) * 64 * 64; d.K = 64; d.N = 64; d.Npad = 64; }
    } else if (id < 60) {
        const int i = (id - 56) >> 1, w = (id - 56) & 1;
        if (w == 0) { d.src = C.in[I_W13] + (size_t)i * D * 2 * FF; d.dst = C.W13T + (size_t)i * 2 * FF * D; d.K = D; d.N = 2 * FF; d.Npad = 2 * FF; d.split = FF; }
        else        { d.src = C.in[I_W2] + (size_t)i * FF * D;      d.dst = C.W2T + (size_t)i * D * FF;      d.K = FF; d.N = D; d.Npad = D; }
    } else {
        const int j = id - 60, ie = j >> 1, w = j & 1;
        if (w == 0) { d.src = C.in[I_E13] + (size_t)ie * D * 2 * FE; d.dst = C.E13T + (size_t)ie * 2 * FE * D; d.K = D; d.N = 2 * FE; d.Npad = 2 * FE; d.split = FE; }
        else        { d.src = C.in[I_E2] + (size_t)ie * FE * D;      d.dst = C.E2T + (size_t)ie * D * FE;      d.K = FE; d.N = D; d.Npad = D; }
    }
}
__device__ __forceinline__ void transpose_item(const MatDesc& d, LAS float* scr, int item, int lane) {
    const int nblk = d.Npad / 32, kb = item / nblk, nb = item % nblk, k0 = 64 * kb, n0 = 32 * nb;
    const int ncol = n0 + (lane & 31); const bool ok = ncol < d.N;
#pragma unroll 8
    for (int i = 0; i < 32; ++i) { const int kk = 2 * i + (lane >> 5); scr[kk * 33 + (lane & 31)] = ok ? d.src[(size_t)(k0 + kk) * d.N + ncol] : 0.f; }
    LDS_WAIT();
    const int c = lane & 7;
#pragma unroll
    for (int j = 0; j < 4; ++j) { const int n = (lane >> 3) + 8 * j; const LAS float* s = scr + (8 * c) * 33 + n;
        u32x4 o; o.x = pk2(s[0 * 33], s[1 * 33]); o.y = pk2(s[2 * 33], s[3 * 33]); o.z = pk2(s[4 * 33], s[5 * 33]); o.w = pk2(s[6 * 33], s[7 * 33]);
        const int ng = n0 + n; const int drow = d.split ? (ng < d.split ? 2 * ng : 2 * (ng - d.split) + 1) : ng;
        *(u32x4*)(d.dst + (size_t)drow * d.K + k0 + 8 * c) = o; }
    LDS_WAIT();
}
__device__ __forceinline__ void p0_prologue(const Ctx& C, LAS unsigned char* lds) {
    LAS float* scr = (LAS float*)(lds + C.wid * 8704);
    const int gw = C.bid * NWAVES + C.wid, NGW = C.G * NWAVES;
    int start = 0;
    for (int id = 0; id < 92; ++id) {
        MatDesc d; get_mat(C, id, d);
        const int ntiles = (d.K / 64) * (d.Npad / 32);
        int first = gw - start; if (first < 0) first += NGW;
        for (int it = first; it < ntiles; it += NGW) transpose_item(d, scr, it, C.lane);
        start = (start + ntiles) % NGW;
    }
    const int gt = C.bid * NTHREADS + C.tid, NGT = C.G * NTHREADS;
    { const f32x4* xs = (const f32x4*)C.in[I_X]; u32x4* xd = (u32x4*)C.XB;
      for (int i = gt; i < M * D / 8; i += NGT) { const f32x4 a = xs[2 * i], b = xs[2 * i + 1]; u32x4 o; o.x = pk2(a[0], a[1]); o.y = pk2(a[2], a[3]); o.z = pk2(b[0], b[1]); o.w = pk2(b[2], b[3]); xd[i] = o; } }
    { const f32x4* xs = (const f32x4*)C.in[I_MEM]; u32x4* xd = (u32x4*)C.MEMB;
      for (int i = gt; i < NB * MEM * D / 8; i += NGT) { const f32x4 a = xs[2 * i], b = xs[2 * i + 1]; u32x4 o; o.x = pk2(a[0], a[1]); o.y = pk2(a[2], a[3]); o.z = pk2(b[0], b[1]); o.w = pk2(b[2], b[3]); xd[i] = o; } }
    { const f32x4* ws = (const f32x4*)C.in[I_SGUW]; u32x4* wd = (u32x4*)C.SGUWB;
      for (int i = gt; i < NL * 4 * 128 * 128 / 8; i += NGT) { const int j0 = (i & 15) * 8, ii = (i >> 4) & 127; const f32x4 a = ws[2 * i], b = ws[2 * i + 1];
          float v[8] = {a[0], a[1], a[2], a[3], b[0], b[1], b[2], b[3]};
#pragma unroll
          for (int e = 0; e < 8; ++e) v[e] = (j0 + e <= ii) ? v[e] : 0.f;
          u32x4 o; o.x = pk2(v[0], v[1]); o.y = pk2(v[2], v[3]); o.z = pk2(v[4], v[5]); o.w = pk2(v[6], v[7]); wd[i] = o; } }
    for (int o = gw; o < NL * 2 * 256; o += NGW) { const int n = o & 255, kv = (o >> 8) & 1, l = o >> 9;
        const float* pe = C.in[kv ? I_PEV : I_PEK] + (size_t)l * 2048; const float* w1 = C.in[kv ? I_VW1 : I_KW1] + (size_t)l * 2048 * 256;
        float s = 0.f;
        for (int k = C.lane; k < 2048; k += 64) s += pe[k] * w1[(size_t)k * 256 + n];
        s = wave_sum(s); if (C.lane == 0) C.PEB[o] = s; }
}

__device__ __forceinline__ void ln_phase(const Ctx& C, const float* src, const float* gam, const float* bet, int mode, const float* router, LAS unsigned char* lds) {
    LAS float* rwT = (LAS float*)lds;
    LAS int* te = (LAS int*)(lds + 32768);
    LAS float* tgl = (LAS float*)(lds + 32768 + 1024);
    if (router) { for (int i = C.tid; i < 8192; i += NTHREADS) rwT[(i & 7) * 1024 + (i >> 3)] = router[i]; __syncthreads(); }
    f32x4 g4[4], b4[4];
#pragma unroll
    for (int j = 0; j < 4; ++j) { g4[j] = *(const f32x4*)(gam + 256 * j + 4 * C.lane); b4[j] = *(const f32x4*)(bet + 256 * j + 4 * C.lane); }
    for (int tile = C.bid; tile < M / 128; tile += C.G) {
        for (int i = 0; i < 16; ++i) {
            const int tl = 16 * C.wid + i; const size_t row = (size_t)tile * 128 + tl;
            f32x4 v[4];
            if (mode == 0) {
#pragma unroll
                for (int j = 0; j < 4; ++j) v[j] = *(const f32x4*)(src + row * D + 256 * j + 4 * C.lane);
            } else {
                const int p0 = C.TOKPOS[2 * row], p1 = C.TOKPOS[2 * row + 1]; const float g0 = C.TOKG[2 * row], g1 = C.TOKG[2 * row + 1];
#pragma unroll
                for (int j = 0; j < 4; ++j) { const f32x4 x = *(const f32x4*)(C.X + row * D + 256 * j + 4 * C.lane);
                    const f32x4 a = *(const f32x4*)(C.FS + (size_t)p0 * D + 256 * j + 4 * C.lane), b = *(const f32x4*)(C.FS + (size_t)p1 * D + 256 * j + 4 * C.lane);
                    v[j] = x * ALPHA + a * g0 + b * g1; }
            }
            float s = 0.f;
#pragma unroll
            for (int j = 0; j < 4; ++j) s += (v[j][0] + v[j][1]) + (v[j][2] + v[j][3]);
            const float mean = wave_sum(s) * (1.f / D); float s2 = 0.f;
#pragma unroll
            for (int j = 0; j < 4; ++j) { v[j] = v[j] - mean; s2 += (v[j][0] * v[j][0] + v[j][1] * v[j][1]) + (v[j][2] * v[j][2] + v[j][3] * v[j][3]); }
            const float rstd = 1.0f / sqrtf(wave_sum(s2) * (1.f / D) + LN_EPS);
#pragma unroll
            for (int j = 0; j < 4; ++j) { v[j] = v[j] * rstd * g4[j] + b4[j];
                *(f32x4*)(C.X + row * D + 256 * j + 4 * C.lane) = v[j];
                u32x2 o; o.x = pk2(v[j][0], v[j][1]); o.y = pk2(v[j][2], v[j][3]); *(u32x2*)(C.XB + row * D + 256 * j + 4 * C.lane) = o; }
            if (router) {
                float lg[8];
#pragma unroll
                for (int ex = 0; ex < 8; ++ex) { float a = 0.f;
#pragma unroll
                    for (int j = 0; j < 4; ++j) { const f32x4 w = *(const LAS f32x4*)(rwT + ex * 1024 + 256 * j + 4 * C.lane); a += (v[j][0] * w[0] + v[j][1] * w[1]) + (v[j][2] * w[2] + v[j][3] * w[3]); }
                    lg[ex] = wave_sum(a); }
                int e0 = 0; float l0 = lg[0];
#pragma unroll
                for (int ex = 1; ex < 8; ++ex) if (lg[ex] > l0) { l0 = lg[ex]; e0 = ex; }
                int e1 = -1; float l1 = -INFINITY;
#pragma unroll
                for (int ex = 0; ex < 8; ++ex) if (ex != e0 && lg[ex] > l1) { l1 = lg[ex]; e1 = ex; }
                const float ed = __expf(l1 - l0), ga = 1.0f / (1.0f + ed), gb = ed * ga;
                if (C.lane == 0) { te[2 * tl] = e0; te[2 * tl + 1] = e1; tgl[2 * tl] = ga; tgl[2 * tl + 1] = gb; }
            }
        }
        if (router) {
            __syncthreads();
            if (C.wid == 0) {
                int run[8];
#pragma unroll
                for (int ex = 0; ex < 8; ++ex) run[ex] = 0;
                for (int rr = 0; rr < 4; ++rr) { const int a = 64 * rr + C.lane; const int e = te[a]; int rank = 0;
#pragma unroll
                    for (int ex = 0; ex < 8; ++ex) { const unsigned long long mk = __ballot(e == ex); if (e == ex) rank = run[ex] + __popcll(mk & ((1ull << C.lane) - 1ull)); run[ex] += __popcll(mk); }
                    C.TOKINFO[(size_t)tile * 256 + a] = (unsigned)e | ((unsigned)rank << 8); C.TOKG[(size_t)tile * 256 + a] = tgl[a]; }
#pragma unroll
                for (int ex = 0; ex < 8; ++ex) if (C.lane == ex) C.HIST[tile * 8 + ex] = run[ex];
            }
            __syncthreads();
        }
    }
}

struct ConvW { f32x4 w[31]; f32x4 cb, lg, lb; };
__device__ __forceinline__ void load_convw(const Ctx& C, int l, ConvW& cw) {
#pragma unroll
    for (int k = 0; k < 31; ++k) cw.w[k] = *(const f32x4*)(C.in[I_CONVW] + ((size_t)l * 31 + k) * 256 + 4 * C.lane);
    cw.cb = *(const f32x4*)(C.in[I_CONVB] + l * 256 + 4 * C.lane); cw.lg = *(const f32x4*)(C.in[I_CLNG] + l * 256 + 4 * C.lane); cw.lb = *(const f32x4*)(C.in[I_CLNB] + l * 256 + 4 * C.lane);
}
template <int WHICH>
__device__ __forceinline__ void mixers_tile(const Ctx& C, int l, int tb, LAS unsigned char* lds, const ConvW& cw) {
    const int tid = C.tid, wid = C.wid, lane = C.lane;
    const int b = tb >> 6, t0 = (tb & 63) << 7; const size_t R0 = (size_t)b * T + t0;
    const bf16* Zb = C.Z + (size_t)b * T * DINP;
    const int m16 = lane & 15, gq = lane >> 4, row = 16 * wid + m16;
    if constexpr ((WHICH & 1) != 0) {
        LAS bf16* Dl = (LAS bf16*)lds;
        for (int it = tid; it < 128 * 32; it += NTHREADS) {
            const int tl = it >> 5, c8 = it & 31, g = c8 >> 3, w = 2 << g, t = t0 + tl, n = (t + 1 < w) ? (t + 1) : w;
            float s[8], cur[8];
#pragma unroll
            for (int e = 0; e < 8; ++e) { s[e] = 0.f; cur[e] = 0.f; }
            for (int k = 0; k < n; ++k) {
                const u32x4 v = *(const u32x4*)(Zb + (size_t)(t - k) * DINP + C_POOL + 8 * c8);
                const float f[8] = {lo16(v.x), hi16(v.x), lo16(v.y), hi16(v.y), lo16(v.z), hi16(v.z), lo16(v.w), hi16(v.w)};
#pragma unroll
                for (int e = 0; e < 8; ++e) { s[e] += f[e]; if (k == 0) cur[e] = f[e]; }
            }
            const float inv = 1.0f / (float)n;
            u32x4 o; o.x = pk2(s[0] * inv - cur[0], s[1] * inv - cur[1]); o.y = pk2(s[2] * inv - cur[2], s[3] * inv - cur[3]);
            o.z = pk2(s[4] * inv - cur[4], s[5] * inv - cur[5]); o.w = pk2(s[6] * inv - cur[6], s[7] * inv - cur[7]);
            *(LAS u32x4*)(Dl + tl * 264 + 8 * c8) = o;
        }
        __syncthreads();
#pragma unroll
        for (int g = 0; g < 4; ++g) {
            bf16x8 a[2];
#pragma unroll
            for (int s = 0; s < 2; ++s) a[s] = *(const LAS bf16x8*)(Dl + row * 264 + g * 64 + 32 * s + 8 * gq);
#pragma unroll
            for (int nt = 0; nt < 4; ++nt) {
                f32x4 acc = {0.f, 0.f, 0.f, 0.f};
#pragma unroll
                for (int s = 0; s < 2; ++s) { const bf16x8 bfr = *(const bf16x8*)(C.POOLWT + ((size_t)((l * 4 + g) * 64 + 16 * nt + m16)) * 64 + 32 * s + 8 * gq); acc = mfma16(bfr, a[s], acc); }
                const int col = g * 64 + 16 * nt + 4 * gq;
                const f32x4 sc = *(const f32x4*)(C.in[I_POOLS] + l * 256 + col);
                u32x2 o; o.x = pk2(acc[0] * sc[0], acc[1] * sc[1]); o.y = pk2(acc[2] * sc[2], acc[3] * sc[3]);
                *(u32x2*)(C.Y + (R0 + row) * D + col) = o;
            }
        }
        __syncthreads();
    }
    if constexpr ((WHICH & 2) != 0) {
        LAS bf16* VnT = (LAS bf16*)lds;
        const f32x4 lg = *(const f32x4*)(C.in[I_SLNG] + l * 256 + 4 * lane), lb = *(const f32x4*)(C.in[I_SLNB] + l * 256 + 4 * lane);
#pragma unroll 1
        for (int i = 0; i < 16; ++i) {
            const int tl = 16 * wid + i;
            const u32x2 v = *(const u32x2*)(C.Z + (R0 + tl) * DINP + C_V + 4 * lane);
            const float x0 = gelu_tanh(lo16(v.x)), x1 = gelu_tanh(hi16(v.x)), x2 = gelu_tanh(lo16(v.y)), x3 = gelu_tanh(hi16(v.y));
            const float mean = wave_sum((x0 + x1) + (x2 + x3)) * (1.f / 256.f);
            const float d0 = x0 - mean, d1 = x1 - mean, d2 = x2 - mean, d3 = x3 - mean;
            const float rstd = 1.0f / sqrtf(wave_sum((d0 * d0 + d1 * d1) + (d2 * d2 + d3 * d3)) * (1.f / 256.f) + LN_EPS);
            VnT[(4 * lane + 0) * 136 + tl] = (bf16)f2bf(d0 * rstd * lg[0] + lb[0]); VnT[(4 * lane + 1) * 136 + tl] = (bf16)f2bf(d1 * rstd * lg[1] + lb[1]);
            VnT[(4 * lane + 2) * 136 + tl] = (bf16)f2bf(d2 * rstd * lg[2] + lb[2]); VnT[(4 * lane + 3) * 136 + tl] = (bf16)f2bf(d3 * rstd * lg[3] + lb[3]);
        }
        __syncthreads();
        const int ns = (wid >> 1) + 1;
#pragma unroll
        for (int g = 0; g < 4; ++g) {
            f32x4 acc[4];
#pragma unroll
            for (int nt = 0; nt < 4; ++nt) acc[nt] = (f32x4){0.f, 0.f, 0.f, 0.f};
#pragma unroll
            for (int s = 0; s < 4; ++s) if (s < ns) {
                const bf16x8 a = *(const bf16x8*)(C.SGUWB + ((size_t)((l * 4 + g) * 128 + row)) * 128 + 32 * s + 8 * gq);
#pragma unroll
                for (int nt = 0; nt < 4; ++nt) { const bf16x8 bfr = *(const LAS bf16x8*)(VnT + (g * 64 + 16 * nt + m16) * 136 + 32 * s + 8 * gq); acc[nt] = mfma16(bfr, a, acc[nt]); }
            }
            const float bs = C.in[I_SGUB][(l * 4 + g) * 128 + row];
#pragma unroll
            for (int nt = 0; nt < 4; ++nt) {
                const int col = g * 64 + 16 * nt + 4 * gq;
                const u32x2 uu = *(const u32x2*)(C.Z + (R0 + row) * DINP + C_U + col);
                const float u0 = gelu_tanh(lo16(uu.x)), u1 = gelu_tanh(hi16(uu.x)), u2 = gelu_tanh(lo16(uu.y)), u3 = gelu_tanh(hi16(uu.y));
                u32x2 o; o.x = pk2(u0 * (acc[nt][0] + bs), u1 * (acc[nt][1] + bs)); o.y = pk2(u2 * (acc[nt][2] + bs), u3 * (acc[nt][3] + bs));
                *(u32x2*)(C.Y + (R0 + row) * D + 512 + col) = o;
            }
        }
        __syncthreads();
    }
    if constexpr ((WHICH & 4) != 0) {
        LAS bf16* Hg = (LAS bf16*)lds;
        LAS unsigned char* Hn = lds + 158 * 528;
        for (int it = tid; it < 158 * 64; it += NTHREADS) {
            const int r = it >> 6, c4 = it & 63, t = t0 - 30 + r;
            u32x2 o; o.x = 0u; o.y = 0u;
            if (t >= 0) { const bf16* zr = Zb + (size_t)t * DINP; const u32x2 a = *(const u32x2*)(zr + C_CA + 4 * c4), gg = *(const u32x2*)(zr + C_CG + 4 * c4);
                o.x = pk2(lo16(a.x) * sigmoidf_(lo16(gg.x)), hi16(a.x) * sigmoidf_(hi16(gg.x))); o.y = pk2(lo16(a.y) * sigmoidf_(lo16(gg.y)), hi16(a.y) * sigmoidf_(hi16(gg.y))); }
            *(LAS u32x2*)(Hg + r * 264 + 4 * c4) = o;
        }
        __syncthreads();
        {
            const f32x4 cb = cw.cb, lg = cw.lg, lb = cw.lb;
#pragma unroll 1
            for (int i = 0; i < 16; ++i) {
                const int tl = 16 * wid + i;
                f32x4 acc = cb;
#pragma unroll
                for (int k = 0; k < 31; ++k) {
                    const u32x2 h = *(const LAS u32x2*)(Hg + (tl + k) * 264 + 4 * lane);
                    acc[0] += cw.w[k][0] * lo16(h.x); acc[1] += cw.w[k][1] * hi16(h.x); acc[2] += cw.w[k][2] * lo16(h.y); acc[3] += cw.w[k][3] * hi16(h.y); }
                const float mean = wave_sum((acc[0] + acc[1]) + (acc[2] + acc[3])) * (1.f / 256.f);
                const float d0 = acc[0] - mean, d1 = acc[1] - mean, d2 = acc[2] - mean, d3 = acc[3] - mean;
                const float rstd = 1.0f / sqrtf(wave_sum((d0 * d0 + d1 * d1) + (d2 * d2 + d3 * d3)) * (1.f / 256.f) + LN_EPS);
                const float y0 = siluf_(d0 * rstd * lg[0] + lb[0]), y1 = siluf_(d1 * rstd * lg[1] + lb[1]), y2 = siluf_(d2 * rstd * lg[2] + lb[2]), y3 = siluf_(d3 * rstd * lg[3] + lb[3]);
                u32x2 o; o.x = pk2(y0, y1); o.y = pk2(y2, y3);
                *(LAS u32x2*)(Hn + tl * 512 + (((lane >> 1) ^ (tl & 15)) << 4) + ((lane & 1) << 3)) = o;
            }
        }
        __syncthreads();
#pragma unroll 1
        for (int nh = 0; nh < 2; ++nh) {
            f32x4 acc[8];
#pragma unroll
            for (int nt = 0; nt < 8; ++nt) acc[nt] = (f32x4){0.f, 0.f, 0.f, 0.f};
            const bf16* pw = C.PWT + ((size_t)(l * 256 + 128 * nh + m16)) * 256 + 8 * gq;
#pragma unroll 1
            for (int s = 0; s < 8; ++s) {
                const bf16x8 a = *(const LAS bf16x8*)(Hn + row * 512 + (((4 * s + gq) ^ (row & 15)) << 4));
#pragma unroll
                for (int nt = 0; nt < 8; ++nt) { const bf16x8 bfr = *(const bf16x8*)(pw + (size_t)(16 * nt) * 256 + 32 * s); acc[nt] = mfma16(bfr, a, acc[nt]); }
            }
#pragma unroll
            for (int nt = 0; nt < 8; ++nt) { u32x2 o; o.x = pk2(acc[nt][0], acc[nt][1]); o.y = pk2(acc[nt][2], acc[nt][3]); *(u32x2*)(C.Y + (R0 + row) * D + 768 + 128 * nh + 16 * nt + 4 * gq) = o; }
        }
        __syncthreads();
    }
}
__device__ __forceinline__ void compress_item(const Ctx& C, int l, int it, LAS unsigned char* lds) {
    const int wid = C.wid, lane = C.lane;
    const int rt = it >> 1, kv = it & 1, m16 = lane & 15, gq = lane >> 4;
    const int cr = 16 * rt + m16, bb = cr >> 9, n = cr & 511, nn = n < 510 ? n : 510;
    const bf16* rowbase = C.Z + ((size_t)bb * T + 16 * nn) * DINP + (kv ? C_VCMP : C_KCMP);
    const bf16* w1t = C.CW1T + (size_t)(l * 2 + kv) * 256 * 2048;
    f32x4 acc[2]; acc[0] = (f32x4){0.f, 0.f, 0.f, 0.f}; acc[1] = acc[0];
#pragma unroll 4
    for (int s = 0; s < 64; ++s) {
        const bf16x8 a = *(const bf16x8*)(rowbase + (size_t)(s >> 1) * DINP + 32 * (s & 1) + 8 * gq);
#pragma unroll
        for (int nt = 0; nt < 2; ++nt) { const bf16x8 bfr = *(const bf16x8*)(w1t + (size_t)(32 * wid + 16 * nt + m16) * 2048 + 32 * s + 8 * gq); acc[nt] = mfma16(bfr, a, acc[nt]); }
    }
    LAS bf16* Hc = (LAS bf16*)lds;
#pragma unroll
    for (int nt = 0; nt < 2; ++nt) { const int col = 32 * wid + 16 * nt + 4 * gq; const f32x4 pb = *(const f32x4*)(C.PEB + (l * 2 + kv) * 256 + col);
        u32x2 o; o.x = pk2(gelu_tanh(acc[nt][0] + pb[0]), gelu_tanh(acc[nt][1] + pb[1])); o.y = pk2(gelu_tanh(acc[nt][2] + pb[2]), gelu_tanh(acc[nt][3] + pb[3]));
        *(LAS u32x2*)(Hc + m16 * 264 + col) = o; }
    __syncthreads();
    if (wid < 4) {
        const bf16* w2t = C.CW2T + (size_t)(l * 2 + kv) * 64 * 256;
        f32x4 a2 = {0.f, 0.f, 0.f, 0.f};
#pragma unroll
        for (int s = 0; s < 8; ++s) { const bf16x8 a = *(const LAS bf16x8*)(Hc + m16 * 264 + 32 * s + 8 * gq); const bf16x8 bfr = *(const bf16x8*)(w2t + (size_t)(16 * wid + m16) * 256 + 32 * s + 8 * gq); a2 = mfma16(bfr, a, a2); }
        { u32x2 o; o.x = pk2(a2[0], a2[1]); o.y = pk2(a2[2], a2[3]); if (n >= NCMP) { o.x = 0u; o.y = 0u; }
          *(u32x2*)((kv ? C.VC : C.KC) + (size_t)cr * 64 + 16 * wid + 4 * gq) = o;
          if (kv) { bf16* vt = C.VCT + ((size_t)bb * 64 + 16 * wid + 4 * gq) * 512 + n;
              vt[0] = (bf16)(o.x & 0xffffu); vt[512] = (bf16)(o.x >> 16); vt[1024] = (bf16)(o.y & 0xffffu); vt[1536] = (bf16)(o.y >> 16); } }
    }
    __syncthreads();
}

__device__ __forceinline__ void nsa_branch(const bf16* kb, const bf16* vb, int pitch, const LAS int* base, int nch, int vlo, int vhi, int chi,
                                           const LAS unsigned* qs, LAS float* sc, float (&o)[4], int lane) {
    float mx0 = -INFINITY, mx1 = -INFINITY, mx2 = -INFINITY, mx3 = -INFINITY;
#pragma unroll 1
    for (int i = 0; i < nch; ++i) {
        asm volatile("" ::: "memory");
        const int r = base[i] + lane; const bool valid = (r >= vlo) && (r <= vhi);
        const int rc = r < 0 ? 0 : (r > chi ? chi : r);
        const u32x4* kp = (const u32x4*)(kb + (size_t)rc * pitch);
        u32x4 kr[8];
#pragma unroll
        for (int c = 0; c < 8; ++c) kr[c] = kp[c];
        float a0 = 0.f, a1 = 0.f, a2 = 0.f, a3 = 0.f;
#pragma unroll
        for (int c = 0; c < 8; ++c) {
            const u32x4 q0 = *(const LAS u32x4*)(qs + 0 * 32 + 4 * c), q1 = *(const LAS u32x4*)(qs + 1 * 32 + 4 * c), q2 = *(const LAS u32x4*)(qs + 2 * 32 + 4 * c), q3 = *(const LAS u32x4*)(qs + 3 * 32 + 4 * c);
            a0 = dot2bf(kr[c].x, q0.x, a0); a0 = dot2bf(kr[c].y, q0.y, a0); a0 = dot2bf(kr[c].z, q0.z, a0); a0 = dot2bf(kr[c].w, q0.w, a0);
            a1 = dot2bf(kr[c].x, q1.x, a1); a1 = dot2bf(kr[c].y, q1.y, a1); a1 = dot2bf(kr[c].z, q1.z, a1); a1 = dot2bf(kr[c].w, q1.w, a1);
            a2 = dot2bf(kr[c].x, q2.x, a2); a2 = dot2bf(kr[c].y, q2.y, a2); a2 = dot2bf(kr[c].z, q2.z, a2); a2 = dot2bf(kr[c].w, q2.w, a2);
            a3 = dot2bf(kr[c].x, q3.x, a3); a3 = dot2bf(kr[c].y, q3.y, a3); a3 = dot2bf(kr[c].z, q3.z, a3); a3 = dot2bf(kr[c].w, q3.w, a3);
        }
        if (!valid) { a0 = -INFINITY; a1 = -INFINITY; a2 = -INFINITY; a3 = -INFINITY; }
        sc[0 * 1024 + 64 * i + lane] = a0; sc[1 * 1024 + 64 * i + lane] = a1; sc[2 * 1024 + 64 * i + lane] = a2; sc[3 * 1024 + 64 * i + lane] = a3;
        mx0 = fmaxf(mx0, a0); mx1 = fmaxf(mx1, a1); mx2 = fmaxf(mx2, a2); mx3 = fmaxf(mx3, a3);
    }
    mx0 = wave_max(mx0); mx1 = wave_max(mx1); mx2 = wave_max(mx2); mx3 = wave_max(mx3);
    float l0 = 0.f, l1 = 0.f, l2 = 0.f, l3 = 0.f;
    for (int i = 0; i < nch; ++i) {
        const float s0 = sc[0 * 1024 + 64 * i + lane], s1 = sc[1 * 1024 + 64 * i + lane], s2 = sc[2 * 1024 + 64 * i + lane], s3 = sc[3 * 1024 + 64 * i + lane];
        const float e0 = (s0 == -INFINITY) ? 0.f : __expf(s0 - mx0), e1 = (s1 == -INFINITY) ? 0.f : __expf(s1 - mx1), e2 = (s2 == -INFINITY) ? 0.f : __expf(s2 - mx2), e3 = (s3 == -INFINITY) ? 0.f : __expf(s3 - mx3);
        sc[0 * 1024 + 64 * i + lane] = e0; sc[1 * 1024 + 64 * i + lane] = e1; sc[2 * 1024 + 64 * i + lane] = e2; sc[3 * 1024 + 64 * i + lane] = e3;
        l0 += e0; l1 += e1; l2 += e2; l3 += e3;
    }
    l0 = wave_sum(l0); l1 = wave_sum(l1); l2 = wave_sum(l2); l3 = wave_sum(l3);
    const float i0 = l0 > 0.f ? 1.0f / l0 : 0.f, i1 = l1 > 0.f ? 1.0f / l1 : 0.f, i2 = l2 > 0.f ? 1.0f / l2 : 0.f, i3 = l3 > 0.f ? 1.0f / l3 : 0.f;
    for (int i = 0; i < nch; ++i) { sc[0 * 1024 + 64 * i + lane] *= i0; sc[1 * 1024 + 64 * i + lane] *= i1; sc[2 * 1024 + 64 * i + lane] *= i2; sc[3 * 1024 + 64 * i + lane] *= i3; }
    LDS_WAIT();
    float o0 = 0.f, o1 = 0.f, o2 = 0.f, o3 = 0.f;
    for (int i = 0; i < nch; ++i) {
        const int b0 = base[i];
        for (int j = 0; j < 64; j += 16) {
            float vv[16];
#pragma unroll
            for (int u = 0; u < 16; ++u) { int r = b0 + j + u; r = r < 0 ? 0 : (r > chi ? chi : r); vv[u] = bf2f((unsigned)vb[(size_t)r * pitch + lane]); }
#pragma unroll
            for (int u4 = 0; u4 < 4; ++u4) {
                const f32x4 p0 = *(const LAS f32x4*)(sc + 0 * 1024 + 64 * i + j + 4 * u4), p1 = *(const LAS f32x4*)(sc + 1 * 1024 + 64 * i + j + 4 * u4), p2 = *(const LAS f32x4*)(sc + 2 * 1024 + 64 * i + j + 4 * u4), p3 = *(const LAS f32x4*)(sc + 3 * 1024 + 64 * i + j + 4 * u4);
#pragma unroll
                for (int u = 0; u < 4; ++u) { const float v1 = vv[4 * u4 + u]; o0 += p0[u] * v1; o1 += p1[u] * v1; o2 += p2[u] * v1; o3 += p3[u] * v1; }
            }
        }
    }
    o[0] = o0; o[1] = o1; o[2] = o2; o[3] = o3;
}
template <bool CHECK>
__device__ __forceinline__ void nsa_query(const Ctx& C, int b, int t, LAS unsigned char* wl  , unsigned* errw) {
    const int lane = C.lane;
    LAS float* sc = (LAS float*)wl;
    LAS unsigned* qs = (LAS unsigned*)(wl + 16384);
    LAS int* base = (LAS int*)(wl + 16384 + 1024);
    const size_t row = (size_t)b * T + t;
    const bf16* zr = C.Z + row * DINP;
    const bf16* Zb = C.Z + (size_t)b * T * DINP;
    { const unsigned w2 = *(const unsigned*)(zr + C_Q + 2 * lane);
      const unsigned w3 = *(const unsigned*)(zr + C_Q + 128 + 2 * lane);
      qs[lane] = pk2(lo16(w2) * 0.125f, hi16(w2) * 0.125f); qs[64 + lane] = pk2(lo16(w3) * 0.125f, hi16(w3) * 0.125f); }
    const int nvalid = (t >= 31) ? ((t - 31) / 16 + 1) : 0;
    const int nchc = (nvalid + 63) >> 6;
    if (lane < 16) base[lane] = 64 * lane;
    LDS_WAIT();
    float oc[4];
    nsa_branch(C.KC + (size_t)b * 512 * 64, C.VC + (size_t)b * 512 * 64, 64, base, nchc, 0, nvalid - 1, 510, qs, sc, oc, lane);
    const int cur = t >> 6;
    float c0, c1;
    {
        float im0 = 0.f, im1 = 0.f;
#pragma unroll
        for (int rr = -1; rr <= 3; ++rr) { const int n0 = 4 * lane + rr, n1 = 4 * (lane + 64) + rr;
            if (n0 >= 0 && n0 < 64 * nchc) im0 += (sc[n0] + sc[1024 + n0]) + (sc[2048 + n0] + sc[3072 + n0]);
            if (n1 < 64 * nchc) im1 += (sc[n1] + sc[1024 + n1]) + (sc[2048 + n1] + sc[3072 + n1]); }
        const int m0 = lane, m1 = lane + 64;
        c0 = (m0 <= cur) ? (im0 + ((m0 == 0 || m0 == cur || m0 == cur - 1) ? 1e4f : 0.f)) : -1.0f;
        c1 = (m1 <= cur) ? (im1 + ((m1 == 0 || m1 == cur || m1 == cur - 1) ? 1e4f : 0.f)) : -1.0f;
    }
    LDS_WAIT();
    for (int r = 0; r < 16; ++r) {
        float bv; int bi;
        if (c0 >= c1) { bv = c0; bi = lane; } else { bv = c1; bi = lane + 64; }
#pragma unroll
        for (int off = 1; off < 64; off <<= 1) { const float ov = __shfl_xor(bv, off); const int oi = __shfl_xor(bi, off); if (ov > bv || (ov == bv && oi < bi)) { bv = ov; bi = oi; } }
        if (bi == lane) c0 = -2.0f; if (bi == lane + 64) c1 = -2.0f;
        if (lane == 0) base[r] = (bv >= 0.f) ? 64 * bi : -1000000;
    }
    LDS_WAIT();
    float os[4];
    nsa_branch(Zb + C_KSEL, Zb + C_VSEL, DINP, base, 16, 0, t, T - 1, qs, sc, os, lane);
    if (lane < 16) base[lane] = t - 511 + 64 * lane;
    LDS_WAIT();
    float ow[4];
    nsa_branch(Zb + C_KWIN, Zb + C_VWIN, DINP, base, 8, 0, t, T - 1, qs, sc, ow, lane);
    float yv[4];
#pragma unroll
    for (int h = 0; h < 4; ++h) {
        const float g0 = sigmoidf_(bf2f((unsigned)zr[C_GATE + 3 * h + 0])), g1 = sigmoidf_(bf2f((unsigned)zr[C_GATE + 3 * h + 1])), g2 = sigmoidf_(bf2f((unsigned)zr[C_GATE + 3 * h + 2]));
        yv[h] = g0 * oc[h] + g1 * os[h] + g2 * ow[h];
        if (!CHECK) C.Y[row * D + 256 + h * 64 + lane] = (bf16)f2bf(yv[h]);
    }
    if (CHECK) {
        const float rmax = wave_max(fmaxf(fmaxf(fabsf(yv[0]), fabsf(yv[1])), fmaxf(fabsf(yv[2]), fabsf(yv[3]))));
        int bad = 0;
#pragma unroll
        for (int h = 0; h < 4; ++h) { const float ym = bf2f((unsigned)C.Y[row * D + 256 + h * 64 + lane]); if (!(fabsf(ym - yv[h]) <= 0.03f * rmax + 2e-4f)) ++bad; }
        const float fb = wave_sum((float)bad);
        if (lane == 0) { atomicAdd(errw, (unsigned)fb); atomicAdd(errw + 64, 256u); }
    }
    LDS_WAIT();
}

__device__ __forceinline__ void xattn_unit(const Ctx& C, int l, int unit, LAS unsigned char* lds) {
    const int tid = C.tid, wid = C.wid, lane = C.lane;
    const int qt = unit & 63, bh = unit >> 6, b = bh >> 2, h = bh & 3;
    const int m16 = lane & 15, gq = lane >> 4;
    const size_t qrow = (size_t)b * T + qt * 128 + 16 * wid + m16;
    bf16x8 qf[8];
#pragma unroll
    for (int s = 0; s < 8; ++s) qf[s] = *(const bf16x8*)(C.Q + qrow * D + h * 256 + 32 * s + 8 * gq);
    const bf16* ksrc = C.KMEM + ((size_t)l * 1024 + b * 256) * 1024 + h * 256;
    for (int it = tid; it < 256 * 32; it += NTHREADS) { const int key = it >> 5, c = it & 31; *(LAS u32x4*)(lds + key * 528 + c * 16) = *(const u32x4*)(ksrc + (size_t)key * 1024 + 8 * c); }
    __syncthreads();
    f32x4 sacc[16];
#pragma unroll
    for (int kt = 0; kt < 16; ++kt) { sacc[kt] = (f32x4){0.f, 0.f, 0.f, 0.f};
#pragma unroll
        for (int s = 0; s < 8; ++s) { const bf16x8 a = *(const LAS bf16x8*)(lds + (16 * kt + m16) * 528 + 64 * s + 16 * gq); sacc[kt] = mfma16(a, qf[s], sacc[kt]); } }
    float mx = -INFINITY;
#pragma unroll
    for (int kt = 0; kt < 16; ++kt) mx = fmaxf(fmaxf(mx, fmaxf(sacc[kt][0], sacc[kt][1])), fmaxf(sacc[kt][2], sacc[kt][3]));
    mx = fmaxf(mx, __shfl_xor(mx, 16)); mx = fmaxf(mx, __shfl_xor(mx, 32));
    const float scl = 0.0625f * 1.4426950408889634f;
    float sum = 0.f;
#pragma unroll
    for (int kt = 0; kt < 16; ++kt)
#pragma unroll
        for (int r = 0; r < 4; ++r) { const float e = exp2f((sacc[kt][r] - mx) * scl); sacc[kt][r] = e; sum += e; }
    sum += __shfl_xor(sum, 16); sum += __shfl_xor(sum, 32);
    const float inv = 1.0f / sum;
    bf16x8 pf[8];
#pragma unroll
    for (int s2 = 0; s2 < 8; ++s2) { u32x4 w; w.x = pk2(sacc[2 * s2][0], sacc[2 * s2][1]); w.y = pk2(sacc[2 * s2][2], sacc[2 * s2][3]); w.z = pk2(sacc[2 * s2 + 1][0], sacc[2 * s2 + 1][1]); w.w = pk2(sacc[2 * s2 + 1][2], sacc[2 * s2 + 1][3]);
        pf[s2] = __builtin_bit_cast(bf16x8, w); }
    __syncthreads();
    const bf16* vsrc = C.VTMEM + ((size_t)l * 4096 + (b * 4 + h) * 256) * 256;
    for (int it = tid; it < 256 * 32; it += NTHREADS) { const int d = it >> 5, c = it & 31; *(LAS u32x4*)(lds + d * 528 + c * 16) = *(const u32x4*)(vsrc + (size_t)d * 256 + 8 * c); }
    __syncthreads();
#pragma unroll
    for (int dt = 0; dt < 16; ++dt) {
        f32x4 oacc = {0.f, 0.f, 0.f, 0.f};
#pragma unroll
        for (int s2 = 0; s2 < 8; ++s2) { const u32x2 lo = *(const LAS u32x2*)(lds + (16 * dt + m16) * 528 + 64 * s2 + 8 * gq), hi = *(const LAS u32x2*)(lds + (16 * dt + m16) * 528 + 64 * s2 + 32 + 8 * gq);
            u32x4 w; w.x = lo.x; w.y = lo.y; w.z = hi.x; w.w = hi.y; oacc = mfma16(__builtin_bit_cast(bf16x8, w), pf[s2], oacc); }
        u32x2 o; o.x = pk2(oacc[0] * inv, oacc[1] * inv); o.y = pk2(oacc[2] * inv, oacc[3] * inv);
        *(u32x2*)(C.Y + qrow * D + h * 256 + 16 * dt + 4 * gq) = o;
    }
    __syncthreads();
}

__device__ __forceinline__ void moe_gather(const Ctx& C, LAS unsigned char* lds) {
    LAS int* sh = (LAS int*)lds;
    for (int i = C.tid; i < 2048; i += NTHREADS) sh[i] = C.HIST[i];
    __syncthreads();
    if (C.tid < 8) { int c = 0; for (int tl = 0; tl < 256; ++tl) c += sh[tl * 8 + C.tid]; sh[2048 + C.tid] = c; }
    __syncthreads();
    if (C.tid == 0) { int acc = 0; for (int ex = 0; ex < 8; ++ex) { sh[2064 + ex] = acc; acc += (sh[2048 + ex] + 255) & ~255; if (C.bid == 0) C.META[ex] = acc >> 8; } if (C.bid == 0) C.META[8] = acc >> 8; }
    __syncthreads();
    for (int tile = C.bid; tile < 256; tile += C.G) {
        if (C.tid < 8) { int c = 0; for (int tl = 0; tl < tile; ++tl) c += sh[tl * 8 + C.tid]; sh[2056 + C.tid] = c; }
        __syncthreads();
        for (int i = 0; i < 32; ++i) {
            const int a = 32 * C.wid + i; const size_t ag = (size_t)tile * 256 + a;
            const unsigned info = C.TOKINFO[ag]; const int e = info & 255u, lr = info >> 8;
            const int dest = sh[2064 + e] + sh[2056 + e] + lr;
            if (C.lane == 0) C.TOKPOS[ag] = dest;
            const u32x4* s = (const u32x4*)(C.XB + ((size_t)tile * 128 + (a >> 1)) * D); u32x4* dd = (u32x4*)(C.XG + (size_t)dest * D);
            dd[C.lane] = s[C.lane]; dd[C.lane + 64] = s[C.lane + 64];
        }
        __syncthreads();
    }
    const int gw = C.bid * NWAVES + C.wid, NGW = C.G * NWAVES;
    for (int ex = 0; ex < 8; ++ex) { const int s0 = sh[2064 + ex] + sh[2048 + ex], e0 = sh[2064 + ex] + ((sh[2048 + ex] + 255) & ~255);
        for (int r = s0 + gw; r < e0; r += NGW) { u32x4* dd = (u32x4*)(C.XG + (size_t)r * D); const u32x4 z = {0u, 0u, 0u, 0u}; dd[C.lane] = z; dd[C.lane + 64] = z; } }
}

__device__ __forceinline__ void vt_tile(const Ctx& C, int tb) {
    const int b = tb >> 6, t0 = (tb & 63) << 7;
    for (int task = C.wid; task < 32; task += NWAVES) {
        const int arr = task >> 4, tg = task & 15; const int t = t0 + 8 * tg;
        const bf16* src = C.Z + ((size_t)b * T + t) * DINP + (arr ? C_VWIN : C_VSEL) + C.lane;
        unsigned v[8];
#pragma unroll
        for (int i = 0; i < 8; ++i) v[i] = src[(size_t)i * DINP];
        u32x4 o; o.x = v[0] | (v[1] << 16); o.y = v[2] | (v[3] << 16); o.z = v[4] | (v[5] << 16); o.w = v[6] | (v[7] << 16);
        *(u32x4*)((arr ? C.VWINT : C.VSELT) + ((size_t)b * 64 + C.lane) * T + t) = o;
    }
}

constexpr int NCT = 2, NQW = 4 * NCT;
struct NsaAcc { f32x4 o[NCT][4]; float m[NCT], l[NCT]; };
__device__ __forceinline__ void nsa_acc_reset(NsaAcc& A) {
#pragma unroll
    for (int ct = 0; ct < NCT; ++ct) { A.m[ct] = -INFINITY; A.l[ct] = 0.f;
#pragma unroll
        for (int dt = 0; dt < 4; ++dt) A.o[ct][dt] = (f32x4){0.f, 0.f, 0.f, 0.f}; }
}
#define NSA_SCL (0.125f * 1.4426950408889634f)
__device__ __forceinline__ void nsa_tile(const bf16* Kp, int kpitch, const bf16* VTp, int vpitch, const bf16x8 (&qf)[NCT][2], int k0,
                                         const int (&lo)[NCT], const int (&hi)[NCT], unsigned ctmask, NsaAcc& A, int c, int g) {
    bf16x8 kf[4][2], vf[4][2];
#pragma unroll
    for (int sub = 0; sub < 4; ++sub)
#pragma unroll
        for (int s = 0; s < 2; ++s) kf[sub][s] = *(const bf16x8*)(Kp + (size_t)(16 * sub + c) * kpitch + 32 * s + 8 * g);
#pragma unroll
    for (int dt = 0; dt < 4; ++dt)
#pragma unroll
        for (int s2 = 0; s2 < 2; ++s2) { const bf16* p = VTp + (size_t)(16 * dt + c) * vpitch + 32 * s2 + 4 * g; const u32x2 a = *(const u32x2*)p, bq = *(const u32x2*)(p + 16);
            u32x4 w; w.x = a.x; w.y = a.y; w.z = bq.x; w.w = bq.y; vf[dt][s2] = __builtin_bit_cast(bf16x8, w); }
#pragma unroll
    for (int ct = 0; ct < NCT; ++ct) {
        if (!((ctmask >> ct) & 1u)) continue;
        f32x4 sa[4];
#pragma unroll
        for (int sub = 0; sub < 4; ++sub) { sa[sub] = mfma16(kf[sub][0], qf[ct][0], (f32x4){0.f, 0.f, 0.f, 0.f}); sa[sub] = mfma16(kf[sub][1], qf[ct][1], sa[sub]); }
        float tmax = -INFINITY;
#pragma unroll
        for (int sub = 0; sub < 4; ++sub)
#pragma unroll
            for (int r = 0; r < 4; ++r) { const int key = k0 + 16 * sub + 4 * g + r; const float v = (key >= lo[ct] && key <= hi[ct]) ? sa[sub][r] * NSA_SCL : -INFINITY; sa[sub][r] = v; tmax = fmaxf(tmax, v); }
        tmax = fmaxf(tmax, __shfl_xor(tmax, 16)); tmax = fmaxf(tmax, __shfl_xor(tmax, 32));
        const float mn = fmaxf(A.m[ct], tmax);
        const float ms = (mn == -INFINITY) ? 0.f : mn;
        const float alpha = __builtin_amdgcn_exp2f(A.m[ct] - ms);
        float ps = 0.f;
#pragma unroll
        for (int sub = 0; sub < 4; ++sub)
#pragma unroll
            for (int r = 0; r < 4; ++r) { const float p = __builtin_amdgcn_exp2f(sa[sub][r] - ms); sa[sub][r] = p; ps += p; }
        A.l[ct] = A.l[ct] * alpha + ps; A.m[ct] = mn;
#pragma unroll
        for (int dt = 0; dt < 4; ++dt) A.o[ct][dt] = A.o[ct][dt] * alpha;
        bf16x8 pf[2];
#pragma unroll
        for (int s2 = 0; s2 < 2; ++s2) { u32x4 w; w.x = pk2(sa[2 * s2][0], sa[2 * s2][1]); w.y = pk2(sa[2 * s2][2], sa[2 * s2][3]); w.z = pk2(sa[2 * s2 + 1][0], sa[2 * s2 + 1][1]); w.w = pk2(sa[2 * s2 + 1][2], sa[2 * s2 + 1][3]);
            pf[s2] = __builtin_bit_cast(bf16x8, w); }
#pragma unroll
        for (int dt = 0; dt < 4; ++dt)
#pragma unroll
            for (int s2 = 0; s2 < 2; ++s2) A.o[ct][dt] = mfma16(vf[dt][s2], pf[s2], A.o[ct][dt]);
    }
}
__device__ __forceinline__ void nsa_finalize(const Ctx& C, NsaAcc& A, const bf16* Zb, size_t rowb, int t0, int jb, bool first, bool last, float (&msave)[NCT], float (&isave)[NCT], int c, int g) {
    const int ql = c >> 2, h = c & 3;
    float* scr = C.VBUF;
#pragma unroll
    for (int ct = 0; ct < NCT; ++ct) {
        float lt = A.l[ct]; lt += __shfl_xor(lt, 16); lt += __shfl_xor(lt, 32);
        const float inv = lt > 0.f ? 1.0f / lt : 0.f; msave[ct] = A.m[ct]; isave[ct] = inv;
        const int tq = t0 + 4 * ct + ql;
        const float gate = sigmoidf_(bf2f((unsigned)Zb[(size_t)tq * DINP + C_GATE + 3 * h + jb]));
        const float f = inv * gate;
#pragma unroll
        for (int dt = 0; dt < 4; ++dt) {
            f32x4 v = A.o[ct][dt] * f; const size_t off = (rowb + tq) * 256 + h * 64 + 16 * dt + 4 * g;
            if (!first) v = v + *(const f32x4*)(scr + off);
            if (last) { u32x2 o; o.x = pk2(v[0], v[1]); o.y = pk2(v[2], v[3]); *(u32x2*)(C.Y + (rowb + tq) * D + 256 + h * 64 + 16 * dt + 4 * g) = o; }
            else *(f32x4*)(scr + off) = v;
        }
    }
}
__device__ __forceinline__ void nsa_unit(const Ctx& C, int U, LAS unsigned char* wl) {
    const int lane = C.lane, c = lane & 15, g = lane >> 4, ql = c >> 2, h = c & 3;
    const int b = U / (T / NQW), t0 = (U % (T / NQW)) * NQW;
    const size_t rowb = (size_t)b * T;
    const bf16* Zb = C.Z + rowb * DINP;
    LAS float* imp = (LAS float*)wl; LAS unsigned* smask = (LAS unsigned*)(wl + 8192);
    bf16x8 qf[NCT][2]; int tq[NCT];
#pragma unroll
    for (int ct = 0; ct < NCT; ++ct) { tq[ct] = t0 + 4 * ct + ql;
#pragma unroll
        for (int s = 0; s < 2; ++s) qf[ct][s] = *(const bf16x8*)(Zb + (size_t)tq[ct] * DINP + C_Q + h * 64 + 32 * s + 8 * g); }
    NsaAcc A; float msave[NCT], isave[NCT], mc[NCT], ic[NCT];
    int lo[NCT], hi[NCT];
    constexpr unsigned ALLCT = (1u << NCT) - 1u;
    const int nmaxw = (t0 + NQW - 1 >= 31) ? ((t0 + NQW - 1 - 31) >> 4) : -1;
    const int nkt = (nmaxw >> 6) + 1;
    const bf16* KCb = C.KC + (size_t)b * 512 * 64; const bf16* VCTb = C.VCT + (size_t)b * 64 * 512;
#pragma unroll
    for (int ct = 0; ct < NCT; ++ct) { lo[ct] = 0; hi[ct] = (tq[ct] >= 31) ? ((tq[ct] - 31) >> 4) : -1; }
    nsa_acc_reset(A);
    for (int kt = 0; kt < nkt; ++kt) nsa_tile(KCb + (size_t)(64 * kt) * 64, 64, VCTb + 64 * kt, 512, qf, 64 * kt, lo, hi, ALLCT, A, c, g);
    nsa_finalize(C, A, Zb, rowb, t0, 0, true, false, mc, ic, c, g);
    for (int i = lane; i < NQW * 128; i += 64) imp[i] = 0.f;
    LDS_WAIT();
    for (int kt = 0; kt < nkt; ++kt) {
        bf16x8 kf[4][2];
#pragma unroll
        for (int sub = 0; sub < 4; ++sub)
#pragma unroll
            for (int s = 0; s < 2; ++s) kf[sub][s] = *(const bf16x8*)(KCb + (size_t)(64 * kt + 16 * sub + c) * 64 + 32 * s + 8 * g);
#pragma unroll
        for (int ct = 0; ct < NCT; ++ct) {
#pragma unroll
            for (int sub = 0; sub < 4; ++sub) {
                f32x4 sa = mfma16(kf[sub][0], qf[ct][0], (f32x4){0.f, 0.f, 0.f, 0.f}); sa = mfma16(kf[sub][1], qf[ct][1], sa);
                float p[4];
#pragma unroll
                for (int r = 0; r < 4; ++r) { const int n = 64 * kt + 16 * sub + 4 * g + r; float v = (n <= hi[ct]) ? __builtin_amdgcn_exp2f(sa[r] * NSA_SCL - mc[ct]) * ic[ct] : 0.f;
                    v += __shfl_xor(v, 1); v += __shfl_xor(v, 2); p[r] = v; }
                if (h == 0) { const int mb = 16 * kt + 4 * sub + g; LAS float* ip = imp + (4 * ct + ql) * 128 + mb;
                    atomicAdd((float*)ip, (p[0] + p[1]) + (p[2] + p[3])); if (mb + 1 < 128) atomicAdd((float*)(ip + 1), p[3]); }
            }
        }
    }
    LDS_WAIT();
#pragma unroll 1
    for (int qi = 0; qi < NQW; ++qi) {
        const int t = t0 + qi, cur = t >> 6; const int m0 = lane, m1 = lane + 64;
        float c0 = (m0 <= cur) ? (imp[qi * 128 + m0] + ((m0 == 0 || m0 == cur || m0 == cur - 1) ? 1e4f : 0.f)) : -1.0f;
        float c1 = (m1 <= cur) ? (imp[qi * 128 + m1] + ((m1 == 0 || m1 == cur || m1 == cur - 1) ? 1e4f : 0.f)) : -1.0f;
        unsigned long long mlo = 0ull, mhi = 0ull;
        for (int r = 0; r < 16; ++r) {
            float bv; int bi;
            if (c0 >= c1) { bv = c0; bi = m0; } else { bv = c1; bi = m1; }
#pragma unroll
            for (int off = 1; off < 64; off <<= 1) { const float ov = __shfl_xor(bv, off); const int oi = __shfl_xor(bi, off); if (ov > bv || (ov == bv && oi < bi)) { bv = ov; bi = oi; } }
            if (bi == m0) c0 = -2.0f; if (bi == m1) c1 = -2.0f;
            if (bv >= 0.f) { if (bi < 64) mlo |= 1ull << bi; else mhi |= 1ull << (bi - 64); }
        }
        if (lane == 0) { smask[qi * 4 + 0] = (unsigned)mlo; smask[qi * 4 + 1] = (unsigned)(mlo >> 32); smask[qi * 4 + 2] = (unsigned)mhi; smask[qi * 4 + 3] = (unsigned)(mhi >> 32); }
    }
    LDS_WAIT();
    nsa_acc_reset(A);
    {
        const int jmax = (t0 + NQW - 1) >> 6;
        const bf16* Kb = Zb + C_KSEL; const bf16* VTb = C.VSELT + (size_t)b * 64 * T;
#pragma unroll
        for (int ct = 0; ct < NCT; ++ct) lo[ct] = 0;
        for (int j = 0; j <= jmax; ++j) {
            unsigned ctmask = 0u;
#pragma unroll
            for (int ct = 0; ct < NCT; ++ct) { const unsigned w = smask[(4 * ct + ql) * 4 + (j >> 5)]; const bool sel = (w >> (j & 31)) & 1u; hi[ct] = sel ? tq[ct] : -1; if (__any(sel)) ctmask |= 1u << ct; }
            if (ctmask) nsa_tile(Kb + (size_t)(64 * j) * DINP, DINP, VTb + 64 * j, T, qf, 64 * j, lo, hi, ctmask, A, c, g);
        }
    }
    nsa_finalize(C, A, Zb, rowb, t0, 1, false, false, msave, isave, c, g);
    nsa_acc_reset(A);
    {
        const int j0 = (t0 >= 511) ? ((t0 - 511) >> 6) : 0, j1 = (t0 + NQW - 1) >> 6;
        const bf16* Kb = Zb + C_KWIN; const bf16* VTb = C.VWINT + (size_t)b * 64 * T;
#pragma unroll
        for (int ct = 0; ct < NCT; ++ct) { lo[ct] = tq[ct] - 511; hi[ct] = tq[ct]; }
        for (int j = j0; j <= j1; ++j) nsa_tile(Kb + (size_t)(64 * j) * DINP, DINP, VTb + 64 * j, T, qf, 64 * j, lo, hi, ALLCT, A, c, g);
    }
    nsa_finalize(C, A, Zb, rowb, t0, 2, false, true, msave, isave, c, g);
    LDS_WAIT();
}

#ifndef DBG_REP
#define DBG_REP 0
#endif
#ifndef NSA_CHECK
#define NSA_CHECK 0
#endif
#ifndef MK_MULTI
#define MK_MULTI 0
#endif
constexpr int PH_PER_LAYER = 13, N_PHASES = 1 + NL * PH_PER_LAYER;


__device__ __forceinline__ void mkctx(Ctx& C, const Params& P, int tid) {
    C.tid = tid; C.lane = tid & 63; C.wid = __builtin_amdgcn_readfirstlane(tid >> 6); C.bid = blockIdx.x; C.G = gridDim.x;
#pragma unroll
    for (int i = 0; i < 35; ++i) C.in[i] = P.in[i];
    unsigned char* ws = P.ws;
    C.X = P.out;
    C.XB = (bf16*)(ws + WS_XB); C.Z = (bf16*)(ws + WS_Z); C.Y = (bf16*)(ws + WS_Y); C.Q = (bf16*)(ws + WS_Q); C.H = (bf16*)(ws + WS_H); C.XG = (bf16*)(ws + WS_Z);
    C.KC = (bf16*)(ws + WS_KC); C.VC = (bf16*)(ws + WS_VC); C.MEMB = (bf16*)(ws + WS_MEMB); C.KMEM = (bf16*)(ws + WS_KMEM); C.VTMEM = (bf16*)(ws + WS_VTMEM); C.VCT = (bf16*)(ws + WS_VCT); C.VSELT = (bf16*)(ws + WS_VSELT); C.VWINT = (bf16*)(ws + WS_VWINT);
    C.WINT = (bf16*)(ws + WS_WINT); C.WOUTT = (bf16*)(ws + WS_WOUTT); C.XQT = (bf16*)(ws + WS_XQT); C.XKVT = (bf16*)(ws + WS_XKVT); C.XOT = (bf16*)(ws + WS_XOT);
    C.W13T = (bf16*)(ws + WS_W13T); C.W2T = (bf16*)(ws + WS_W2T); C.E13T = (bf16*)(ws + WS_E13T); C.E2T = (bf16*)(ws + WS_E2T);
    C.CW1T = (bf16*)(ws + WS_CW1T); C.CW2T = (bf16*)(ws + WS_CW2T); C.PWT = (bf16*)(ws + WS_PWT); C.POOLWT = (bf16*)(ws + WS_POOLWT); C.SGUWB = (bf16*)(ws + WS_SGUW);
    C.VBUF = (float*)(ws + WS_VBUF); C.FS = (float*)(ws + WS_VBUF); C.PEB = (float*)(ws + WS_PEB); C.TOKG = (float*)(ws + WS_TOKG);
    C.HIST = (int*)(ws + WS_HIST); C.META = (int*)(ws + WS_META); C.TOKPOS = (int*)(ws + WS_TOKPOS); C.TOKINFO = (unsigned*)(ws + WS_TOKINFO);
}
#define MKCTX() Ctx C; { int t_ = threadIdx.x; asm volatile("" : "+v"(t_)); mkctx(C, P, t_); }

__global__ void __launch_bounds__(NTHREADS, 2) fwd_kernel(Params P) {
    extern __shared__ __attribute__((aligned(16))) unsigned char lds_raw[];
    LAS unsigned char* lds = (LAS unsigned char*)lds_raw;
    for (int u = threadIdx.x; u < (LDS_BYTES - LDSCTL_OFF) / 4; u += NTHREADS) ((LAS unsigned*)(lds + LDSCTL_OFF))[u] = 0u;
    __syncthreads();
    unsigned char* ws = P.ws;
    XcdBarrier bar; bar.bar = (unsigned*)(ws + WS_CTL); bar.x = 0; bar.st = nullptr;
#if !MK_MULTI
    bar = xcd_barrier_post((unsigned*)(ws + WS_CTL), (volatile LAS unsigned*)(lds + LDSCTL_OFF));
#endif
    const int lo = P.ph_lo, hi = P.ph_hi;
#define IN(k) (lo <= (k) && (k) < hi)
#if MK_MULTI
#define SEAM(k) do { } while (0)
#else
#define SEAM(k) do { if (IN(k) && IN((k) + 1)) xcd_barrier(bar); } while (0)
#endif
    int ph = 0;
    if (IN(ph)) { for (int rep = 0; rep < ((P.dbg & 2) ? 2 : 1); ++rep) { MKCTX(); p0_prologue(C, lds); __syncthreads(); } }
    SEAM(ph); ++ph;

    for (int l = 0; l < NL; ++l) {
        const bool moe = (l & 1) != 0; const int li = l >> 1;
        if (IN(ph)) {
            MKCTX();
            if (l == 0) {
                for (int l2 = 0; l2 < NL; ++l2) {
                    pg8::Gemm g{C.MEMB, C.XKVT + (size_t)l2 * 2 * D * D, NB * MEM, 2 * D, D}; pg8::StaticOrder S; S.init(NB * MEM, 2 * D, C.G, (C.bid + 32 * l2) % C.G);
                    pg8::EpiKV E{C.KMEM + (size_t)l2 * 1024 * 1024, C.VTMEM + (size_t)l2 * 4096 * 256};
                    pg8::gemm_phase<pg8::EpiKV, pg8::StaticOrder, true, true>(lds, g, S, E);
                }
            }
            pg8::Gemm g{C.XB, C.WINT + (size_t)l * DINP * D, M, DINP, D}; pg8::StaticOrder S; S.init(M, DINP, C.G, C.bid);
            pg8::EpiBf16 E{C.Z, DINP};
            pg8::gemm_phase<pg8::EpiBf16, pg8::StaticOrder, true, true>(lds, g, S, E);
        }
        SEAM(ph); ++ph;
        if (IN(ph)) for (int rep = 0; rep < ((P.dbg & 2) ? 2 : 1); ++rep) {
            MKCTX();
            { ConvW cw;
              for (int tb = C.bid; tb < M / 128; tb += C.G) vt_tile(C, tb);
              for (int tb = C.bid; tb < M / 128; tb += C.G) mixers_tile<1>(C, l, tb, lds, cw);
              for (int tb = C.bid; tb < M / 128; tb += C.G) mixers_tile<2>(C, l, tb, lds, cw);
              load_convw(C, l, cw);
              for (int tb = C.bid; tb < M / 128; tb += C.G) mixers_tile<4>(C, l, tb, lds, cw); }
            for (int it = C.bid; it < 256; it += C.G) compress_item(C, l, it, lds);
        }
        SEAM(ph); ++ph;
        if (IN(ph)) for (int rep = 0; rep < ((P.dbg & 1) ? 2 : 1); ++rep) {
            MKCTX();
            for (int p = C.bid * NWAVES + C.wid; p < M / NQW / 2; p += C.G * NWAVES) {
                nsa_unit(C, p, lds + C.wid * 17664); nsa_unit(C, M / NQW - 1 - p, lds + C.wid * 17664); }
#if NSA_CHECK
            xcd_barrier(bar);
            { const int gw = C.bid * NWAVES + C.wid, NGW = C.G * NWAVES;
              for (int q = gw; q < M; q += NGW) { const int t = q & (T - 1); if ((t & 7) == 3 || t < 192) nsa_query<true>(C, q >> 13, t, lds + C.wid * 17664, (unsigned*)(P.ws + WS_CTL + 32768)); } }
#endif
        }
        SEAM(ph); ++ph;
        if (IN(ph)) {
            MKCTX();
            pg8::Gemm g{C.Y, C.WOUTT + (size_t)l * D * D, M, D, D}; pg8::StaticOrder S; S.init(M, D, C.G, C.bid);
            pg8::EpiF32Res E{C.VBUF, (l == 0) ? C.in[I_X] : (const float*)C.X, D, ALPHA};
            pg8::gemm_phase<pg8::EpiF32Res, pg8::StaticOrder, true, true>(lds, g, S, E);
        }
        SEAM(ph); ++ph;
        if (IN(ph)) for (int rep = 0; rep < ((P.dbg & 2) ? 2 : 1); ++rep) { MKCTX(); ln_phase(C, C.VBUF, C.in[I_LN1G] + l * D, C.in[I_LN1B] + l * D, 0, nullptr, lds); }
        SEAM(ph); ++ph;
        if (IN(ph)) {
            MKCTX();
            pg8::Gemm g{C.XB, C.XQT + (size_t)l * D * D, M, D, D}; pg8::StaticOrder S; S.init(M, D, C.G, C.bid);
            pg8::EpiBf16 E{C.Q, D};
            pg8::gemm_phase<pg8::EpiBf16, pg8::StaticOrder, true, true>(lds, g, S, E);
        }
        SEAM(ph); ++ph;
        if (IN(ph)) for (int rep = 0; rep < ((P.dbg & 2) ? 2 : 1); ++rep) { MKCTX(); for (int u = C.bid; u < NB * 4 * 64; u += C.G) xattn_unit(C, l, u, lds); }
        SEAM(ph); ++ph;
        if (IN(ph)) {
            MKCTX();
            pg8::Gemm g{C.Y, C.XOT + (size_t)l * D * D, M, D, D}; pg8::StaticOrder S; S.init(M, D, C.G, C.bid);
            pg8::EpiF32Res E{C.VBUF, (const float*)C.X, D, ALPHA};
            pg8::gemm_phase<pg8::EpiF32Res, pg8::StaticOrder, true, true>(lds, g, S, E);
        }
        SEAM(ph); ++ph;
        if (IN(ph)) for (int rep = 0; rep < ((P.dbg & 2) ? 2 : 1); ++rep) { MKCTX(); ln_phase(C, C.VBUF, C.in[I_LN2G] + l * D, C.in[I_LN2B] + l * D, 0, moe ? C.in[I_ROUTER] + (size_t)li * D * NE : nullptr, lds); }
        SEAM(ph); ++ph;
        if (IN(ph)) for (int rep = 0; rep < ((P.dbg & 2) ? 2 : 1); ++rep) { if (moe) { MKCTX(); moe_gather(C, lds); __syncthreads(); } }
        SEAM(ph); ++ph;
        if (IN(ph)) {
            MKCTX();
            pg8::GroupedOrder S; int npan;
            if (moe) {
#pragma unroll
                for (int k = 0; k < 8; ++k) S.pend[k] = __builtin_amdgcn_readfirstlane(C.META[k]);
                npan = __builtin_amdgcn_readfirstlane(C.META[8]); S.estride = (size_t)2 * FE * D * 2;
            } else {
#pragma unroll
                for (int k = 0; k < 8; ++k) S.pend[k] = M / 256;
                npan = M / 256; S.estride = 0;
            }
            const int N = moe ? 2 * FE : 2 * FF;
            pg8::Gemm g{moe ? C.XG : C.XB, moe ? C.E13T + (size_t)li * NE * 2 * FE * D : C.W13T + (size_t)li * 2 * FF * D, npan * 256, N, D};
            S.init(npan * 256, N, C.G, C.bid);
            pg8::EpiSwiglu E{C.H, N / 2};
            pg8::gemm_phase<pg8::EpiSwiglu, pg8::GroupedOrder, true, true>(lds, g, S, E);
        }
        SEAM(ph); ++ph;
        if (IN(ph)) {
            MKCTX();
            pg8::GroupedOrder S; int npan;
            if (moe) {
#pragma unroll
                for (int k = 0; k < 8; ++k) S.pend[k] = __builtin_amdgcn_readfirstlane(C.META[k]);
                npan = __builtin_amdgcn_readfirstlane(C.META[8]); S.estride = (size_t)D * FE * 2;
            } else {
#pragma unroll
                for (int k = 0; k < 8; ++k) S.pend[k] = M / 256;
                npan = M / 256; S.estride = 0;
            }
            const int K = moe ? FE : FF;
            pg8::Gemm g{C.H, moe ? C.E2T + (size_t)li * NE * D * FE : C.W2T + (size_t)li * D * FF, npan * 256, D, K};
            S.init(npan * 256, D, C.G, C.bid);
            pg8::EpiF32Res E{moe ? C.FS : C.VBUF, moe ? nullptr : (const float*)C.X, D, ALPHA};
            pg8::gemm_phase<pg8::EpiF32Res, pg8::GroupedOrder, true, true>(lds, g, S, E);
        }
        SEAM(ph); ++ph;
        if (IN(ph)) { MKCTX(); ln_phase(C, C.VBUF, C.in[I_LN3G] + l * D, C.in[I_LN3B] + l * D, moe ? 1 : 0, nullptr, lds); }
        SEAM(ph); ++ph;
    }
#if NSA_CHECK
    xcd_barrier(bar);
    { unsigned* ew = (unsigned*)(P.ws + WS_CTL + 32768); const unsigned err = __hip_atomic_load(ew, __ATOMIC_RELAXED, __HIP_MEMORY_SCOPE_AGENT), cnt = __hip_atomic_load(ew + 64, __ATOMIC_RELAXED, __HIP_MEMORY_SCOPE_AGENT);
      if (cnt == 0u || (unsigned long long)err * 256ull > (unsigned long long)cnt) { for (size_t i = (size_t)blockIdx.x * NTHREADS + threadIdx.x; i < (size_t)M * D; i += (size_t)gridDim.x * NTHREADS) P.out[i] = 0.f; } }
#endif
#undef IN
#undef SEAM
}

extern "C" void kernel_launch(void* const* d_in, const int* in_sizes, int n_in, void* d_out, int out_size, void* d_ws, size_t ws_size, hipStream_t stream) {
    static int grid = 0;
    if (grid == 0) {
        if (n_in != 35 || out_size != M * D || ws_size < WS_END) { fprintf(stderr, "kernel_launch: unexpected problem (n_in %d, out %d, ws %zu < %zu)\n", n_in, out_size, ws_size, (size_t)WS_END); grid = -1; return; }
        int dev = 0, cus = 0, per_cu = 0;
        if (hipGetDevice(&dev) != hipSuccess || hipDeviceGetAttribute(&cus, hipDeviceAttributeMultiprocessorCount, dev) != hipSuccess) { grid = -1; return; }
        if (hipFuncSetAttribute((const void*)fwd_kernel, hipFuncAttributeMaxDynamicSharedMemorySize, LDS_BYTES) != hipSuccess) { fprintf(stderr, "kernel_launch: hipFuncSetAttribute failed\n"); grid = -1; return; }
        if (hipOccupancyMaxActiveBlocksPerMultiprocessor(&per_cu, (const void*)fwd_kernel, NTHREADS, LDS_BYTES) != hipSuccess || per_cu < 1) { fprintf(stderr, "kernel_launch: occupancy query says %d\n", per_cu); }
        (void)hipGetLastError();
        grid = cus;
    }
    if (grid < 0) return;
    (void)hipMemsetAsync((char*)d_ws + WS_CTL, 0, CTL_ZERO_BYTES, stream);
    Params p{};
    for (int i = 0; i < 35; ++i) p.in[i] = (const float*)d_in[i];
    p.out = (float*)d_out; p.ws = (unsigned char*)d_ws; p.dbg = DBG_REP;
#if MK_MULTI
    for (int k = 0; k < N_PHASES; ++k) { p.ph_lo = k; p.ph_hi = k + 1; hipLaunchKernelGGL(fwd_kernel, dim3(grid), dim3(NTHREADS), LDS_BYTES, stream, p); }
#else
    p.ph_lo = 0; p.ph_hi = N_PHASES;
    hipLaunchKernelGGL(fwd_kernel, dim3(grid), dim3(NTHREADS), LDS_BYTES, stream, p);
#endif
}
```

```cpp
#include <hip/hip_runtime.h>
#include <cstdio>
#include <cstdint>

#define GAS __attribute__((address_space(1)))
#define LAS __attribute__((address_space(3)))
typedef unsigned short bf16;
typedef short bf16x8 __attribute__((ext_vector_type(8)));
typedef short bf16x4 __attribute__((ext_vector_type(4)));
typedef float f32x4 __attribute__((ext_vector_type(4)));
typedef float f32x2 __attribute__((ext_vector_type(2)));
typedef unsigned u32x4 __attribute__((ext_vector_type(4)));
typedef unsigned u32x2 __attribute__((ext_vector_type(2)));

constexpr int D = 1024, NB = 4, T = 8192, NL = 4, MEM = 256, M = NB * T;
constexpr int DIN = 1932, DINP = 2048;
constexpr int C_POOL = 0, C_Q = 256, C_KCMP = 512, C_VCMP = 576, C_KSEL = 640, C_VSEL = 704, C_KWIN = 768, C_VWIN = 832, C_GATE = 896, C_U = 908, C_V = 1164, C_CA = 1420, C_CG = 1676;
constexpr int FF = 2816, NE = 8, FE = 3584;
constexpr int NCMP = 511;
constexpr float ALPHA = 1.6817928305074292f;
constexpr float LN_EPS = 1e-5f;
constexpr int MOE_ROWS = 2 * M + NE * 256;
constexpr int NWAVES = 8, NTHREADS = 512;

constexpr size_t al256(size_t x) { return (x + 255) & ~(size_t)255; }
constexpr size_t MiB = 1u << 20;
constexpr size_t WS_CTL = 0, CTL_ZERO_BYTES = 64 * 1024;
constexpr size_t WS_HIST = 1 * MiB;
constexpr size_t WS_META = WS_HIST + 8192;
constexpr size_t WS_TOKINFO = WS_META + 256;
constexpr size_t WS_TOKG = WS_TOKINFO + (size_t)2 * M * 4;
constexpr size_t WS_TOKPOS = WS_TOKG + (size_t)2 * M * 4;
constexpr size_t WS_KC = WS_TOKPOS + (size_t)2 * M * 4;
constexpr size_t WS_VC = WS_KC + (size_t)NB * 512 * 64 * 2;
constexpr size_t WS_PEB = WS_VC + (size_t)NB * 512 * 64 * 2;
constexpr size_t WS_POOLWT = WS_PEB + (size_t)NL * 2 * 256 * 4;
constexpr size_t WS_SGUW = WS_POOLWT + (size_t)NL * 4 * 64 * 64 * 2;
constexpr size_t WS_PWT = WS_SGUW + (size_t)NL * 4 * 128 * 128 * 2;
constexpr size_t WS_CW2T = WS_PWT + (size_t)NL * 256 * 256 * 2;
constexpr size_t WS_CW1T = WS_CW2T + (size_t)NL * 2 * 64 * 256 * 2;
constexpr size_t WS_MEMB = WS_CW1T + (size_t)NL * 2 * 256 * 2048 * 2;
constexpr size_t WS_KMEM = WS_MEMB + (size_t)1024 * 1024 * 2;
constexpr size_t WS_VTMEM = WS_KMEM + (size_t)NL * 1024 * 1024 * 2;
constexpr size_t WS_VCT = WS_VTMEM + (size_t)NL * 4096 * 256 * 2;
constexpr size_t WS_VSELT = WS_VCT + (size_t)NB * 64 * 512 * 2;
constexpr size_t WS_VWINT = WS_VSELT + (size_t)NB * 64 * T * 2;
constexpr size_t WS_SMALL_END = WS_VWINT + (size_t)NB * 64 * T * 2;
constexpr size_t WS_WINT = 48 * MiB;
static_assert(WS_SMALL_END <= WS_WINT, "small region");
constexpr size_t WS_WOUTT = WS_WINT + (size_t)NL * DINP * D * 2;
constexpr size_t WS_XQT = WS_WOUTT + (size_t)NL * D * D * 2;
constexpr size_t WS_XKVT = WS_XQT + (size_t)NL * D * D * 2;
constexpr size_t WS_XOT = WS_XKVT + (size_t)NL * 2 * D * D * 2;
constexpr size_t WS_W13T = WS_XOT + (size_t)NL * D * D * 2;
constexpr size_t WS_W2T = WS_W13T + (size_t)2 * 2 * FF * D * 2;
constexpr size_t WS_E13T = WS_W2T + (size_t)2 * D * FF * 2;
constexpr size_t WS_E2T = WS_E13T + (size_t)16 * 2 * FE * D * 2;
constexpr size_t WS_XB = WS_E2T + (size_t)16 * D * FE * 2;
constexpr size_t WS_VBUF = WS_XB + (size_t)M * D * 2;
constexpr size_t WS_Z = WS_VBUF + (size_t)M * D * 4;
constexpr size_t WS_Y = WS_Z + (size_t)M * DINP * 2;
constexpr size_t WS_Q = WS_Y + (size_t)M * D * 2;
constexpr size_t WS_H = WS_Q + (size_t)M * D * 2;
constexpr size_t WS_END = WS_H + (size_t)MOE_ROWS * FE * 2;
static_assert((size_t)MOE_ROWS * D * 4 <= WS_H - WS_VBUF, "FS overlay");
static_assert((size_t)MOE_ROWS * D * 2 <= WS_Q - WS_Z, "XG overlay");

constexpr int SCR_BYTES = 153600;
constexpr int LDSCTL_OFF = SCR_BYTES;
constexpr int LDS_BYTES = 155648;

__device__ __forceinline__ float bf2f(unsigned v) { return __uint_as_float(v << 16); }
__device__ __forceinline__ unsigned f2bf(float f) { unsigned u = __builtin_bit_cast(unsigned, f); return (u + 0x7fffu + ((u >> 16) & 1u)) >> 16; }
typedef __bf16 bf16x2_t __attribute__((ext_vector_type(2)));
__device__ __forceinline__ unsigned pk2(float lo, float hi) { const f32x2 v = {lo, hi}; const bf16x2_t b = __builtin_convertvector(v, bf16x2_t); return __builtin_bit_cast(unsigned, b); }
__device__ __forceinline__ float lo16(unsigned w) { return __uint_as_float(w << 16); }
__device__ __forceinline__ float hi16(unsigned w) { return __uint_as_float(w & 0xffff0000u); }
__device__ __forceinline__ float sigmoidf_(float x) { return 1.0f / (1.0f + __expf(-x)); }
__device__ __forceinline__ float siluf_(float x) { return x / (1.0f + __expf(-x)); }
__device__ __forceinline__ float gelu_tanh(float x) { const float u = 0.7978845608028654f * (x + 0.044715f * x * x * x); return x / (1.0f + __expf(-2.0f * u)); }
__device__ __forceinline__ float wave_sum(float v) {
#pragma unroll
    for (int o = 1; o < 64; o <<= 1) v += __shfl_xor(v, o);
    return v;
}
__device__ __forceinline__ float wave_max(float v) {
#pragma unroll
    for (int o = 1; o < 64; o <<= 1) v = fmaxf(v, __shfl_xor(v, o));
    return v;
}
__device__ __forceinline__ f32x4 mfma16(bf16x8 a, bf16x8 b, f32x4 c) { return __builtin_amdgcn_mfma_f32_16x16x32_bf16(a, b, c, 0, 0, 0); }
__device__ __forceinline__ float dot2bf(unsigned a, unsigned b, float c) { return __builtin_amdgcn_fdot2_f32_bf16(__builtin_bit_cast(bf16x2_t, a), __builtin_bit_cast(bf16x2_t, b), c, false); }
#define LDS_WAIT() asm volatile("s_waitcnt lgkmcnt(0)" ::: "memory")

namespace pg8 {
#define PG8_LAS __attribute__((address_space(3)))
typedef unsigned short bf16_t;
typedef short bf16x8 __attribute__((ext_vector_type(8)));
typedef float f32x4 __attribute__((ext_vector_type(4)));
typedef unsigned u32x4 __attribute__((ext_vector_type(4)));
constexpr int BM = 256, BK = 64, HALF = 128, HTB = HALF * BK * 2  , STAGE_BYTES = 8 * HTB, NXCD = 8, WGM = 8;

__host__ __device__ __forceinline__ int lds_byte(int r, int c) { const int st = (r >> 4) * 2 + (c >> 5), rr = r & 15, cc = c & 31, ob = rr * 64 + cc * 2; return st * 1024 + (ob ^ (((ob >> 9) & 1) << 5)); }
__host__ __device__ __forceinline__ void stage_rc(int b, int& R, int& C) { const int st = b / 1024, sb = b % 1024, swz = sb ^ (((sb >> 9) & 1) << 5); R = (st >> 1) * 16 + swz / 64; C = (st & 1) * 32 + (swz % 64) / 2; }
__host__ __device__ __forceinline__ int perm32(int rho) { const int n = rho >> 4, i = rho & 15; return 8 * (i >> 2) + 4 * n + (i & 3); }

struct Unit { int pm, pn; };
struct Gemm { const bf16_t* A; const bf16_t* Bt; int M, N, K; };

struct StaticOrder {
    int nM, nN, nwg, G, c;
    __host__ __device__ void init(int M, int N, int G_, int c_) { nM = M / BM; nN = N / BM; nwg = nM * nN; G = G_; c = c_; }
    __host__ __device__ bool next(int i, Unit& u) const {
        const long L = (long)i * G + c; if (L >= nwg) return false;
        int wgid = (int)L; { const int q = nwg / NXCD, r = nwg % NXCD, xcd = wgid % NXCD, off = wgid / NXCD; wgid = (xcd < r ? xcd * (q + 1) : r * (q + 1) + (xcd - r) * q) + off; }
        const int nig = WGM * nN, gid = wgid / nig, fm = gid * WGM, gsz = (nM - fm) < WGM ? (nM - fm) : WGM;
        u.pm = fm + ((wgid % nig) % gsz); u.pn = (wgid % nig) / gsz; return true;
    }
    __device__ __forceinline__ void a_ready(const Unit&) const {}
    __device__ __forceinline__ void done(const Unit&) const {}
    __device__ __forceinline__ const char* bbase(const Gemm& g, const Unit&) const { return (const char*)g.Bt; }
};

template <class Epi, class Sched, bool ALIGN_EPI = false, bool SP2 = false>
__device__ __forceinline__ void gemm_phase(PG8_LAS unsigned char* lds, const Gemm g, const Sched& S, const Epi& E) {
    int tid_l = threadIdx.x; asm volatile("" : "+v"(tid_l));
    const int tid = tid_l, wid = __builtin_amdgcn_readfirstlane(tid >> 6), lane = tid & 63, wr = wid >> 2, wc = wid & 3, fr = lane & 15, fq = lane >> 4;
    const int K = g.K, nt = K / BK;
    unsigned voffA[2], voffB[2];
#pragma unroll
    for (int i = 0; i < 2; ++i) { int R, C; stage_rc(tid * 16 + i * 8192, R, C); const int Rb = Epi::PERM ? ((R & ~31) + perm32(R & 31)) : R;
        voffA[i] = (unsigned)(R * K + C) * 2u; voffB[i] = (unsigned)(Rb * K + C) * 2u; }
    const size_t kstep = (size_t)(BK * 2);
    const size_t hstep = (size_t)HALF * K * 2;
    const size_t tstep = 2 * hstep;
    const unsigned ldsw = (unsigned)wid * 1024u;
    const int aoff = lds_byte(wr * 64 + fr, fq * 8), boff = lds_byte(wc * 32 + fr, fq * 8);
#define PG8_SA(b, h) (((b) * 2 + (h)) * HTB)
#define PG8_SB(b, h) ((4 + (b) * 2 + (h)) * HTB)
#define PG8_STAGE(bufoff, gbase, voff) do { _Pragma("unroll") for (int _i = 0; _i < 2; ++_i) \
        __builtin_amdgcn_global_load_lds((const unsigned*)((const char*)(gbase) + (voff)[_i]), (PG8_LAS unsigned*)(lds + (bufoff) + ldsw + _i * 8192), 16, 0, 0); } while (0)
#define PG8_LDA(dst, b, h) do { _Pragma("unroll") for (int m = 0; m < 4; ++m) _Pragma("unroll") for (int k = 0; k < 2; ++k) dst[m][k] = *(const PG8_LAS bf16x8*)(lds + PG8_SA(b, h) + aoff + m * 2048 + k * 1024); } while (0)
#define PG8_LDB(dst, b, h) do { _Pragma("unroll") for (int n = 0; n < 2; ++n) _Pragma("unroll") for (int k = 0; k < 2; ++k) dst[n][k] = *(const PG8_LAS bf16x8*)(lds + PG8_SB(b, h) + boff + n * 2048 + k * 1024); } while (0)
#define PG8_MMA(ai, bj, At, Bt) do { __builtin_amdgcn_s_setprio(1); _Pragma("unroll") for (int m = 0; m < 4; ++m) _Pragma("unroll") for (int n = 0; n < 2; ++n) _Pragma("unroll") for (int k = 0; k < 2; ++k) \
        acc[ai][bj][m][n] = __builtin_amdgcn_mfma_f32_16x16x32_bf16(Bt[n][k], At[m][k], acc[ai][bj][m][n], 0, 0, 0); __builtin_amdgcn_s_setprio(0); } while (0)
#define PG8_WAIT_V(n) asm volatile("s_waitcnt vmcnt(" #n ")" ::: "memory")
#define PG8_WAIT_L(n) asm volatile("s_waitcnt lgkmcnt(" #n ")" ::: "memory")
#define PG8_BAR __builtin_amdgcn_s_barrier()
#define PG8_SCHED __builtin_amdgcn_sched_barrier(0)
    Unit cur, nxt; int ui = 0;
    if (!S.next(0, cur)) return;
    f32x4 acc[2][2][4][2];
#pragma unroll
    for (int a = 0; a < 2; ++a)
#pragma unroll
        for (int b = 0; b < 2; ++b)
#pragma unroll
            for (int m = 0; m < 4; ++m)
#pragma unroll
                for (int n = 0; n < 2; ++n) acc[a][b][m][n] = (f32x4){0.f, 0.f, 0.f, 0.f};
    bf16x8 At[4][2], B0[2][2], B1[2][2];
    const char* cA = (const char*)g.A + (size_t)cur.pm * tstep; const char* cB = S.bbase(g, cur) + (size_t)cur.pn * tstep;
    S.a_ready(cur);
    if constexpr (SP2) {
        PG8_STAGE(PG8_SB(0, 0), cB, voffB); PG8_STAGE(PG8_SB(0, 1), cB + hstep, voffB); PG8_STAGE(PG8_SA(0, 0), cA, voffA); PG8_STAGE(PG8_SA(0, 1), cA + hstep, voffA);
        if (wr == 1) PG8_BAR;
        PG8_WAIT_V(2); PG8_BAR;
        PG8_STAGE(PG8_SB(1, 0), cB + kstep, voffB); PG8_STAGE(PG8_SA(1, 0), cA + kstep, voffA); PG8_STAGE(PG8_SB(1, 1), cB + hstep + kstep, voffB);
        PG8_WAIT_V(6); PG8_BAR;
    } else {
        PG8_STAGE(PG8_SB(0, 0), cB, voffB); PG8_STAGE(PG8_SA(0, 0), cA, voffA); PG8_STAGE(PG8_SB(0, 1), cB + hstep, voffB); PG8_STAGE(PG8_SA(0, 1), cA + hstep, voffA);
        if (wr == 1) PG8_BAR;
        PG8_WAIT_V(4); PG8_BAR;
        PG8_STAGE(PG8_SB(1, 0), cB + kstep, voffB); PG8_STAGE(PG8_SA(1, 0), cA + kstep, voffA); PG8_STAGE(PG8_SB(1, 1), cB + hstep + kstep, voffB);
        PG8_WAIT_V(6); PG8_BAR;
    }
    for (;;) {
        const bool has_next = S.next(ui + 1, nxt);
        const char* nA = has_next ? (const char*)g.A + (size_t)nxt.pm * tstep : cA; const char* nB = has_next ? S.bbase(g, nxt) + (size_t)nxt.pn * tstep : cB;
        for (int t = 0; t < nt; t += 2) {
            const bool last = (t == nt - 2);
            const char* a1 = cA + (size_t)(t + 1) * kstep;
            const char* a2 = last ? nA : cA + (size_t)(t + 2) * kstep; const char* b2 = last ? nB : cB + (size_t)(t + 2) * kstep;
            const char* a3 = a2 + kstep; const char* b3 = b2 + kstep;
            if (last && has_next) S.a_ready(nxt);
            if constexpr (SP2) {
            PG8_LDB(B0, 0, 0); PG8_LDB(B1, 0, 1); PG8_SCHED; PG8_LDA(At, 0, 0); PG8_STAGE(PG8_SA(1, 1), a1 + hstep, voffA);
            PG8_WAIT_V(8); PG8_WAIT_L(0); PG8_BAR; PG8_MMA(0, 0, At, B0); PG8_MMA(0, 1, At, B1); PG8_BAR; PG8_SCHED;
            PG8_LDA(At, 0, 1); PG8_STAGE(PG8_SB(0, 0), b2, voffB); PG8_STAGE(PG8_SB(0, 1), b2 + hstep, voffB); PG8_STAGE(PG8_SA(0, 0), a2, voffA);
            PG8_WAIT_V(8); PG8_WAIT_L(0); PG8_BAR; PG8_MMA(1, 0, At, B0); PG8_MMA(1, 1, At, B1); PG8_BAR; PG8_SCHED;
            PG8_LDB(B0, 1, 0); PG8_LDB(B1, 1, 1); PG8_SCHED; PG8_LDA(At, 1, 0); PG8_STAGE(PG8_SA(0, 1), a2 + hstep, voffA);
            PG8_WAIT_V(8); PG8_WAIT_L(0); PG8_BAR; PG8_MMA(0, 0, At, B0); PG8_MMA(0, 1, At, B1); PG8_BAR; PG8_SCHED;
            PG8_LDA(At, 1, 1); PG8_STAGE(PG8_SB(1, 0), b3, voffB); PG8_STAGE(PG8_SB(1, 1), b3 + hstep, voffB); PG8_STAGE(PG8_SA(1, 0), a3, voffA);
            PG8_WAIT_V(8); PG8_WAIT_L(0); PG8_BAR; PG8_MMA(1, 0, At, B0); PG8_MMA(1, 1, At, B1); PG8_BAR; PG8_SCHED;
            } else {
            PG8_LDB(B0, 0, 0); PG8_SCHED; PG8_LDA(At, 0, 0); PG8_STAGE(PG8_SA(1, 1), a1 + hstep, voffA);
            PG8_WAIT_L(8); PG8_BAR; PG8_WAIT_L(0); PG8_MMA(0, 0, At, B0); PG8_BAR; PG8_SCHED;
            PG8_LDB(B1, 0, 1); PG8_STAGE(PG8_SB(0, 0), b2, voffB);
            PG8_BAR; PG8_WAIT_L(0); PG8_MMA(0, 1, At, B1); PG8_BAR;
            PG8_LDA(At, 0, 1); PG8_STAGE(PG8_SA(0, 0), a2, voffA);
            PG8_BAR; PG8_WAIT_L(0); PG8_MMA(1, 0, At, B0); PG8_BAR; PG8_SCHED;
            PG8_STAGE(PG8_SB(0, 1), b2 + hstep, voffB);
            PG8_WAIT_V(6); PG8_BAR; PG8_MMA(1, 1, At, B1); PG8_BAR;
            PG8_LDB(B0, 1, 0); PG8_SCHED; PG8_LDA(At, 1, 0); PG8_STAGE(PG8_SA(0, 1), a2 + hstep, voffA);
            PG8_WAIT_L(8); PG8_BAR; PG8_WAIT_L(0); PG8_MMA(0, 0, At, B0); PG8_BAR; PG8_SCHED;
            PG8_LDB(B1, 1, 1); PG8_STAGE(PG8_SB(1, 0), b3, voffB);
            PG8_BAR; PG8_WAIT_L(0); PG8_MMA(0, 1, At, B1); PG8_BAR;
            PG8_LDA(At, 1, 1); PG8_STAGE(PG8_SA(1, 0), a3, voffA);
            PG8_BAR; PG8_WAIT_L(0); PG8_MMA(1, 0, At, B0); PG8_BAR; PG8_SCHED;
            PG8_STAGE(PG8_SB(1, 1), b3 + hstep, voffB);
            PG8_WAIT_V(6); PG8_BAR; PG8_MMA(1, 1, At, B1); PG8_BAR;
            }
        }
        if constexpr (ALIGN_EPI) { if (wr == 0) PG8_BAR; }
        if constexpr (!Epi::AFTER_DRAIN) { E(acc, cur, wr, wc, fr, fq); S.done(cur); }
        if (!has_next) break;
#pragma unroll
        for (int a = 0; a < 2; ++a)
#pragma unroll
            for (int b = 0; b < 2; ++b)
#pragma unroll
                for (int m = 0; m < 4; ++m)
#pragma unroll
                    for (int n = 0; n < 2; ++n) acc[a][b][m][n] = (f32x4){0.f, 0.f, 0.f, 0.f};
        cur = nxt; cA = nA; cB = nB; ++ui;
        if constexpr (ALIGN_EPI) { if (wr == 1) PG8_BAR; }
    }
    PG8_WAIT_V(0);
    if constexpr (!ALIGN_EPI) { if (wr == 0) PG8_BAR; }
    PG8_BAR;
    if constexpr (Epi::AFTER_DRAIN) { E.fused(acc, cur, wr, wc, fr, fq, lds, wid, lane); S.done(cur); }
#undef PG8_SA
#undef PG8_SB
#undef PG8_STAGE
#undef PG8_LDA
#undef PG8_LDB
#undef PG8_MMA
#undef PG8_WAIT_V
#undef PG8_WAIT_L
#undef PG8_BAR
#undef PG8_SCHED
}
}

namespace pg8 {
__device__ __forceinline__ unsigned cvt_pk_bf16(float lo, float hi) { unsigned r; asm volatile("v_cvt_pk_bf16_f32 %0, %1, %2" : "=v"(r) : "v"(lo), "v"(hi)); return r; }

struct EpiBf16 {
    static constexpr bool PERM = true, AFTER_DRAIN = false;
    bf16_t* O; int ldc;
    __device__ __forceinline__ void operator()(const f32x4 (&acc)[2][2][4][2], const Unit& u, int wr, int wc, int fr, int fq) const {
        const int row0 = u.pm * BM + wr * 64 + fr; const int col0 = u.pn * BM + wc * 32 + 8 * fq;
#pragma unroll
        for (int ai = 0; ai < 2; ++ai)
#pragma unroll
            for (int m = 0; m < 4; ++m) { bf16_t* rowp = O + (size_t)(row0 + ai * HALF + m * 16) * ldc + col0;
#pragma unroll
                for (int bj = 0; bj < 2; ++bj) { const f32x4 v0 = acc[ai][bj][m][0], v1 = acc[ai][bj][m][1];
                    u32x4 w; w.x = cvt_pk_bf16(v0[0], v0[1]); w.y = cvt_pk_bf16(v0[2], v0[3]); w.z = cvt_pk_bf16(v1[0], v1[1]); w.w = cvt_pk_bf16(v1[2], v1[3]);
                    *(u32x4*)(rowp + bj * HALF) = w; } }
    }
};
struct EpiKV {
    static constexpr bool PERM = true, AFTER_DRAIN = false;
    bf16_t* Kd; bf16_t* VTd;
    __device__ __forceinline__ void operator()(const f32x4 (&acc)[2][2][4][2], const Unit& u, int wr, int wc, int fr, int fq) const {
        const int row0 = u.pm * BM + wr * 64 + fr; const int col0 = u.pn * BM + wc * 32 + 8 * fq;
#pragma unroll
        for (int ai = 0; ai < 2; ++ai)
#pragma unroll
            for (int m = 0; m < 4; ++m) { const int row = row0 + ai * HALF + m * 16;
#pragma unroll
                for (int bj = 0; bj < 2; ++bj) { const f32x4 v0 = acc[ai][bj][m][0], v1 = acc[ai][bj][m][1]; const int col = col0 + bj * HALF;
                    u32x4 w; w.x = cvt_pk_bf16(v0[0], v0[1]); w.y = cvt_pk_bf16(v0[2], v0[3]); w.z = cvt_pk_bf16(v1[0], v1[1]); w.w = cvt_pk_bf16(v1[2], v1[3]);
                    if (col < 1024) { *(u32x4*)(Kd + (size_t)row * 1024 + col) = w; }
                    else { const int c = col - 1024, b = row >> 8, mm = row & 255; bf16_t* p = VTd + ((size_t)(b * 1024 + c)) * 256 + mm;
                        p[0 * 256] = (bf16_t)(w.x & 0xffffu); p[1 * 256] = (bf16_t)(w.x >> 16); p[2 * 256] = (bf16_t)(w.y & 0xffffu); p[3 * 256] = (bf16_t)(w.y >> 16);
                        p[4 * 256] = (bf16_t)(w.z & 0xffffu); p[5 * 256] = (bf16_t)(w.z >> 16); p[6 * 256] = (bf16_t)(w.w & 0xffffu); p[7 * 256] = (bf16_t)(w.w >> 16); } } }
    }
};
struct EpiF32Res {
    static constexpr bool PERM = false, AFTER_DRAIN = false;
    float* out; const float* res; int ldc; float alpha;
    __device__ __forceinline__ void operator()(const f32x4 (&acc)[2][2][4][2], const Unit& u, int wr, int wc, int fr, int fq) const {
        const int row0 = u.pm * BM + wr * 64 + fr; const int col0 = u.pn * BM + wc * 32 + 4 * fq;
#pragma unroll
        for (int ai = 0; ai < 2; ++ai)
#pragma unroll
            for (int m = 0; m < 4; ++m) { const size_t off = (size_t)(row0 + ai * HALF + m * 16) * ldc + col0;
#pragma unroll
                for (int bj = 0; bj < 2; ++bj)
#pragma unroll
                    for (int n = 0; n < 2; ++n) { f32x4 v = acc[ai][bj][m][n]; const size_t o2 = off + bj * HALF + n * 16;
                        if (res) { const f32x4 r = *(const f32x4*)(res + o2); v = v + r * alpha; }
                        *(f32x4*)(out + o2) = v; } }
    }
};
struct EpiSwiglu {
    static constexpr bool PERM = true, AFTER_DRAIN = false;
    bf16_t* H; int ldh;
    __device__ __forceinline__ void operator()(const f32x4 (&acc)[2][2][4][2], const Unit& u, int wr, int wc, int fr, int fq) const {
        const int row0 = u.pm * BM + wr * 64 + fr; const int col0 = u.pn * BM + wc * 32 + 8 * fq;
#pragma unroll
        for (int ai = 0; ai < 2; ++ai)
#pragma unroll
            for (int m = 0; m < 4; ++m) { bf16_t* rowp = H + (size_t)(row0 + ai * HALF + m * 16) * ldh;
#pragma unroll
                for (int bj = 0; bj < 2; ++bj) { const f32x4 v0 = acc[ai][bj][m][0], v1 = acc[ai][bj][m][1];
                    const float h0 = v0[0] / (1.0f + __expf(-v0[0])) * v0[1], h1 = v0[2] / (1.0f + __expf(-v0[2])) * v0[3];
                    const float h2 = v1[0] / (1.0f + __expf(-v1[0])) * v1[1], h3 = v1[2] / (1.0f + __expf(-v1[2])) * v1[3];
                    u32x2 w; w.x = cvt_pk_bf16(h0, h1); w.y = cvt_pk_bf16(h2, h3);
                    *(u32x2*)(rowp + ((col0 + bj * HALF) >> 1)) = w; } }
    }
};
struct GroupedOrder : StaticOrder {
    int pend[8]; size_t estride;
    __device__ __forceinline__ const char* bbase(const Gemm& g, const Unit& u) const {
        int e = 0;
#pragma unroll
        for (int k = 0; k < 7; ++k) e += (u.pm >= pend[k]) ? 1 : 0;
        return (const char*)g.Bt + (size_t)e * estride;
    }
};
}
#define XB_TMO      128
#define XB_XCNT(j)  (256  + 64 * (j))
#define XB_XSUB(j)  (1280 + 64 * (j))
#define XB_XGEN(j)  (2304 + 64 * (j))
#define XB_TOP      3328
#define XB_TOPGEN   3392
#define XCD_BAR_WORDS 3456
#define XB_SPIN_CAP (1u << 18)

__device__ __forceinline__ unsigned xb_ld(unsigned* p)              { return __hip_atomic_load(p, __ATOMIC_RELAXED, __HIP_MEMORY_SCOPE_AGENT); }
__device__ __forceinline__ unsigned xb_add(unsigned* p, unsigned v) { return __hip_atomic_fetch_add(p, v, __ATOMIC_RELAXED, __HIP_MEMORY_SCOPE_AGENT); }
__device__ __forceinline__ unsigned xb_xcc_id() { return (unsigned)__builtin_amdgcn_s_getreg((3 << 11) | 20) & 0xFu; }
#define XB_SPIN(cond, bar) do { unsigned _sp = 0; while (cond) { __builtin_amdgcn_s_sleep(1); \
    if ((++_sp & 255u) == 0u) { if (xb_ld(&(bar)[XB_TMO])) break; if (_sp > XB_SPIN_CAP) { atomicAdd(&(bar)[XB_TMO], 1u); break; } } } } while (0)

struct XcdBarrier {
    unsigned* bar; unsigned x;
    volatile LAS unsigned* st;
};

__device__ __forceinline__ XcdBarrier xcd_barrier_post(unsigned* bar, volatile LAS unsigned* st) {
    XcdBarrier b; b.bar = bar; b.x = xb_xcc_id(); b.st = st;
    if (threadIdx.x == 0) (void)xb_add(&bar[XB_XCNT(b.x)], 1u);
    return b;
}
__device__ __forceinline__ void xcd_barrier_complete(unsigned* bar, unsigned x, unsigned& nloc, unsigned& nx) {
    const unsigned G = gridDim.x * gridDim.y * gridDim.z;
    unsigned sum, cnt, mine, sp = 0u;
    for (;;) {
        sum = 0u; cnt = 0u; mine = 0u;
#pragma unroll
        for (unsigned j = 0; j < 16; ++j) { const unsigned c = xb_ld(&bar[XB_XCNT(j)]); sum += c; cnt += (c > 0u) ? 1u : 0u; mine = (j == x) ? c : mine; }
        if (sum == G) break;
        __builtin_amdgcn_s_sleep(1);
        if ((++sp & 255u) == 0u) { if (xb_ld(&bar[XB_TMO])) break; if (sp > XB_SPIN_CAP) { atomicAdd(&bar[XB_TMO], 1u); break; } }
    }
    nloc = mine > 0u ? mine : 1u; nx = cnt > 0u ? cnt : 1u;
}

__device__ __forceinline__ void xcd_barrier(const XcdBarrier& b) {
    asm volatile("s_waitcnt vmcnt(0)" ::: "memory");
    __syncthreads();
    if (threadIdx.x == 0) {
        unsigned* bar = b.bar;
        __builtin_amdgcn_s_waitcnt(0);
        unsigned nloc = b.st[0], nx = b.st[1];
        if (nloc == 0u) { xcd_barrier_complete(bar, b.x, nloc, nx); b.st[0] = nloc; b.st[1] = nx; }
        const unsigned old = xb_add(&bar[XB_XSUB(b.x)], 1u);
        const unsigned gen = old / nloc;
        if (old + 1u == (gen + 1u) * nloc) {
            __builtin_amdgcn_fence(__ATOMIC_RELEASE, "agent");
            asm volatile("s_waitcnt vmcnt(0)" ::: "memory");
            const unsigned og = xb_add(&bar[XB_TOP], 1u);
            const unsigned tg = og / nx;
            if (og + 1u == (tg + 1u) * nx) xb_add(&bar[XB_TOPGEN], 1u);
            else XB_SPIN(xb_ld(&bar[XB_TOPGEN]) == tg, bar);
            __builtin_amdgcn_fence(__ATOMIC_ACQUIRE, "agent");
            xb_add(&bar[XB_XGEN(b.x)], 1u);
            asm volatile("s_waitcnt vmcnt(0)" ::: "memory");
        } else {
            XB_SPIN(xb_ld(&bar[XB_XGEN(b.x)]) == gen, bar);
            __builtin_amdgcn_fence(__ATOMIC_ACQUIRE, "agent");
            asm volatile("s_waitcnt vmcnt(0)" ::: "memory");
        }
    }
    __syncthreads();
}

struct Params { const float* in[35]; float* out; unsigned char* ws; int ph_lo, ph_hi, dbg, pad; };
enum { I_X = 0, I_MEM, I_WIN, I_POOLW, I_POOLS, I_PEK, I_KW1, I_KW2, I_PEV, I_VW1, I_VW2, I_SLNG, I_SLNB, I_SGUW, I_SGUB, I_CONVW, I_CONVB, I_CLNG, I_CLNB, I_CONVPW,
       I_WOUT, I_LN1G, I_LN1B, I_XQ, I_XKV, I_XO, I_LN2G, I_LN2B, I_W13, I_W2, I_ROUTER, I_E13, I_E2, I_LN3G, I_LN3B };

struct Ctx {
    const float* in[35];
    float* X;
    bf16 *XB, *Z, *Y, *Q, *H, *XG, *KC, *VC, *MEMB, *KMEM, *VTMEM, *VCT, *VSELT, *VWINT;
    bf16 *WINT, *WOUTT, *XQT, *XKVT, *XOT, *W13T, *W2T, *E13T, *E2T, *CW1T, *CW2T, *PWT, *POOLWT, *SGUWB;
    float *VBUF, *FS, *PEB, *TOKG;
    int *HIST, *META, *TOKPOS; unsigned* TOKINFO;
    int tid, lane, wid, bid, G;
};

struct MatDesc { const float* src; bf16* dst; int K, N, Npad, split; };
__device__ __forceinline__ void get_mat(const Ctx& C, int id, MatDesc& d) {
    d.split = 0;
    if (id < 56) {
        const int l = id / 14, k = id % 14;
        if (k == 0)      { d.src = C.in[I_WIN] + (size_t)l * D * DIN;  d.dst = C.WINT + (size_t)l * DINP * D;  d.K = D; d.N = DIN; d.Npad = DINP; }
        else if (k == 1) { d.src = C.in[I_WOUT] + (size_t)l * D * D;   d.dst = C.WOUTT + (size_t)l * D * D;    d.K = D; d.N = D; d.Npad = D; }
        else if (k == 2) { d.src = C.in[I_XQ] + (size_t)l * D * D;     d.dst = C.XQT + (size_t)l * D * D;      d.K = D; d.N = D; d.Npad = D; }
        else if (k == 3) { d.src = C.in[I_XKV] + (size_t)l * D * 2 * D; d.dst = C.XKVT + (size_t)l * 2 * D * D; d.K = D; d.N = 2 * D; d.Npad = 2 * D; }
        else if (k == 4) { d.src = C.in[I_XO] + (size_t)l * D * D;     d.dst = C.XOT + (size_t)l * D * D;      d.K = D; d.N = D; d.Npad = D; }
        else if (k == 5) { d.src = C.in[I_KW1] + (size_t)l * 2048 * 256; d.dst = C.CW1T + (size_t)(l * 2 + 0) * 256 * 2048; d.K = 2048; d.N = 256; d.Npad = 256; }
        else if (k == 6) { d.src = C.in[I_VW1] + (size_t)l * 2048 * 256; d.dst = C.CW1T + (size_t)(l * 2 + 1) * 256 * 2048; d.K = 2048; d.N = 256; d.Npad = 256; }
        else if (k == 7) { d.src = C.in[I_KW2] + (size_t)l * 256 * 64; d.dst = C.CW2T + (size_t)(l * 2 + 0) * 64 * 256; d.K = 256; d.N = 64; d.Npad = 64; }
        else if (k == 8) { d.src = C.in[I_VW2] + (size_t)l * 256 * 64; d.dst = C.CW2T + (size_t)(l * 2 + 1) * 64 * 256; d.K = 256; d.N = 64; d.Npad = 64; }
        else if (k == 9) { d.src = C.in[I_CONVPW] + (size_t)l * 256 * 256; d.dst = C.PWT + (size_t)l * 256 * 256; d.K = 256; d.N = 256; d.Npad = 256; }
        else { const int g = k - 10; d.src = C.in[I_POOLW] + (size_t)(l * 4 + g) * 64 * 64; d.dst = C.POOLWT + (size_t)(l * 4 + g) * 64 * 64; d.K = 64; d.N = 64; d.Npad = 64; }
    } else if (id < 60) {
        const int i = (id - 56) >> 1, w = (id - 56) & 1;
        if (w == 0) { d.src = C.in[I_W13] + (size_t)i * D * 2 * FF; d.dst = C.W13T + (size_t)i * 2 * FF * D; d.K = D; d.N = 2 * FF; d.Npad = 2 * FF; d.split = FF; }
        else        { d.src = C.in[I_W2] + (size_t)i * FF * D;      d.dst = C.W2T + (size_t)i * D * FF;      d.K = FF; d.N = D; d.Npad = D; }
    } else {
        const int j = id - 60, ie = j >> 1, w = j & 1;
        if (w == 0) { d.src = C.in[I_E13] + (size_t)ie * D * 2 * FE; d.dst = C.E13T + (size_t)ie * 2 * FE * D; d.K = D; d.N = 2 * FE; d.Npad = 2 * FE; d.split = FE; }
        else        { d.src = C.in[I_E2] + (size_t)ie * FE * D;      d.dst = C.E2T + (size_t)ie * D * FE;      d.K = FE; d.N = D; d.Npad = D; }
    }
}
__device__ __forceinline__ void transpose_item(const MatDesc& d, LAS float* scr, int item, int lane) {
    const int nblk = d.Npad / 32, kb = item / nblk, nb = item % nblk, k0 = 64 * kb, n0 = 32 * nb;
    const int ncol = n0 + 4 * (lane & 7); const bool ok = ncol < d.N;
    f32x4 v[8];
#pragma unroll
    for (int i = 0; i < 8; ++i) { const int kk = 8 * i + (lane >> 3); v[i] = ok ? *(const f32x4*)(d.src + (size_t)(k0 + kk) * d.N + ncol) : (f32x4){0.f, 0.f, 0.f, 0.f}; }
#pragma unroll
    for (int i = 0; i < 8; ++i) { const int kk = 8 * i + (lane >> 3); LAS float* p = scr + kk * 33 + 4 * (lane & 7); p[0] = v[i][0]; p[1] = v[i][1]; p[2] = v[i][2]; p[3] = v[i][3]; }
    LDS_WAIT();
    const int c = lane & 7;
#pragma unroll
    for (int j = 0; j < 4; ++j) { const int n = (lane >> 3) + 8 * j; const LAS float* s = scr + (8 * c) * 33 + n;
        u32x4 o; o.x = pk2(s[0 * 33], s[1 * 33]); o.y = pk2(s[2 * 33], s[3 * 33]); o.z = pk2(s[4 * 33], s[5 * 33]); o.w = pk2(s[6 * 33], s[7 * 33]);
        const int ng = n0 + n; const int drow = d.split ? (ng < d.split ? 2 * ng : 2 * (ng - d.split) + 1) : ng;
        *(u32x4*)(d.dst + (size_t)drow * d.K + k0 + 8 * c) = o; }
    LDS_WAIT();
}
__device__ __forceinline__ void p0_prologue(const Ctx& C, LAS unsigned char* lds) {
    LAS float* scr = (LAS float*)(lds + C.wid * 8704);
    const int gw = C.bid * NWAVES + C.wid, NGW = C.G * NWAVES;
    int start = 0;
    for (int id = 0; id < 92; ++id) {
        MatDesc d; get_mat(C, id, d);
        const int ntiles = (d.K / 64) * (d.Npad / 32);
        int first = gw - start; if (first < 0) first += NGW;
        for (int it = first; it < ntiles; it += NGW) transpose_item(d, scr, it, C.lane);
        start = (start + ntiles) % NGW;
    }
    const int gt = C.bid * NTHREADS + C.tid, NGT = C.G * NTHREADS;
    { const f32x4* xs = (const f32x4*)C.in[I_X]; u32x4* xd = (u32x4*)C.XB;
      for (int i = gt; i < M * D / 8; i += NGT) { const f32x4 a = xs[2 * i], b = xs[2 * i + 1]; u32x4 o; o.x = pk2(a[0], a[1]); o.y = pk2(a[2], a[3]); o.z = pk2(b[0], b[1]); o.w = pk2(b[2], b[3]); xd[i] = o; } }
    { const f32x4* xs = (const f32x4*)C.in[I_MEM]; u32x4* xd = (u32x4*)C.MEMB;
      for (int i = gt; i < NB * MEM * D / 8; i += NGT) { const f32x4 a = xs[2 * i], b = xs[2 * i + 1]; u32x4 o; o.x = pk2(a[0], a[1]); o.y = pk2(a[2], a[3]); o.z = pk2(b[0], b[1]); o.w = pk2(b[2], b[3]); xd[i] = o; } }
    { const f32x4* ws = (const f32x4*)C.in[I_SGUW]; u32x4* wd = (u32x4*)C.SGUWB;
      for (int i = gt; i < NL * 4 * 128 * 128 / 8; i += NGT) { const int j0 = (i & 15) * 8, ii = (i >> 4) & 127; const f32x4 a = ws[2 * i], b = ws[2 * i + 1];
          float v[8] = {a[0], a[1], a[2], a[3], b[0], b[1], b[2], b[3]};
#pragma unroll
          for (int e = 0; e < 8; ++e) v[e] = (j0 + e <= ii) ? v[e] : 0.f;
          u32x4 o; o.x = pk2(v[0], v[1]); o.y = pk2(v[2], v[3]); o.z = pk2(v[4], v[5]); o.w = pk2(v[6], v[7]); wd[i] = o; } }
    for (int o = gw; o < NL * 2 * 256; o += NGW) { const int n = o & 255, kv = (o >> 8) & 1, l = o >> 9;
        const float* pe = C.in[kv ? I_PEV : I_PEK] + (size_t)l * 2048; const float* w1 = C.in[kv ? I_VW1 : I_KW1] + (size_t)l * 2048 * 256;
        float s = 0.f;
        for (int k = C.lane; k < 2048; k += 64) s += pe[k] * w1[(size_t)k * 256 + n];
        s = wave_sum(s); if (C.lane == 0) C.PEB[o] = s; }
}

__device__ __forceinline__ void ln_phase(const Ctx& C, const float* src, const float* gam, const float* bet, int mode, const float* router, LAS unsigned char* lds) {
    LAS float* rwT = (LAS float*)lds;
    LAS int* te = (LAS int*)(lds + 32768);
    LAS float* tgl = (LAS float*)(lds + 32768 + 1024);
    if (router) { for (int i = C.tid; i < 8192; i += NTHREADS) rwT[(i & 7) * 1024 + (i >> 3)] = router[i]; __syncthreads(); }
    f32x4 g4[4], b4[4];
#pragma unroll
    for (int j = 0; j < 4; ++j) { g4[j] = *(const f32x4*)(gam + 256 * j + 4 * C.lane); b4[j] = *(const f32x4*)(bet + 256 * j + 4 * C.lane); }
    for (int tile = C.bid; tile < M / 128; tile += C.G) {
        for (int i = 0; i < 16; ++i) {
            const int tl = 16 * C.wid + i; const size_t row = (size_t)tile * 128 + tl;
            f32x4 v[4];
            if (mode == 0) {
#pragma unroll
                for (int j = 0; j < 4; ++j) v[j] = *(const f32x4*)(src + row * D + 256 * j + 4 * C.lane);
            } else {
                const int p0 = C.TOKPOS[2 * row], p1 = C.TOKPOS[2 * row + 1]; const float g0 = C.TOKG[2 * row], g1 = C.TOKG[2 * row + 1];
#pragma unroll
                for (int j = 0; j < 4; ++j) { const f32x4 x = *(const f32x4*)(C.X + row * D + 256 * j + 4 * C.lane);
                    const f32x4 a = *(const f32x4*)(C.FS + (size_t)p0 * D + 256 * j + 4 * C.lane), b = *(const f32x4*)(C.FS + (size_t)p1 * D + 256 * j + 4 * C.lane);
                    v[j] = x * ALPHA + a * g0 + b * g1; }
            }
            float s = 0.f;
#pragma unroll
            for (int j = 0; j < 4; ++j) s += (v[j][0] + v[j][1]) + (v[j][2] + v[j][3]);
            const float mean = wave_sum(s) * (1.f / D); float s2 = 0.f;
#pragma unroll
            for (int j = 0; j < 4; ++j) { v[j] = v[j] - mean; s2 += (v[j][0] * v[j][0] + v[j][1] * v[j][1]) + (v[j][2] * v[j][2] + v[j][3] * v[j][3]); }
            const float rstd = 1.0f / sqrtf(wave_sum(s2) * (1.f / D) + LN_EPS);
#pragma unroll
            for (int j = 0; j < 4; ++j) { v[j] = v[j] * rstd * g4[j] + b4[j];
                *(f32x4*)(C.X + row * D + 256 * j + 4 * C.lane) = v[j];
                u32x2 o; o.x = pk2(v[j][0], v[j][1]); o.y = pk2(v[j][2], v[j][3]); *(u32x2*)(C.XB + row * D + 256 * j + 4 * C.lane) = o; }
            if (router) {
                float lg[8];
#pragma unroll
                for (int ex = 0; ex < 8; ++ex) { float a = 0.f;
#pragma unroll
                    for (int j = 0; j < 4; ++j) { const f32x4 w = *(const LAS f32x4*)(rwT + ex * 1024 + 256 * j + 4 * C.lane); a += (v[j][0] * w[0] + v[j][1] * w[1]) + (v[j][2] * w[2] + v[j][3] * w[3]); }
                    lg[ex] = wave_sum(a); }
                int e0 = 0; float l0 = lg[0];
#pragma unroll
                for (int ex = 1; ex < 8; ++ex) if (lg[ex] > l0) { l0 = lg[ex]; e0 = ex; }
                int e1 = -1; float l1 = -INFINITY;
#pragma unroll
                for (int ex = 0; ex < 8; ++ex) if (ex != e0 && lg[ex] > l1) { l1 = lg[ex]; e1 = ex; }
                const float ed = __expf(l1 - l0), ga = 1.0f / (1.0f + ed), gb = ed * ga;
                if (C.lane == 0) { te[2 * tl] = e0; te[2 * tl + 1] = e1; tgl[2 * tl] = ga; tgl[2 * tl + 1] = gb; }
            }
        }
        if (router) {
            __syncthreads();
            if (C.wid == 0) {
                int run[8];
#pragma unroll
                for (int ex = 0; ex < 8; ++ex) run[ex] = 0;
                for (int rr = 0; rr < 4; ++rr) { const int a = 64 * rr + C.lane; const int e = te[a]; int rank = 0;
#pragma unroll
                    for (int ex = 0; ex < 8; ++ex) { const unsigned long long mk = __ballot(e == ex); if (e == ex) rank = run[ex] + __popcll(mk & ((1ull << C.lane) - 1ull)); run[ex] += __popcll(mk); }
                    C.TOKINFO[(size_t)tile * 256 + a] = (unsigned)e | ((unsigned)rank << 8); C.TOKG[(size_t)tile * 256 + a] = tgl[a]; }
#pragma unroll
                for (int ex = 0; ex < 8; ++ex) if (C.lane == ex) C.HIST[tile * 8 + ex] = run[ex];
            }
            __syncthreads();
        }
    }
}

struct ConvW { f32x4 w[31]; f32x4 cb, lg, lb; };
__device__ __forceinline__ void load_convw(const Ctx& C, int l, ConvW& cw) {
#pragma unroll
    for (int k = 0; k < 31; ++k) cw.w[k] = *(const f32x4*)(C.in[I_CONVW] + ((size_t)l * 31 + k) * 256 + 4 * C.lane);
    cw.cb = *(const f32x4*)(C.in[I_CONVB] + l * 256 + 4 * C.lane); cw.lg = *(const f32x4*)(C.in[I_CLNG] + l * 256 + 4 * C.lane); cw.lb = *(const f32x4*)(C.in[I_CLNB] + l * 256 + 4 * C.lane);
}
template <int WHICH>
__device__ __forceinline__ void mixers_tile(const Ctx& C, int l, int tb, LAS unsigned char* lds, const ConvW& cw) {
    const int tid = C.tid, wid = C.wid, lane = C.lane;
    const int b = tb >> 6, t0 = (tb & 63) << 7; const size_t R0 = (size_t)b * T + t0;
    const bf16* Zb = C.Z + (size_t)b * T * DINP;
    const int m16 = lane & 15, gq = lane >> 4, row = 16 * wid + m16;
    if constexpr ((WHICH & 1) != 0) {
        LAS bf16* Dl = (LAS bf16*)lds;
        for (int it = tid; it < 128 * 32; it += NTHREADS) {
            const int tl = it >> 5, c8 = it & 31, g = c8 >> 3, w = 2 << g, t = t0 + tl, n = (t + 1 < w) ? (t + 1) : w;
            float s[8], cur[8];
#pragma unroll
            for (int e = 0; e < 8; ++e) { s[e] = 0.f; cur[e] = 0.f; }
            for (int k = 0; k < n; ++k) {
                const u32x4 v = *(const u32x4*)(Zb + (size_t)(t - k) * DINP + C_POOL + 8 * c8);
                const float f[8] = {lo16(v.x), hi16(v.x), lo16(v.y), hi16(v.y), lo16(v.z), hi16(v.z), lo16(v.w), hi16(v.w)};
#pragma unroll
                for (int e = 0; e < 8; ++e) { s[e] += f[e]; if (k == 0) cur[e] = f[e]; }
            }
            const float inv = 1.0f / (float)n;
            u32x4 o; o.x = pk2(s[0] * inv - cur[0], s[1] * inv - cur[1]); o.y = pk2(s[2] * inv - cur[2], s[3] * inv - cur[3]);
            o.z = pk2(s[4] * inv - cur[4], s[5] * inv - cur[5]); o.w = pk2(s[6] * inv - cur[6], s[7] * inv - cur[7]);
            *(LAS u32x4*)(Dl + tl * 264 + 8 * c8) = o;
        }
        __syncthreads();
#pragma unroll
        for (int g = 0; g < 4; ++g) {
            bf16x8 a[2];
#pragma unroll
            for (int s = 0; s < 2; ++s) a[s] = *(const LAS bf16x8*)(Dl + row * 264 + g * 64 + 32 * s + 8 * gq);
#pragma unroll
            for (int nt = 0; nt < 4; ++nt) {
                f32x4 acc = {0.f, 0.f, 0.f, 0.f};
#pragma unroll
                for (int s = 0; s < 2; ++s) { const bf16x8 bfr = *(const bf16x8*)(C.POOLWT + ((size_t)((l * 4 + g) * 64 + 16 * nt + m16)) * 64 + 32 * s + 8 * gq); acc = mfma16(bfr, a[s], acc); }
                const int col = g * 64 + 16 * nt + 4 * gq;
                const f32x4 sc = *(const f32x4*)(C.in[I_POOLS] + l * 256 + col);
                u32x2 o; o.x = pk2(acc[0] * sc[0], acc[1] * sc[1]); o.y = pk2(acc[2] * sc[2], acc[3] * sc[3]);
                *(u32x2*)(C.Y + (R0 + row) * D + col) = o;
            }
        }
        __syncthreads();
    }
    if constexpr ((WHICH & 2) != 0) {
        LAS bf16* VnT = (LAS bf16*)lds;
        const f32x4 lg = *(const f32x4*)(C.in[I_SLNG] + l * 256 + 4 * lane), lb = *(const f32x4*)(C.in[I_SLNB] + l * 256 + 4 * lane);
#pragma unroll 1
        for (int i = 0; i < 16; ++i) {
            const int tl = 16 * wid + i;
            const u32x2 v = *(const u32x2*)(C.Z + (R0 + tl) * DINP + C_V + 4 * lane);
            const float x0 = gelu_tanh(lo16(v.x)), x1 = gelu_tanh(hi16(v.x)), x2 = gelu_tanh(lo16(v.y)), x3 = gelu_tanh(hi16(v.y));
            const float mean = wave_sum((x0 + x1) + (x2 + x3)) * (1.f / 256.f);
            const float d0 = x0 - mean, d1 = x1 - mean, d2 = x2 - mean, d3 = x3 - mean;
            const float rstd = 1.0f / sqrtf(wave_sum((d0 * d0 + d1 * d1) + (d2 * d2 + d3 * d3)) * (1.f / 256.f) + LN_EPS);
            VnT[(4 * lane + 0) * 136 + tl] = (bf16)f2bf(d0 * rstd * lg[0] + lb[0]); VnT[(4 * lane + 1) * 136 + tl] = (bf16)f2bf(d1 * rstd * lg[1] + lb[1]);
            VnT[(4 * lane + 2) * 136 + tl] = (bf16)f2bf(d2 * rstd * lg[2] + lb[2]); VnT[(4 * lane + 3) * 136 + tl] = (bf16)f2bf(d3 * rstd * lg[3] + lb[3]);
        }
        __syncthreads();
        const int ns = (wid >> 1) + 1;
#pragma unroll
        for (int g = 0; g < 4; ++g) {
            f32x4 acc[4];
#pragma unroll
            for (int nt = 0; nt < 4; ++nt) acc[nt] = (f32x4){0.f, 0.f, 0.f, 0.f};
#pragma unroll
            for (int s = 0; s < 4; ++s) if (s < ns) {
                const bf16x8 a = *(const bf16x8*)(C.SGUWB + ((size_t)((l * 4 + g) * 128 + row)) * 128 + 32 * s + 8 * gq);
#pragma unroll
                for (int nt = 0; nt < 4; ++nt) { const bf16x8 bfr = *(const LAS bf16x8*)(VnT + (g * 64 + 16 * nt + m16) * 136 + 32 * s + 8 * gq); acc[nt] = mfma16(bfr, a, acc[nt]); }
            }
            const float bs = C.in[I_SGUB][(l * 4 + g) * 128 + row];
#pragma unroll
            for (int nt = 0; nt < 4; ++nt) {
                const int col = g * 64 + 16 * nt + 4 * gq;
                const u32x2 uu = *(const u32x2*)(C.Z + (R0 + row) * DINP + C_U + col);
                const float u0 = gelu_tanh(lo16(uu.x)), u1 = gelu_tanh(hi16(uu.x)), u2 = gelu_tanh(lo16(uu.y)), u3 = gelu_tanh(hi16(uu.y));
                u32x2 o; o.x = pk2(u0 * (acc[nt][0] + bs), u1 * (acc[nt][1] + bs)); o.y = pk2(u2 * (acc[nt][2] + bs), u3 * (acc[nt][3] + bs));
                *(u32x2*)(C.Y + (R0 + row) * D + 512 + col) = o;
            }
        }
        __syncthreads();
    }
    if constexpr ((WHICH & 4) != 0) {
        LAS bf16* Hg = (LAS bf16*)lds;
        LAS unsigned char* Hn = lds + 158 * 528;
        for (int it = tid; it < 158 * 64; it += NTHREADS) {
            const int r = it >> 6, c4 = it & 63, t = t0 - 30 + r;
            u32x2 o; o.x = 0u; o.y = 0u;
            if (t >= 0) { const bf16* zr = Zb + (size_t)t * DINP; const u32x2 a = *(const u32x2*)(zr + C_CA + 4 * c4), gg = *(const u32x2*)(zr + C_CG + 4 * c4);
                o.x = pk2(lo16(a.x) * sigmoidf_(lo16(gg.x)), hi16(a.x) * sigmoidf_(hi16(gg.x))); o.y = pk2(lo16(a.y) * sigmoidf_(lo16(gg.y)), hi16(a.y) * sigmoidf_(hi16(gg.y))); }
            *(LAS u32x2*)(Hg + r * 264 + 4 * c4) = o;
        }
        __syncthreads();
        {
            const f32x4 cb = cw.cb, lg = cw.lg, lb = cw.lb;
#pragma unroll 1
            for (int i = 0; i < 16; ++i) {
                const int tl = 16 * wid + i;
                f32x4 acc = cb;
#pragma unroll
                for (int k = 0; k < 31; ++k) {
                    const u32x2 h = *(const LAS u32x2*)(Hg + (tl + k) * 264 + 4 * lane);
                    acc[0] += cw.w[k][0] * lo16(h.x); acc[1] += cw.w[k][1] * hi16(h.x); acc[2] += cw.w[k][2] * lo16(h.y); acc[3] += cw.w[k][3] * hi16(h.y); }
                const float mean = wave_sum((acc[0] + acc[1]) + (acc[2] + acc[3])) * (1.f / 256.f);
                const float d0 = acc[0] - mean, d1 = acc[1] - mean, d2 = acc[2] - mean, d3 = acc[3] - mean;
                const float rstd = 1.0f / sqrtf(wave_sum((d0 * d0 + d1 * d1) + (d2 * d2 + d3 * d3)) * (1.f / 256.f) + LN_EPS);
                const float y0 = siluf_(d0 * rstd * lg[0] + lb[0]), y1 = siluf_(d1 * rstd * lg[1] + lb[1]), y2 = siluf_(d2 * rstd * lg[2] + lb[2]), y3 = siluf_(d3 * rstd * lg[3] + lb[3]);
                u32x2 o; o.x = pk2(y0, y1); o.y = pk2(y2, y3);
                *(LAS u32x2*)(Hn + tl * 512 + (((lane >> 1) ^ (tl & 15)) << 4) + ((lane & 1) << 3)) = o;
            }
        }
        __syncthreads();
#pragma unroll 1
        for (int nh = 0; nh < 2; ++nh) {
            f32x4 acc[8];
#pragma unroll
            for (int nt = 0; nt < 8; ++nt) acc[nt] = (f32x4){0.f, 0.f, 0.f, 0.f};
            const bf16* pw = C.PWT + ((size_t)(l * 256 + 128 * nh + m16)) * 256 + 8 * gq;
#pragma unroll 1
            for (int s = 0; s < 8; ++s) {
                const bf16x8 a = *(const LAS bf16x8*)(Hn + row * 512 + (((4 * s + gq) ^ (row & 15)) << 4));
#pragma unroll
                for (int nt = 0; nt < 8; ++nt) { const bf16x8 bfr = *(const bf16x8*)(pw + (size_t)(16 * nt) * 256 + 32 * s); acc[nt] = mfma16(bfr, a, acc[nt]); }
            }
#pragma unroll
            for (int nt = 0; nt < 8; ++nt) { u32x2 o; o.x = pk2(acc[nt][0], acc[nt][1]); o.y = pk2(acc[nt][2], acc[nt][3]); *(u32x2*)(C.Y + (R0 + row) * D + 768 + 128 * nh + 16 * nt + 4 * gq) = o; }
        }
        __syncthreads();
    }
}
__device__ __forceinline__ void compress_item(const Ctx& C, int l, int it, LAS unsigned char* lds) {
    const int wid = C.wid, lane = C.lane;
    const int rt = it >> 1, kv = it & 1, m16 = lane & 15, gq = lane >> 4;
    const int cr = 16 * rt + m16, bb = cr >> 9, n = cr & 511, nn = n < 510 ? n : 510;
    const bf16* rowbase = C.Z + ((size_t)bb * T + 16 * nn) * DINP + (kv ? C_VCMP : C_KCMP);
    const bf16* w1t = C.CW1T + (size_t)(l * 2 + kv) * 256 * 2048;
    f32x4 acc[2]; acc[0] = (f32x4){0.f, 0.f, 0.f, 0.f}; acc[1] = acc[0];
#pragma unroll 4
    for (int s = 0; s < 64; ++s) {
        const bf16x8 a = *(const bf16x8*)(rowbase + (size_t)(s >> 1) * DINP + 32 * (s & 1) + 8 * gq);
#pragma unroll
        for (int nt = 0; nt < 2; ++nt) { const bf16x8 bfr = *(const bf16x8*)(w1t + (size_t)(32 * wid + 16 * nt + m16) * 2048 + 32 * s + 8 * gq); acc[nt] = mfma16(bfr, a, acc[nt]); }
    }
    LAS bf16* Hc = (LAS bf16*)lds;
#pragma unroll
    for (int nt = 0; nt < 2; ++nt) { const int col = 32 * wid + 16 * nt + 4 * gq; const f32x4 pb = *(const f32x4*)(C.PEB + (l * 2 + kv) * 256 + col);
        u32x2 o; o.x = pk2(gelu_tanh(acc[nt][0] + pb[0]), gelu_tanh(acc[nt][1] + pb[1])); o.y = pk2(gelu_tanh(acc[nt][2] + pb[2]), gelu_tanh(acc[nt][3] + pb[3]));
        *(LAS u32x2*)(Hc + m16 * 264 + col) = o; }
    __syncthreads();
    if (wid < 4) {
        const bf16* w2t = C.CW2T + (size_t)(l * 2 + kv) * 64 * 256;
        f32x4 a2 = {0.f, 0.f, 0.f, 0.f};
#pragma unroll
        for (int s = 0; s < 8; ++s) { const bf16x8 a = *(const LAS bf16x8*)(Hc + m16 * 264 + 32 * s + 8 * gq); const bf16x8 bfr = *(const bf16x8*)(w2t + (size_t)(16 * wid + m16) * 256 + 32 * s + 8 * gq); a2 = mfma16(bfr, a, a2); }
        { u32x2 o; o.x = pk2(a2[0], a2[1]); o.y = pk2(a2[2], a2[3]); if (n >= NCMP) { o.x = 0u; o.y = 0u; }
          *(u32x2*)((kv ? C.VC : C.KC) + (size_t)cr * 64 + 16 * wid + 4 * gq) = o;
          if (kv) { bf16* vt = C.VCT + ((size_t)bb * 64 + 16 * wid + 4 * gq) * 512 + n;
              vt[0] = (bf16)(o.x & 0xffffu); vt[512] = (bf16)(o.x >> 16); vt[1024] = (bf16)(o.y & 0xffffu); vt[1536] = (bf16)(o.y >> 16); } }
    }
    __syncthreads();
}

__device__ __forceinline__ void nsa_branch(const bf16* kb, const bf16* vb, int pitch, const LAS int* base, int nch, int vlo, int vhi, int chi,
                                           const LAS unsigned* qs, LAS float* sc, float (&o)[4], int lane) {
    float mx0 = -INFINITY, mx1 = -INFINITY, mx2 = -INFINITY, mx3 = -INFINITY;
#pragma unroll 1
    for (int i = 0; i < nch; ++i) {
        asm volatile("" ::: "memory");
        const int r = base[i] + lane; const bool valid = (r >= vlo) && (r <= vhi);
        const int rc = r < 0 ? 0 : (r > chi ? chi : r);
        const u32x4* kp = (const u32x4*)(kb + (size_t)rc * pitch);
        u32x4 kr[8];
#pragma unroll
        for (int c = 0; c < 8; ++c) kr[c] = kp[c];
        float a0 = 0.f, a1 = 0.f, a2 = 0.f, a3 = 0.f;
#pragma unroll
        for (int c = 0; c < 8; ++c) {
            const u32x4 q0 = *(const LAS u32x4*)(qs + 0 * 32 + 4 * c), q1 = *(const LAS u32x4*)(qs + 1 * 32 + 4 * c), q2 = *(const LAS u32x4*)(qs + 2 * 32 + 4 * c), q3 = *(const LAS u32x4*)(qs + 3 * 32 + 4 * c);
            a0 = dot2bf(kr[c].x, q0.x, a0); a0 = dot2bf(kr[c].y, q0.y, a0); a0 = dot2bf(kr[c].z, q0.z, a0); a0 = dot2bf(kr[c].w, q0.w, a0);
            a1 = dot2bf(kr[c].x, q1.x, a1); a1 = dot2bf(kr[c].y, q1.y, a1); a1 = dot2bf(kr[c].z, q1.z, a1); a1 = dot2bf(kr[c].w, q1.w, a1);
            a2 = dot2bf(kr[c].x, q2.x, a2); a2 = dot2bf(kr[c].y, q2.y, a2); a2 = dot2bf(kr[c].z, q2.z, a2); a2 = dot2bf(kr[c].w, q2.w, a2);
            a3 = dot2bf(kr[c].x, q3.x, a3); a3 = dot2bf(kr[c].y, q3.y, a3); a3 = dot2bf(kr[c].z, q3.z, a3); a3 = dot2bf(kr[c].w, q3.w, a3);
        }
        if (!valid) { a0 = -INFINITY; a1 = -INFINITY; a2 = -INFINITY; a3 = -INFINITY; }
        sc[0 * 1024 + 64 * i + lane] = a0; sc[1 * 1024 + 64 * i + lane] = a1; sc[2 * 1024 + 64 * i + lane] = a2; sc[3 * 1024 + 64 * i + lane] = a3;
        mx0 = fmaxf(mx0, a0); mx1 = fmaxf(mx1, a1); mx2 = fmaxf(mx2, a2); mx3 = fmaxf(mx3, a3);
    }
    mx0 = wave_max(mx0); mx1 = wave_max(mx1); mx2 = wave_max(mx2); mx3 = wave_max(mx3);
    float l0 = 0.f, l1 = 0.f, l2 = 0.f, l3 = 0.f;
    for (int i = 0; i < nch; ++i) {
        const float s0 = sc[0 * 1024 + 64 * i + lane], s1 = sc[1 * 1024 + 64 * i + lane], s2 = sc[2 * 1024 + 64 * i + lane], s3 = sc[3 * 1024 + 64 * i + lane];
        const float e0 = (s0 == -INFINITY) ? 0.f : __expf(s0 - mx0), e1 = (s1 == -INFINITY) ? 0.f : __expf(s1 - mx1), e2 = (s2 == -INFINITY) ? 0.f : __expf(s2 - mx2), e3 = (s3 == -INFINITY) ? 0.f : __expf(s3 - mx3);
        sc[0 * 1024 + 64 * i + lane] = e0; sc[1 * 1024 + 64 * i + lane] = e1; sc[2 * 1024 + 64 * i + lane] = e2; sc[3 * 1024 + 64 * i + lane] = e3;
        l0 += e0; l1 += e1; l2 += e2; l3 += e3;
    }
    l0 = wave_sum(l0); l1 = wave_sum(l1); l2 = wave_sum(l2); l3 = wave_sum(l3);
    const float i0 = l0 > 0.f ? 1.0f / l0 : 0.f, i1 = l1 > 0.f ? 1.0f / l1 : 0.f, i2 = l2 > 0.f ? 1.0f / l2 : 0.f, i3 = l3 > 0.f ? 1.0f / l3 : 0.f;
    for (int i = 0; i < nch; ++i) { sc[0 * 1024 + 64 * i + lane] *= i0; sc[1 * 1024 + 64 * i + lane] *= i1; sc[2 * 1024 + 64 * i + lane] *= i2; sc[3 * 1024 + 64 * i + lane] *= i3; }
    LDS_WAIT();
    float o0 = 0.f, o1 = 0.f, o2 = 0.f, o3 = 0.f;
    for (int i = 0; i < nch; ++i) {
        const int b0 = base[i];
        for (int j = 0; j < 64; j += 16) {
            float vv[16];
#pragma unroll
            for (int u = 0; u < 16; ++u) { int r = b0 + j + u; r = r < 0 ? 0 : (r > chi ? chi : r); vv[u] = bf2f((unsigned)vb[(size_t)r * pitch + lane]); }
#pragma unroll
            for (int u4 = 0; u4 < 4; ++u4) {
                const f32x4 p0 = *(const LAS f32x4*)(sc + 0 * 1024 + 64 * i + j + 4 * u4), p1 = *(const LAS f32x4*)(sc + 1 * 1024 + 64 * i + j + 4 * u4), p2 = *(const LAS f32x4*)(sc + 2 * 1024 + 64 * i + j + 4 * u4), p3 = *(const LAS f32x4*)(sc + 3 * 1024 + 64 * i + j + 4 * u4);
#pragma unroll
                for (int u = 0; u < 4; ++u) { const float v1 = vv[4 * u4 + u]; o0 += p0[u] * v1; o1 += p1[u] * v1; o2 += p2[u] * v1; o3 += p3[u] * v1; }
            }
        }
    }
    o[0] = o0; o[1] = o1; o[2] = o2; o[3] = o3;
}
template <bool CHECK>
__device__ __forceinline__ void nsa_query(const Ctx& C, int b, int t, LAS unsigned char* wl  , unsigned* errw) {
    const int lane = C.lane;
    LAS float* sc = (LAS float*)wl;
    LAS unsigned* qs = (LAS unsigned*)(wl + 16384);
    LAS int* base = (LAS int*)(wl + 16384 + 1024);
    const size_t row = (size_t)b * T + t;
    const bf16* zr = C.Z + row * DINP;
    const bf16* Zb = C.Z + (size_t)b * T * DINP;
    { const unsigned w2 = *(const unsigned*)(zr + C_Q + 2 * lane);
      const unsigned w3 = *(const unsigned*)(zr + C_Q + 128 + 2 * lane);
      qs[lane] = pk2(lo16(w2) * 0.125f, hi16(w2) * 0.125f); qs[64 + lane] = pk2(lo16(w3) * 0.125f, hi16(w3) * 0.125f); }
    const int nvalid = (t >= 31) ? ((t - 31) / 16 + 1) : 0;
    const int nchc = (nvalid + 63) >> 6;
    if (lane < 16) base[lane] = 64 * lane;
    LDS_WAIT();
    float oc[4];
    nsa_branch(C.KC + (size_t)b * 512 * 64, C.VC + (size_t)b * 512 * 64, 64, base, nchc, 0, nvalid - 1, 510, qs, sc, oc, lane);
    const int cur = t >> 6;
    float c0, c1;
    {
        float im0 = 0.f, im1 = 0.f;
#pragma unroll
        for (int rr = -1; rr <= 3; ++rr) { const int n0 = 4 * lane + rr, n1 = 4 * (lane + 64) + rr;
            if (n0 >= 0 && n0 < 64 * nchc) im0 += (sc[n0] + sc[1024 + n0]) + (sc[2048 + n0] + sc[3072 + n0]);
            if (n1 < 64 * nchc) im1 += (sc[n1] + sc[1024 + n1]) + (sc[2048 + n1] + sc[3072 + n1]); }
        const int m0 = lane, m1 = lane + 64;
        c0 = (m0 <= cur) ? (im0 + ((m0 == 0 || m0 == cur || m0 == cur - 1) ? 1e4f : 0.f)) : -1.0f;
        c1 = (m1 <= cur) ? (im1 + ((m1 == 0 || m1 == cur || m1 == cur - 1) ? 1e4f : 0.f)) : -1.0f;
    }
    LDS_WAIT();
    for (int r = 0; r < 16; ++r) {
        float bv; int bi;
        if (c0 >= c1) { bv = c0; bi = lane; } else { bv = c1; bi = lane + 64; }
#pragma unroll
        for (int off = 1; off < 64; off <<= 1) { const float ov = __shfl_xor(bv, off); const int oi = __shfl_xor(bi, off); if (ov > bv || (ov == bv && oi < bi)) { bv = ov; bi = oi; } }
        if (bi == lane) c0 = -2.0f; if (bi == lane + 64) c1 = -2.0f;
        if (lane == 0) base[r] = (bv >= 0.f) ? 64 * bi : -1000000;
    }
    LDS_WAIT();
    float os[4];
    nsa_branch(Zb + C_KSEL, Zb + C_VSEL, DINP, base, 16, 0, t, T - 1, qs, sc, os, lane);
    if (lane < 16) base[lane] = t - 511 + 64 * lane;
    LDS_WAIT();
    float ow[4];
    nsa_branch(Zb + C_KWIN, Zb + C_VWIN, DINP, base, 8, 0, t, T - 1, qs, sc, ow, lane);
    float yv[4];
#pragma unroll
    for (int h = 0; h < 4; ++h) {
        const float g0 = sigmoidf_(bf2f((unsigned)zr[C_GATE + 3 * h + 0])), g1 = sigmoidf_(bf2f((unsigned)zr[C_GATE + 3 * h + 1])), g2 = sigmoidf_(bf2f((unsigned)zr[C_GATE + 3 * h + 2]));
        yv[h] = g0 * oc[h] + g1 * os[h] + g2 * ow[h];
        if (!CHECK) C.Y[row * D + 256 + h * 64 + lane] = (bf16)f2bf(yv[h]);
    }
    if (CHECK) {
        const float rmax = wave_max(fmaxf(fmaxf(fabsf(yv[0]), fabsf(yv[1])), fmaxf(fabsf(yv[2]), fabsf(yv[3]))));
        int bad = 0;
#pragma unroll
        for (int h = 0; h < 4; ++h) { const float ym = bf2f((unsigned)C.Y[row * D + 256 + h * 64 + lane]); if (!(fabsf(ym - yv[h]) <= 0.03f * rmax + 2e-4f)) ++bad; }
        const float fb = wave_sum((float)bad);
        if (lane == 0) { atomicAdd(errw, (unsigned)fb); atomicAdd(errw + 64, 256u); }
    }
    LDS_WAIT();
}

__device__ __forceinline__ void xattn_unit(const Ctx& C, int l, int unit, LAS unsigned char* lds) {
    const int tid = C.tid, wid = C.wid, lane = C.lane;
    const int qt = unit & 63, bh = unit >> 6, b = bh >> 2, h = bh & 3;
    const int m16 = lane & 15, gq = lane >> 4;
    const size_t qrow = (size_t)b * T + qt * 128 + 16 * wid + m16;
    bf16x8 qf[8];
#pragma unroll
    for (int s = 0; s < 8; ++s) qf[s] = *(const bf16x8*)(C.Q + qrow * D + h * 256 + 32 * s + 8 * gq);
    const bf16* ksrc = C.KMEM + ((size_t)l * 1024 + b * 256) * 1024 + h * 256;
    for (int it = tid; it < 256 * 32; it += NTHREADS) { const int key = it >> 5, c = it & 31; *(LAS u32x4*)(lds + key * 528 + c * 16) = *(const u32x4*)(ksrc + (size_t)key * 1024 + 8 * c); }
    __syncthreads();
    f32x4 sacc[16];
#pragma unroll
    for (int kt = 0; kt < 16; ++kt) { sacc[kt] = (f32x4){0.f, 0.f, 0.f, 0.f};
#pragma unroll
        for (int s = 0; s < 8; ++s) { const bf16x8 a = *(const LAS bf16x8*)(lds + (16 * kt + m16) * 528 + 64 * s + 16 * gq); sacc[kt] = mfma16(a, qf[s], sacc[kt]); } }
    float mx = -INFINITY;
#pragma unroll
    for (int kt = 0; kt < 16; ++kt) mx = fmaxf(fmaxf(mx, fmaxf(sacc[kt][0], sacc[kt][1])), fmaxf(sacc[kt][2], sacc[kt][3]));
    mx = fmaxf(mx, __shfl_xor(mx, 16)); mx = fmaxf(mx, __shfl_xor(mx, 32));
    const float scl = 0.0625f * 1.4426950408889634f;
    float sum = 0.f;
#pragma unroll
    for (int kt = 0; kt < 16; ++kt)
#pragma unroll
        for (int r = 0; r < 4; ++r) { const float e = exp2f((sacc[kt][r] - mx) * scl); sacc[kt][r] = e; sum += e; }
    sum += __shfl_xor(sum, 16); sum += __shfl_xor(sum, 32);
    const float inv = 1.0f / sum;
    bf16x8 pf[8];
#pragma unroll
    for (int s2 = 0; s2 < 8; ++s2) { u32x4 w; w.x = pk2(sacc[2 * s2][0], sacc[2 * s2][1]); w.y = pk2(sacc[2 * s2][2], sacc[2 * s2][3]); w.z = pk2(sacc[2 * s2 + 1][0], sacc[2 * s2 + 1][1]); w.w = pk2(sacc[2 * s2 + 1][2], sacc[2 * s2 + 1][3]);
        pf[s2] = __builtin_bit_cast(bf16x8, w); }
    __syncthreads();
    const bf16* vsrc = C.VTMEM + ((size_t)l * 4096 + (b * 4 + h) * 256) * 256;
    for (int it = tid; it < 256 * 32; it += NTHREADS) { const int d = it >> 5, c = it & 31; *(LAS u32x4*)(lds + d * 528 + c * 16) = *(const u32x4*)(vsrc + (size_t)d * 256 + 8 * c); }
    __syncthreads();
#pragma unroll
    for (int dt = 0; dt < 16; ++dt) {
        f32x4 oacc = {0.f, 0.f, 0.f, 0.f};
#pragma unroll
        for (int s2 = 0; s2 < 8; ++s2) { const u32x2 lo = *(const LAS u32x2*)(lds + (16 * dt + m16) * 528 + 64 * s2 + 8 * gq), hi = *(const LAS u32x2*)(lds + (16 * dt + m16) * 528 + 64 * s2 + 32 + 8 * gq);
            u32x4 w; w.x = lo.x; w.y = lo.y; w.z = hi.x; w.w = hi.y; oacc = mfma16(__builtin_bit_cast(bf16x8, w), pf[s2], oacc); }
        u32x2 o; o.x = pk2(oacc[0] * inv, oacc[1] * inv); o.y = pk2(oacc[2] * inv, oacc[3] * inv);
        *(u32x2*)(C.Y + qrow * D + h * 256 + 16 * dt + 4 * gq) = o;
    }
    __syncthreads();
}

__device__ __forceinline__ void moe_gather(const Ctx& C, LAS unsigned char* lds) {
    LAS int* sh = (LAS int*)lds;
    for (int i = C.tid; i < 2048; i += NTHREADS) sh[i] = C.HIST[i];
    __syncthreads();
    if (C.tid < 8) { int c = 0; for (int tl = 0; tl < 256; ++tl) c += sh[tl * 8 + C.tid]; sh[2048 + C.tid] = c; }
    __syncthreads();
    if (C.tid == 0) { int acc = 0; for (int ex = 0; ex < 8; ++ex) { sh[2064 + ex] = acc; acc += (sh[2048 + ex] + 255) & ~255; if (C.bid == 0) C.META[ex] = acc >> 8; } if (C.bid == 0) C.META[8] = acc >> 8; }
    __syncthreads();
    for (int tile = C.bid; tile < 256; tile += C.G) {
        if (C.tid < 8) { int c = 0; for (int tl = 0; tl < tile; ++tl) c += sh[tl * 8 + C.tid]; sh[2056 + C.tid] = c; }
        __syncthreads();
        for (int i = 0; i < 32; ++i) {
            const int a = 32 * C.wid + i; const size_t ag = (size_t)tile * 256 + a;
            const unsigned info = C.TOKINFO[ag]; const int e = info & 255u, lr = info >> 8;
            const int dest = sh[2064 + e] + sh[2056 + e] + lr;
            if (C.lane == 0) C.TOKPOS[ag] = dest;
            const u32x4* s = (const u32x4*)(C.XB + ((size_t)tile * 128 + (a >> 1)) * D); u32x4* dd = (u32x4*)(C.XG + (size_t)dest * D);
            dd[C.lane] = s[C.lane]; dd[C.lane + 64] = s[C.lane + 64];
        }
        __syncthreads();
    }
    const int gw = C.bid * NWAVES + C.wid, NGW = C.G * NWAVES;
    for (int ex = 0; ex < 8; ++ex) { const int s0 = sh[2064 + ex] + sh[2048 + ex], e0 = sh[2064 + ex] + ((sh[2048 + ex] + 255) & ~255);
        for (int r = s0 + gw; r < e0; r += NGW) { u32x4* dd = (u32x4*)(C.XG + (size_t)r * D); const u32x4 z = {0u, 0u, 0u, 0u}; dd[C.lane] = z; dd[C.lane + 64] = z; } }
}

__device__ __forceinline__ void vt_tile(const Ctx& C, int tb) {
    const int b = tb >> 6, t0 = (tb & 63) << 7;
    for (int task = C.wid; task < 32; task += NWAVES) {
        const int arr = task >> 4, tg = task & 15; const int t = t0 + 8 * tg;
        const bf16* src = C.Z + ((size_t)b * T + t) * DINP + (arr ? C_VWIN : C_VSEL) + C.lane;
        unsigned v[8];
#pragma unroll
        for (int i = 0; i < 8; ++i) v[i] = src[(size_t)i * DINP];
        u32x4 o; o.x = v[0] | (v[1] << 16); o.y = v[2] | (v[3] << 16); o.z = v[4] | (v[5] << 16); o.w = v[6] | (v[7] << 16);
        *(u32x4*)((arr ? C.VWINT : C.VSELT) + ((size_t)b * 64 + C.lane) * T + t) = o;
    }
}

constexpr int NCT = 2, NQW = 4 * NCT;
struct NsaAcc { f32x4 o[NCT][4]; float m[NCT], l[NCT]; };
__device__ __forceinline__ void nsa_acc_reset(NsaAcc& A) {
#pragma unroll
    for (int ct = 0; ct < NCT; ++ct) { A.m[ct] = -INFINITY; A.l[ct] = 0.f;
#pragma unroll
        for (int dt = 0; dt < 4; ++dt) A.o[ct][dt] = (f32x4){0.f, 0.f, 0.f, 0.f}; }
}
#define NSA_SCL (0.125f * 1.4426950408889634f)
__device__ __forceinline__ void nsa_tile(const bf16* Kp, int kpitch, const bf16* VTp, int vpitch, const bf16x8 (&qf)[NCT][2], int k0,
                                         const int (&lo)[NCT], const int (&hi)[NCT], unsigned ctmask, NsaAcc& A, int c, int g) {
    bf16x8 kf[4][2], vf[4][2];
    const unsigned kl = (unsigned)(c * kpitch + 8 * g) * 2u, vl = (unsigned)(c * vpitch + 4 * g) * 2u;
#pragma unroll
    for (int sub = 0; sub < 4; ++sub)
#pragma unroll
        for (int s = 0; s < 2; ++s) kf[sub][s] = *(const bf16x8*)((const char*)(Kp + (size_t)(16 * sub) * kpitch + 32 * s) + kl);
#pragma unroll
    for (int dt = 0; dt < 4; ++dt)
#pragma unroll
        for (int s2 = 0; s2 < 2; ++s2) { const char* p = (const char*)(VTp + (size_t)(16 * dt) * vpitch + 32 * s2) + vl; const u32x2 a = *(const u32x2*)p, bq = *(const u32x2*)(p + 32);
            u32x4 w; w.x = a.x; w.y = a.y; w.z = bq.x; w.w = bq.y; vf[dt][s2] = __builtin_bit_cast(bf16x8, w); }
#pragma unroll
    for (int ct = 0; ct < NCT; ++ct) {
        if (!((ctmask >> ct) & 1u)) continue;
        f32x4 sa[4];
#pragma unroll
        for (int sub = 0; sub < 4; ++sub) { sa[sub] = mfma16(kf[sub][0], qf[ct][0], (f32x4){0.f, 0.f, 0.f, 0.f}); sa[sub] = mfma16(kf[sub][1], qf[ct][1], sa[sub]); }
        {
            const bool allv = (lo[ct] <= k0) && (k0 + 63 <= hi[ct]); const bool nonev = (hi[ct] < k0) || (lo[ct] > k0 + 63);
            if (__any(!(allv || nonev))) {
#pragma unroll
                for (int sub = 0; sub < 4; ++sub)
#pragma unroll
                    for (int r = 0; r < 4; ++r) { const int key = k0 + 16 * sub + 4 * g + r; sa[sub][r] = (key >= lo[ct] && key <= hi[ct]) ? sa[sub][r] : -INFINITY; }
            } else if (__any(nonev)) {
#pragma unroll
                for (int sub = 0; sub < 4; ++sub)
#pragma unroll
                    for (int r = 0; r < 4; ++r) sa[sub][r] = allv ? sa[sub][r] : -INFINITY;
            }
        }
        float tmax = fmaxf(fmaxf(fmaxf(sa[0][0], sa[0][1]), fmaxf(sa[0][2], sa[0][3])), fmaxf(fmaxf(sa[1][0], sa[1][1]), fmaxf(sa[1][2], sa[1][3])));
        tmax = fmaxf(tmax, fmaxf(fmaxf(fmaxf(sa[2][0], sa[2][1]), fmaxf(sa[2][2], sa[2][3])), fmaxf(fmaxf(sa[3][0], sa[3][1]), fmaxf(sa[3][2], sa[3][3]))));
        tmax = fmaxf(tmax, __shfl_xor(tmax, 16)); tmax = fmaxf(tmax, __shfl_xor(tmax, 32));
        tmax *= NSA_SCL;
        if (__any(tmax > A.m[ct])) {
            const float mn = fmaxf(A.m[ct], tmax);
            const float alpha = __builtin_amdgcn_exp2f(A.m[ct] - ((mn == -INFINITY) ? 0.f : mn));
            A.l[ct] *= alpha; A.m[ct] = mn;
#pragma unroll
            for (int dt = 0; dt < 4; ++dt) A.o[ct][dt] = A.o[ct][dt] * alpha;
        }
        const float nms = (A.m[ct] == -INFINITY) ? 0.f : -A.m[ct];
        float ps = 0.f;
#pragma unroll
        for (int sub = 0; sub < 4; ++sub)
#pragma unroll
            for (int r = 0; r < 4; ++r) { const float p = __builtin_amdgcn_exp2f(fmaf(sa[sub][r], NSA_SCL, nms)); sa[sub][r] = p; ps += p; }
        A.l[ct] += ps;
        bf16x8 pf[2];
#pragma unroll
        for (int s2 = 0; s2 < 2; ++s2) { u32x4 w; w.x = pk2(sa[2 * s2][0], sa[2 * s2][1]); w.y = pk2(sa[2 * s2][2], sa[2 * s2][3]); w.z = pk2(sa[2 * s2 + 1][0], sa[2 * s2 + 1][1]); w.w = pk2(sa[2 * s2 + 1][2], sa[2 * s2 + 1][3]);
            pf[s2] = __builtin_bit_cast(bf16x8, w); }
#pragma unroll
        for (int dt = 0; dt < 4; ++dt)
#pragma unroll
            for (int s2 = 0; s2 < 2; ++s2) A.o[ct][dt] = mfma16(vf[dt][s2], pf[s2], A.o[ct][dt]);
    }
}
__device__ __forceinline__ void nsa_finalize(const Ctx& C, NsaAcc& A, const bf16* Zb, size_t rowb, int t0, int jb, bool first, bool last, float (&msave)[NCT], float (&isave)[NCT], int c, int g) {
    const int ql = c >> 2, h = c & 3;
    float* scr = C.VBUF;
#pragma unroll
    for (int ct = 0; ct < NCT; ++ct) {
        float lt = A.l[ct]; lt += __shfl_xor(lt, 16); lt += __shfl_xor(lt, 32);
        const float inv = lt > 0.f ? 1.0f / lt : 0.f; msave[ct] = A.m[ct]; isave[ct] = inv;
        const int tq = t0 + 4 * ct + ql;
        const float gate = sigmoidf_(bf2f((unsigned)Zb[(size_t)tq * DINP + C_GATE + 3 * h + jb]));
        const float f = inv * gate;
#pragma unroll
        for (int dt = 0; dt < 4; ++dt) {
            f32x4 v = A.o[ct][dt] * f; const size_t off = (rowb + tq) * 256 + h * 64 + 16 * dt + 4 * g;
            if (!first) v = v + *(const f32x4*)(scr + off);
            if (last) { u32x2 o; o.x = pk2(v[0], v[1]); o.y = pk2(v[2], v[3]); *(u32x2*)(C.Y + (rowb + tq) * D + 256 + h * 64 + 16 * dt + 4 * g) = o; }
            else *(f32x4*)(scr + off) = v;
        }
    }
}
__device__ __forceinline__ void nsa_unit(const Ctx& C, int U, LAS unsigned char* wl) {
    const int lane = C.lane, c = lane & 15, g = lane >> 4, ql = c >> 2, h = c & 3;
    const int b = U / (T / NQW), t0 = (U % (T / NQW)) * NQW;
    const size_t rowb = (size_t)b * T;
    const bf16* Zb = C.Z + rowb * DINP;
    LAS float* imp = (LAS float*)wl; LAS unsigned* smask = (LAS unsigned*)(wl + 8192);
    bf16x8 qf[NCT][2]; int tq[NCT];
#pragma unroll
    for (int ct = 0; ct < NCT; ++ct) { tq[ct] = t0 + 4 * ct + ql;
#pragma unroll
        for (int s = 0; s < 2; ++s) qf[ct][s] = *(const bf16x8*)(Zb + (size_t)tq[ct] * DINP + C_Q + h * 64 + 32 * s + 8 * g); }
    NsaAcc A; float msave[NCT], isave[NCT], mc[NCT], ic[NCT];
    int lo[NCT], hi[NCT];
    constexpr unsigned ALLCT = (1u << NCT) - 1u;
    const int nmaxw = (t0 + NQW - 1 >= 31) ? ((t0 + NQW - 1 - 31) >> 4) : -1;
    const int nkt = (nmaxw >> 6) + 1;
    const bf16* KCb = C.KC + (size_t)b * 512 * 64; const bf16* VCTb = C.VCT + (size_t)b * 64 * 512;
#pragma unroll
    for (int ct = 0; ct < NCT; ++ct) { lo[ct] = 0; hi[ct] = (tq[ct] >= 31) ? ((tq[ct] - 31) >> 4) : -1; }
    nsa_acc_reset(A);
    for (int kt = 0; kt < nkt; ++kt) nsa_tile(KCb + (size_t)(64 * kt) * 64, 64, VCTb + 64 * kt, 512, qf, 64 * kt, lo, hi, ALLCT, A, c, g);
    nsa_finalize(C, A, Zb, rowb, t0, 0, true, false, mc, ic, c, g);
    for (int i = lane; i < NQW * 128; i += 64) imp[i] = 0.f;
    LDS_WAIT();
    for (int kt = 0; kt < nkt; ++kt) {
        bf16x8 kf[4][2];
#pragma unroll
        for (int sub = 0; sub < 4; ++sub)
#pragma unroll
            for (int s = 0; s < 2; ++s) kf[sub][s] = *(const bf16x8*)((const char*)(KCb + (size_t)(64 * kt + 16 * sub) * 64 + 32 * s) + (unsigned)(c * 64 + 8 * g) * 2u);
#pragma unroll
        for (int ct = 0; ct < NCT; ++ct) {
#pragma unroll
            for (int sub = 0; sub < 4; ++sub) {
                f32x4 sa = mfma16(kf[sub][0], qf[ct][0], (f32x4){0.f, 0.f, 0.f, 0.f}); sa = mfma16(kf[sub][1], qf[ct][1], sa);
                float p[4];
#pragma unroll
                for (int r = 0; r < 4; ++r) { const int n = 64 * kt + 16 * sub + 4 * g + r; float v = (n <= hi[ct]) ? __builtin_amdgcn_exp2f(sa[r] * NSA_SCL - mc[ct]) * ic[ct] : 0.f;
                    v += __shfl_xor(v, 1); v += __shfl_xor(v, 2); p[r] = v; }
                if (h == 0) { const int mb = 16 * kt + 4 * sub + g; LAS float* ip = imp + (4 * ct + ql) * 128 + mb;
                    atomicAdd((float*)ip, (p[0] + p[1]) + (p[2] + p[3])); if (mb + 1 < 128) atomicAdd((float*)(ip + 1), p[3]); }
            }
        }
    }
    LDS_WAIT();
#pragma unroll 1
    for (int qi = 0; qi < NQW; ++qi) {
        const int t = t0 + qi, cur = t >> 6; const int m0 = lane, m1 = lane + 64;
        unsigned long long mlo, mhi;
        if (cur < 16) { mlo = __ballot(m0 <= cur); mhi = 0ull; }
        else {
            const float s0 = imp[qi * 128 + m0] + ((m0 == 0 || m0 == cur || m0 == cur - 1) ? 1e4f : 0.f), s1 = imp[qi * 128 + m1] + ((m1 == 0 || m1 == cur || m1 == cur - 1) ? 1e4f : 0.f);
            const unsigned u0 = (m0 <= cur) ? __float_as_uint(s0) + 1u : 0u, u1 = (m1 <= cur) ? __float_as_uint(s1) + 1u : 0u;
            unsigned tau = 0u;
            for (int bit = 30; bit >= 0; --bit) { const unsigned cand = tau | (1u << bit); const int cnt = __popcll(__ballot(u0 >= cand)) + __popcll(__ballot(u1 >= cand)); if (cnt >= 16) tau = cand; }
            const unsigned long long g0 = __ballot(u0 > tau), g1 = __ballot(u1 > tau), e0 = __ballot(u0 == tau), e1 = __ballot(u1 == tau);
            int need = 16 - __popcll(g0) - __popcll(g1);
            const unsigned long long lt = (1ull << lane) - 1ull;
            const unsigned long long k0m = __ballot(((e0 >> lane) & 1ull) && __popcll(e0 & lt) < need); need -= __popcll(k0m);
            const unsigned long long k1m = __ballot(((e1 >> lane) & 1ull) && __popcll(e1 & lt) < need);
            mlo = g0 | k0m; mhi = g1 | k1m;
        }
        if (lane == 0) { smask[qi * 4 + 0] = (unsigned)mlo; smask[qi * 4 + 1] = (unsigned)(mlo >> 32); smask[qi * 4 + 2] = (unsigned)mhi; smask[qi * 4 + 3] = (unsigned)(mhi >> 32); }
    }
    LDS_WAIT();
    nsa_acc_reset(A);
    {
        const int jmax = (t0 + NQW - 1) >> 6;
        const bf16* Kb = Zb + C_KSEL; const bf16* VTb = C.VSELT + (size_t)b * 64 * T;
#pragma unroll
        for (int ct = 0; ct < NCT; ++ct) lo[ct] = 0;
        for (int j = 0; j <= jmax; ++j) {
            unsigned ctmask = 0u;
#pragma unroll
            for (int ct = 0; ct < NCT; ++ct) { const unsigned w = smask[(4 * ct + ql) * 4 + (j >> 5)]; const bool sel = (w >> (j & 31)) & 1u; hi[ct] = sel ? tq[ct] : -1; if (__any(sel)) ctmask |= 1u << ct; }
            if (ctmask) nsa_tile(Kb + (size_t)(64 * j) * DINP, DINP, VTb + 64 * j, T, qf, 64 * j, lo, hi, ctmask, A, c, g);
        }
    }
    nsa_finalize(C, A, Zb, rowb, t0, 1, false, false, msave, isave, c, g);
    nsa_acc_reset(A);
    {
        const int j0 = (t0 >= 511) ? ((t0 - 511) >> 6) : 0, j1 = (t0 + NQW - 1) >> 6;
        const bf16* Kb = Zb + C_KWIN; const bf16* VTb = C.VWINT + (size_t)b * 64 * T;
#pragma unroll
        for (int ct = 0; ct < NCT; ++ct) { lo[ct] = tq[ct] - 511; hi[ct] = tq[ct]; }
        for (int j = j0; j <= j1; ++j) nsa_tile(Kb + (size_t)(64 * j) * DINP, DINP, VTb + 64 * j, T, qf, 64 * j, lo, hi, ALLCT, A, c, g);
    }
    nsa_finalize(C, A, Zb, rowb, t0, 2, false, true, msave, isave, c, g);
    LDS_WAIT();
}

#ifndef DBG_REP
#define DBG_REP 0
#endif
#ifndef NSA_CHECK
#define NSA_CHECK 0
#endif
#ifndef MK_MULTI
#define MK_MULTI 0
#endif
constexpr int PH_PER_LAYER = 13, N_PHASES = 1 + NL * PH_PER_LAYER;


__device__ __forceinline__ void mkctx(Ctx& C, const Params& P, int tid) {
    C.tid = tid; C.lane = tid & 63; C.wid = __builtin_amdgcn_readfirstlane(tid >> 6); C.bid = blockIdx.x; C.G = gridDim.x;
#pragma unroll
    for (int i = 0; i < 35; ++i) C.in[i] = P.in[i];
    unsigned char* ws = P.ws;
    C.X = P.out;
    C.XB = (bf16*)(ws + WS_XB); C.Z = (bf16*)(ws + WS_Z); C.Y = (bf16*)(ws + WS_Y); C.Q = (bf16*)(ws + WS_Q); C.H = (bf16*)(ws + WS_H); C.XG = (bf16*)(ws + WS_Z);
    C.KC = (bf16*)(ws + WS_KC); C.VC = (bf16*)(ws + WS_VC); C.MEMB = (bf16*)(ws + WS_MEMB); C.KMEM = (bf16*)(ws + WS_KMEM); C.VTMEM = (bf16*)(ws + WS_VTMEM); C.VCT = (bf16*)(ws + WS_VCT); C.VSELT = (bf16*)(ws + WS_VSELT); C.VWINT = (bf16*)(ws + WS_VWINT);
    C.WINT = (bf16*)(ws + WS_WINT); C.WOUTT = (bf16*)(ws + WS_WOUTT); C.XQT = (bf16*)(ws + WS_XQT); C.XKVT = (bf16*)(ws + WS_XKVT); C.XOT = (bf16*)(ws + WS_XOT);
    C.W13T = (bf16*)(ws + WS_W13T); C.W2T = (bf16*)(ws + WS_W2T); C.E13T = (bf16*)(ws + WS_E13T); C.E2T = (bf16*)(ws + WS_E2T);
    C.CW1T = (bf16*)(ws + WS_CW1T); C.CW2T = (bf16*)(ws + WS_CW2T); C.PWT = (bf16*)(ws + WS_PWT); C.POOLWT = (bf16*)(ws + WS_POOLWT); C.SGUWB = (bf16*)(ws + WS_SGUW);
    C.VBUF = (float*)(ws + WS_VBUF); C.FS = (float*)(ws + WS_VBUF); C.PEB = (float*)(ws + WS_PEB); C.TOKG = (float*)(ws + WS_TOKG);
    C.HIST = (int*)(ws + WS_HIST); C.META = (int*)(ws + WS_META); C.TOKPOS = (int*)(ws + WS_TOKPOS); C.TOKINFO = (unsigned*)(ws + WS_TOKINFO);
}
#define MKCTX() Ctx C; { int t_ = threadIdx.x; asm volatile("" : "+v"(t_)); mkctx(C, P, t_); }

__global__ void __launch_bounds__(NTHREADS, 2) fwd_kernel(Params P) {
    extern __shared__ __attribute__((aligned(16))) unsigned char lds_raw[];
    LAS unsigned char* lds = (LAS unsigned char*)lds_raw;
    for (int u = threadIdx.x; u < (LDS_BYTES - LDSCTL_OFF) / 4; u += NTHREADS) ((LAS unsigned*)(lds + LDSCTL_OFF))[u] = 0u;
    __syncthreads();
    unsigned char* ws = P.ws;
    XcdBarrier bar; bar.bar = (unsigned*)(ws + WS_CTL); bar.x = 0; bar.st = nullptr;
#if !MK_MULTI
    bar = xcd_barrier_post((unsigned*)(ws + WS_CTL), (volatile LAS unsigned*)(lds + LDSCTL_OFF));
#endif
    const int lo = P.ph_lo, hi = P.ph_hi;
#define IN(k) (lo <= (k) && (k) < hi)
#if MK_MULTI
#define SEAM(k) do { } while (0)
#else
#define SEAM(k) do { if (IN(k) && IN((k) + 1)) xcd_barrier(bar); } while (0)
#endif
    int ph = 0;
    if (IN(ph)) { for (int rep = 0; rep < ((P.dbg & 2) ? 2 : 1); ++rep) { MKCTX(); p0_prologue(C, lds); __syncthreads(); } }
    SEAM(ph); ++ph;

    for (int l = 0; l < NL; ++l) {
        const bool moe = (l & 1) != 0; const int li = l >> 1;
        if (IN(ph)) {
            MKCTX();
            if (l == 0) {
                for (int l2 = 0; l2 < NL; ++l2) {
                    pg8::Gemm g{C.MEMB, C.XKVT + (size_t)l2 * 2 * D * D, NB * MEM, 2 * D, D}; pg8::StaticOrder S; S.init(NB * MEM, 2 * D, C.G, (C.bid + 32 * l2) % C.G);
                    pg8::EpiKV E{C.KMEM + (size_t)l2 * 1024 * 1024, C.VTMEM + (size_t)l2 * 4096 * 256};
                    pg8::gemm_phase<pg8::EpiKV, pg8::StaticOrder, true, true>(lds, g, S, E);
                }
            }
            pg8::Gemm g{C.XB, C.WINT + (size_t)l * DINP * D, M, DINP, D}; pg8::StaticOrder S; S.init(M, DINP, C.G, C.bid);
            pg8::EpiBf16 E{C.Z, DINP};
            pg8::gemm_phase<pg8::EpiBf16, pg8::StaticOrder, true, true>(lds, g, S, E);
        }
        SEAM(ph); ++ph;
        if (IN(ph)) for (int rep = 0; rep < ((P.dbg & 4) ? 2 : 1); ++rep) {
            MKCTX();
            { ConvW cw;
              for (int tb = C.bid; tb < M / 128; tb += C.G) vt_tile(C, tb);
              for (int tb = C.bid; tb < M / 128; tb += C.G) mixers_tile<1>(C, l, tb, lds, cw);
              for (int tb = C.bid; tb < M / 128; tb += C.G) mixers_tile<2>(C, l, tb, lds, cw);
              load_convw(C, l, cw);
              for (int tb = C.bid; tb < M / 128; tb += C.G) mixers_tile<4>(C, l, tb, lds, cw); }
            for (int it = C.bid; it < 256; it += C.G) compress_item(C, l, it, lds);
        }
        SEAM(ph); ++ph;
        if (IN(ph)) for (int rep = 0; rep < ((P.dbg & 1) ? 2 : 1); ++rep) {
            MKCTX();
            for (int slot = C.bid * NWAVES + C.wid; slot < M / NQW / 2; slot += C.G * NWAVES) {
                int bb = slot >> 9, lw = slot & 511;
                if (C.G == 256) { bb = (C.bid & 7) >> 1; lw = (((C.bid >> 3) << 1) + (C.bid & 1)) * NWAVES + C.wid; }
#pragma unroll 1
                for (int k = 0; k < 2; ++k) nsa_unit(C, bb * (T / NQW) + (k ? (T / NQW - 1 - lw) : lw), lds + C.wid * 17664);
            }
#if NSA_CHECK
            xcd_barrier(bar);
            { const int gw = C.bid * NWAVES + C.wid, NGW = C.G * NWAVES;
              for (int q = gw; q < M; q += NGW) { const int t = q & (T - 1); if ((((unsigned)q * 2654435761u) >> 29) == 0u || t < 192) nsa_query<true>(C, q >> 13, t, lds + C.wid * 17664, (unsigned*)(P.ws + WS_CTL + 32768)); } }
#endif
        }
        SEAM(ph); ++ph;
        if (IN(ph)) {
            MKCTX();
            pg8::Gemm g{C.Y, C.WOUTT + (size_t)l * D * D, M, D, D}; pg8::StaticOrder S; S.init(M, D, C.G, C.bid);
            pg8::EpiF32Res E{C.VBUF, (l == 0) ? C.in[I_X] : (const float*)C.X, D, ALPHA};
            pg8::gemm_phase<pg8::EpiF32Res, pg8::StaticOrder, true, true>(lds, g, S, E);
        }
        SEAM(ph); ++ph;
        if (IN(ph)) for (int rep = 0; rep < ((P.dbg & 8) ? 2 : 1); ++rep) { MKCTX(); ln_phase(C, C.VBUF, C.in[I_LN1G] + l * D, C.in[I_LN1B] + l * D, 0, nullptr, lds); }
        SEAM(ph); ++ph;
        if (IN(ph)) {
            MKCTX();
            pg8::Gemm g{C.XB, C.XQT + (size_t)l * D * D, M, D, D}; pg8::StaticOrder S; S.init(M, D, C.G, C.bid);
            pg8::EpiBf16 E{C.Q, D};
            pg8::gemm_phase<pg8::EpiBf16, pg8::StaticOrder, true, true>(lds, g, S, E);
        }
        SEAM(ph); ++ph;
        if (IN(ph)) for (int rep = 0; rep < ((P.dbg & 16) ? 2 : 1); ++rep) { MKCTX(); for (int u = C.bid; u < NB * 4 * 64; u += C.G) xattn_unit(C, l, u, lds); }
        SEAM(ph); ++ph;
        if (IN(ph)) {
            MKCTX();
            pg8::Gemm g{C.Y, C.XOT + (size_t)l * D * D, M, D, D}; pg8::StaticOrder S; S.init(M, D, C.G, C.bid);
            pg8::EpiF32Res E{C.VBUF, (const float*)C.X, D, ALPHA};
            pg8::gemm_phase<pg8::EpiF32Res, pg8::StaticOrder, true, true>(lds, g, S, E);
        }
        SEAM(ph); ++ph;
        if (IN(ph)) for (int rep = 0; rep < ((P.dbg & 8) ? 2 : 1); ++rep) { MKCTX(); ln_phase(C, C.VBUF, C.in[I_LN2G] + l * D, C.in[I_LN2B] + l * D, 0, moe ? C.in[I_ROUTER] + (size_t)li * D * NE : nullptr, lds); }
        SEAM(ph); ++ph;
        if (IN(ph)) for (int rep = 0; rep < ((P.dbg & 32) ? 2 : 1); ++rep) { if (moe) { MKCTX(); moe_gather(C, lds); __syncthreads(); } }
        if (moe || MK_MULTI) SEAM(ph);
        ++ph;
        if (IN(ph)) {
            MKCTX();
            pg8::GroupedOrder S; int npan;
            if (moe) {
#pragma unroll
                for (int k = 0; k < 8; ++k) S.pend[k] = __builtin_amdgcn_readfirstlane(C.META[k]);
                npan = __builtin_amdgcn_readfirstlane(C.META[8]); S.estride = (size_t)2 * FE * D * 2;
            } else {
#pragma unroll
                for (int k = 0; k < 8; ++k) S.pend[k] = M / 256;
                npan = M / 256; S.estride = 0;
            }
            const int N = moe ? 2 * FE : 2 * FF;
            pg8::Gemm g{moe ? C.XG : C.XB, moe ? C.E13T + (size_t)li * NE * 2 * FE * D : C.W13T + (size_t)li * 2 * FF * D, npan * 256, N, D};
            S.init(npan * 256, N, C.G, C.bid);
            pg8::EpiSwiglu E{C.H, N / 2};
            pg8::gemm_phase<pg8::EpiSwiglu, pg8::GroupedOrder, true, true>(lds, g, S, E);
        }
        SEAM(ph); ++ph;
        if (IN(ph)) {
            MKCTX();
            pg8::GroupedOrder S; int npan;
            if (moe) {
#pragma unroll
                for (int k = 0; k < 8; ++k) S.pend[k] = __builtin_amdgcn_readfirstlane(C.META[k]);
                npan = __builtin_amdgcn_readfirstlane(C.META[8]); S.estride = (size_t)D * FE * 2;
            } else {
#pragma unroll
                for (int k = 0; k < 8; ++k) S.pend[k] = M / 256;
                npan = M / 256; S.estride = 0;
            }
            const int K = moe ? FE : FF;
            pg8::Gemm g{C.H, moe ? C.E2T + (size_t)li * NE * D * FE : C.W2T + (size_t)li * D * FF, npan * 256, D, K};
            S.init(npan * 256, D, C.G, C.bid);
            pg8::EpiF32Res E{moe ? C.FS : C.VBUF, moe ? nullptr : (const float*)C.X, D, ALPHA};
            pg8::gemm_phase<pg8::EpiF32Res, pg8::GroupedOrder, true, true>(lds, g, S, E);
        }
        SEAM(ph); ++ph;
        if (IN(ph)) { MKCTX(); ln_phase(C, C.VBUF, C.in[I_LN3G] + l * D, C.in[I_LN3B] + l * D, moe ? 1 : 0, nullptr, lds); }
        SEAM(ph); ++ph;
    }
#if NSA_CHECK
    xcd_barrier(bar);
    { unsigned* ew = (unsigned*)(P.ws + WS_CTL + 32768); const unsigned err = __hip_atomic_load(ew, __ATOMIC_RELAXED, __HIP_MEMORY_SCOPE_AGENT), cnt = __hip_atomic_load(ew + 64, __ATOMIC_RELAXED, __HIP_MEMORY_SCOPE_AGENT);
      if (cnt == 0u || (unsigned long long)err * 256ull > (unsigned long long)cnt) { for (size_t i = (size_t)blockIdx.x * NTHREADS + threadIdx.x; i < (size_t)M * D; i += (size_t)gridDim.x * NTHREADS) P.out[i] = 0.f; } }
#endif
#undef IN
#undef SEAM
}

extern "C" void kernel_launch(void* const* d_in, const int* in_sizes, int n_in, void* d_out, int out_size, void* d_ws, size_t ws_size, hipStream_t stream) {
    static int grid = 0;
    if (grid == 0) {
        if (n_in != 35 || out_size != M * D || ws_size < WS_END) { fprintf(stderr, "kernel_launch: unexpected problem (n_in %d, out %d, ws %zu < %zu)\n", n_in, out_size, ws_size, (size_t)WS_END); grid = -1; return; }
        int dev = 0, cus = 0, per_cu = 0;
        if (hipGetDevice(&dev) != hipSuccess || hipDeviceGetAttribute(&cus, hipDeviceAttributeMultiprocessorCount, dev) != hipSuccess) { grid = -1; return; }
        if (hipFuncSetAttribute((const void*)fwd_kernel, hipFuncAttributeMaxDynamicSharedMemorySize, LDS_BYTES) != hipSuccess) { fprintf(stderr, "kernel_launch: hipFuncSetAttribute failed\n"); grid = -1; return; }
        if (hipOccupancyMaxActiveBlocksPerMultiprocessor(&per_cu, (const void*)fwd_kernel, NTHREADS, LDS_BYTES) != hipSuccess || per_cu < 1) { fprintf(stderr, "kernel_launch: occupancy query says %d\n", per_cu); }
        (void)hipGetLastError();
        grid = cus;
    }
    if (grid < 0) return;
    (void)hipMemsetAsync((char*)d_ws + WS_CTL, 0, CTL_ZERO_BYTES, stream);
    Params p{};
    for (int i = 0; i < 35; ++i) p.in[i] = (const float*)d_in[i];
    p.out = (float*)d_out; p.ws = (unsigned char*)d_ws; p.dbg = DBG_REP;
#if MK_MULTI
    for (int k = 0; k < N_PHASES; ++k) { p.ph_lo = k; p.ph_hi = k + 1; hipLaunchKernelGGL(fwd_kernel, dim3(grid), dim3(NTHREADS), LDS_BYTES, stream, p); }
#else
    p.ph_lo = 0; p.ph_hi = N_PHASES;
    hipLaunchKernelGGL(fwd_kernel, dim3(grid), dim3(NTHREADS), LDS_BYTES, stream, p);
#endif
}
```

```cpp
#include <hip/hip_runtime.h>
#include <cstdio>
#include <cstdint>

#define GAS __attribute__((address_space(1)))
#define LAS __attribute__((address_space(3)))
typedef unsigned short bf16;
typedef short bf16x8 __attribute__((ext_vector_type(8)));
typedef short bf16x4 __attribute__((ext_vector_type(4)));
typedef float f32x4 __attribute__((ext_vector_type(4)));
typedef float f32x2 __attribute__((ext_vector_type(2)));
typedef unsigned u32x4 __attribute__((ext_vector_type(4)));
typedef unsigned u32x2 __attribute__((ext_vector_type(2)));

constexpr int D = 1024, NB = 4, T = 8192, NL = 4, MEM = 256, M = NB * T;
constexpr int DIN = 1932, DINP = 2048;
constexpr int C_POOL = 0, C_Q = 256, C_KCMP = 512, C_VCMP = 576, C_KSEL = 640, C_VSEL = 704, C_KWIN = 768, C_VWIN = 832, C_GATE = 896, C_U = 908, C_V = 1164, C_CA = 1420, C_CG = 1676;
constexpr int FF = 2816, NE = 8, FE = 3584;
constexpr int NCMP = 511;
constexpr float ALPHA = 1.6817928305074292f;
constexpr float LN_EPS = 1e-5f;
constexpr int MOE_ROWS = 2 * M + NE * 256;
constexpr int NWAVES = 8, NTHREADS = 512;

constexpr size_t al256(size_t x) { return (x + 255) & ~(size_t)255; }
constexpr size_t MiB = 1u << 20;
constexpr size_t WS_CTL = 0, CTL_ZERO_BYTES = 64 * 1024;
constexpr size_t WS_HIST = 1 * MiB;
constexpr size_t WS_META = WS_HIST + 8192;
constexpr size_t WS_TOKINFO = WS_META + 256;
constexpr size_t WS_TOKG = WS_TOKINFO + (size_t)2 * M * 4;
constexpr size_t WS_TOKPOS = WS_TOKG + (size_t)2 * M * 4;
constexpr size_t WS_KC = WS_TOKPOS + (size_t)2 * M * 4;
constexpr size_t WS_VC = WS_KC + (size_t)NB * 512 * 64 * 2;
constexpr size_t WS_PEB = WS_VC + (size_t)NB * 512 * 64 * 2;
constexpr size_t WS_POOLWT = WS_PEB + (size_t)NL * 2 * 256 * 4;
constexpr size_t WS_SGUW = WS_POOLWT + (size_t)NL * 4 * 64 * 64 * 2;
constexpr size_t WS_PWT = WS_SGUW + (size_t)NL * 4 * 128 * 128 * 2;
constexpr size_t WS_CW2T = WS_PWT + (size_t)NL * 256 * 256 * 2;
constexpr size_t WS_CW1T = WS_CW2T + (size_t)NL * 2 * 64 * 256 * 2;
constexpr size_t WS_MEMB = WS_CW1T + (size_t)NL * 2 * 256 * 2048 * 2;
constexpr size_t WS_KMEM = WS_MEMB + (size_t)1024 * 1024 * 2;
constexpr size_t WS_VTMEM = WS_KMEM + (size_t)NL * 1024 * 1024 * 2;
constexpr size_t WS_KCF = WS_VTMEM + (size_t)NL * 4096 * 256 * 2;
constexpr size_t WS_VCF = WS_KCF + (size_t)NB * 8 * 4096 * 2;
constexpr size_t WS_KSELF = WS_VCF + (size_t)NB * 8 * 4096 * 2;
constexpr size_t WS_VSELF = WS_KSELF + (size_t)NB * 128 * 4096 * 2;
constexpr size_t WS_KWINF = WS_VSELF + (size_t)NB * 128 * 4096 * 2;
constexpr size_t WS_VWINF = WS_KWINF + (size_t)NB * 128 * 4096 * 2;
constexpr size_t WS_SMALL_END = WS_VWINF + (size_t)NB * 128 * 4096 * 2;
constexpr size_t WS_WINT = 48 * MiB;
static_assert(WS_SMALL_END <= WS_WINT, "small region");
constexpr size_t WS_WOUTT = WS_WINT + (size_t)NL * DINP * D * 2;
constexpr size_t WS_XQT = WS_WOUTT + (size_t)NL * D * D * 2;
constexpr size_t WS_XKVT = WS_XQT + (size_t)NL * D * D * 2;
constexpr size_t WS_XOT = WS_XKVT + (size_t)NL * 2 * D * D * 2;
constexpr size_t WS_W13T = WS_XOT + (size_t)NL * D * D * 2;
constexpr size_t WS_W2T = WS_W13T + (size_t)2 * 2 * FF * D * 2;
constexpr size_t WS_E13T = WS_W2T + (size_t)2 * D * FF * 2;
constexpr size_t WS_E2T = WS_E13T + (size_t)16 * 2 * FE * D * 2;
constexpr size_t WS_XB = WS_E2T + (size_t)16 * D * FE * 2;
constexpr size_t WS_VBUF = WS_XB + (size_t)M * D * 2;
constexpr size_t WS_Z = WS_VBUF + (size_t)M * D * 4;
constexpr size_t WS_Y = WS_Z + (size_t)M * DINP * 2;
constexpr size_t WS_Q = WS_Y + (size_t)M * D * 2;
constexpr size_t WS_H = WS_Q + (size_t)M * D * 2;
constexpr size_t WS_END = WS_H + (size_t)MOE_ROWS * FE * 2;
static_assert((size_t)MOE_ROWS * D * 4 <= WS_H - WS_VBUF, "FS overlay");
static_assert((size_t)MOE_ROWS * D * 2 <= WS_Q - WS_Z, "XG overlay");

constexpr int SCR_BYTES = 153600;
constexpr int LDSCTL_OFF = SCR_BYTES;
constexpr int LDS_BYTES = 155648;

__device__ __forceinline__ float bf2f(unsigned v) { return __uint_as_float(v << 16); }
__device__ __forceinline__ unsigned f2bf(float f) { unsigned u = __builtin_bit_cast(unsigned, f); return (u + 0x7fffu + ((u >> 16) & 1u)) >> 16; }
typedef __bf16 bf16x2_t __attribute__((ext_vector_type(2)));
__device__ __forceinline__ unsigned pk2(float lo, float hi) { const f32x2 v = {lo, hi}; const bf16x2_t b = __builtin_convertvector(v, bf16x2_t); return __builtin_bit_cast(unsigned, b); }
__device__ __forceinline__ float lo16(unsigned w) { return __uint_as_float(w << 16); }
__device__ __forceinline__ float hi16(unsigned w) { return __uint_as_float(w & 0xffff0000u); }
__device__ __forceinline__ float sigmoidf_(float x) { return 1.0f / (1.0f + __expf(-x)); }
__device__ __forceinline__ float siluf_(float x) { return x / (1.0f + __expf(-x)); }
__device__ __forceinline__ float gelu_tanh(float x) { const float u = 0.7978845608028654f * (x + 0.044715f * x * x * x); return x / (1.0f + __expf(-2.0f * u)); }
__device__ __forceinline__ float wave_sum(float v) {
#pragma unroll
    for (int o = 1; o < 64; o <<= 1) v += __shfl_xor(v, o);
    return v;
}
__device__ __forceinline__ float wave_max(float v) {
#pragma unroll
    for (int o = 1; o < 64; o <<= 1) v = fmaxf(v, __shfl_xor(v, o));
    return v;
}
__device__ __forceinline__ f32x4 mfma16(bf16x8 a, bf16x8 b, f32x4 c) { return __builtin_amdgcn_mfma_f32_16x16x32_bf16(a, b, c, 0, 0, 0); }
__device__ __forceinline__ float dot2bf(unsigned a, unsigned b, float c) { return __builtin_amdgcn_fdot2_f32_bf16(__builtin_bit_cast(bf16x2_t, a), __builtin_bit_cast(bf16x2_t, b), c, false); }
#define LDS_WAIT() asm volatile("s_waitcnt lgkmcnt(0)" ::: "memory")

namespace pg8 {
#define PG8_LAS __attribute__((address_space(3)))
typedef unsigned short bf16_t;
typedef short bf16x8 __attribute__((ext_vector_type(8)));
typedef float f32x4 __attribute__((ext_vector_type(4)));
typedef unsigned u32x4 __attribute__((ext_vector_type(4)));
constexpr int BM = 256, BK = 64, HALF = 128, HTB = HALF * BK * 2  , STAGE_BYTES = 8 * HTB, NXCD = 8, WGM = 8;

__host__ __device__ __forceinline__ int lds_byte(int r, int c) { const int st = (r >> 4) * 2 + (c >> 5), rr = r & 15, cc = c & 31, ob = rr * 64 + cc * 2; return st * 1024 + (ob ^ (((ob >> 9) & 1) << 5)); }
__host__ __device__ __forceinline__ void stage_rc(int b, int& R, int& C) { const int st = b / 1024, sb = b % 1024, swz = sb ^ (((sb >> 9) & 1) << 5); R = (st >> 1) * 16 + swz / 64; C = (st & 1) * 32 + (swz % 64) / 2; }
__host__ __device__ __forceinline__ int perm32(int rho) { const int n = rho >> 4, i = rho & 15; return 8 * (i >> 2) + 4 * n + (i & 3); }

struct Unit { int pm, pn; };
struct Gemm { const bf16_t* A; const bf16_t* Bt; int M, N, K; };

struct StaticOrder {
    int nM, nN, nwg, G, c;
    __host__ __device__ void init(int M, int N, int G_, int c_) { nM = M / BM; nN = N / BM; nwg = nM * nN; G = G_; c = c_; }
    __host__ __device__ bool next(int i, Unit& u) const {
        const long L = (long)i * G + c; if (L >= nwg) return false;
        int wgid = (int)L; { const int q = nwg / NXCD, r = nwg % NXCD, xcd = wgid % NXCD, off = wgid / NXCD; wgid = (xcd < r ? xcd * (q + 1) : r * (q + 1) + (xcd - r) * q) + off; }
        const int nig = WGM * nN, gid = wgid / nig, fm = gid * WGM, gsz = (nM - fm) < WGM ? (nM - fm) : WGM;
        u.pm = fm + ((wgid % nig) % gsz); u.pn = (wgid % nig) / gsz; return true;
    }
    __device__ __forceinline__ void a_ready(const Unit&) const {}
    __device__ __forceinline__ void done(const Unit&) const {}
    __device__ __forceinline__ const char* bbase(const Gemm& g, const Unit&) const { return (const char*)g.Bt; }
};

template <class Epi, class Sched, bool ALIGN_EPI = false, bool SP2 = false>
__device__ __forceinline__ void gemm_phase(PG8_LAS unsigned char* lds, const Gemm g, const Sched& S, const Epi& E) {
    int tid_l = threadIdx.x; asm volatile("" : "+v"(tid_l));
    const int tid = tid_l, wid = __builtin_amdgcn_readfirstlane(tid >> 6), lane = tid & 63, wr = wid >> 2, wc = wid & 3, fr = lane & 15, fq = lane >> 4;
    const int K = g.K, nt = K / BK;
    unsigned voffA[2], voffB[2];
#pragma unroll
    for (int i = 0; i < 2; ++i) { int R, C; stage_rc(tid * 16 + i * 8192, R, C); const int Rb = Epi::PERM ? ((R & ~31) + perm32(R & 31)) : R;
        voffA[i] = (unsigned)(R * K + C) * 2u; voffB[i] = (unsigned)(Rb * K + C) * 2u; }
    const size_t kstep = (size_t)(BK * 2);
    const size_t hstep = (size_t)HALF * K * 2;
    const size_t tstep = 2 * hstep;
    const unsigned ldsw = (unsigned)wid * 1024u;
    const int aoff = lds_byte(wr * 64 + fr, fq * 8), boff = lds_byte(wc * 32 + fr, fq * 8);
#define PG8_SA(b, h) (((b) * 2 + (h)) * HTB)
#define PG8_SB(b, h) ((4 + (b) * 2 + (h)) * HTB)
#define PG8_STAGE(bufoff, gbase, voff) do { _Pragma("unroll") for (int _i = 0; _i < 2; ++_i) \
        __builtin_amdgcn_global_load_lds((const unsigned*)((const char*)(gbase) + (voff)[_i]), (PG8_LAS unsigned*)(lds + (bufoff) + ldsw + _i * 8192), 16, 0, 0); } while (0)
#define PG8_LDA(dst, b, h) do { _Pragma("unroll") for (int m = 0; m < 4; ++m) _Pragma("unroll") for (int k = 0; k < 2; ++k) dst[m][k] = *(const PG8_LAS bf16x8*)(lds + PG8_SA(b, h) + aoff + m * 2048 + k * 1024); } while (0)
#define PG8_LDB(dst, b, h) do { _Pragma("unroll") for (int n = 0; n < 2; ++n) _Pragma("unroll") for (int k = 0; k < 2; ++k) dst[n][k] = *(const PG8_LAS bf16x8*)(lds + PG8_SB(b, h) + boff + n * 2048 + k * 1024); } while (0)
#define PG8_MMA(ai, bj, At, Bt) do { __builtin_amdgcn_s_setprio(1); _Pragma("unroll") for (int m = 0; m < 4; ++m) _Pragma("unroll") for (int n = 0; n < 2; ++n) _Pragma("unroll") for (int k = 0; k < 2; ++k) \
        acc[ai][bj][m][n] = __builtin_amdgcn_mfma_f32_16x16x32_bf16(Bt[n][k], At[m][k], acc[ai][bj][m][n], 0, 0, 0); __builtin_amdgcn_s_setprio(0); } while (0)
#define PG8_WAIT_V(n) asm volatile("s_waitcnt vmcnt(" #n ")" ::: "memory")
#define PG8_WAIT_L(n) asm volatile("s_waitcnt lgkmcnt(" #n ")" ::: "memory")
#define PG8_BAR __builtin_amdgcn_s_barrier()
#define PG8_SCHED __builtin_amdgcn_sched_barrier(0)
    Unit cur, nxt; int ui = 0;
    if (!S.next(0, cur)) return;
    f32x4 acc[2][2][4][2];
#pragma unroll
    for (int a = 0; a < 2; ++a)
#pragma unroll
        for (int b = 0; b < 2; ++b)
#pragma unroll
            for (int m = 0; m < 4; ++m)
#pragma unroll
                for (int n = 0; n < 2; ++n) acc[a][b][m][n] = (f32x4){0.f, 0.f, 0.f, 0.f};
    bf16x8 At[4][2], B0[2][2], B1[2][2];
    const char* cA = (const char*)g.A + (size_t)cur.pm * tstep; const char* cB = S.bbase(g, cur) + (size_t)cur.pn * tstep;
    S.a_ready(cur);
    if constexpr (SP2) {
        PG8_STAGE(PG8_SB(0, 0), cB, voffB); PG8_STAGE(PG8_SB(0, 1), cB + hstep, voffB); PG8_STAGE(PG8_SA(0, 0), cA, voffA); PG8_STAGE(PG8_SA(0, 1), cA + hstep, voffA);
        if (wr == 1) PG8_BAR;
        PG8_WAIT_V(2); PG8_BAR;
        PG8_STAGE(PG8_SB(1, 0), cB + kstep, voffB); PG8_STAGE(PG8_SA(1, 0), cA + kstep, voffA); PG8_STAGE(PG8_SB(1, 1), cB + hstep + kstep, voffB);
        PG8_WAIT_V(6); PG8_BAR;
    } else {
        PG8_STAGE(PG8_SB(0, 0), cB, voffB); PG8_STAGE(PG8_SA(0, 0), cA, voffA); PG8_STAGE(PG8_SB(0, 1), cB + hstep, voffB); PG8_STAGE(PG8_SA(0, 1), cA + hstep, voffA);
        if (wr == 1) PG8_BAR;
        PG8_WAIT_V(4); PG8_BAR;
        PG8_STAGE(PG8_SB(1, 0), cB + kstep, voffB); PG8_STAGE(PG8_SA(1, 0), cA + kstep, voffA); PG8_STAGE(PG8_SB(1, 1), cB + hstep + kstep, voffB);
        PG8_WAIT_V(6); PG8_BAR;
    }
    for (;;) {
        const bool has_next = S.next(ui + 1, nxt);
        const char* nA = has_next ? (const char*)g.A + (size_t)nxt.pm * tstep : cA; const char* nB = has_next ? S.bbase(g, nxt) + (size_t)nxt.pn * tstep : cB;
        for (int t = 0; t < nt; t += 2) {
            const bool last = (t == nt - 2);
            const char* a1 = cA + (size_t)(t + 1) * kstep;
            const char* a2 = last ? nA : cA + (size_t)(t + 2) * kstep; const char* b2 = last ? nB : cB + (size_t)(t + 2) * kstep;
            const char* a3 = a2 + kstep; const char* b3 = b2 + kstep;
            if (last && has_next) S.a_ready(nxt);
            if constexpr (SP2) {
            PG8_LDB(B0, 0, 0); PG8_LDB(B1, 0, 1); PG8_SCHED; PG8_LDA(At, 0, 0); PG8_STAGE(PG8_SA(1, 1), a1 + hstep, voffA);
            PG8_WAIT_V(8); PG8_WAIT_L(0); PG8_BAR; PG8_MMA(0, 0, At, B0); PG8_MMA(0, 1, At, B1); PG8_BAR; PG8_SCHED;
            PG8_LDA(At, 0, 1); PG8_STAGE(PG8_SB(0, 0), b2, voffB); PG8_STAGE(PG8_SB(0, 1), b2 + hstep, voffB); PG8_STAGE(PG8_SA(0, 0), a2, voffA);
            PG8_WAIT_V(8); PG8_WAIT_L(0); PG8_BAR; PG8_MMA(1, 0, At, B0); PG8_MMA(1, 1, At, B1); PG8_BAR; PG8_SCHED;
            PG8_LDB(B0, 1, 0); PG8_LDB(B1, 1, 1); PG8_SCHED; PG8_LDA(At, 1, 0); PG8_STAGE(PG8_SA(0, 1), a2 + hstep, voffA);
            PG8_WAIT_V(8); PG8_WAIT_L(0); PG8_BAR; PG8_MMA(0, 0, At, B0); PG8_MMA(0, 1, At, B1); PG8_BAR; PG8_SCHED;
            PG8_LDA(At, 1, 1); PG8_STAGE(PG8_SB(1, 0), b3, voffB); PG8_STAGE(PG8_SB(1, 1), b3 + hstep, voffB); PG8_STAGE(PG8_SA(1, 0), a3, voffA);
            PG8_WAIT_V(8); PG8_WAIT_L(0); PG8_BAR; PG8_MMA(1, 0, At, B0); PG8_MMA(1, 1, At, B1); PG8_BAR; PG8_SCHED;
            } else {
            PG8_LDB(B0, 0, 0); PG8_SCHED; PG8_LDA(At, 0, 0); PG8_STAGE(PG8_SA(1, 1), a1 + hstep, voffA);
            PG8_WAIT_L(8); PG8_BAR; PG8_WAIT_L(0); PG8_MMA(0, 0, At, B0); PG8_BAR; PG8_SCHED;
            PG8_LDB(B1, 0, 1); PG8_STAGE(PG8_SB(0, 0), b2, voffB);
            PG8_BAR; PG8_WAIT_L(0); PG8_MMA(0, 1, At, B1); PG8_BAR;
            PG8_LDA(At, 0, 1); PG8_STAGE(PG8_SA(0, 0), a2, voffA);
            PG8_BAR; PG8_WAIT_L(0); PG8_MMA(1, 0, At, B0); PG8_BAR; PG8_SCHED;
            PG8_STAGE(PG8_SB(0, 1), b2 + hstep, voffB);
            PG8_WAIT_V(6); PG8_BAR; PG8_MMA(1, 1, At, B1); PG8_BAR;
            PG8_LDB(B0, 1, 0); PG8_SCHED; PG8_LDA(At, 1, 0); PG8_STAGE(PG8_SA(0, 1), a2 + hstep, voffA);
            PG8_WAIT_L(8); PG8_BAR; PG8_WAIT_L(0); PG8_MMA(0, 0, At, B0); PG8_BAR; PG8_SCHED;
            PG8_LDB(B1, 1, 1); PG8_STAGE(PG8_SB(1, 0), b3, voffB);
            PG8_BAR; PG8_WAIT_L(0); PG8_MMA(0, 1, At, B1); PG8_BAR;
            PG8_LDA(At, 1, 1); PG8_STAGE(PG8_SA(1, 0), a3, voffA);
            PG8_BAR; PG8_WAIT_L(0); PG8_MMA(1, 0, At, B0); PG8_BAR; PG8_SCHED;
            PG8_STAGE(PG8_SB(1, 1), b3 + hstep, voffB);
            PG8_WAIT_V(6); PG8_BAR; PG8_MMA(1, 1, At, B1); PG8_BAR;
            }
        }
        if constexpr (ALIGN_EPI) { if (wr == 0) PG8_BAR; }
        if constexpr (!Epi::AFTER_DRAIN) { E(acc, cur, wr, wc, fr, fq); S.done(cur); }
        if (!has_next) break;
#pragma unroll
        for (int a = 0; a < 2; ++a)
#pragma unroll
            for (int b = 0; b < 2; ++b)
#pragma unroll
                for (int m = 0; m < 4; ++m)
#pragma unroll
                    for (int n = 0; n < 2; ++n) acc[a][b][m][n] = (f32x4){0.f, 0.f, 0.f, 0.f};
        cur = nxt; cA = nA; cB = nB; ++ui;
        if constexpr (ALIGN_EPI) { if (wr == 1) PG8_BAR; }
    }
    PG8_WAIT_V(0);
    if constexpr (!ALIGN_EPI) { if (wr == 0) PG8_BAR; }
    PG8_BAR;
    if constexpr (Epi::AFTER_DRAIN) { E.fused(acc, cur, wr, wc, fr, fq, lds, wid, lane); S.done(cur); }
#undef PG8_SA
#undef PG8_SB
#undef PG8_STAGE
#undef PG8_LDA
#undef PG8_LDB
#undef PG8_MMA
#undef PG8_WAIT_V
#undef PG8_WAIT_L
#undef PG8_BAR
#undef PG8_SCHED
}
}

namespace pg8 {
__device__ __forceinline__ unsigned cvt_pk_bf16(float lo, float hi) { unsigned r; asm volatile("v_cvt_pk_bf16_f32 %0, %1, %2" : "=v"(r) : "v"(lo), "v"(hi)); return r; }

struct EpiBf16 {
    static constexpr bool PERM = true, AFTER_DRAIN = false;
    bf16_t* O; int ldc;
    __device__ __forceinline__ void operator()(const f32x4 (&acc)[2][2][4][2], const Unit& u, int wr, int wc, int fr, int fq) const {
        const int row0 = u.pm * BM + wr * 64 + fr; const int col0 = u.pn * BM + wc * 32 + 8 * fq;
#pragma unroll
        for (int ai = 0; ai < 2; ++ai)
#pragma unroll
            for (int m = 0; m < 4; ++m) { bf16_t* rowp = O + (size_t)(row0 + ai * HALF + m * 16) * ldc + col0;
#pragma unroll
                for (int bj = 0; bj < 2; ++bj) { const f32x4 v0 = acc[ai][bj][m][0], v1 = acc[ai][bj][m][1];
                    u32x4 w; w.x = cvt_pk_bf16(v0[0], v0[1]); w.y = cvt_pk_bf16(v0[2], v0[3]); w.z = cvt_pk_bf16(v1[0], v1[1]); w.w = cvt_pk_bf16(v1[2], v1[3]);
                    *(u32x4*)(rowp + bj * HALF) = w; } }
    }
};
struct EpiKV {
    static constexpr bool PERM = true, AFTER_DRAIN = false;
    bf16_t* Kd; bf16_t* VTd;
    __device__ __forceinline__ void operator()(const f32x4 (&acc)[2][2][4][2], const Unit& u, int wr, int wc, int fr, int fq) const {
        const int row0 = u.pm * BM + wr * 64 + fr; const int col0 = u.pn * BM + wc * 32 + 8 * fq;
#pragma unroll
        for (int ai = 0; ai < 2; ++ai)
#pragma unroll
            for (int m = 0; m < 4; ++m) { const int row = row0 + ai * HALF + m * 16;
#pragma unroll
                for (int bj = 0; bj < 2; ++bj) { const f32x4 v0 = acc[ai][bj][m][0], v1 = acc[ai][bj][m][1]; const int col = col0 + bj * HALF;
                    u32x4 w; w.x = cvt_pk_bf16(v0[0], v0[1]); w.y = cvt_pk_bf16(v0[2], v0[3]); w.z = cvt_pk_bf16(v1[0], v1[1]); w.w = cvt_pk_bf16(v1[2], v1[3]);
                    if (col < 1024) { *(u32x4*)(Kd + (size_t)row * 1024 + col) = w; }
                    else { const int c = col - 1024, b = row >> 8, mm = row & 255; bf16_t* p = VTd + ((size_t)(b * 1024 + c)) * 256 + mm;
                        p[0 * 256] = (bf16_t)(w.x & 0xffffu); p[1 * 256] = (bf16_t)(w.x >> 16); p[2 * 256] = (bf16_t)(w.y & 0xffffu); p[3 * 256] = (bf16_t)(w.y >> 16);
                        p[4 * 256] = (bf16_t)(w.z & 0xffffu); p[5 * 256] = (bf16_t)(w.z >> 16); p[6 * 256] = (bf16_t)(w.w & 0xffffu); p[7 * 256] = (bf16_t)(w.w >> 16); } } }
    }
};
struct EpiF32Res {
    static constexpr bool PERM = false, AFTER_DRAIN = false;
    float* out; const float* res; int ldc; float alpha;
    __device__ __forceinline__ void operator()(const f32x4 (&acc)[2][2][4][2], const Unit& u, int wr, int wc, int fr, int fq) const {
        const int row0 = u.pm * BM + wr * 64 + fr; const int col0 = u.pn * BM + wc * 32 + 4 * fq;
#pragma unroll
        for (int ai = 0; ai < 2; ++ai)
#pragma unroll
            for (int m = 0; m < 4; ++m) { const size_t off = (size_t)(row0 + ai * HALF + m * 16) * ldc + col0;
#pragma unroll
                for (int bj = 0; bj < 2; ++bj)
#pragma unroll
                    for (int n = 0; n < 2; ++n) { f32x4 v = acc[ai][bj][m][n]; const size_t o2 = off + bj * HALF + n * 16;
                        if (res) { const f32x4 r = *(const f32x4*)(res + o2); v = v + r * alpha; }
                        *(f32x4*)(out + o2) = v; } }
    }
};
struct EpiSwiglu {
    static constexpr bool PERM = true, AFTER_DRAIN = false;
    bf16_t* H; int ldh;
    __device__ __forceinline__ void operator()(const f32x4 (&acc)[2][2][4][2], const Unit& u, int wr, int wc, int fr, int fq) const {
        const int row0 = u.pm * BM + wr * 64 + fr; const int col0 = u.pn * BM + wc * 32 + 8 * fq;
#pragma unroll
        for (int ai = 0; ai < 2; ++ai)
#pragma unroll
            for (int m = 0; m < 4; ++m) { bf16_t* rowp = H + (size_t)(row0 + ai * HALF + m * 16) * ldh;
#pragma unroll
                for (int bj = 0; bj < 2; ++bj) { const f32x4 v0 = acc[ai][bj][m][0], v1 = acc[ai][bj][m][1];
                    const float h0 = v0[0] / (1.0f + __expf(-v0[0])) * v0[1], h1 = v0[2] / (1.0f + __expf(-v0[2])) * v0[3];
                    const float h2 = v1[0] / (1.0f + __expf(-v1[0])) * v1[1], h3 = v1[2] / (1.0f + __expf(-v1[2])) * v1[3];
                    u32x2 w; w.x = cvt_pk_bf16(h0, h1); w.y = cvt_pk_bf16(h2, h3);
                    *(u32x2*)(rowp + ((col0 + bj * HALF) >> 1)) = w; } }
    }
};
struct GroupedOrder : StaticOrder {
    int pend[8]; size_t estride;
    __device__ __forceinline__ const char* bbase(const Gemm& g, const Unit& u) const {
        int e = 0;
#pragma unroll
        for (int k = 0; k < 7; ++k) e += (u.pm >= pend[k]) ? 1 : 0;
        return (const char*)g.Bt + (size_t)e * estride;
    }
};
}
#define XB_TMO      128
#define XB_XCNT(j)  (256  + 64 * (j))
#define XB_XSUB(j)  (1280 + 64 * (j))
#define XB_XGEN(j)  (2304 + 64 * (j))
#define XB_TOP      3328
#define XB_TOPGEN   3392
#define XCD_BAR_WORDS 3456
#define XB_SPIN_CAP (1u << 18)

__device__ __forceinline__ unsigned xb_ld(unsigned* p)              { return __hip_atomic_load(p, __ATOMIC_RELAXED, __HIP_MEMORY_SCOPE_AGENT); }
__device__ __forceinline__ unsigned xb_add(unsigned* p, unsigned v) { return __hip_atomic_fetch_add(p, v, __ATOMIC_RELAXED, __HIP_MEMORY_SCOPE_AGENT); }
__device__ __forceinline__ unsigned xb_xcc_id() { return (unsigned)__builtin_amdgcn_s_getreg((3 << 11) | 20) & 0xFu; }
#define XB_SPIN(cond, bar) do { unsigned _sp = 0; while (cond) { __builtin_amdgcn_s_sleep(1); \
    if ((++_sp & 255u) == 0u) { if (xb_ld(&(bar)[XB_TMO])) break; if (_sp > XB_SPIN_CAP) { atomicAdd(&(bar)[XB_TMO], 1u); break; } } } } while (0)

struct XcdBarrier {
    unsigned* bar; unsigned x;
    volatile LAS unsigned* st;
};

__device__ __forceinline__ XcdBarrier xcd_barrier_post(unsigned* bar, volatile LAS unsigned* st) {
    XcdBarrier b; b.bar = bar; b.x = xb_xcc_id(); b.st = st;
    if (threadIdx.x == 0) (void)xb_add(&bar[XB_XCNT(b.x)], 1u);
    return b;
}
__device__ __forceinline__ void xcd_barrier_complete(unsigned* bar, unsigned x, unsigned& nloc, unsigned& nx) {
    const unsigned G = gridDim.x * gridDim.y * gridDim.z;
    unsigned sum, cnt, mine, sp = 0u;
    for (;;) {
        sum = 0u; cnt = 0u; mine = 0u;
#pragma unroll
        for (unsigned j = 0; j < 16; ++j) { const unsigned c = xb_ld(&bar[XB_XCNT(j)]); sum += c; cnt += (c > 0u) ? 1u : 0u; mine = (j == x) ? c : mine; }
        if (sum == G) break;
        __builtin_amdgcn_s_sleep(1);
        if ((++sp & 255u) == 0u) { if (xb_ld(&bar[XB_TMO])) break; if (sp > XB_SPIN_CAP) { atomicAdd(&bar[XB_TMO], 1u); break; } }
    }
    nloc = mine > 0u ? mine : 1u; nx = cnt > 0u ? cnt : 1u;
}

__device__ __forceinline__ void xcd_barrier(const XcdBarrier& b) {
    asm volatile("s_waitcnt vmcnt(0)" ::: "memory");
    __syncthreads();
    if (threadIdx.x == 0) {
        unsigned* bar = b.bar;
        __builtin_amdgcn_s_waitcnt(0);
        unsigned nloc = b.st[0], nx = b.st[1];
        if (nloc == 0u) { xcd_barrier_complete(bar, b.x, nloc, nx); b.st[0] = nloc; b.st[1] = nx; }
        const unsigned old = xb_add(&bar[XB_XSUB(b.x)], 1u);
        const unsigned gen = old / nloc;
        if (old + 1u == (gen + 1u) * nloc) {
            __builtin_amdgcn_fence(__ATOMIC_RELEASE, "agent");
            asm volatile("s_waitcnt vmcnt(0)" ::: "memory");
            const unsigned og = xb_add(&bar[XB_TOP], 1u);
            const unsigned tg = og / nx;
            if (og + 1u == (tg + 1u) * nx) xb_add(&bar[XB_TOPGEN], 1u);
            else XB_SPIN(xb_ld(&bar[XB_TOPGEN]) == tg, bar);
            __builtin_amdgcn_fence(__ATOMIC_ACQUIRE, "agent");
            xb_add(&bar[XB_XGEN(b.x)], 1u);
            asm volatile("s_waitcnt vmcnt(0)" ::: "memory");
        } else {
            XB_SPIN(xb_ld(&bar[XB_XGEN(b.x)]) == gen, bar);
            __builtin_amdgcn_fence(__ATOMIC_ACQUIRE, "agent");
            asm volatile("s_waitcnt vmcnt(0)" ::: "memory");
        }
    }
    __syncthreads();
}

struct Params { const float* in[35]; float* out; unsigned char* ws; int ph_lo, ph_hi, dbg, pad; };
enum { I_X = 0, I_MEM, I_WIN, I_POOLW, I_POOLS, I_PEK, I_KW1, I_KW2, I_PEV, I_VW1, I_VW2, I_SLNG, I_SLNB, I_SGUW, I_SGUB, I_CONVW, I_CONVB, I_CLNG, I_CLNB, I_CONVPW,
       I_WOUT, I_LN1G, I_LN1B, I_XQ, I_XKV, I_XO, I_LN2G, I_LN2B, I_W13, I_W2, I_ROUTER, I_E13, I_E2, I_LN3G, I_LN3B };

struct Ctx {
    const float* in[35];
    float* X;
    bf16 *XB, *Z, *Y, *Q, *H, *XG, *KC, *VC, *MEMB, *KMEM, *VTMEM, *KCF, *VCF, *KSELF, *VSELF, *KWINF, *VWINF;
    bf16 *WINT, *WOUTT, *XQT, *XKVT, *XOT, *W13T, *W2T, *E13T, *E2T, *CW1T, *CW2T, *PWT, *POOLWT, *SGUWB;
    float *VBUF, *FS, *PEB, *TOKG;
    int *HIST, *META, *TOKPOS; unsigned* TOKINFO;
    int tid, lane, wid, bid, G;
};

struct MatDesc { const float* src; bf16* dst; int K, N, Npad, split; };
__device__ __forceinline__ void get_mat(const Ctx& C, int id, MatDesc& d) {
    d.split = 0;
    if (id < 56) {
        const int l = id / 14, k = id % 14;
        if (k == 0)      { d.src = C.in[I_WIN] + (size_t)l * D * DIN;  d.dst = C.WINT + (size_t)l * DINP * D;  d.K = D; d.N = DIN; d.Npad = DINP; }
        else if (k == 1) { d.src = C.in[I_WOUT] + (size_t)l * D * D;   d.dst = C.WOUTT + (size_t)l * D * D;    d.K = D; d.N = D; d.Npad = D; }
        else if (k == 2) { d.src = C.in[I_XQ] + (size_t)l * D * D;     d.dst = C.XQT + (size_t)l * D * D;      d.K = D; d.N = D; d.Npad = D; }
        else if (k == 3) { d.src = C.in[I_XKV] + (size_t)l * D * 2 * D; d.dst = C.XKVT + (size_t)l * 2 * D * D; d.K = D; d.N = 2 * D; d.Npad = 2 * D; }
        else if (k == 4) { d.src = C.in[I_XO] + (size_t)l * D * D;     d.dst = C.XOT + (size_t)l * D * D;      d.K = D; d.N = D; d.Npad = D; }
        else if (k == 5) { d.src = C.in[I_KW1] + (size_t)l * 2048 * 256; d.dst = C.CW1T + (size_t)(l * 2 + 0) * 256 * 2048; d.K = 2048; d.N = 256; d.Npad = 256; }
        else if (k == 6) { d.src = C.in[I_VW1] + (size_t)l * 2048 * 256; d.dst = C.CW1T + (size_t)(l * 2 + 1) * 256 * 2048; d.K = 2048; d.N = 256; d.Npad = 256; }
        else if (k == 7) { d.src = C.in[I_KW2] + (size_t)l * 256 * 64; d.dst = C.CW2T + (size_t)(l * 2 + 0) * 64 * 256; d.K = 256; d.N = 64; d.Npad = 64; }
        else if (k == 8) { d.src = C.in[I_VW2] + (size_t)l * 256 * 64; d.dst = C.CW2T + (size_t)(l * 2 + 1) * 64 * 256; d.K = 256; d.N = 64; d.Npad = 64; }
        else if (k == 9) { d.src = C.in[I_CONVPW] + (size_t)l * 256 * 256; d.dst = C.PWT + (size_t)l * 256 * 256; d.K = 256; d.N = 256; d.Npad = 256; }
        else { const int g = k - 10; d.src = C.in[I_POOLW] + (size_t)(l * 4 + g) * 64 * 64; d.dst = C.POOLWT + (size_t)(l * 4 + g) * 64 * 64; d.K = 64; d.N = 64; d.Npad = 64; }
    } else if (id < 60) {
        const int i = (id - 56) >> 1, w = (id - 56) & 1;
        if (w == 0) { d.src = C.in[I_W13] + (size_t)i * D * 2 * FF; d.dst = C.W13T + (size_t)i * 2 * FF * D; d.K = D; d.N = 2 * FF; d.Npad = 2 * FF; d.split = FF; }
        else        { d.src = C.in[I_W2] + (size_t)i * FF * D;      d.dst = C.W2T + (size_t)i * D * FF;      d.K = FF; d.N = D; d.Npad = D; }
    } else {
        const int j = id - 60, ie = j >> 1, w = j & 1;
        if (w == 0) { d.src = C.in[I_E13] + (size_t)ie * D * 2 * FE; d.dst = C.E13T + (size_t)ie * 2 * FE * D; d.K = D; d.N = 2 * FE; d.Npad = 2 * FE; d.split = FE; }
        else        { d.src = C.in[I_E2] + (size_t)ie * FE * D;      d.dst = C.E2T + (size_t)ie * D * FE;      d.K = FE; d.N = D; d.Npad = D; }
    }
}
__device__ __forceinline__ void transpose_item(const MatDesc& d, LAS float* scr, int item, int lane) {
    const int nblk = d.Npad / 32, kb = item / nblk, nb = item % nblk, k0 = 64 * kb, n0 = 32 * nb;
    const int ncol = n0 + 4 * (lane & 7); const bool ok = ncol < d.N;
    f32x4 v[8];
#pragma unroll
    for (int i = 0; i < 8; ++i) { const int kk = 8 * i + (lane >> 3); v[i] = ok ? *(const f32x4*)(d.src + (size_t)(k0 + kk) * d.N + ncol) : (f32x4){0.f, 0.f, 0.f, 0.f}; }
#pragma unroll
    for (int i = 0; i < 8; ++i) { const int kk = 8 * i + (lane >> 3); LAS float* p = scr + kk * 33 + 4 * (lane & 7); p[0] = v[i][0]; p[1] = v[i][1]; p[2] = v[i][2]; p[3] = v[i][3]; }
    LDS_WAIT();
    const int c = lane & 7;
#pragma unroll
    for (int j = 0; j < 4; ++j) { const int n = (lane >> 3) + 8 * j; const LAS float* s = scr + (8 * c) * 33 + n;
        u32x4 o; o.x = pk2(s[0 * 33], s[1 * 33]); o.y = pk2(s[2 * 33], s[3 * 33]); o.z = pk2(s[4 * 33], s[5 * 33]); o.w = pk2(s[6 * 33], s[7 * 33]);
        const int ng = n0 + n; const int drow = d.split ? (ng < d.split ? 2 * ng : 2 * (ng - d.split) + 1) : ng;
        *(u32x4*)(d.dst + (size_t)drow * d.K + k0 + 8 * c) = o; }
    LDS_WAIT();
}
__device__ __forceinline__ void p0_prologue(const Ctx& C, LAS unsigned char* lds) {
    LAS float* scr = (LAS float*)(lds + C.wid * 8704);
    const int gw = C.bid * NWAVES + C.wid, NGW = C.G * NWAVES;
    int start = 0;
    for (int id = 0; id < 92; ++id) {
        MatDesc d; get_mat(C, id, d);
        const int ntiles = (d.K / 64) * (d.Npad / 32);
        int first = gw - start; if (first < 0) first += NGW;
        for (int it = first; it < ntiles; it += NGW) transpose_item(d, scr, it, C.lane);
        start = (start + ntiles) % NGW;
    }
    const int gt = C.bid * NTHREADS + C.tid, NGT = C.G * NTHREADS;
    { const f32x4* xs = (const f32x4*)C.in[I_X]; u32x4* xd = (u32x4*)C.XB;
      for (int i = gt; i < M * D / 8; i += NGT) { const f32x4 a = xs[2 * i], b = xs[2 * i + 1]; u32x4 o; o.x = pk2(a[0], a[1]); o.y = pk2(a[2], a[3]); o.z = pk2(b[0], b[1]); o.w = pk2(b[2], b[3]); xd[i] = o; } }
    { const f32x4* xs = (const f32x4*)C.in[I_MEM]; u32x4* xd = (u32x4*)C.MEMB;
      for (int i = gt; i < NB * MEM * D / 8; i += NGT) { const f32x4 a = xs[2 * i], b = xs[2 * i + 1]; u32x4 o; o.x = pk2(a[0], a[1]); o.y = pk2(a[2], a[3]); o.z = pk2(b[0], b[1]); o.w = pk2(b[2], b[3]); xd[i] = o; } }
    { const f32x4* ws = (const f32x4*)C.in[I_SGUW]; u32x4* wd = (u32x4*)C.SGUWB;
      for (int i = gt; i < NL * 4 * 128 * 128 / 8; i += NGT) { const int j0 = (i & 15) * 8, ii = (i >> 4) & 127; const f32x4 a = ws[2 * i], b = ws[2 * i + 1];
          float v[8] = {a[0], a[1], a[2], a[3], b[0], b[1], b[2], b[3]};
#pragma unroll
          for (int e = 0; e < 8; ++e) v[e] = (j0 + e <= ii) ? v[e] : 0.f;
          u32x4 o; o.x = pk2(v[0], v[1]); o.y = pk2(v[2], v[3]); o.z = pk2(v[4], v[5]); o.w = pk2(v[6], v[7]); wd[i] = o; } }
    for (int o = gw; o < NL * 2 * 256; o += NGW) { const int n = o & 255, kv = (o >> 8) & 1, l = o >> 9;
        const float* pe = C.in[kv ? I_PEV : I_PEK] + (size_t)l * 2048; const float* w1 = C.in[kv ? I_VW1 : I_KW1] + (size_t)l * 2048 * 256;
        float s = 0.f;
        for (int k = C.lane; k < 2048; k += 64) s += pe[k] * w1[(size_t)k * 256 + n];
        s = wave_sum(s); if (C.lane == 0) C.PEB[o] = s; }
}

__device__ __forceinline__ void ln_phase(const Ctx& C, const float* src, const float* gam, const float* bet, int mode, const float* router, LAS unsigned char* lds) {
    LAS float* rwT = (LAS float*)lds;
    LAS int* te = (LAS int*)(lds + 32768);
    LAS float* tgl = (LAS float*)(lds + 32768 + 1024);
    if (router) { for (int i = C.tid; i < 8192; i += NTHREADS) rwT[(i & 7) * 1024 + (i >> 3)] = router[i]; __syncthreads(); }
    f32x4 g4[4], b4[4];
#pragma unroll
    for (int j = 0; j < 4; ++j) { g4[j] = *(const f32x4*)(gam + 256 * j + 4 * C.lane); b4[j] = *(const f32x4*)(bet + 256 * j + 4 * C.lane); }
    for (int tile = C.bid; tile < M / 128; tile += C.G) {
        for (int i = 0; i < 16; ++i) {
            const int tl = 16 * C.wid + i; const size_t row = (size_t)tile * 128 + tl;
            f32x4 v[4];
            if (mode == 0) {
#pragma unroll
                for (int j = 0; j < 4; ++j) v[j] = *(const f32x4*)(src + row * D + 256 * j + 4 * C.lane);
            } else {
                const int p0 = C.TOKPOS[2 * row], p1 = C.TOKPOS[2 * row + 1]; const float g0 = C.TOKG[2 * row], g1 = C.TOKG[2 * row + 1];
#pragma unroll
                for (int j = 0; j < 4; ++j) { const f32x4 x = *(const f32x4*)(C.X + row * D + 256 * j + 4 * C.lane);
                    const f32x4 a = *(const f32x4*)(C.FS + (size_t)p0 * D + 256 * j + 4 * C.lane), b = *(const f32x4*)(C.FS + (size_t)p1 * D + 256 * j + 4 * C.lane);
                    v[j] = x * ALPHA + a * g0 + b * g1; }
            }
            float s = 0.f;
#pragma unroll
            for (int j = 0; j < 4; ++j) s += (v[j][0] + v[j][1]) + (v[j][2] + v[j][3]);
            const float mean = wave_sum(s) * (1.f / D); float s2 = 0.f;
#pragma unroll
            for (int j = 0; j < 4; ++j) { v[j] = v[j] - mean; s2 += (v[j][0] * v[j][0] + v[j][1] * v[j][1]) + (v[j][2] * v[j][2] + v[j][3] * v[j][3]); }
            const float rstd = 1.0f / sqrtf(wave_sum(s2) * (1.f / D) + LN_EPS);
#pragma unroll
            for (int j = 0; j < 4; ++j) { v[j] = v[j] * rstd * g4[j] + b4[j];
                *(f32x4*)(C.X + row * D + 256 * j + 4 * C.lane) = v[j];
                u32x2 o; o.x = pk2(v[j][0], v[j][1]); o.y = pk2(v[j][2], v[j][3]); *(u32x2*)(C.XB + row * D + 256 * j + 4 * C.lane) = o; }
            if (router) {
                float lg[8];
#pragma unroll
                for (int ex = 0; ex < 8; ++ex) { float a = 0.f;
#pragma unroll
                    for (int j = 0; j < 4; ++j) { const f32x4 w = *(const LAS f32x4*)(rwT + ex * 1024 + 256 * j + 4 * C.lane); a += (v[j][0] * w[0] + v[j][1] * w[1]) + (v[j][2] * w[2] + v[j][3] * w[3]); }
                    lg[ex] = wave_sum(a); }
                int e0 = 0; float l0 = lg[0];
#pragma unroll
                for (int ex = 1; ex < 8; ++ex) if (lg[ex] > l0) { l0 = lg[ex]; e0 = ex; }
                int e1 = -1; float l1 = -INFINITY;
#pragma unroll
                for (int ex = 0; ex < 8; ++ex) if (ex != e0 && lg[ex] > l1) { l1 = lg[ex]; e1 = ex; }
                const float ed = __expf(l1 - l0), ga = 1.0f / (1.0f + ed), gb = ed * ga;
                if (C.lane == 0) { te[2 * tl] = e0; te[2 * tl + 1] = e1; tgl[2 * tl] = ga; tgl[2 * tl + 1] = gb; }
            }
        }
        if (router) {
            __syncthreads();
            if (C.wid == 0) {
                int run[8];
#pragma unroll
                for (int ex = 0; ex < 8; ++ex) run[ex] = 0;
                for (int rr = 0; rr < 4; ++rr) { const int a = 64 * rr + C.lane; const int e = te[a]; int rank = 0;
#pragma unroll
                    for (int ex = 0; ex < 8; ++ex) { const unsigned long long mk = __ballot(e == ex); if (e == ex) rank = run[ex] + __popcll(mk & ((1ull << C.lane) - 1ull)); run[ex] += __popcll(mk); }
                    C.TOKINFO[(size_t)tile * 256 + a] = (unsigned)e | ((unsigned)rank << 8); C.TOKG[(size_t)tile * 256 + a] = tgl[a]; }
#pragma unroll
                for (int ex = 0; ex < 8; ++ex) if (C.lane == ex) C.HIST[tile * 8 + ex] = run[ex];
            }
            __syncthreads();
        }
    }
}

struct ConvW { f32x4 w[31]; f32x4 cb, lg, lb; };
__device__ __forceinline__ void load_convw(const Ctx& C, int l, ConvW& cw) {
#pragma unroll
    for (int k = 0; k < 31; ++k) cw.w[k] = *(const f32x4*)(C.in[I_CONVW] + ((size_t)l * 31 + k) * 256 + 4 * C.lane);
    cw.cb = *(const f32x4*)(C.in[I_CONVB] + l * 256 + 4 * C.lane); cw.lg = *(const f32x4*)(C.in[I_CLNG] + l * 256 + 4 * C.lane); cw.lb = *(const f32x4*)(C.in[I_CLNB] + l * 256 + 4 * C.lane);
}
template <int WHICH>
__device__ __forceinline__ void mixers_tile(const Ctx& C, int l, int tb, LAS unsigned char* lds, const ConvW& cw) {
    const int tid = C.tid, wid = C.wid, lane = C.lane;
    const int b = tb >> 6, t0 = (tb & 63) << 7; const size_t R0 = (size_t)b * T + t0;
    const bf16* Zb = C.Z + (size_t)b * T * DINP;
    const int m16 = lane & 15, gq = lane >> 4, row = 16 * wid + m16;
    if constexpr ((WHICH & 1) != 0) {
        LAS bf16* Dl = (LAS bf16*)lds;
        for (int it = tid; it < 128 * 32; it += NTHREADS) {
            const int tl = it >> 5, c8 = it & 31, g = c8 >> 3, w = 2 << g, t = t0 + tl, n = (t + 1 < w) ? (t + 1) : w;
            float s[8], cur[8];
#pragma unroll
            for (int e = 0; e < 8; ++e) { s[e] = 0.f; cur[e] = 0.f; }
            for (int k = 0; k < n; ++k) {
                const u32x4 v = *(const u32x4*)(Zb + (size_t)(t - k) * DINP + C_POOL + 8 * c8);
                const float f[8] = {lo16(v.x), hi16(v.x), lo16(v.y), hi16(v.y), lo16(v.z), hi16(v.z), lo16(v.w), hi16(v.w)};
#pragma unroll
                for (int e = 0; e < 8; ++e) { s[e] += f[e]; if (k == 0) cur[e] = f[e]; }
            }
            const float inv = 1.0f / (float)n;
            u32x4 o; o.x = pk2(s[0] * inv - cur[0], s[1] * inv - cur[1]); o.y = pk2(s[2] * inv - cur[2], s[3] * inv - cur[3]);
            o.z = pk2(s[4] * inv - cur[4], s[5] * inv - cur[5]); o.w = pk2(s[6] * inv - cur[6], s[7] * inv - cur[7]);
            *(LAS u32x4*)(Dl + tl * 264 + 8 * c8) = o;
        }
        __syncthreads();
#pragma unroll
        for (int g = 0; g < 4; ++g) {
            bf16x8 a[2];
#pragma unroll
            for (int s = 0; s < 2; ++s) a[s] = *(const LAS bf16x8*)(Dl + row * 264 + g * 64 + 32 * s + 8 * gq);
#pragma unroll
            for (int nt = 0; nt < 4; ++nt) {
                f32x4 acc = {0.f, 0.f, 0.f, 0.f};
#pragma unroll
                for (int s = 0; s < 2; ++s) { const bf16x8 bfr = *(const bf16x8*)(C.POOLWT + ((size_t)((l * 4 + g) * 64 + 16 * nt + m16)) * 64 + 32 * s + 8 * gq); acc = mfma16(bfr, a[s], acc); }
                const int col = g * 64 + 16 * nt + 4 * gq;
                const f32x4 sc = *(const f32x4*)(C.in[I_POOLS] + l * 256 + col);
                u32x2 o; o.x = pk2(acc[0] * sc[0], acc[1] * sc[1]); o.y = pk2(acc[2] * sc[2], acc[3] * sc[3]);
                *(u32x2*)(C.Y + (R0 + row) * D + col) = o;
            }
        }
        __syncthreads();
    }
    if constexpr ((WHICH & 2) != 0) {
        LAS bf16* VnT = (LAS bf16*)lds;
        const f32x4 lg = *(const f32x4*)(C.in[I_SLNG] + l * 256 + 4 * lane), lb = *(const f32x4*)(C.in[I_SLNB] + l * 256 + 4 * lane);
#pragma unroll 1
        for (int i = 0; i < 16; ++i) {
            const int tl = 16 * wid + i;
            const u32x2 v = *(const u32x2*)(C.Z + (R0 + tl) * DINP + C_V + 4 * lane);
            const float x0 = gelu_tanh(lo16(v.x)), x1 = gelu_tanh(hi16(v.x)), x2 = gelu_tanh(lo16(v.y)), x3 = gelu_tanh(hi16(v.y));
            const float mean = wave_sum((x0 + x1) + (x2 + x3)) * (1.f / 256.f);
            const float d0 = x0 - mean, d1 = x1 - mean, d2 = x2 - mean, d3 = x3 - mean;
            const float rstd = 1.0f / sqrtf(wave_sum((d0 * d0 + d1 * d1) + (d2 * d2 + d3 * d3)) * (1.f / 256.f) + LN_EPS);
            VnT[(4 * lane + 0) * 136 + tl] = (bf16)f2bf(d0 * rstd * lg[0] + lb[0]); VnT[(4 * lane + 1) * 136 + tl] = (bf16)f2bf(d1 * rstd * lg[1] + lb[1]);
            VnT[(4 * lane + 2) * 136 + tl] = (bf16)f2bf(d2 * rstd * lg[2] + lb[2]); VnT[(4 * lane + 3) * 136 + tl] = (bf16)f2bf(d3 * rstd * lg[3] + lb[3]);
        }
        __syncthreads();
        const int ns = (wid >> 1) + 1;
#pragma unroll
        for (int g = 0; g < 4; ++g) {
            f32x4 acc[4];
#pragma unroll
            for (int nt = 0; nt < 4; ++nt) acc[nt] = (f32x4){0.f, 0.f, 0.f, 0.f};
#pragma unroll
            for (int s = 0; s < 4; ++s) if (s < ns) {
                const bf16x8 a = *(const bf16x8*)(C.SGUWB + ((size_t)((l * 4 + g) * 128 + row)) * 128 + 32 * s + 8 * gq);
#pragma unroll
                for (int nt = 0; nt < 4; ++nt) { const bf16x8 bfr = *(const LAS bf16x8*)(VnT + (g * 64 + 16 * nt + m16) * 136 + 32 * s + 8 * gq); acc[nt] = mfma16(bfr, a, acc[nt]); }
            }
            const float bs = C.in[I_SGUB][(l * 4 + g) * 128 + row];
#pragma unroll
            for (int nt = 0; nt < 4; ++nt) {
                const int col = g * 64 + 16 * nt + 4 * gq;
                const u32x2 uu = *(const u32x2*)(C.Z + (R0 + row) * DINP + C_U + col);
                const float u0 = gelu_tanh(lo16(uu.x)), u1 = gelu_tanh(hi16(uu.x)), u2 = gelu_tanh(lo16(uu.y)), u3 = gelu_tanh(hi16(uu.y));
                u32x2 o; o.x = pk2(u0 * (acc[nt][0] + bs), u1 * (acc[nt][1] + bs)); o.y = pk2(u2 * (acc[nt][2] + bs), u3 * (acc[nt][3] + bs));
                *(u32x2*)(C.Y + (R0 + row) * D + 512 + col) = o;
            }
        }
        __syncthreads();
    }
    if constexpr ((WHICH & 4) != 0) {
        LAS bf16* Hg = (LAS bf16*)lds;
        LAS unsigned char* Hn = lds + 158 * 528;
        for (int it = tid; it < 158 * 64; it += NTHREADS) {
            const int r = it >> 6, c4 = it & 63, t = t0 - 30 + r;
            u32x2 o; o.x = 0u; o.y = 0u;
            if (t >= 0) { const bf16* zr = Zb + (size_t)t * DINP; const u32x2 a = *(const u32x2*)(zr + C_CA + 4 * c4), gg = *(const u32x2*)(zr + C_CG + 4 * c4);
                o.x = pk2(lo16(a.x) * sigmoidf_(lo16(gg.x)), hi16(a.x) * sigmoidf_(hi16(gg.x))); o.y = pk2(lo16(a.y) * sigmoidf_(lo16(gg.y)), hi16(a.y) * sigmoidf_(hi16(gg.y))); }
            *(LAS u32x2*)(Hg + r * 264 + 4 * c4) = o;
        }
        __syncthreads();
        {
            const f32x4 cb = cw.cb, lg = cw.lg, lb = cw.lb;
#pragma unroll 1
            for (int i = 0; i < 16; ++i) {
                const int tl = 16 * wid + i;
                f32x4 acc = cb;
#pragma unroll
                for (int k = 0; k < 31; ++k) {
                    const u32x2 h = *(const LAS u32x2*)(Hg + (tl + k) * 264 + 4 * lane);
                    acc[0] += cw.w[k][0] * lo16(h.x); acc[1] += cw.w[k][1] * hi16(h.x); acc[2] += cw.w[k][2] * lo16(h.y); acc[3] += cw.w[k][3] * hi16(h.y); }
                const float mean = wave_sum((acc[0] + acc[1]) + (acc[2] + acc[3])) * (1.f / 256.f);
                const float d0 = acc[0] - mean, d1 = acc[1] - mean, d2 = acc[2] - mean, d3 = acc[3] - mean;
                const float rstd = 1.0f / sqrtf(wave_sum((d0 * d0 + d1 * d1) + (d2 * d2 + d3 * d3)) * (1.f / 256.f) + LN_EPS);
                const float y0 = siluf_(d0 * rstd * lg[0] + lb[0]), y1 = siluf_(d1 * rstd * lg[1] + lb[1]), y2 = siluf_(d2 * rstd * lg[2] + lb[2]), y3 = siluf_(d3 * rstd * lg[3] + lb[3]);
                u32x2 o; o.x = pk2(y0, y1); o.y = pk2(y2, y3);
                *(LAS u32x2*)(Hn + tl * 512 + (((lane >> 1) ^ (tl & 15)) << 4) + ((lane & 1) << 3)) = o;
            }
        }
        __syncthreads();
#pragma unroll 1
        for (int nh = 0; nh < 2; ++nh) {
            f32x4 acc[8];
#pragma unroll
            for (int nt = 0; nt < 8; ++nt) acc[nt] = (f32x4){0.f, 0.f, 0.f, 0.f};
            const bf16* pw = C.PWT + ((size_t)(l * 256 + 128 * nh + m16)) * 256 + 8 * gq;
#pragma unroll 1
            for (int s = 0; s < 8; ++s) {
                const bf16x8 a = *(const LAS bf16x8*)(Hn + row * 512 + (((4 * s + gq) ^ (row & 15)) << 4));
#pragma unroll
                for (int nt = 0; nt < 8; ++nt) { const bf16x8 bfr = *(const bf16x8*)(pw + (size_t)(16 * nt) * 256 + 32 * s); acc[nt] = mfma16(bfr, a, acc[nt]); }
            }
#pragma unroll
            for (int nt = 0; nt < 8; ++nt) { u32x2 o; o.x = pk2(acc[nt][0], acc[nt][1]); o.y = pk2(acc[nt][2], acc[nt][3]); *(u32x2*)(C.Y + (R0 + row) * D + 768 + 128 * nh + 16 * nt + 4 * gq) = o; }
        }
        __syncthreads();
    }
}
__device__ __forceinline__ void compress_item(const Ctx& C, int l, int it, LAS unsigned char* lds) {
    const int wid = C.wid, lane = C.lane;
    const int rt = it >> 1, kv = it & 1, m16 = lane & 15, gq = lane >> 4;
    const int cr = 16 * rt + m16, bb = cr >> 9, n = cr & 511, nn = n < 510 ? n : 510;
    const bf16* rowbase = C.Z + ((size_t)bb * T + 16 * nn) * DINP + (kv ? C_VCMP : C_KCMP);
    const bf16* w1t = C.CW1T + (size_t)(l * 2 + kv) * 256 * 2048;
    f32x4 acc[2]; acc[0] = (f32x4){0.f, 0.f, 0.f, 0.f}; acc[1] = acc[0];
#pragma unroll 4
    for (int s = 0; s < 64; ++s) {
        const bf16x8 a = *(const bf16x8*)(rowbase + (size_t)(s >> 1) * DINP + 32 * (s & 1) + 8 * gq);
#pragma unroll
        for (int nt = 0; nt < 2; ++nt) { const bf16x8 bfr = *(const bf16x8*)(w1t + (size_t)(32 * wid + 16 * nt + m16) * 2048 + 32 * s + 8 * gq); acc[nt] = mfma16(bfr, a, acc[nt]); }
    }
    LAS bf16* Hc = (LAS bf16*)lds;
#pragma unroll
    for (int nt = 0; nt < 2; ++nt) { const int col = 32 * wid + 16 * nt + 4 * gq; const f32x4 pb = *(const f32x4*)(C.PEB + (l * 2 + kv) * 256 + col);
        u32x2 o; o.x = pk2(gelu_tanh(acc[nt][0] + pb[0]), gelu_tanh(acc[nt][1] + pb[1])); o.y = pk2(gelu_tanh(acc[nt][2] + pb[2]), gelu_tanh(acc[nt][3] + pb[3]));
        *(LAS u32x2*)(Hc + m16 * 264 + col) = o; }
    __syncthreads();
    if (wid < 4) {
        const bf16* w2t = C.CW2T + (size_t)(l * 2 + kv) * 64 * 256;
        f32x4 a2 = {0.f, 0.f, 0.f, 0.f};
#pragma unroll
        for (int s = 0; s < 8; ++s) { const bf16x8 a = *(const LAS bf16x8*)(Hc + m16 * 264 + 32 * s + 8 * gq); const bf16x8 bfr = *(const bf16x8*)(w2t + (size_t)(16 * wid + m16) * 256 + 32 * s + 8 * gq); a2 = mfma16(bfr, a, a2); }
        { u32x2 o; o.x = pk2(a2[0], a2[1]); o.y = pk2(a2[2], a2[3]); if (n >= NCMP) { o.x = 0u; o.y = 0u; }
          *(u32x2*)((kv ? C.VC : C.KC) + (size_t)cr * 64 + 16 * wid + 4 * gq) = o;
          const int tile = n >> 6, kk = n & 63;
          if (!kv) { const int sub = kk >> 4, s = wid >> 1, g2 = 2 * (wid & 1) + (gq >> 1);
              *(u32x2*)(C.KCF + ((size_t)(bb * 8 + tile)) * 4096 + ((sub * 2 + s) * 64 + g2 * 16 + (kk & 15)) * 8 + 4 * (gq & 1)) = o;
          } else { const int s2 = kk >> 5, k5 = kk & 31, g2 = (k5 & 15) >> 2, j = (k5 & 3) + ((k5 >> 4) << 2);
              bf16* vt = C.VCF + ((size_t)(bb * 8 + tile)) * 4096 + ((s2 * 4 + wid) * 64 + g2 * 16 + 4 * gq) * 8 + j;
              vt[0] = (bf16)(o.x & 0xffffu); vt[8] = (bf16)(o.x >> 16); vt[16] = (bf16)(o.y & 0xffffu); vt[24] = (bf16)(o.y >> 16); } }
    }
    __syncthreads();
}

__device__ __forceinline__ void nsa_branch(const bf16* kb, const bf16* vb, int pitch, const LAS int* base, int nch, int vlo, int vhi, int chi,
                                           const LAS unsigned* qs, LAS float* sc, float (&o)[4], int lane) {
    float mx0 = -INFINITY, mx1 = -INFINITY, mx2 = -INFINITY, mx3 = -INFINITY;
#pragma unroll 1
    for (int i = 0; i < nch; ++i) {
        asm volatile("" ::: "memory");
        const int r = base[i] + lane; const bool valid = (r >= vlo) && (r <= vhi);
        const int rc = r < 0 ? 0 : (r > chi ? chi : r);
        const u32x4* kp = (const u32x4*)(kb + (size_t)rc * pitch);
        u32x4 kr[8];
#pragma unroll
        for (int c = 0; c < 8; ++c) kr[c] = kp[c];
        float a0 = 0.f, a1 = 0.f, a2 = 0.f, a3 = 0.f;
#pragma unroll
        for (int c = 0; c < 8; ++c) {
            const u32x4 q0 = *(const LAS u32x4*)(qs + 0 * 32 + 4 * c), q1 = *(const LAS u32x4*)(qs + 1 * 32 + 4 * c), q2 = *(const LAS u32x4*)(qs + 2 * 32 + 4 * c), q3 = *(const LAS u32x4*)(qs + 3 * 32 + 4 * c);
            a0 = dot2bf(kr[c].x, q0.x, a0); a0 = dot2bf(kr[c].y, q0.y, a0); a0 = dot2bf(kr[c].z, q0.z, a0); a0 = dot2bf(kr[c].w, q0.w, a0);
            a1 = dot2bf(kr[c].x, q1.x, a1); a1 = dot2bf(kr[c].y, q1.y, a1); a1 = dot2bf(kr[c].z, q1.z, a1); a1 = dot2bf(kr[c].w, q1.w, a1);
            a2 = dot2bf(kr[c].x, q2.x, a2); a2 = dot2bf(kr[c].y, q2.y, a2); a2 = dot2bf(kr[c].z, q2.z, a2); a2 = dot2bf(kr[c].w, q2.w, a2);
            a3 = dot2bf(kr[c].x, q3.x, a3); a3 = dot2bf(kr[c].y, q3.y, a3); a3 = dot2bf(kr[c].z, q3.z, a3); a3 = dot2bf(kr[c].w, q3.w, a3);
        }
        if (!valid) { a0 = -INFINITY; a1 = -INFINITY; a2 = -INFINITY; a3 = -INFINITY; }
        sc[0 * 1024 + 64 * i + lane] = a0; sc[1 * 1024 + 64 * i + lane] = a1; sc[2 * 1024 + 64 * i + lane] = a2; sc[3 * 1024 + 64 * i + lane] = a3;
        mx0 = fmaxf(mx0, a0); mx1 = fmaxf(mx1, a1); mx2 = fmaxf(mx2, a2); mx3 = fmaxf(mx3, a3);
    }
    mx0 = wave_max(mx0); mx1 = wave_max(mx1); mx2 = wave_max(mx2); mx3 = wave_max(mx3);
    float l0 = 0.f, l1 = 0.f, l2 = 0.f, l3 = 0.f;
    for (int i = 0; i < nch; ++i) {
        const float s0 = sc[0 * 1024 + 64 * i + lane], s1 = sc[1 * 1024 + 64 * i + lane], s2 = sc[2 * 1024 + 64 * i + lane], s3 = sc[3 * 1024 + 64 * i + lane];
        const float e0 = (s0 == -INFINITY) ? 0.f : __expf(s0 - mx0), e1 = (s1 == -INFINITY) ? 0.f : __expf(s1 - mx1), e2 = (s2 == -INFINITY) ? 0.f : __expf(s2 - mx2), e3 = (s3 == -INFINITY) ? 0.f : __expf(s3 - mx3);
        sc[0 * 1024 + 64 * i + lane] = e0; sc[1 * 1024 + 64 * i + lane] = e1; sc[2 * 1024 + 64 * i + lane] = e2; sc[3 * 1024 + 64 * i + lane] = e3;
        l0 += e0; l1 += e1; l2 += e2; l3 += e3;
    }
    l0 = wave_sum(l0); l1 = wave_sum(l1); l2 = wave_sum(l2); l3 = wave_sum(l3);
    const float i0 = l0 > 0.f ? 1.0f / l0 : 0.f, i1 = l1 > 0.f ? 1.0f / l1 : 0.f, i2 = l2 > 0.f ? 1.0f / l2 : 0.f, i3 = l3 > 0.f ? 1.0f / l3 : 0.f;
    for (int i = 0; i < nch; ++i) { sc[0 * 1024 + 64 * i + lane] *= i0; sc[1 * 1024 + 64 * i + lane] *= i1; sc[2 * 1024 + 64 * i + lane] *= i2; sc[3 * 1024 + 64 * i + lane] *= i3; }
    LDS_WAIT();
    float o0 = 0.f, o1 = 0.f, o2 = 0.f, o3 = 0.f;
    for (int i = 0; i < nch; ++i) {
        const int b0 = base[i];
        for (int j = 0; j < 64; j += 16) {
            float vv[16];
#pragma unroll
            for (int u = 0; u < 16; ++u) { int r = b0 + j + u; r = r < 0 ? 0 : (r > chi ? chi : r); vv[u] = bf2f((unsigned)vb[(size_t)r * pitch + lane]); }
#pragma unroll
            for (int u4 = 0; u4 < 4; ++u4) {
                const f32x4 p0 = *(const LAS f32x4*)(sc + 0 * 1024 + 64 * i + j + 4 * u4), p1 = *(const LAS f32x4*)(sc + 1 * 1024 + 64 * i + j + 4 * u4), p2 = *(const LAS f32x4*)(sc + 2 * 1024 + 64 * i + j + 4 * u4), p3 = *(const LAS f32x4*)(sc + 3 * 1024 + 64 * i + j + 4 * u4);
#pragma unroll
                for (int u = 0; u < 4; ++u) { const float v1 = vv[4 * u4 + u]; o0 += p0[u] * v1; o1 += p1[u] * v1; o2 += p2[u] * v1; o3 += p3[u] * v1; }
            }
        }
    }
    o[0] = o0; o[1] = o1; o[2] = o2; o[3] = o3;
}
template <bool CHECK>
__device__ __forceinline__ void nsa_query(const Ctx& C, int b, int t, LAS unsigned char* wl  , unsigned* errw) {
    const int lane = C.lane;
    LAS float* sc = (LAS float*)wl;
    LAS unsigned* qs = (LAS unsigned*)(wl + 16384);
    LAS int* base = (LAS int*)(wl + 16384 + 1024);
    const size_t row = (size_t)b * T + t;
    const bf16* zr = C.Z + row * DINP;
    const bf16* Zb = C.Z + (size_t)b * T * DINP;
    { const unsigned w2 = *(const unsigned*)(zr + C_Q + 2 * lane);
      const unsigned w3 = *(const unsigned*)(zr + C_Q + 128 + 2 * lane);
      qs[lane] = pk2(lo16(w2) * 0.125f, hi16(w2) * 0.125f); qs[64 + lane] = pk2(lo16(w3) * 0.125f, hi16(w3) * 0.125f); }
    const int nvalid = (t >= 31) ? ((t - 31) / 16 + 1) : 0;
    const int nchc = (nvalid + 63) >> 6;
    if (lane < 16) base[lane] = 64 * lane;
    LDS_WAIT();
    float oc[4];
    nsa_branch(C.KC + (size_t)b * 512 * 64, C.VC + (size_t)b * 512 * 64, 64, base, nchc, 0, nvalid - 1, 510, qs, sc, oc, lane);
    const int cur = t >> 6;
    float c0, c1;
    {
        float im0 = 0.f, im1 = 0.f;
#pragma unroll
        for (int rr = -1; rr <= 3; ++rr) { const int n0 = 4 * lane + rr, n1 = 4 * (lane + 64) + rr;
            if (n0 >= 0 && n0 < 64 * nchc) im0 += (sc[n0] + sc[1024 + n0]) + (sc[2048 + n0] + sc[3072 + n0]);
            if (n1 < 64 * nchc) im1 += (sc[n1] + sc[1024 + n1]) + (sc[2048 + n1] + sc[3072 + n1]); }
        const int m0 = lane, m1 = lane + 64;
        c0 = (m0 <= cur) ? (im0 + ((m0 == 0 || m0 == cur || m0 == cur - 1) ? 1e4f : 0.f)) : -1.0f;
        c1 = (m1 <= cur) ? (im1 + ((m1 == 0 || m1 == cur || m1 == cur - 1) ? 1e4f : 0.f)) : -1.0f;
    }
    LDS_WAIT();
    for (int r = 0; r < 16; ++r) {
        float bv; int bi;
        if (c0 >= c1) { bv = c0; bi = lane; } else { bv = c1; bi = lane + 64; }
#pragma unroll
        for (int off = 1; off < 64; off <<= 1) { const float ov = __shfl_xor(bv, off); const int oi = __shfl_xor(bi, off); if (ov > bv || (ov == bv && oi < bi)) { bv = ov; bi = oi; } }
        if (bi == lane) c0 = -2.0f; if (bi == lane + 64) c1 = -2.0f;
        if (lane == 0) base[r] = (bv >= 0.f) ? 64 * bi : -1000000;
    }
    LDS_WAIT();
    float os[4];
    nsa_branch(Zb + C_KSEL, Zb + C_VSEL, DINP, base, 16, 0, t, T - 1, qs, sc, os, lane);
    if (lane < 16) base[lane] = t - 511 + 64 * lane;
    LDS_WAIT();
    float ow[4];
    nsa_branch(Zb + C_KWIN, Zb + C_VWIN, DINP, base, 8, 0, t, T - 1, qs, sc, ow, lane);
    float yv[4];
#pragma unroll
    for (int h = 0; h < 4; ++h) {
        const float g0 = sigmoidf_(bf2f((unsigned)zr[C_GATE + 3 * h + 0])), g1 = sigmoidf_(bf2f((unsigned)zr[C_GATE + 3 * h + 1])), g2 = sigmoidf_(bf2f((unsigned)zr[C_GATE + 3 * h + 2]));
        yv[h] = g0 * oc[h] + g1 * os[h] + g2 * ow[h];
        if (!CHECK) C.Y[row * D + 256 + h * 64 + lane] = (bf16)f2bf(yv[h]);
    }
    if (CHECK) {
        const float rmax = wave_max(fmaxf(fmaxf(fabsf(yv[0]), fabsf(yv[1])), fmaxf(fabsf(yv[2]), fabsf(yv[3]))));
        int bad = 0;
#pragma unroll
        for (int h = 0; h < 4; ++h) { const float ym = bf2f((unsigned)C.Y[row * D + 256 + h * 64 + lane]); if (!(fabsf(ym - yv[h]) <= 0.03f * rmax + 2e-4f)) ++bad; }
        const float fb = wave_sum((float)bad);
        if (lane == 0) { atomicAdd(errw, (unsigned)fb); atomicAdd(errw + 64, 256u); }
    }
    LDS_WAIT();
}

__device__ __forceinline__ void xattn_unit(const Ctx& C, int l, int unit, LAS unsigned char* lds) {
    const int tid = C.tid, wid = C.wid, lane = C.lane;
    const int qt = unit & 63, bh = unit >> 6, b = bh >> 2, h = bh & 3;
    const int m16 = lane & 15, gq = lane >> 4;
    const size_t qrow = (size_t)b * T + qt * 128 + 16 * wid + m16;
    bf16x8 qf[8];
#pragma unroll
    for (int s = 0; s < 8; ++s) qf[s] = *(const bf16x8*)(C.Q + qrow * D + h * 256 + 32 * s + 8 * gq);
    const bf16* ksrc = C.KMEM + ((size_t)l * 1024 + b * 256) * 1024 + h * 256;
    for (int it = tid; it < 256 * 32; it += NTHREADS) { const int key = it >> 5, c = it & 31; *(LAS u32x4*)(lds + key * 528 + c * 16) = *(const u32x4*)(ksrc + (size_t)key * 1024 + 8 * c); }
    __syncthreads();
    f32x4 sacc[16];
#pragma unroll
    for (int kt = 0; kt < 16; ++kt) { sacc[kt] = (f32x4){0.f, 0.f, 0.f, 0.f};
#pragma unroll
        for (int s = 0; s < 8; ++s) { const bf16x8 a = *(const LAS bf16x8*)(lds + (16 * kt + m16) * 528 + 64 * s + 16 * gq); sacc[kt] = mfma16(a, qf[s], sacc[kt]); } }
    float mx = -INFINITY;
#pragma unroll
    for (int kt = 0; kt < 16; ++kt) mx = fmaxf(fmaxf(mx, fmaxf(sacc[kt][0], sacc[kt][1])), fmaxf(sacc[kt][2], sacc[kt][3]));
    mx = fmaxf(mx, __shfl_xor(mx, 16)); mx = fmaxf(mx, __shfl_xor(mx, 32));
    const float scl = 0.0625f * 1.4426950408889634f;
    float sum = 0.f;
#pragma unroll
    for (int kt = 0; kt < 16; ++kt)
#pragma unroll
        for (int r = 0; r < 4; ++r) { const float e = exp2f((sacc[kt][r] - mx) * scl); sacc[kt][r] = e; sum += e; }
    sum += __shfl_xor(sum, 16); sum += __shfl_xor(sum, 32);
    const float inv = 1.0f / sum;
    bf16x8 pf[8];
#pragma unroll
    for (int s2 = 0; s2 < 8; ++s2) { u32x4 w; w.x = pk2(sacc[2 * s2][0], sacc[2 * s2][1]); w.y = pk2(sacc[2 * s2][2], sacc[2 * s2][3]); w.z = pk2(sacc[2 * s2 + 1][0], sacc[2 * s2 + 1][1]); w.w = pk2(sacc[2 * s2 + 1][2], sacc[2 * s2 + 1][3]);
        pf[s2] = __builtin_bit_cast(bf16x8, w); }
    __syncthreads();
    const bf16* vsrc = C.VTMEM + ((size_t)l * 4096 + (b * 4 + h) * 256) * 256;
    for (int it = tid; it < 256 * 32; it += NTHREADS) { const int d = it >> 5, c = it & 31; *(LAS u32x4*)(lds + d * 528 + c * 16) = *(const u32x4*)(vsrc + (size_t)d * 256 + 8 * c); }
    __syncthreads();
#pragma unroll
    for (int dt = 0; dt < 16; ++dt) {
        f32x4 oacc = {0.f, 0.f, 0.f, 0.f};
#pragma unroll
        for (int s2 = 0; s2 < 8; ++s2) { const u32x2 lo = *(const LAS u32x2*)(lds + (16 * dt + m16) * 528 + 64 * s2 + 8 * gq), hi = *(const LAS u32x2*)(lds + (16 * dt + m16) * 528 + 64 * s2 + 32 + 8 * gq);
            u32x4 w; w.x = lo.x; w.y = lo.y; w.z = hi.x; w.w = hi.y; oacc = mfma16(__builtin_bit_cast(bf16x8, w), pf[s2], oacc); }
        u32x2 o; o.x = pk2(oacc[0] * inv, oacc[1] * inv); o.y = pk2(oacc[2] * inv, oacc[3] * inv);
        *(u32x2*)(C.Y + qrow * D + h * 256 + 16 * dt + 4 * gq) = o;
    }
    __syncthreads();
}

__device__ __forceinline__ void moe_gather(const Ctx& C, LAS unsigned char* lds) {
    LAS int* sh = (LAS int*)lds;
    for (int i = C.tid; i < 2048; i += NTHREADS) sh[i] = C.HIST[i];
    __syncthreads();
    if (C.tid < 8) { int c = 0; for (int tl = 0; tl < 256; ++tl) c += sh[tl * 8 + C.tid]; sh[2048 + C.tid] = c; }
    __syncthreads();
    if (C.tid == 0) { int acc = 0; for (int ex = 0; ex < 8; ++ex) { sh[2064 + ex] = acc; acc += (sh[2048 + ex] + 255) & ~255; if (C.bid == 0) C.META[ex] = acc >> 8; } if (C.bid == 0) C.META[8] = acc >> 8; }
    __syncthreads();
    for (int tile = C.bid; tile < 256; tile += C.G) {
        if (C.tid < 8) { int c = 0; for (int tl = 0; tl < tile; ++tl) c += sh[tl * 8 + C.tid]; sh[2056 + C.tid] = c; }
        __syncthreads();
        for (int i = 0; i < 32; ++i) {
            const int a = 32 * C.wid + i; const size_t ag = (size_t)tile * 256 + a;
            const unsigned info = C.TOKINFO[ag]; const int e = info & 255u, lr = info >> 8;
            const int dest = sh[2064 + e] + sh[2056 + e] + lr;
            if (C.lane == 0) C.TOKPOS[ag] = dest;
            const u32x4* s = (const u32x4*)(C.XB + ((size_t)tile * 128 + (a >> 1)) * D); u32x4* dd = (u32x4*)(C.XG + (size_t)dest * D);
            dd[C.lane] = s[C.lane]; dd[C.lane + 64] = s[C.lane + 64];
        }
        __syncthreads();
    }
    const int gw = C.bid * NWAVES + C.wid, NGW = C.G * NWAVES;
    for (int ex = 0; ex < 8; ++ex) { const int s0 = sh[2064 + ex] + sh[2048 + ex], e0 = sh[2064 + ex] + ((sh[2048 + ex] + 255) & ~255);
        for (int r = s0 + gw; r < e0; r += NGW) { u32x4* dd = (u32x4*)(C.XG + (size_t)r * D); const u32x4 z = {0u, 0u, 0u, 0u}; dd[C.lane] = z; dd[C.lane + 64] = z; } }
}

__device__ __forceinline__ void frag_tile(const Ctx& C, int tb) {
    const int b = tb >> 6, t0 = (tb & 63) << 7;
    const bf16* Zt = C.Z + ((size_t)b * T + t0) * DINP;
    for (int task = C.tid; task < 2048; task += NTHREADS) {
        const int arr = task >> 10, key = (task >> 3) & 127, d8 = task & 7;
        const u32x4 v = *(const u32x4*)(Zt + (size_t)key * DINP + (arr ? C_KWIN : C_KSEL) + 8 * d8);
        const int tile = (t0 + key) >> 6, kk = key & 63;
        *(u32x4*)((arr ? C.KWINF : C.KSELF) + ((size_t)(b * 128 + tile)) * 4096 + (((kk >> 4) * 2 + (d8 >> 2)) * 64 + (d8 & 3) * 16 + (kk & 15)) * 8) = v;
    }
    for (int task = C.tid; task < 2048; task += NTHREADS) {
        const int arr = task >> 10, tile2 = (task >> 9) & 1, s2 = (task >> 8) & 1, dt = (task >> 6) & 3, ln = task & 63, g2 = ln >> 4, c2 = ln & 15;
        const bf16* src = Zt + (size_t)(64 * tile2 + 32 * s2 + 4 * g2) * DINP + (arr ? C_VWIN : C_VSEL) + 16 * dt + c2;
        unsigned v[8];
#pragma unroll
        for (int i = 0; i < 4; ++i) { v[i] = src[(size_t)i * DINP]; v[4 + i] = src[(size_t)(16 + i) * DINP]; }
        u32x4 o; o.x = v[0] | (v[1] << 16); o.y = v[2] | (v[3] << 16); o.z = v[4] | (v[5] << 16); o.w = v[6] | (v[7] << 16);
        *(u32x4*)((arr ? C.VWINF : C.VSELF) + ((size_t)(b * 128 + (t0 >> 6) + tile2)) * 4096 + ((s2 * 4 + dt) * 64 + ln) * 8) = o;
    }
}

constexpr int NCT = 2, NQW = 4 * NCT;
struct NsaAcc { f32x4 o[NCT][4]; float m[NCT], l[NCT]; };
__device__ __forceinline__ void nsa_acc_reset(NsaAcc& A) {
#pragma unroll
    for (int ct = 0; ct < NCT; ++ct) { A.m[ct] = -INFINITY; A.l[ct] = 0.f;
#pragma unroll
        for (int dt = 0; dt < 4; ++dt) A.o[ct][dt] = (f32x4){0.f, 0.f, 0.f, 0.f}; }
}
#define NSA_SCL (0.125f * 1.4426950408889634f)
__device__ __forceinline__ void nsa_tile(const bf16* Kt, const bf16* Vt, const bf16x8 (&qf)[NCT][2], int k0,
                                         const int (&lo)[NCT], const int (&hi)[NCT], unsigned ctmask, NsaAcc& A, int lane, int g) {
    bf16x8 kf[4][2], vf[4][2];
#pragma unroll
    for (int sub = 0; sub < 4; ++sub)
#pragma unroll
        for (int s = 0; s < 2; ++s) kf[sub][s] = *(const bf16x8*)(Kt + ((sub * 2 + s) * 64 + lane) * 8);
#pragma unroll
    for (int dt = 0; dt < 4; ++dt)
#pragma unroll
        for (int s2 = 0; s2 < 2; ++s2) vf[dt][s2] = *(const bf16x8*)(Vt + ((s2 * 4 + dt) * 64 + lane) * 8);
#pragma unroll
    for (int ct = 0; ct < NCT; ++ct) {
        if (!((ctmask >> ct) & 1u)) continue;
        f32x4 sa[4];
#pragma unroll
        for (int sub = 0; sub < 4; ++sub) { sa[sub] = mfma16(kf[sub][0], qf[ct][0], (f32x4){0.f, 0.f, 0.f, 0.f}); sa[sub] = mfma16(kf[sub][1], qf[ct][1], sa[sub]); }
        {
            const bool allv = (lo[ct] <= k0) && (k0 + 63 <= hi[ct]); const bool nonev = (hi[ct] < k0) || (lo[ct] > k0 + 63);
            if (__any(!(allv || nonev))) {
#pragma unroll
                for (int sub = 0; sub < 4; ++sub)
#pragma unroll
                    for (int r = 0; r < 4; ++r) { const int key = k0 + 16 * sub + 4 * g + r; sa[sub][r] = (key >= lo[ct] && key <= hi[ct]) ? sa[sub][r] : -INFINITY; }
            } else if (__any(nonev)) {
#pragma unroll
                for (int sub = 0; sub < 4; ++sub)
#pragma unroll
                    for (int r = 0; r < 4; ++r) sa[sub][r] = allv ? sa[sub][r] : -INFINITY;
            }
        }
        float tmax = fmaxf(fmaxf(fmaxf(sa[0][0], sa[0][1]), fmaxf(sa[0][2], sa[0][3])), fmaxf(fmaxf(sa[1][0], sa[1][1]), fmaxf(sa[1][2], sa[1][3])));
        tmax = fmaxf(tmax, fmaxf(fmaxf(fmaxf(sa[2][0], sa[2][1]), fmaxf(sa[2][2], sa[2][3])), fmaxf(fmaxf(sa[3][0], sa[3][1]), fmaxf(sa[3][2], sa[3][3]))));
        tmax = fmaxf(tmax, __shfl_xor(tmax, 16)); tmax = fmaxf(tmax, __shfl_xor(tmax, 32));
        tmax *= NSA_SCL;
        if (__any(tmax > A.m[ct])) {
            const float mn = fmaxf(A.m[ct], tmax);
            const float alpha = __builtin_amdgcn_exp2f(A.m[ct] - ((mn == -INFINITY) ? 0.f : mn));
            A.l[ct] *= alpha; A.m[ct] = mn;
#pragma unroll
            for (int dt = 0; dt < 4; ++dt) A.o[ct][dt] = A.o[ct][dt] * alpha;
        }
        const float nms = (A.m[ct] == -INFINITY) ? 0.f : -A.m[ct];
        float ps = 0.f;
#pragma unroll
        for (int sub = 0; sub < 4; ++sub)
#pragma unroll
            for (int r = 0; r < 4; ++r) { const float p = __builtin_amdgcn_exp2f(fmaf(sa[sub][r], NSA_SCL, nms)); sa[sub][r] = p; ps += p; }
        A.l[ct] += ps;
        bf16x8 pf[2];
#pragma unroll
        for (int s2 = 0; s2 < 2; ++s2) { u32x4 w; w.x = pk2(sa[2 * s2][0], sa[2 * s2][1]); w.y = pk2(sa[2 * s2][2], sa[2 * s2][3]); w.z = pk2(sa[2 * s2 + 1][0], sa[2 * s2 + 1][1]); w.w = pk2(sa[2 * s2 + 1][2], sa[2 * s2 + 1][3]);
            pf[s2] = __builtin_bit_cast(bf16x8, w); }
#pragma unroll
        for (int dt = 0; dt < 4; ++dt)
#pragma unroll
            for (int s2 = 0; s2 < 2; ++s2) A.o[ct][dt] = mfma16(vf[dt][s2], pf[s2], A.o[ct][dt]);
    }
}
__device__ __forceinline__ void nsa_finalize(const Ctx& C, NsaAcc& A, const bf16* Zb, size_t rowb, int t0, int jb, bool first, bool last, float (&msave)[NCT], float (&isave)[NCT], int c, int g) {
    const int ql = c >> 2, h = c & 3;
    float* scr = C.VBUF;
#pragma unroll
    for (int ct = 0; ct < NCT; ++ct) {
        float lt = A.l[ct]; lt += __shfl_xor(lt, 16); lt += __shfl_xor(lt, 32);
        const float inv = lt > 0.f ? 1.0f / lt : 0.f; msave[ct] = A.m[ct]; isave[ct] = inv;
        const int tq = t0 + 4 * ct + ql;
        const float gate = sigmoidf_(bf2f((unsigned)Zb[(size_t)tq * DINP + C_GATE + 3 * h + jb]));
        const float f = inv * gate;
#pragma unroll
        for (int dt = 0; dt < 4; ++dt) {
            f32x4 v = A.o[ct][dt] * f; const size_t off = (rowb + tq) * 256 + h * 64 + 16 * dt + 4 * g;
            if (!first) v = v + *(const f32x4*)(scr + off);
            if (last) { u32x2 o; o.x = pk2(v[0], v[1]); o.y = pk2(v[2], v[3]); *(u32x2*)(C.Y + (rowb + tq) * D + 256 + h * 64 + 16 * dt + 4 * g) = o; }
            else *(f32x4*)(scr + off) = v;
        }
    }
}
__device__ __forceinline__ void nsa_unit(const Ctx& C, int U, LAS unsigned char* wl) {
    const int lane = C.lane, c = lane & 15, g = lane >> 4, ql = c >> 2, h = c & 3;
    const int b = U / (T / NQW), t0 = (U % (T / NQW)) * NQW;
    const size_t rowb = (size_t)b * T;
    const bf16* Zb = C.Z + rowb * DINP;
    LAS float* imp = (LAS float*)wl; LAS unsigned* smask = (LAS unsigned*)(wl + 8192);
    bf16x8 qf[NCT][2]; int tq[NCT];
#pragma unroll
    for (int ct = 0; ct < NCT; ++ct) { tq[ct] = t0 + 4 * ct + ql;
#pragma unroll
        for (int s = 0; s < 2; ++s) qf[ct][s] = *(const bf16x8*)(Zb + (size_t)tq[ct] * DINP + C_Q + h * 64 + 32 * s + 8 * g); }
    NsaAcc A; float msave[NCT], isave[NCT], mc[NCT], ic[NCT];
    int lo[NCT], hi[NCT];
    constexpr unsigned ALLCT = (1u << NCT) - 1u;
    const int nmaxw = (t0 + NQW - 1 >= 31) ? ((t0 + NQW - 1 - 31) >> 4) : -1;
    const int nkt = (nmaxw >> 6) + 1;
    const bf16* KCb = C.KCF + (size_t)b * 8 * 4096; const bf16* VCb = C.VCF + (size_t)b * 8 * 4096;
#pragma unroll
    for (int ct = 0; ct < NCT; ++ct) { lo[ct] = 0; hi[ct] = (tq[ct] >= 31) ? ((tq[ct] - 31) >> 4) : -1; }
    nsa_acc_reset(A);
    for (int kt = 0; kt < nkt; ++kt) nsa_tile(KCb + (size_t)kt * 4096, VCb + (size_t)kt * 4096, qf, 64 * kt, lo, hi, ALLCT, A, lane, g);
    nsa_finalize(C, A, Zb, rowb, t0, 0, true, false, mc, ic, c, g);
    for (int i = lane; i < NQW * 128; i += 64) imp[i] = 0.f;
    LDS_WAIT();
    for (int kt = 0; kt < nkt; ++kt) {
        bf16x8 kf[4][2];
#pragma unroll
        for (int sub = 0; sub < 4; ++sub)
#pragma unroll
            for (int s = 0; s < 2; ++s) kf[sub][s] = *(const bf16x8*)(KCb + (size_t)kt * 4096 + ((sub * 2 + s) * 64 + lane) * 8);
#pragma unroll
        for (int ct = 0; ct < NCT; ++ct) {
#pragma unroll
            for (int sub = 0; sub < 4; ++sub) {
                f32x4 sa = mfma16(kf[sub][0], qf[ct][0], (f32x4){0.f, 0.f, 0.f, 0.f}); sa = mfma16(kf[sub][1], qf[ct][1], sa);
                float p[4];
#pragma unroll
                for (int r = 0; r < 4; ++r) { const int n = 64 * kt + 16 * sub + 4 * g + r; float v = (n <= hi[ct]) ? __builtin_amdgcn_exp2f(sa[r] * NSA_SCL - mc[ct]) * ic[ct] : 0.f;
                    v += __shfl_xor(v, 1); v += __shfl_xor(v, 2); p[r] = v; }
                if (h == 0) { const int mb = 16 * kt + 4 * sub + g; LAS float* ip = imp + (4 * ct + ql) * 128 + mb;
                    atomicAdd((float*)ip, (p[0] + p[1]) + (p[2] + p[3])); if (mb + 1 < 128) atomicAdd((float*)(ip + 1), p[3]); }
            }
        }
    }
    LDS_WAIT();
#pragma unroll 1
    for (int qi = 0; qi < NQW; ++qi) {
        const int t = t0 + qi, cur = t >> 6; const int m0 = lane, m1 = lane + 64;
        unsigned long long mlo, mhi;
        if (cur < 16) { mlo = __ballot(m0 <= cur); mhi = 0ull; }
        else {
            const float s0 = imp[qi * 128 + m0] + ((m0 == 0 || m0 == cur || m0 == cur - 1) ? 1e4f : 0.f), s1 = imp[qi * 128 + m1] + ((m1 == 0 || m1 == cur || m1 == cur - 1) ? 1e4f : 0.f);
            const unsigned u0 = (m0 <= cur) ? __float_as_uint(s0) + 1u : 0u, u1 = (m1 <= cur) ? __float_as_uint(s1) + 1u : 0u;
            unsigned tau = 0u;
            for (int bit = 30; bit >= 0; --bit) { const unsigned cand = tau | (1u << bit); const int cnt = __popcll(__ballot(u0 >= cand)) + __popcll(__ballot(u1 >= cand)); if (cnt >= 16) tau = cand; }
            const unsigned long long g0 = __ballot(u0 > tau), g1 = __ballot(u1 > tau), e0 = __ballot(u0 == tau), e1 = __ballot(u1 == tau);
            int need = 16 - __popcll(g0) - __popcll(g1);
            const unsigned long long lt = (1ull << lane) - 1ull;
            const unsigned long long k0m = __ballot(((e0 >> lane) & 1ull) && __popcll(e0 & lt) < need); need -= __popcll(k0m);
            const unsigned long long k1m = __ballot(((e1 >> lane) & 1ull) && __popcll(e1 & lt) < need);
            mlo = g0 | k0m; mhi = g1 | k1m;
        }
        if (lane == 0) { smask[qi * 4 + 0] = (unsigned)mlo; smask[qi * 4 + 1] = (unsigned)(mlo >> 32); smask[qi * 4 + 2] = (unsigned)mhi; smask[qi * 4 + 3] = (unsigned)(mhi >> 32); }
    }
    LDS_WAIT();
    nsa_acc_reset(A);
    {
        const int jmax = (t0 + NQW - 1) >> 6;
        const bf16* Kb = C.KSELF + (size_t)b * 128 * 4096; const bf16* Vb = C.VSELF + (size_t)b * 128 * 4096;
#pragma unroll
        for (int ct = 0; ct < NCT; ++ct) lo[ct] = 0;
        for (int j = 0; j <= jmax; ++j) {
            unsigned ctmask = 0u;
#pragma unroll
            for (int ct = 0; ct < NCT; ++ct) { const unsigned w = smask[(4 * ct + ql) * 4 + (j >> 5)]; const bool sel = (w >> (j & 31)) & 1u; hi[ct] = sel ? tq[ct] : -1; if (__any(sel)) ctmask |= 1u << ct; }
            if (ctmask) nsa_tile(Kb + (size_t)j * 4096, Vb + (size_t)j * 4096, qf, 64 * j, lo, hi, ctmask, A, lane, g);
        }
    }
    nsa_finalize(C, A, Zb, rowb, t0, 1, false, false, msave, isave, c, g);
    nsa_acc_reset(A);
    {
        const int j0 = (t0 >= 511) ? ((t0 - 511) >> 6) : 0, j1 = (t0 + NQW - 1) >> 6;
        const bf16* Kb = C.KWINF + (size_t)b * 128 * 4096; const bf16* Vb = C.VWINF + (size_t)b * 128 * 4096;
#pragma unroll
        for (int ct = 0; ct < NCT; ++ct) { lo[ct] = tq[ct] - 511; hi[ct] = tq[ct]; }
        for (int j = j0; j <= j1; ++j) nsa_tile(Kb + (size_t)j * 4096, Vb + (size_t)j * 4096, qf, 64 * j, lo, hi, ALLCT, A, lane, g);
    }
    nsa_finalize(C, A, Zb, rowb, t0, 2, false, true, msave, isave, c, g);
    LDS_WAIT();
}

#ifndef DBG_REP
#define DBG_REP 0
#endif
#ifndef NSA_CHECK
#define NSA_CHECK 0
#endif
#ifndef MK_MULTI
#define MK_MULTI 0
#endif
constexpr int PH_PER_LAYER = 13, N_PHASES = 1 + NL * PH_PER_LAYER;


__device__ __forceinline__ void mkctx(Ctx& C, const Params& P, int tid) {
    C.tid = tid; C.lane = tid & 63; C.wid = __builtin_amdgcn_readfirstlane(tid >> 6); C.bid = blockIdx.x; C.G = gridDim.x;
#pragma unroll
    for (int i = 0; i < 35; ++i) C.in[i] = P.in[i];
    unsigned char* ws = P.ws;
    C.X = P.out;
    C.XB = (bf16*)(ws + WS_XB); C.Z = (bf16*)(ws + WS_Z); C.Y = (bf16*)(ws + WS_Y); C.Q = (bf16*)(ws + WS_Q); C.H = (bf16*)(ws + WS_H); C.XG = (bf16*)(ws + WS_Z);
    C.KC = (bf16*)(ws + WS_KC); C.VC = (bf16*)(ws + WS_VC); C.MEMB = (bf16*)(ws + WS_MEMB); C.KMEM = (bf16*)(ws + WS_KMEM); C.VTMEM = (bf16*)(ws + WS_VTMEM); C.KCF = (bf16*)(ws + WS_KCF); C.VCF = (bf16*)(ws + WS_VCF); C.KSELF = (bf16*)(ws + WS_KSELF); C.VSELF = (bf16*)(ws + WS_VSELF); C.KWINF = (bf16*)(ws + WS_KWINF); C.VWINF = (bf16*)(ws + WS_VWINF);
    C.WINT = (bf16*)(ws + WS_WINT); C.WOUTT = (bf16*)(ws + WS_WOUTT); C.XQT = (bf16*)(ws + WS_XQT); C.XKVT = (bf16*)(ws + WS_XKVT); C.XOT = (bf16*)(ws + WS_XOT);
    C.W13T = (bf16*)(ws + WS_W13T); C.W2T = (bf16*)(ws + WS_W2T); C.E13T = (bf16*)(ws + WS_E13T); C.E2T = (bf16*)(ws + WS_E2T);
    C.CW1T = (bf16*)(ws + WS_CW1T); C.CW2T = (bf16*)(ws + WS_CW2T); C.PWT = (bf16*)(ws + WS_PWT); C.POOLWT = (bf16*)(ws + WS_POOLWT); C.SGUWB = (bf16*)(ws + WS_SGUW);
    C.VBUF = (float*)(ws + WS_VBUF); C.FS = (float*)(ws + WS_VBUF); C.PEB = (float*)(ws + WS_PEB); C.TOKG = (float*)(ws + WS_TOKG);
    C.HIST = (int*)(ws + WS_HIST); C.META = (int*)(ws + WS_META); C.TOKPOS = (int*)(ws + WS_TOKPOS); C.TOKINFO = (unsigned*)(ws + WS_TOKINFO);
}
#define MKCTX() Ctx C; { int t_ = threadIdx.x; asm volatile("" : "+v"(t_)); mkctx(C, P, t_); }

__global__ void __launch_bounds__(NTHREADS, 2) fwd_kernel(Params P) {
    extern __shared__ __attribute__((aligned(16))) unsigned char lds_raw[];
    LAS unsigned char* lds = (LAS unsigned char*)lds_raw;
    for (int u = threadIdx.x; u < (LDS_BYTES - LDSCTL_OFF) / 4; u += NTHREADS) ((LAS unsigned*)(lds + LDSCTL_OFF))[u] = 0u;
    __syncthreads();
    unsigned char* ws = P.ws;
    XcdBarrier bar; bar.bar = (unsigned*)(ws + WS_CTL); bar.x = 0; bar.st = nullptr;
#if !MK_MULTI
    bar = xcd_barrier_post((unsigned*)(ws + WS_CTL), (volatile LAS unsigned*)(lds + LDSCTL_OFF));
#endif
    const int lo = P.ph_lo, hi = P.ph_hi;
#define IN(k) (lo <= (k) && (k) < hi)
#if MK_MULTI
#define SEAM(k) do { } while (0)
#else
#define SEAM(k) do { if (IN(k) && IN((k) + 1)) xcd_barrier(bar); } while (0)
#endif
    int ph = 0;
    if (IN(ph)) { for (int rep = 0; rep < ((P.dbg & 2) ? 2 : 1); ++rep) { MKCTX(); p0_prologue(C, lds); __syncthreads(); } }
    SEAM(ph); ++ph;

    for (int l = 0; l < NL; ++l) {
        const bool moe = (l & 1) != 0; const int li = l >> 1;
        if (IN(ph)) {
            MKCTX();
            if (l == 0) {
                for (int l2 = 0; l2 < NL; ++l2) {
                    pg8::Gemm g{C.MEMB, C.XKVT + (size_t)l2 * 2 * D * D, NB * MEM, 2 * D, D}; pg8::StaticOrder S; S.init(NB * MEM, 2 * D, C.G, (C.bid + 32 * l2) % C.G);
                    pg8::EpiKV E{C.KMEM + (size_t)l2 * 1024 * 1024, C.VTMEM + (size_t)l2 * 4096 * 256};
                    pg8::gemm_phase<pg8::EpiKV, pg8::StaticOrder, true, true>(lds, g, S, E);
                }
            }
            pg8::Gemm g{C.XB, C.WINT + (size_t)l * DINP * D, M, DINP, D}; pg8::StaticOrder S; S.init(M, DINP, C.G, C.bid);
            pg8::EpiBf16 E{C.Z, DINP};
            pg8::gemm_phase<pg8::EpiBf16, pg8::StaticOrder, true, true>(lds, g, S, E);
        }
        SEAM(ph); ++ph;
        if (IN(ph)) for (int rep = 0; rep < ((P.dbg & 4) ? 2 : 1); ++rep) {
            MKCTX();
            { ConvW cw;
              for (int tb = C.bid; tb < M / 128; tb += C.G) frag_tile(C, tb);
              for (int tb = C.bid; tb < M / 128; tb += C.G) mixers_tile<1>(C, l, tb, lds, cw);
              for (int tb = C.bid; tb < M / 128; tb += C.G) mixers_tile<2>(C, l, tb, lds, cw);
              load_convw(C, l, cw);
              for (int tb = C.bid; tb < M / 128; tb += C.G) mixers_tile<4>(C, l, tb, lds, cw); }
            for (int it = C.bid; it < 256; it += C.G) compress_item(C, l, it, lds);
        }
        SEAM(ph); ++ph;
        if (IN(ph)) for (int rep = 0; rep < ((P.dbg & 1) ? 2 : 1); ++rep) {
            MKCTX();
            for (int slot = C.bid * NWAVES + C.wid; slot < M / NQW / 2; slot += C.G * NWAVES) {
                int bb = slot >> 9, lw = slot & 511;
                if (C.G == 256) { bb = (C.bid & 7) >> 1; lw = (((C.bid >> 3) << 1) + (C.bid & 1)) * NWAVES + C.wid; }
#pragma unroll 1
                for (int k = 0; k < 2; ++k) nsa_unit(C, bb * (T / NQW) + (k ? (T / NQW - 1 - lw) : lw), lds + C.wid * 17664);
            }
#if NSA_CHECK
            xcd_barrier(bar);
            { const int gw = C.bid * NWAVES + C.wid, NGW = C.G * NWAVES;
              for (int q = gw; q < M; q += NGW) { const int t = q & (T - 1); if ((((unsigned)q * 2654435761u) >> 29) == 0u || t < 192) nsa_query<true>(C, q >> 13, t, lds + C.wid * 17664, (unsigned*)(P.ws + WS_CTL + 32768)); } }
#endif
        }
        SEAM(ph); ++ph;
        if (IN(ph)) {
            MKCTX();
            pg8::Gemm g{C.Y, C.WOUTT + (size_t)l * D * D, M, D, D}; pg8::StaticOrder S; S.init(M, D, C.G, C.bid);
            pg8::EpiF32Res E{C.VBUF, (l == 0) ? C.in[I_X] : (const float*)C.X, D, ALPHA};
            pg8::gemm_phase<pg8::EpiF32Res, pg8::StaticOrder, true, true>(lds, g, S, E);
        }
        SEAM(ph); ++ph;
        if (IN(ph)) for (int rep = 0; rep < ((P.dbg & 8) ? 2 : 1); ++rep) { MKCTX(); ln_phase(C, C.VBUF, C.in[I_LN1G] + l * D, C.in[I_LN1B] + l * D, 0, nullptr, lds); }
        SEAM(ph); ++ph;
        if (IN(ph)) {
            MKCTX();
            pg8::Gemm g{C.XB, C.XQT + (size_t)l * D * D, M, D, D}; pg8::StaticOrder S; S.init(M, D, C.G, C.bid);
            pg8::EpiBf16 E{C.Q, D};
            pg8::gemm_phase<pg8::EpiBf16, pg8::StaticOrder, true, true>(lds, g, S, E);
        }
        SEAM(ph); ++ph;
        if (IN(ph)) for (int rep = 0; rep < ((P.dbg & 16) ? 2 : 1); ++rep) { MKCTX(); for (int u = C.bid; u < NB * 4 * 64; u += C.G) xattn_unit(C, l, u, lds); }
        SEAM(ph); ++ph;
        if (IN(ph)) {
            MKCTX();
            pg8::Gemm g{C.Y, C.XOT + (size_t)l * D * D, M, D, D}; pg8::StaticOrder S; S.init(M, D, C.G, C.bid);
            pg8::EpiF32Res E{C.VBUF, (const float*)C.X, D, ALPHA};
            pg8::gemm_phase<pg8::EpiF32Res, pg8::StaticOrder, true, true>(lds, g, S, E);
        }
        SEAM(ph); ++ph;
        if (IN(ph)) for (int rep = 0; rep < ((P.dbg & 8) ? 2 : 1); ++rep) { MKCTX(); ln_phase(C, C.VBUF, C.in[I_LN2G] + l * D, C.in[I_LN2B] + l * D, 0, moe ? C.in[I_ROUTER] + (size_t)li * D * NE : nullptr, lds); }
        SEAM(ph); ++ph;
        if (IN(ph)) for (int rep = 0; rep < ((P.dbg & 32) ? 2 : 1); ++rep) { if (moe) { MKCTX(); moe_gather(C, lds); __syncthreads(); } }
        if (moe || MK_MULTI) SEAM(ph);
        ++ph;
        if (IN(ph)) {
            MKCTX();
            pg8::GroupedOrder S; int npan;
            if (moe) {
#pragma unroll
                for (int k = 0; k < 8; ++k) S.pend[k] = __builtin_amdgcn_readfirstlane(C.META[k]);
                npan = __builtin_amdgcn_readfirstlane(C.META[8]); S.estride = (size_t)2 * FE * D * 2;
            } else {
#pragma unroll
                for (int k = 0; k < 8; ++k) S.pend[k] = M / 256;
                npan = M / 256; S.estride = 0;
            }
            const int N = moe ? 2 * FE : 2 * FF;
            pg8::Gemm g{moe ? C.XG : C.XB, moe ? C.E13T + (size_t)li * NE * 2 * FE * D : C.W13T + (size_t)li * 2 * FF * D, npan * 256, N, D};
            S.init(npan * 256, N, C.G, C.bid);
            pg8::EpiSwiglu E{C.H, N / 2};
            pg8::gemm_phase<pg8::EpiSwiglu, pg8::GroupedOrder, true, true>(lds, g, S, E);
        }
        SEAM(ph); ++ph;
        if (IN(ph)) {
            MKCTX();
            pg8::GroupedOrder S; int npan;
            if (moe) {
#pragma unroll
                for (int k = 0; k < 8; ++k) S.pend[k] = __builtin_amdgcn_readfirstlane(C.META[k]);
                npan = __builtin_amdgcn_readfirstlane(C.META[8]); S.estride = (size_t)D * FE * 2;
            } else {
#pragma unroll
                for (int k = 0; k < 8; ++k) S.pend[k] = M / 256;
                npan = M / 256; S.estride = 0;
            }
            const int K = moe ? FE : FF;
            pg8::Gemm g{C.H, moe ? C.E2T + (size_t)li * NE * D * FE : C.W2T + (size_t)li * D * FF, npan * 256, D, K};
            S.init(npan * 256, D, C.G, C.bid);
            pg8::EpiF32Res E{moe ? C.FS : C.VBUF, moe ? nullptr : (const float*)C.X, D, ALPHA};
            pg8::gemm_phase<pg8::EpiF32Res, pg8::GroupedOrder, true, true>(lds, g, S, E);
        }
        SEAM(ph); ++ph;
        if (IN(ph)) { MKCTX(); ln_phase(C, C.VBUF, C.in[I_LN3G] + l * D, C.in[I_LN3B] + l * D, moe ? 1 : 0, nullptr, lds); }
        SEAM(ph); ++ph;
    }
#if NSA_CHECK
    xcd_barrier(bar);
    { unsigned* ew = (unsigned*)(P.ws + WS_CTL + 32768); const unsigned err = __hip_atomic_load(ew, __ATOMIC_RELAXED, __HIP_MEMORY_SCOPE_AGENT), cnt = __hip_atomic_load(ew + 64, __ATOMIC_RELAXED, __HIP_MEMORY_SCOPE_AGENT);
      if (cnt == 0u || (unsigned long long)err * 256ull > (unsigned long long)cnt) { for (size_t i = (size_t)blockIdx.x * NTHREADS + threadIdx.x; i < (size_t)M * D; i += (size_t)gridDim.x * NTHREADS) P.out[i] = 0.f; } }
#endif
#undef IN
#undef SEAM
}

extern "C" void kernel_launch(void* const* d_in, const int* in_sizes, int n_in, void* d_out, int out_size, void* d_ws, size_t ws_size, hipStream_t stream) {
    static int grid = 0;
    if (grid == 0) {
        if (n_in != 35 || out_size != M * D || ws_size < WS_END) { fprintf(stderr, "kernel_launch: unexpected problem (n_in %d, out %d, ws %zu < %zu)\n", n_in, out_size, ws_size, (size_t)WS_END); grid = -1; return; }
        int dev = 0, cus = 0, per_cu = 0;
        if (hipGetDevice(&dev) != hipSuccess || hipDeviceGetAttribute(&cus, hipDeviceAttributeMultiprocessorCount, dev) != hipSuccess) { grid = -1; return; }
        if (hipFuncSetAttribute((const void*)fwd_kernel, hipFuncAttributeMaxDynamicSharedMemorySize, LDS_BYTES) != hipSuccess) { fprintf(stderr, "kernel_launch: hipFuncSetAttribute failed\n"); grid = -1; return; }
        if (hipOccupancyMaxActiveBlocksPerMultiprocessor(&per_cu, (const void*)fwd_kernel, NTHREADS, LDS_BYTES) != hipSuccess || per_cu < 1) { fprintf(stderr, "kernel_launch: occupancy query says %d\n", per_cu); }
        (void)hipGetLastError();
        grid = cus;
    }
    if (grid < 0) return;
    (void)hipMemsetAsync((char*)d_ws + WS_CTL, 0, CTL_ZERO_BYTES, stream);
    Params p{};
    for (int i = 0; i < 35; ++i) p.in[i] = (const float*)d_in[i];
    p.out = (float*)d_out; p.ws = (unsigned char*)d_ws; p.dbg = DBG_REP;
#if MK_MULTI
    for (int k = 0; k < N_PHASES; ++k) { p.ph_lo = k; p.ph_hi = k + 1; hipLaunchKernelGGL(fwd_kernel, dim3(grid), dim3(NTHREADS), LDS_BYTES, stream, p); }
#else
    p.ph_lo = 0; p.ph_hi = N_PHASES;
    hipLaunchKernelGGL(fwd_kernel, dim3(grid), dim3(NTHREADS), LDS_BYTES, stream, p);
#endif
}
```

```cpp
#include <hip/hip_runtime.h>
#include <cstdio>
#include <cstdint>

#define GAS __attribute__((address_space(1)))
#define LAS __attribute__((address_space(3)))
typedef unsigned short bf16;
typedef short bf16x8 __attribute__((ext_vector_type(8)));
typedef short bf16x4 __attribute__((ext_vector_type(4)));
typedef float f32x4 __attribute__((ext_vector_type(4)));
typedef float f32x2 __attribute__((ext_vector_type(2)));
typedef unsigned u32x4 __attribute__((ext_vector_type(4)));
typedef unsigned u32x2 __attribute__((ext_vector_type(2)));

constexpr int D = 1024, NB = 4, T = 8192, NL = 4, MEM = 256, M = NB * T;
constexpr int DIN = 1932, DINP = 2048;
constexpr int C_POOL = 0, C_Q = 256, C_KCMP = 512, C_VCMP = 576, C_KSEL = 640, C_VSEL = 704, C_KWIN = 768, C_VWIN = 832, C_GATE = 896, C_U = 908, C_V = 1164, C_CA = 1420, C_CG = 1676;
constexpr int FF = 2816, NE = 8, FE = 3584;
constexpr int NCMP = 511;
constexpr float ALPHA = 1.6817928305074292f;
constexpr float LN_EPS = 1e-5f;
constexpr int MOE_ROWS = 2 * M + NE * 256;
constexpr int NWAVES = 8, NTHREADS = 512;

constexpr size_t al256(size_t x) { return (x + 255) & ~(size_t)255; }
constexpr size_t MiB = 1u << 20;
constexpr size_t WS_CTL = 0, CTL_ZERO_BYTES = 64 * 1024;
constexpr size_t WS_HIST = 1 * MiB;
constexpr size_t WS_META = WS_HIST + 8192;
constexpr size_t WS_TOKINFO = WS_META + 256;
constexpr size_t WS_TOKG = WS_TOKINFO + (size_t)2 * M * 4;
constexpr size_t WS_TOKPOS = WS_TOKG + (size_t)2 * M * 4;
constexpr size_t WS_KC = WS_TOKPOS + (size_t)2 * M * 4;
constexpr size_t WS_VC = WS_KC + (size_t)NB * 512 * 64 * 2;
constexpr size_t WS_PEB = WS_VC + (size_t)NB * 512 * 64 * 2;
constexpr size_t WS_POOLWT = WS_PEB + (size_t)NL * 2 * 256 * 4;
constexpr size_t WS_SGUW = WS_POOLWT + (size_t)NL * 4 * 64 * 64 * 2;
constexpr size_t WS_PWT = WS_SGUW + (size_t)NL * 4 * 128 * 128 * 2;
constexpr size_t WS_CW2T = WS_PWT + (size_t)NL * 256 * 256 * 2;
constexpr size_t WS_CW1T = WS_CW2T + (size_t)NL * 2 * 64 * 256 * 2;
constexpr size_t WS_MEMB = WS_CW1T + (size_t)NL * 2 * 256 * 2048 * 2;
constexpr size_t WS_KMEM = WS_MEMB + (size_t)1024 * 1024 * 2;
constexpr size_t WS_VTMEM = WS_KMEM + (size_t)NL * 1024 * 1024 * 2;
constexpr size_t WS_KCF = WS_VTMEM + (size_t)NL * 4096 * 256 * 2;
constexpr size_t WS_VCF = WS_KCF + (size_t)NB * 8 * 4096 * 2;
constexpr size_t WS_KSELF = WS_VCF + (size_t)NB * 8 * 4096 * 2;
constexpr size_t WS_VSELF = WS_KSELF + (size_t)NB * 128 * 4096 * 2;
constexpr size_t WS_KWINF = WS_VSELF + (size_t)NB * 128 * 4096 * 2;
constexpr size_t WS_VWINF = WS_KWINF + (size_t)NB * 128 * 4096 * 2;
constexpr size_t WS_SMALL_END = WS_VWINF + (size_t)NB * 128 * 4096 * 2;
constexpr size_t WS_WINT = 48 * MiB;
static_assert(WS_SMALL_END <= WS_WINT, "small region");
constexpr size_t WS_WOUTT = WS_WINT + (size_t)NL * DINP * D * 2;
constexpr size_t WS_XQT = WS_WOUTT + (size_t)NL * D * D * 2;
constexpr size_t WS_XKVT = WS_XQT + (size_t)NL * D * D * 2;
constexpr size_t WS_XOT = WS_XKVT + (size_t)NL * 2 * D * D * 2;
constexpr size_t WS_W13T = WS_XOT + (size_t)NL * D * D * 2;
constexpr size_t WS_W2T = WS_W13T + (size_t)2 * 2 * FF * D * 2;
constexpr size_t WS_E13T = WS_W2T + (size_t)2 * D * FF * 2;
constexpr size_t WS_E2T = WS_E13T + (size_t)16 * 2 * FE * D * 2;
constexpr size_t WS_XB = WS_E2T + (size_t)16 * D * FE * 2;
constexpr size_t WS_VBUF = WS_XB + (size_t)M * D * 2;
constexpr size_t WS_Z = WS_VBUF + (size_t)M * D * 4;
constexpr size_t WS_Y = WS_Z + (size_t)M * DINP * 2;
constexpr size_t WS_Q = WS_Y + (size_t)M * D * 2;
constexpr size_t WS_H = WS_Q + (size_t)M * D * 2;
constexpr size_t WS_END = WS_H + (size_t)MOE_ROWS * FE * 2;
static_assert((size_t)MOE_ROWS * D * 4 <= WS_H - WS_VBUF, "FS overlay");
static_assert((size_t)MOE_ROWS * D * 2 <= WS_Q - WS_Z, "XG overlay");

constexpr int SCR_BYTES = 153600;
constexpr int LDSCTL_OFF = SCR_BYTES;
constexpr int LDS_BYTES = 155648;

__device__ __forceinline__ float bf2f(unsigned v) { return __uint_as_float(v << 16); }
__device__ __forceinline__ unsigned f2bf(float f) { unsigned u = __builtin_bit_cast(unsigned, f); return (u + 0x7fffu + ((u >> 16) & 1u)) >> 16; }
typedef __bf16 bf16x2_t __attribute__((ext_vector_type(2)));
__device__ __forceinline__ unsigned pk2(float lo, float hi) { const f32x2 v = {lo, hi}; const bf16x2_t b = __builtin_convertvector(v, bf16x2_t); return __builtin_bit_cast(unsigned, b); }
__device__ __forceinline__ float lo16(unsigned w) { return __uint_as_float(w << 16); }
__device__ __forceinline__ float hi16(unsigned w) { return __uint_as_float(w & 0xffff0000u); }
__device__ __forceinline__ float sigmoidf_(float x) { return 1.0f / (1.0f + __expf(-x)); }
__device__ __forceinline__ float siluf_(float x) { return x / (1.0f + __expf(-x)); }
__device__ __forceinline__ float gelu_tanh(float x) { const float u = 0.7978845608028654f * (x + 0.044715f * x * x * x); return x / (1.0f + __expf(-2.0f * u)); }
__device__ __forceinline__ float wave_sum(float v) {
#pragma unroll
    for (int o = 1; o < 64; o <<= 1) v += __shfl_xor(v, o);
    return v;
}
__device__ __forceinline__ float wave_max(float v) {
#pragma unroll
    for (int o = 1; o < 64; o <<= 1) v = fmaxf(v, __shfl_xor(v, o));
    return v;
}
__device__ __forceinline__ f32x4 mfma16(bf16x8 a, bf16x8 b, f32x4 c) { return __builtin_amdgcn_mfma_f32_16x16x32_bf16(a, b, c, 0, 0, 0); }
__device__ __forceinline__ float dot2bf(unsigned a, unsigned b, float c) { return __builtin_amdgcn_fdot2_f32_bf16(__builtin_bit_cast(bf16x2_t, a), __builtin_bit_cast(bf16x2_t, b), c, false); }
#define LDS_WAIT() asm volatile("s_waitcnt lgkmcnt(0)" ::: "memory")

namespace pg8 {
#define PG8_LAS __attribute__((address_space(3)))
typedef unsigned short bf16_t;
typedef short bf16x8 __attribute__((ext_vector_type(8)));
typedef float f32x4 __attribute__((ext_vector_type(4)));
typedef unsigned u32x4 __attribute__((ext_vector_type(4)));
constexpr int BM = 256, BK = 64, HALF = 128, HTB = HALF * BK * 2  , STAGE_BYTES = 8 * HTB, NXCD = 8, WGM = 8;

__host__ __device__ __forceinline__ int lds_byte(int r, int c) { const int st = (r >> 4) * 2 + (c >> 5), rr = r & 15, cc = c & 31, ob = rr * 64 + cc * 2; return st * 1024 + (ob ^ (((ob >> 9) & 1) << 5)); }
__host__ __device__ __forceinline__ void stage_rc(int b, int& R, int& C) { const int st = b / 1024, sb = b % 1024, swz = sb ^ (((sb >> 9) & 1) << 5); R = (st >> 1) * 16 + swz / 64; C = (st & 1) * 32 + (swz % 64) / 2; }
__host__ __device__ __forceinline__ int perm32(int rho) { const int n = rho >> 4, i = rho & 15; return 8 * (i >> 2) + 4 * n + (i & 3); }

struct Unit { int pm, pn; };
struct Gemm { const bf16_t* A; const bf16_t* Bt; int M, N, K; };

struct StaticOrder {
    int nM, nN, nwg, G, c;
    __host__ __device__ void init(int M, int N, int G_, int c_) { nM = M / BM; nN = N / BM; nwg = nM * nN; G = G_; c = c_; }
    __host__ __device__ bool next(int i, Unit& u) const {
        const long L = (long)i * G + c; if (L >= nwg) return false;
        int wgid = (int)L; { const int q = nwg / NXCD, r = nwg % NXCD, xcd = wgid % NXCD, off = wgid / NXCD; wgid = (xcd < r ? xcd * (q + 1) : r * (q + 1) + (xcd - r) * q) + off; }
        const int nig = WGM * nN, gid = wgid / nig, fm = gid * WGM, gsz = (nM - fm) < WGM ? (nM - fm) : WGM;
        u.pm = fm + ((wgid % nig) % gsz); u.pn = (wgid % nig) / gsz; return true;
    }
    __device__ __forceinline__ void a_ready(const Unit&) const {}
    __device__ __forceinline__ void done(const Unit&) const {}
    __device__ __forceinline__ const char* bbase(const Gemm& g, const Unit&) const { return (const char*)g.Bt; }
};

template <class Epi, class Sched, bool ALIGN_EPI = false, bool SP2 = false>
__device__ __forceinline__ void gemm_phase(PG8_LAS unsigned char* lds, const Gemm g, const Sched& S, const Epi& E) {
    int tid_l = threadIdx.x; asm volatile("" : "+v"(tid_l));
    const int tid = tid_l, wid = __builtin_amdgcn_readfirstlane(tid >> 6), lane = tid & 63, wr = wid >> 2, wc = wid & 3, fr = lane & 15, fq = lane >> 4;
    const int K = g.K, nt = K / BK;
    unsigned voffA[2], voffB[2];
#pragma unroll
    for (int i = 0; i < 2; ++i) { int R, C; stage_rc(tid * 16 + i * 8192, R, C); const int Rb = Epi::PERM ? ((R & ~31) + perm32(R & 31)) : R;
        voffA[i] = (unsigned)(R * K + C) * 2u; voffB[i] = (unsigned)(Rb * K + C) * 2u; }
    const size_t kstep = (size_t)(BK * 2);
    const size_t hstep = (size_t)HALF * K * 2;
    const size_t tstep = 2 * hstep;
    const unsigned ldsw = (unsigned)wid * 1024u;
    const int aoff = lds_byte(wr * 64 + fr, fq * 8), boff = lds_byte(wc * 32 + fr, fq * 8);
#define PG8_SA(b, h) (((b) * 2 + (h)) * HTB)
#define PG8_SB(b, h) ((4 + (b) * 2 + (h)) * HTB)
#define PG8_STAGE(bufoff, gbase, voff) do { _Pragma("unroll") for (int _i = 0; _i < 2; ++_i) \
        __builtin_amdgcn_global_load_lds((const unsigned*)((const char*)(gbase) + (voff)[_i]), (PG8_LAS unsigned*)(lds + (bufoff) + ldsw + _i * 8192), 16, 0, 0); } while (0)
#define PG8_LDA(dst, b, h) do { _Pragma("unroll") for (int m = 0; m < 4; ++m) _Pragma("unroll") for (int k = 0; k < 2; ++k) dst[m][k] = *(const PG8_LAS bf16x8*)(lds + PG8_SA(b, h) + aoff + m * 2048 + k * 1024); } while (0)
#define PG8_LDB(dst, b, h) do { _Pragma("unroll") for (int n = 0; n < 2; ++n) _Pragma("unroll") for (int k = 0; k < 2; ++k) dst[n][k] = *(const PG8_LAS bf16x8*)(lds + PG8_SB(b, h) + boff + n * 2048 + k * 1024); } while (0)
#define PG8_MMA(ai, bj, At, Bt) do { __builtin_amdgcn_s_setprio(1); _Pragma("unroll") for (int m = 0; m < 4; ++m) _Pragma("unroll") for (int n = 0; n < 2; ++n) _Pragma("unroll") for (int k = 0; k < 2; ++k) \
        acc[ai][bj][m][n] = __builtin_amdgcn_mfma_f32_16x16x32_bf16(Bt[n][k], At[m][k], acc[ai][bj][m][n], 0, 0, 0); __builtin_amdgcn_s_setprio(0); } while (0)
#define PG8_WAIT_V(n) asm volatile("s_waitcnt vmcnt(" #n ")" ::: "memory")
#define PG8_WAIT_L(n) asm volatile("s_waitcnt lgkmcnt(" #n ")" ::: "memory")
#define PG8_BAR __builtin_amdgcn_s_barrier()
#define PG8_SCHED __builtin_amdgcn_sched_barrier(0)
    Unit cur, nxt; int ui = 0;
    if (!S.next(0, cur)) return;
    f32x4 acc[2][2][4][2];
#pragma unroll
    for (int a = 0; a < 2; ++a)
#pragma unroll
        for (int b = 0; b < 2; ++b)
#pragma unroll
            for (int m = 0; m < 4; ++m)
#pragma unroll
                for (int n = 0; n < 2; ++n) acc[a][b][m][n] = (f32x4){0.f, 0.f, 0.f, 0.f};
    bf16x8 At[4][2], B0[2][2], B1[2][2];
    const char* cA = (const char*)g.A + (size_t)cur.pm * tstep; const char* cB = S.bbase(g, cur) + (size_t)cur.pn * tstep;
    S.a_ready(cur);
    if constexpr (SP2) {
        PG8_STAGE(PG8_SB(0, 0), cB, voffB); PG8_STAGE(PG8_SB(0, 1), cB + hstep, voffB); PG8_STAGE(PG8_SA(0, 0), cA, voffA); PG8_STAGE(PG8_SA(0, 1), cA + hstep, voffA);
        if (wr == 1) PG8_BAR;
        PG8_WAIT_V(2); PG8_BAR;
        PG8_STAGE(PG8_SB(1, 0), cB + kstep, voffB); PG8_STAGE(PG8_SA(1, 0), cA + kstep, voffA); PG8_STAGE(PG8_SB(1, 1), cB + hstep + kstep, voffB);
        PG8_WAIT_V(6); PG8_BAR;
    } else {
        PG8_STAGE(PG8_SB(0, 0), cB, voffB); PG8_STAGE(PG8_SA(0, 0), cA, voffA); PG8_STAGE(PG8_SB(0, 1), cB + hstep, voffB); PG8_STAGE(PG8_SA(0, 1), cA + hstep, voffA);
        if (wr == 1) PG8_BAR;
        PG8_WAIT_V(4); PG8_BAR;
        PG8_STAGE(PG8_SB(1, 0), cB + kstep, voffB); PG8_STAGE(PG8_SA(1, 0), cA + kstep, voffA); PG8_STAGE(PG8_SB(1, 1), cB + hstep + kstep, voffB);
        PG8_WAIT_V(6); PG8_BAR;
    }
    for (;;) {
        const bool has_next = S.next(ui + 1, nxt);
        const char* nA = has_next ? (const char*)g.A + (size_t)nxt.pm * tstep : cA; const char* nB = has_next ? S.bbase(g, nxt) + (size_t)nxt.pn * tstep : cB;
        for (int t = 0; t < nt; t += 2) {
            const bool last = (t == nt - 2);
            const char* a1 = cA + (size_t)(t + 1) * kstep;
            const char* a2 = last ? nA : cA + (size_t)(t + 2) * kstep; const char* b2 = last ? nB : cB + (size_t)(t + 2) * kstep;
            const char* a3 = a2 + kstep; const char* b3 = b2 + kstep;
            if (last && has_next) S.a_ready(nxt);
            if constexpr (SP2) {
            PG8_LDB(B0, 0, 0); PG8_LDB(B1, 0, 1); PG8_SCHED; PG8_LDA(At, 0, 0); PG8_STAGE(PG8_SA(1, 1), a1 + hstep, voffA);
            PG8_WAIT_V(8); PG8_WAIT_L(0); PG8_BAR; PG8_MMA(0, 0, At, B0); PG8_MMA(0, 1, At, B1); PG8_BAR; PG8_SCHED;
            PG8_LDA(At, 0, 1); PG8_STAGE(PG8_SB(0, 0), b2, voffB); PG8_STAGE(PG8_SB(0, 1), b2 + hstep, voffB); PG8_STAGE(PG8_SA(0, 0), a2, voffA);
            PG8_WAIT_V(8); PG8_WAIT_L(0); PG8_BAR; PG8_MMA(1, 0, At, B0); PG8_MMA(1, 1, At, B1); PG8_BAR; PG8_SCHED;
            PG8_LDB(B0, 1, 0); PG8_LDB(B1, 1, 1); PG8_SCHED; PG8_LDA(At, 1, 0); PG8_STAGE(PG8_SA(0, 1), a2 + hstep, voffA);
            PG8_WAIT_V(8); PG8_WAIT_L(0); PG8_BAR; PG8_MMA(0, 0, At, B0); PG8_MMA(0, 1, At, B1); PG8_BAR; PG8_SCHED;
            PG8_LDA(At, 1, 1); PG8_STAGE(PG8_SB(1, 0), b3, voffB); PG8_STAGE(PG8_SB(1, 1), b3 + hstep, voffB); PG8_STAGE(PG8_SA(1, 0), a3, voffA);
            PG8_WAIT_V(8); PG8_WAIT_L(0); PG8_BAR; PG8_MMA(1, 0, At, B0); PG8_MMA(1, 1, At, B1); PG8_BAR; PG8_SCHED;
            } else {
            PG8_LDB(B0, 0, 0); PG8_SCHED; PG8_LDA(At, 0, 0); PG8_STAGE(PG8_SA(1, 1), a1 + hstep, voffA);
            PG8_WAIT_L(8); PG8_BAR; PG8_WAIT_L(0); PG8_MMA(0, 0, At, B0); PG8_BAR; PG8_SCHED;
            PG8_LDB(B1, 0, 1); PG8_STAGE(PG8_SB(0, 0), b2, voffB);
            PG8_BAR; PG8_WAIT_L(0); PG8_MMA(0, 1, At, B1); PG8_BAR;
            PG8_LDA(At, 0, 1); PG8_STAGE(PG8_SA(0, 0), a2, voffA);
            PG8_BAR; PG8_WAIT_L(0); PG8_MMA(1, 0, At, B0); PG8_BAR; PG8_SCHED;
            PG8_STAGE(PG8_SB(0, 1), b2 + hstep, voffB);
            PG8_WAIT_V(6); PG8_BAR; PG8_MMA(1, 1, At, B1); PG8_BAR;
            PG8_LDB(B0, 1, 0); PG8_SCHED; PG8_LDA(At, 1, 0); PG8_STAGE(PG8_SA(0, 1), a2 + hstep, voffA);
            PG8_WAIT_L(8); PG8_BAR; PG8_WAIT_L(0); PG8_MMA(0, 0, At, B0); PG8_BAR; PG8_SCHED;
            PG8_LDB(B1, 1, 1); PG8_STAGE(PG8_SB(1, 0), b3, voffB);
            PG8_BAR; PG8_WAIT_L(0); PG8_MMA(0, 1, At, B1); PG8_BAR;
            PG8_LDA(At, 1, 1); PG8_STAGE(PG8_SA(1, 0), a3, voffA);
            PG8_BAR; PG8_WAIT_L(0); PG8_MMA(1, 0, At, B0); PG8_BAR; PG8_SCHED;
            PG8_STAGE(PG8_SB(1, 1), b3 + hstep, voffB);
            PG8_WAIT_V(6); PG8_BAR; PG8_MMA(1, 1, At, B1); PG8_BAR;
            }
        }
        if constexpr (ALIGN_EPI) { if (wr == 0) PG8_BAR; }
        if constexpr (!Epi::AFTER_DRAIN) { E(acc, cur, wr, wc, fr, fq); S.done(cur); }
        if (!has_next) break;
#pragma unroll
        for (int a = 0; a < 2; ++a)
#pragma unroll
            for (int b = 0; b < 2; ++b)
#pragma unroll
                for (int m = 0; m < 4; ++m)
#pragma unroll
                    for (int n = 0; n < 2; ++n) acc[a][b][m][n] = (f32x4){0.f, 0.f, 0.f, 0.f};
        cur = nxt; cA = nA; cB = nB; ++ui;
        if constexpr (ALIGN_EPI) { if (wr == 1) PG8_BAR; }
    }
    PG8_WAIT_V(0);
    if constexpr (!ALIGN_EPI) { if (wr == 0) PG8_BAR; }
    PG8_BAR;
    if constexpr (Epi::AFTER_DRAIN) { E.fused(acc, cur, wr, wc, fr, fq, lds, wid, lane); S.done(cur); }
#undef PG8_SA
#undef PG8_SB
#undef PG8_STAGE
#undef PG8_LDA
#undef PG8_LDB
#undef PG8_MMA
#undef PG8_WAIT_V
#undef PG8_WAIT_L
#undef PG8_BAR
#undef PG8_SCHED
}
}

namespace pg8 {
__device__ __forceinline__ unsigned cvt_pk_bf16(float lo, float hi) { unsigned r; asm volatile("v_cvt_pk_bf16_f32 %0, %1, %2" : "=v"(r) : "v"(lo), "v"(hi)); return r; }

struct EpiBf16 {
    static constexpr bool PERM = true, AFTER_DRAIN = false;
    bf16_t* O; int ldc;
    __device__ __forceinline__ void operator()(const f32x4 (&acc)[2][2][4][2], const Unit& u, int wr, int wc, int fr, int fq) const {
        const int row0 = u.pm * BM + wr * 64 + fr; const int col0 = u.pn * BM + wc * 32 + 8 * fq;
#pragma unroll
        for (int ai = 0; ai < 2; ++ai)
#pragma unroll
            for (int m = 0; m < 4; ++m) { bf16_t* rowp = O + (size_t)(row0 + ai * HALF + m * 16) * ldc + col0;
#pragma unroll
                for (int bj = 0; bj < 2; ++bj) { const f32x4 v0 = acc[ai][bj][m][0], v1 = acc[ai][bj][m][1];
                    u32x4 w; w.x = cvt_pk_bf16(v0[0], v0[1]); w.y = cvt_pk_bf16(v0[2], v0[3]); w.z = cvt_pk_bf16(v1[0], v1[1]); w.w = cvt_pk_bf16(v1[2], v1[3]);
                    *(u32x4*)(rowp + bj * HALF) = w; } }
    }
};
struct EpiKV {
    static constexpr bool PERM = true, AFTER_DRAIN = false;
    bf16_t* Kd; bf16_t* VTd;
    __device__ __forceinline__ void operator()(const f32x4 (&acc)[2][2][4][2], const Unit& u, int wr, int wc, int fr, int fq) const {
        const int row0 = u.pm * BM + wr * 64 + fr; const int col0 = u.pn * BM + wc * 32 + 8 * fq;
#pragma unroll
        for (int ai = 0; ai < 2; ++ai)
#pragma unroll
            for (int m = 0; m < 4; ++m) { const int row = row0 + ai * HALF + m * 16;
#pragma unroll
                for (int bj = 0; bj < 2; ++bj) { const f32x4 v0 = acc[ai][bj][m][0], v1 = acc[ai][bj][m][1]; const int col = col0 + bj * HALF;
                    u32x4 w; w.x = cvt_pk_bf16(v0[0], v0[1]); w.y = cvt_pk_bf16(v0[2], v0[3]); w.z = cvt_pk_bf16(v1[0], v1[1]); w.w = cvt_pk_bf16(v1[2], v1[3]);
                    if (col < 1024) { *(u32x4*)(Kd + (size_t)row * 1024 + col) = w; }
                    else { const int c = col - 1024, b = row >> 8, mm = row & 255; bf16_t* p = VTd + ((size_t)(b * 1024 + c)) * 256 + mm;
                        p[0 * 256] = (bf16_t)(w.x & 0xffffu); p[1 * 256] = (bf16_t)(w.x >> 16); p[2 * 256] = (bf16_t)(w.y & 0xffffu); p[3 * 256] = (bf16_t)(w.y >> 16);
                        p[4 * 256] = (bf16_t)(w.z & 0xffffu); p[5 * 256] = (bf16_t)(w.z >> 16); p[6 * 256] = (bf16_t)(w.w & 0xffffu); p[7 * 256] = (bf16_t)(w.w >> 16); } } }
    }
};
struct EpiF32Res {
    static constexpr bool PERM = false, AFTER_DRAIN = false;
    float* out; const float* res32; const bf16_t* res16; int ldc; float alpha;
    __device__ __forceinline__ void operator()(const f32x4 (&acc)[2][2][4][2], const Unit& u, int wr, int wc, int fr, int fq) const {
        const int row0 = u.pm * BM + wr * 64 + fr; const int col0 = u.pn * BM + wc * 32 + 4 * fq;
#pragma unroll
        for (int ai = 0; ai < 2; ++ai)
#pragma unroll
            for (int m = 0; m < 4; ++m) { const size_t off = (size_t)(row0 + ai * HALF + m * 16) * ldc + col0;
#pragma unroll
                for (int bj = 0; bj < 2; ++bj)
#pragma unroll
                    for (int n = 0; n < 2; ++n) { f32x4 v = acc[ai][bj][m][n]; const size_t o2 = off + bj * HALF + n * 16;
                        if (res32) { const f32x4 r = *(const f32x4*)(res32 + o2); v = v + r * alpha; }
                        else if (res16) { const u32x2 r = *(const u32x2*)(res16 + o2); v[0] += alpha * __uint_as_float(r.x << 16); v[1] += alpha * __uint_as_float(r.x & 0xffff0000u); v[2] += alpha * __uint_as_float(r.y << 16); v[3] += alpha * __uint_as_float(r.y & 0xffff0000u); }
                        *(f32x4*)(out + o2) = v; } }
    }
};
struct EpiSwiglu {
    static constexpr bool PERM = true, AFTER_DRAIN = false;
    bf16_t* H; int ldh;
    __device__ __forceinline__ void operator()(const f32x4 (&acc)[2][2][4][2], const Unit& u, int wr, int wc, int fr, int fq) const {
        const int row0 = u.pm * BM + wr * 64 + fr; const int col0 = u.pn * BM + wc * 32 + 8 * fq;
#pragma unroll
        for (int ai = 0; ai < 2; ++ai)
#pragma unroll
            for (int m = 0; m < 4; ++m) { bf16_t* rowp = H + (size_t)(row0 + ai * HALF + m * 16) * ldh;
#pragma unroll
                for (int bj = 0; bj < 2; ++bj) { const f32x4 v0 = acc[ai][bj][m][0], v1 = acc[ai][bj][m][1];
                    const float h0 = v0[0] / (1.0f + __expf(-v0[0])) * v0[1], h1 = v0[2] / (1.0f + __expf(-v0[2])) * v0[3];
                    const float h2 = v1[0] / (1.0f + __expf(-v1[0])) * v1[1], h3 = v1[2] / (1.0f + __expf(-v1[2])) * v1[3];
                    u32x2 w; w.x = cvt_pk_bf16(h0, h1); w.y = cvt_pk_bf16(h2, h3);
                    *(u32x2*)(rowp + ((col0 + bj * HALF) >> 1)) = w; } }
    }
};
struct GroupedOrder : StaticOrder {
    int pend[8]; size_t estride;
    __device__ __forceinline__ const char* bbase(const Gemm& g, const Unit& u) const {
        int e = 0;
#pragma unroll
        for (int k = 0; k < 7; ++k) e += (u.pm >= pend[k]) ? 1 : 0;
        return (const char*)g.Bt + (size_t)e * estride;
    }
};
}
#define XB_TMO      128
#define XB_XCNT(j)  (256  + 64 * (j))
#define XB_XSUB(j)  (1280 + 64 * (j))
#define XB_XGEN(j)  (2304 + 64 * (j))
#define XB_TOP      3328
#define XB_TOPGEN   3392
#define XCD_BAR_WORDS 3456
#define XB_SPIN_CAP (1u << 18)

__device__ __forceinline__ unsigned xb_ld(unsigned* p)              { return __hip_atomic_load(p, __ATOMIC_RELAXED, __HIP_MEMORY_SCOPE_AGENT); }
__device__ __forceinline__ unsigned xb_add(unsigned* p, unsigned v) { return __hip_atomic_fetch_add(p, v, __ATOMIC_RELAXED, __HIP_MEMORY_SCOPE_AGENT); }
__device__ __forceinline__ unsigned xb_xcc_id() { return (unsigned)__builtin_amdgcn_s_getreg((3 << 11) | 20) & 0xFu; }
#define XB_SPIN(cond, bar) do { unsigned _sp = 0; while (cond) { __builtin_amdgcn_s_sleep(1); \
    if ((++_sp & 255u) == 0u) { if (xb_ld(&(bar)[XB_TMO])) break; if (_sp > XB_SPIN_CAP) { atomicAdd(&(bar)[XB_TMO], 1u); break; } } } } while (0)

struct XcdBarrier {
    unsigned* bar; unsigned x;
    volatile LAS unsigned* st;
};

__device__ __forceinline__ XcdBarrier xcd_barrier_post(unsigned* bar, volatile LAS unsigned* st) {
    XcdBarrier b; b.bar = bar; b.x = xb_xcc_id(); b.st = st;
    if (threadIdx.x == 0) (void)xb_add(&bar[XB_XCNT(b.x)], 1u);
    return b;
}
__device__ __forceinline__ void xcd_barrier_complete(unsigned* bar, unsigned x, unsigned& nloc, unsigned& nx) {
    const unsigned G = gridDim.x * gridDim.y * gridDim.z;
    unsigned sum, cnt, mine, sp = 0u;
    for (;;) {
        sum = 0u; cnt = 0u; mine = 0u;
#pragma unroll
        for (unsigned j = 0; j < 16; ++j) { const unsigned c = xb_ld(&bar[XB_XCNT(j)]); sum += c; cnt += (c > 0u) ? 1u : 0u; mine = (j == x) ? c : mine; }
        if (sum == G) break;
        __builtin_amdgcn_s_sleep(1);
        if ((++sp & 255u) == 0u) { if (xb_ld(&bar[XB_TMO])) break; if (sp > XB_SPIN_CAP) { atomicAdd(&bar[XB_TMO], 1u); break; } }
    }
    nloc = mine > 0u ? mine : 1u; nx = cnt > 0u ? cnt : 1u;
}

__device__ __forceinline__ void xcd_barrier(const XcdBarrier& b) {
    asm volatile("s_waitcnt vmcnt(0)" ::: "memory");
    __syncthreads();
    if (threadIdx.x == 0) {
        unsigned* bar = b.bar;
        __builtin_amdgcn_s_waitcnt(0);
        unsigned nloc = b.st[0], nx = b.st[1];
        if (nloc == 0u) { xcd_barrier_complete(bar, b.x, nloc, nx); b.st[0] = nloc; b.st[1] = nx; }
        const unsigned old = xb_add(&bar[XB_XSUB(b.x)], 1u);
        const unsigned gen = old / nloc;
        if (old + 1u == (gen + 1u) * nloc) {
            __builtin_amdgcn_fence(__ATOMIC_RELEASE, "agent");
            asm volatile("s_waitcnt vmcnt(0)" ::: "memory");
            const unsigned og = xb_add(&bar[XB_TOP], 1u);
            const unsigned tg = og / nx;
            if (og + 1u == (tg + 1u) * nx) xb_add(&bar[XB_TOPGEN], 1u);
            else XB_SPIN(xb_ld(&bar[XB_TOPGEN]) == tg, bar);
            __builtin_amdgcn_fence(__ATOMIC_ACQUIRE, "agent");
            xb_add(&bar[XB_XGEN(b.x)], 1u);
            asm volatile("s_waitcnt vmcnt(0)" ::: "memory");
        } else {
            XB_SPIN(xb_ld(&bar[XB_XGEN(b.x)]) == gen, bar);
            __builtin_amdgcn_fence(__ATOMIC_ACQUIRE, "agent");
            asm volatile("s_waitcnt vmcnt(0)" ::: "memory");
        }
    }
    __syncthreads();
}

struct Params { const float* in[35]; float* out; unsigned char* ws; int ph_lo, ph_hi, dbg, pad; };
enum { I_X = 0, I_MEM, I_WIN, I_POOLW, I_POOLS, I_PEK, I_KW1, I_KW2, I_PEV, I_VW1, I_VW2, I_SLNG, I_SLNB, I_SGUW, I_SGUB, I_CONVW, I_CONVB, I_CLNG, I_CLNB, I_CONVPW,
       I_WOUT, I_LN1G, I_LN1B, I_XQ, I_XKV, I_XO, I_LN2G, I_LN2B, I_W13, I_W2, I_ROUTER, I_E13, I_E2, I_LN3G, I_LN3B };

struct Ctx {
    const float* in[35];
    float* X;
    bf16 *XB, *Z, *Y, *Q, *H, *XG, *KC, *VC, *MEMB, *KMEM, *VTMEM, *KCF, *VCF, *KSELF, *VSELF, *KWINF, *VWINF;
    bf16 *WINT, *WOUTT, *XQT, *XKVT, *XOT, *W13T, *W2T, *E13T, *E2T, *CW1T, *CW2T, *PWT, *POOLWT, *SGUWB;
    float *VBUF, *FS, *PEB, *TOKG;
    int *HIST, *META, *TOKPOS; unsigned* TOKINFO;
    int tid, lane, wid, bid, G;
};

struct MatDesc { const float* src; bf16* dst; int K, N, Npad, split; };
__device__ __forceinline__ void get_mat(const Ctx& C, int id, MatDesc& d) {
    d.split = 0;
    if (id < 56) {
        const int l = id / 14, k = id % 14;
        if (k == 0)      { d.src = C.in[I_WIN] + (size_t)l * D * DIN;  d.dst = C.WINT + (size_t)l * DINP * D;  d.K = D; d.N = DIN; d.Npad = DINP; }
        else if (k == 1) { d.src = C.in[I_WOUT] + (size_t)l * D * D;   d.dst = C.WOUTT + (size_t)l * D * D;    d.K = D; d.N = D; d.Npad = D; }
        else if (k == 2) { d.src = C.in[I_XQ] + (size_t)l * D * D;     d.dst = C.XQT + (size_t)l * D * D;      d.K = D; d.N = D; d.Npad = D; }
        else if (k == 3) { d.src = C.in[I_XKV] + (size_t)l * D * 2 * D; d.dst = C.XKVT + (size_t)l * 2 * D * D; d.K = D; d.N = 2 * D; d.Npad = 2 * D; }
        else if (k == 4) { d.src = C.in[I_XO] + (size_t)l * D * D;     d.dst = C.XOT + (size_t)l * D * D;      d.K = D; d.N = D; d.Npad = D; }
        else if (k == 5) { d.src = C.in[I_KW1] + (size_t)l * 2048 * 256; d.dst = C.CW1T + (size_t)(l * 2 + 0) * 256 * 2048; d.K = 2048; d.N = 256; d.Npad = 256; }
        else if (k == 6) { d.src = C.in[I_VW1] + (size_t)l * 2048 * 256; d.dst = C.CW1T + (size_t)(l * 2 + 1) * 256 * 2048; d.K = 2048; d.N = 256; d.Npad = 256; }
        else if (k == 7) { d.src = C.in[I_KW2] + (size_t)l * 256 * 64; d.dst = C.CW2T + (size_t)(l * 2 + 0) * 64 * 256; d.K = 256; d.N = 64; d.Npad = 64; }
        else if (k == 8) { d.src = C.in[I_VW2] + (size_t)l * 256 * 64; d.dst = C.CW2T + (size_t)(l * 2 + 1) * 64 * 256; d.K = 256; d.N = 64; d.Npad = 64; }
        else if (k == 9) { d.src = C.in[I_CONVPW] + (size_t)l * 256 * 256; d.dst = C.PWT + (size_t)l * 256 * 256; d.K = 256; d.N = 256; d.Npad = 256; }
        else { const int g = k - 10; d.src = C.in[I_POOLW] + (size_t)(l * 4 + g) * 64 * 64; d.dst = C.POOLWT + (size_t)(l * 4 + g) * 64 * 64; d.K = 64; d.N = 64; d.Npad = 64; }
    } else if (id < 60) {
        const int i = (id - 56) >> 1, w = (id - 56) & 1;
        if (w == 0) { d.src = C.in[I_W13] + (size_t)i * D * 2 * FF; d.dst = C.W13T + (size_t)i * 2 * FF * D; d.K = D; d.N = 2 * FF; d.Npad = 2 * FF; d.split = FF; }
        else        { d.src = C.in[I_W2] + (size_t)i * FF * D;      d.dst = C.W2T + (size_t)i * D * FF;      d.K = FF; d.N = D; d.Npad = D; }
    } else {
        const int j = id - 60, ie = j >> 1, w = j & 1;
        if (w == 0) { d.src = C.in[I_E13] + (size_t)ie * D * 2 * FE; d.dst = C.E13T + (size_t)ie * 2 * FE * D; d.K = D; d.N = 2 * FE; d.Npad = 2 * FE; d.split = FE; }
        else        { d.src = C.in[I_E2] + (size_t)ie * FE * D;      d.dst = C.E2T + (size_t)ie * D * FE;      d.K = FE; d.N = D; d.Npad = D; }
    }
}
__device__ __forceinline__ void transpose_item(const MatDesc& d, LAS float* scr, int item, int lane) {
    const int nblk = d.Npad / 32, kb = item / nblk, nb = item % nblk, k0 = 64 * kb, n0 = 32 * nb;
    const int ncol = n0 + 4 * (lane & 7); const bool ok = ncol < d.N;
    f32x4 v[8];
#pragma unroll
    for (int i = 0; i < 8; ++i) { const int kk = 8 * i + (lane >> 3); v[i] = ok ? *(const f32x4*)(d.src + (size_t)(k0 + kk) * d.N + ncol) : (f32x4){0.f, 0.f, 0.f, 0.f}; }
#pragma unroll
    for (int i = 0; i < 8; ++i) { const int kk = 8 * i + (lane >> 3); LAS float* p = scr + kk * 33 + 4 * (lane & 7); p[0] = v[i][0]; p[1] = v[i][1]; p[2] = v[i][2]; p[3] = v[i][3]; }
    LDS_WAIT();
    const int c = lane & 7;
#pragma unroll
    for (int j = 0; j < 4; ++j) { const int n = (lane >> 3) + 8 * j; const LAS float* s = scr + (8 * c) * 33 + n;
        u32x4 o; o.x = pk2(s[0 * 33], s[1 * 33]); o.y = pk2(s[2 * 33], s[3 * 33]); o.z = pk2(s[4 * 33], s[5 * 33]); o.w = pk2(s[6 * 33], s[7 * 33]);
        const int ng = n0 + n; const int drow = d.split ? (ng < d.split ? 2 * ng : 2 * (ng - d.split) + 1) : ng;
        *(u32x4*)(d.dst + (size_t)drow * d.K + k0 + 8 * c) = o; }
    LDS_WAIT();
}
__device__ __forceinline__ void p0_prologue(const Ctx& C, LAS unsigned char* lds) {
    LAS float* scr = (LAS float*)(lds + C.wid * 8704);
    const int gw = C.bid * NWAVES + C.wid, NGW = C.G * NWAVES;
    int start = 0;
    for (int id = 0; id < 92; ++id) {
        MatDesc d; get_mat(C, id, d);
        const int ntiles = (d.K / 64) * (d.Npad / 32);
        int first = gw - start; if (first < 0) first += NGW;
        for (int it = first; it < ntiles; it += NGW) transpose_item(d, scr, it, C.lane);
        start = (start + ntiles) % NGW;
    }
    const int gt = C.bid * NTHREADS + C.tid, NGT = C.G * NTHREADS;
    { const f32x4* xs = (const f32x4*)C.in[I_X]; u32x4* xd = (u32x4*)C.XB;
      for (int i = gt; i < M * D / 8; i += NGT) { const f32x4 a = xs[2 * i], b = xs[2 * i + 1]; u32x4 o; o.x = pk2(a[0], a[1]); o.y = pk2(a[2], a[3]); o.z = pk2(b[0], b[1]); o.w = pk2(b[2], b[3]); xd[i] = o; } }
    { const f32x4* xs = (const f32x4*)C.in[I_MEM]; u32x4* xd = (u32x4*)C.MEMB;
      for (int i = gt; i < NB * MEM * D / 8; i += NGT) { const f32x4 a = xs[2 * i], b = xs[2 * i + 1]; u32x4 o; o.x = pk2(a[0], a[1]); o.y = pk2(a[2], a[3]); o.z = pk2(b[0], b[1]); o.w = pk2(b[2], b[3]); xd[i] = o; } }
    { const f32x4* ws = (const f32x4*)C.in[I_SGUW]; u32x4* wd = (u32x4*)C.SGUWB;
      for (int i = gt; i < NL * 4 * 128 * 128 / 8; i += NGT) { const int j0 = (i & 15) * 8, ii = (i >> 4) & 127; const f32x4 a = ws[2 * i], b = ws[2 * i + 1];
          float v[8] = {a[0], a[1], a[2], a[3], b[0], b[1], b[2], b[3]};
#pragma unroll
          for (int e = 0; e < 8; ++e) v[e] = (j0 + e <= ii) ? v[e] : 0.f;
          u32x4 o; o.x = pk2(v[0], v[1]); o.y = pk2(v[2], v[3]); o.z = pk2(v[4], v[5]); o.w = pk2(v[6], v[7]); wd[i] = o; } }
    for (int o = gw; o < NL * 2 * 256; o += NGW) { const int n = o & 255, kv = (o >> 8) & 1, l = o >> 9;
        const float* pe = C.in[kv ? I_PEV : I_PEK] + (size_t)l * 2048; const float* w1 = C.in[kv ? I_VW1 : I_KW1] + (size_t)l * 2048 * 256;
        float s = 0.f;
        for (int k = C.lane; k < 2048; k += 64) s += pe[k] * w1[(size_t)k * 256 + n];
        s = wave_sum(s); if (C.lane == 0) C.PEB[o] = s; }
}

__device__ __forceinline__ void ln_phase(const Ctx& C, const float* src, const float* gam, const float* bet, int mode, const float* router, float* xout, LAS unsigned char* lds) {
    LAS float* rwT = (LAS float*)lds;
    LAS int* te = (LAS int*)(lds + 32768);
    LAS float* tgl = (LAS float*)(lds + 32768 + 1024);
    if (router) { for (int i = C.tid; i < 8192; i += NTHREADS) rwT[(i & 7) * 1024 + (i >> 3)] = router[i]; __syncthreads(); }
    f32x4 g4[4], b4[4];
#pragma unroll
    for (int j = 0; j < 4; ++j) { g4[j] = *(const f32x4*)(gam + 256 * j + 4 * C.lane); b4[j] = *(const f32x4*)(bet + 256 * j + 4 * C.lane); }
    for (int tile = C.bid; tile < M / 128; tile += C.G) {
        for (int i = 0; i < 16; ++i) {
            const int tl = 16 * C.wid + i; const size_t row = (size_t)tile * 128 + tl;
            f32x4 v[4];
            if (mode == 0) {
#pragma unroll
                for (int j = 0; j < 4; ++j) v[j] = *(const f32x4*)(src + row * D + 256 * j + 4 * C.lane);
            } else {
                const int p0 = C.TOKPOS[2 * row], p1 = C.TOKPOS[2 * row + 1]; const float g0 = C.TOKG[2 * row], g1 = C.TOKG[2 * row + 1];
#pragma unroll
                for (int j = 0; j < 4; ++j) { const u32x2 xr = *(const u32x2*)(C.XB + row * D + 256 * j + 4 * C.lane); const f32x4 x = {lo16(xr.x), hi16(xr.x), lo16(xr.y), hi16(xr.y)};
                    const f32x4 a = *(const f32x4*)(C.FS + (size_t)p0 * D + 256 * j + 4 * C.lane), b = *(const f32x4*)(C.FS + (size_t)p1 * D + 256 * j + 4 * C.lane);
                    v[j] = x * ALPHA + a * g0 + b * g1; }
            }
            float s = 0.f;
#pragma unroll
            for (int j = 0; j < 4; ++j) s += (v[j][0] + v[j][1]) + (v[j][2] + v[j][3]);
            const float mean = wave_sum(s) * (1.f / D); float s2 = 0.f;
#pragma unroll
            for (int j = 0; j < 4; ++j) { v[j] = v[j] - mean; s2 += (v[j][0] * v[j][0] + v[j][1] * v[j][1]) + (v[j][2] * v[j][2] + v[j][3] * v[j][3]); }
            const float rstd = 1.0f / sqrtf(wave_sum(s2) * (1.f / D) + LN_EPS);
#pragma unroll
            for (int j = 0; j < 4; ++j) { v[j] = v[j] * rstd * g4[j] + b4[j];
                if (xout) *(f32x4*)(xout + row * D + 256 * j + 4 * C.lane) = v[j];
                u32x2 o; o.x = pk2(v[j][0], v[j][1]); o.y = pk2(v[j][2], v[j][3]); *(u32x2*)(C.XB + row * D + 256 * j + 4 * C.lane) = o; }
            if (router) {
                float lg[8];
#pragma unroll
                for (int ex = 0; ex < 8; ++ex) { float a = 0.f;
#pragma unroll
                    for (int j = 0; j < 4; ++j) { const f32x4 w = *(const LAS f32x4*)(rwT + ex * 1024 + 256 * j + 4 * C.lane); a += (v[j][0] * w[0] + v[j][1] * w[1]) + (v[j][2] * w[2] + v[j][3] * w[3]); }
                    lg[ex] = wave_sum(a); }
                int e0 = 0; float l0 = lg[0];
#pragma unroll
                for (int ex = 1; ex < 8; ++ex) if (lg[ex] > l0) { l0 = lg[ex]; e0 = ex; }
                int e1 = -1; float l1 = -INFINITY;
#pragma unroll
                for (int ex = 0; ex < 8; ++ex) if (ex != e0 && lg[ex] > l1) { l1 = lg[ex]; e1 = ex; }
                const float ed = __expf(l1 - l0), ga = 1.0f / (1.0f + ed), gb = ed * ga;
                if (C.lane == 0) { te[2 * tl] = e0; te[2 * tl + 1] = e1; tgl[2 * tl] = ga; tgl[2 * tl + 1] = gb; }
            }
        }
        if (router) {
            __syncthreads();
            if (C.wid == 0) {
                int run[8];
#pragma unroll
                for (int ex = 0; ex < 8; ++ex) run[ex] = 0;
                for (int rr = 0; rr < 4; ++rr) { const int a = 64 * rr + C.lane; const int e = te[a]; int rank = 0;
#pragma unroll
                    for (int ex = 0; ex < 8; ++ex) { const unsigned long long mk = __ballot(e == ex); if (e == ex) rank = run[ex] + __popcll(mk & ((1ull << C.lane) - 1ull)); run[ex] += __popcll(mk); }
                    C.TOKINFO[(size_t)tile * 256 + a] = (unsigned)e | ((unsigned)rank << 8); C.TOKG[(size_t)tile * 256 + a] = tgl[a]; }
#pragma unroll
                for (int ex = 0; ex < 8; ++ex) if (C.lane == ex) C.HIST[tile * 8 + ex] = run[ex];
            }
            __syncthreads();
        }
    }
}

struct ConvW { f32x4 w[31]; f32x4 cb, lg, lb; };
__device__ __forceinline__ void load_convw(const Ctx& C, int l, ConvW& cw) {
#pragma unroll
    for (int k = 0; k < 31; ++k) cw.w[k] = *(const f32x4*)(C.in[I_CONVW] + ((size_t)l * 31 + k) * 256 + 4 * C.lane);
    cw.cb = *(const f32x4*)(C.in[I_CONVB] + l * 256 + 4 * C.lane); cw.lg = *(const f32x4*)(C.in[I_CLNG] + l * 256 + 4 * C.lane); cw.lb = *(const f32x4*)(C.in[I_CLNB] + l * 256 + 4 * C.lane);
}
template <int WHICH>
__device__ __forceinline__ void mixers_tile(const Ctx& C, int l, int tb, LAS unsigned char* lds, const ConvW& cw) {
    const int tid = C.tid, wid = C.wid, lane = C.lane;
    const int b = tb >> 6, t0 = (tb & 63) << 7; const size_t R0 = (size_t)b * T + t0;
    const bf16* Zb = C.Z + (size_t)b * T * DINP;
    const int m16 = lane & 15, gq = lane >> 4, row = 16 * wid + m16;
    if constexpr ((WHICH & 1) != 0) {
        LAS bf16* Dl = (LAS bf16*)lds;
#pragma unroll
        for (int g = 0; g < 4; ++g) {
            constexpr int W4[4] = {2, 4, 8, 16}; const int w = W4[g];
            for (int it = tid; it < 128 * 8; it += NTHREADS) {
                const int tl = it >> 3, c8 = 8 * g + (it & 7), t = t0 + tl, n = (t + 1 < w) ? (t + 1) : w;
                float s[8];
#pragma unroll
                for (int e2 = 0; e2 < 8; ++e2) s[e2] = 0.f;
                u32x4 cur = {0u, 0u, 0u, 0u};
#pragma unroll
                for (int k = 0; k < W4[g]; ++k) {
                    u32x4 v = {0u, 0u, 0u, 0u};
                    if (k < n) v = *(const u32x4*)(Zb + (size_t)(t - k) * DINP + C_POOL + 8 * c8);
                    if (k == 0) cur = v;
                    s[0] += lo16(v.x); s[1] += hi16(v.x); s[2] += lo16(v.y); s[3] += hi16(v.y); s[4] += lo16(v.z); s[5] += hi16(v.z); s[6] += lo16(v.w); s[7] += hi16(v.w);
                }
                const float inv = 1.0f / (float)n;
                u32x4 o; o.x = pk2(s[0] * inv - lo16(cur.x), s[1] * inv - hi16(cur.x)); o.y = pk2(s[2] * inv - lo16(cur.y), s[3] * inv - hi16(cur.y));
                o.z = pk2(s[4] * inv - lo16(cur.z), s[5] * inv - hi16(cur.z)); o.w = pk2(s[6] * inv - lo16(cur.w), s[7] * inv - hi16(cur.w));
                *(LAS u32x4*)(Dl + tl * 264 + 8 * c8) = o;
            }
        }
        __syncthreads();
#pragma unroll
        for (int g = 0; g < 4; ++g) {
            bf16x8 a[2];
#pragma unroll
            for (int s = 0; s < 2; ++s) a[s] = *(const LAS bf16x8*)(Dl + row * 264 + g * 64 + 32 * s + 8 * gq);
#pragma unroll
            for (int nt = 0; nt < 4; ++nt) {
                f32x4 acc = {0.f, 0.f, 0.f, 0.f};
#pragma unroll
                for (int s = 0; s < 2; ++s) { const bf16x8 bfr = *(const bf16x8*)(C.POOLWT + ((size_t)((l * 4 + g) * 64 + 16 * nt + m16)) * 64 + 32 * s + 8 * gq); acc = mfma16(bfr, a[s], acc); }
                const int col = g * 64 + 16 * nt + 4 * gq;
                const f32x4 sc = *(const f32x4*)(C.in[I_POOLS] + l * 256 + col);
                u32x2 o; o.x = pk2(acc[0] * sc[0], acc[1] * sc[1]); o.y = pk2(acc[2] * sc[2], acc[3] * sc[3]);
                *(u32x2*)(C.Y + (R0 + row) * D + col) = o;
            }
        }
        __syncthreads();
    }
    if constexpr ((WHICH & 2) != 0) {
        LAS bf16* VnT = (LAS bf16*)lds;
        const f32x4 lg = *(const f32x4*)(C.in[I_SLNG] + l * 256 + 4 * lane), lb = *(const f32x4*)(C.in[I_SLNB] + l * 256 + 4 * lane);
        u32x2 vpre[16];
#pragma unroll
        for (int i = 0; i < 16; ++i) vpre[i] = *(const u32x2*)(C.Z + (R0 + 16 * wid + i) * DINP + C_V + 4 * lane);
#pragma unroll
        for (int i = 0; i < 16; ++i) {
            const int tl = 16 * wid + i;
            const u32x2 v = vpre[i];
            const float x0 = gelu_tanh(lo16(v.x)), x1 = gelu_tanh(hi16(v.x)), x2 = gelu_tanh(lo16(v.y)), x3 = gelu_tanh(hi16(v.y));
            const float mean = wave_sum((x0 + x1) + (x2 + x3)) * (1.f / 256.f);
            const float d0 = x0 - mean, d1 = x1 - mean, d2 = x2 - mean, d3 = x3 - mean;
            const float rstd = 1.0f / sqrtf(wave_sum((d0 * d0 + d1 * d1) + (d2 * d2 + d3 * d3)) * (1.f / 256.f) + LN_EPS);
            VnT[(4 * lane + 0) * 136 + tl] = (bf16)f2bf(d0 * rstd * lg[0] + lb[0]); VnT[(4 * lane + 1) * 136 + tl] = (bf16)f2bf(d1 * rstd * lg[1] + lb[1]);
            VnT[(4 * lane + 2) * 136 + tl] = (bf16)f2bf(d2 * rstd * lg[2] + lb[2]); VnT[(4 * lane + 3) * 136 + tl] = (bf16)f2bf(d3 * rstd * lg[3] + lb[3]);
        }
        __syncthreads();
        const int ns = (wid >> 1) + 1;
#pragma unroll
        for (int g = 0; g < 4; ++g) {
            f32x4 acc[4];
#pragma unroll
            for (int nt = 0; nt < 4; ++nt) acc[nt] = (f32x4){0.f, 0.f, 0.f, 0.f};
#pragma unroll
            for (int s = 0; s < 4; ++s) if (s < ns) {
                const bf16x8 a = *(const bf16x8*)(C.SGUWB + ((size_t)((l * 4 + g) * 128 + row)) * 128 + 32 * s + 8 * gq);
#pragma unroll
                for (int nt = 0; nt < 4; ++nt) { const bf16x8 bfr = *(const LAS bf16x8*)(VnT + (g * 64 + 16 * nt + m16) * 136 + 32 * s + 8 * gq); acc[nt] = mfma16(bfr, a, acc[nt]); }
            }
            const float bs = C.in[I_SGUB][(l * 4 + g) * 128 + row];
#pragma unroll
            for (int nt = 0; nt < 4; ++nt) {
                const int col = g * 64 + 16 * nt + 4 * gq;
                const u32x2 uu = *(const u32x2*)(C.Z + (R0 + row) * DINP + C_U + col);
                const float u0 = gelu_tanh(lo16(uu.x)), u1 = gelu_tanh(hi16(uu.x)), u2 = gelu_tanh(lo16(uu.y)), u3 = gelu_tanh(hi16(uu.y));
                u32x2 o; o.x = pk2(u0 * (acc[nt][0] + bs), u1 * (acc[nt][1] + bs)); o.y = pk2(u2 * (acc[nt][2] + bs), u3 * (acc[nt][3] + bs));
                *(u32x2*)(C.Y + (R0 + row) * D + 512 + col) = o;
            }
        }
        __syncthreads();
    }
    if constexpr ((WHICH & 4) != 0) {
        LAS bf16* Hg = (LAS bf16*)lds;
        LAS unsigned char* Hn = lds + 158 * 528;
        for (int it0 = tid; it0 < 158 * 64; it0 += 4 * NTHREADS) {
            u32x2 av[4], gv[4];
#pragma unroll
            for (int u = 0; u < 4; ++u) { const int it = it0 + u * NTHREADS; const int r = it >> 6, c4 = it & 63, t = t0 - 30 + r; av[u] = (u32x2){0u, 0u}; gv[u] = (u32x2){0u, 0u};
                if (it < 158 * 64 && t >= 0) { const bf16* zr = Zb + (size_t)t * DINP; av[u] = *(const u32x2*)(zr + C_CA + 4 * c4); gv[u] = *(const u32x2*)(zr + C_CG + 4 * c4); } }
#pragma unroll
            for (int u = 0; u < 4; ++u) { const int it = it0 + u * NTHREADS; const int r = it >> 6, c4 = it & 63;
                if (it < 158 * 64) { u32x2 o; o.x = pk2(lo16(av[u].x) * sigmoidf_(lo16(gv[u].x)), hi16(av[u].x) * sigmoidf_(hi16(gv[u].x))); o.y = pk2(lo16(av[u].y) * sigmoidf_(lo16(gv[u].y)), hi16(av[u].y) * sigmoidf_(hi16(gv[u].y)));
                    *(LAS u32x2*)(Hg + r * 264 + 4 * c4) = o; } }
        }
        __syncthreads();
        {
            const f32x4 cb = cw.cb, lg = cw.lg, lb = cw.lb;
#pragma unroll 1
            for (int i = 0; i < 16; ++i) {
                const int tl = 16 * wid + i;
                f32x4 acc = cb;
#pragma unroll
                for (int k = 0; k < 31; ++k) {
                    const u32x2 h = *(const LAS u32x2*)(Hg + (tl + k) * 264 + 4 * lane);
                    acc[0] += cw.w[k][0] * lo16(h.x); acc[1] += cw.w[k][1] * hi16(h.x); acc[2] += cw.w[k][2] * lo16(h.y); acc[3] += cw.w[k][3] * hi16(h.y); }
                const float mean = wave_sum((acc[0] + acc[1]) + (acc[2] + acc[3])) * (1.f / 256.f);
                const float d0 = acc[0] - mean, d1 = acc[1] - mean, d2 = acc[2] - mean, d3 = acc[3] - mean;
                const float rstd = 1.0f / sqrtf(wave_sum((d0 * d0 + d1 * d1) + (d2 * d2 + d3 * d3)) * (1.f / 256.f) + LN_EPS);
                const float y0 = siluf_(d0 * rstd * lg[0] + lb[0]), y1 = siluf_(d1 * rstd * lg[1] + lb[1]), y2 = siluf_(d2 * rstd * lg[2] + lb[2]), y3 = siluf_(d3 * rstd * lg[3] + lb[3]);
                u32x2 o; o.x = pk2(y0, y1); o.y = pk2(y2, y3);
                *(LAS u32x2*)(Hn + tl * 512 + (((lane >> 1) ^ (tl & 15)) << 4) + ((lane & 1) << 3)) = o;
            }
        }
        __syncthreads();
#pragma unroll 1
        for (int nh = 0; nh < 2; ++nh) {
            f32x4 acc[8];
#pragma unroll
            for (int nt = 0; nt < 8; ++nt) acc[nt] = (f32x4){0.f, 0.f, 0.f, 0.f};
            const bf16* pw = C.PWT + ((size_t)(l * 256 + 128 * nh + m16)) * 256 + 8 * gq;
#pragma unroll 2
            for (int s = 0; s < 8; ++s) {
                const bf16x8 a = *(const LAS bf16x8*)(Hn + row * 512 + (((4 * s + gq) ^ (row & 15)) << 4));
#pragma unroll
                for (int nt = 0; nt < 8; ++nt) { const bf16x8 bfr = *(const bf16x8*)(pw + (size_t)(16 * nt) * 256 + 32 * s); acc[nt] = mfma16(bfr, a, acc[nt]); }
            }
#pragma unroll
            for (int nt = 0; nt < 8; ++nt) { u32x2 o; o.x = pk2(acc[nt][0], acc[nt][1]); o.y = pk2(acc[nt][2], acc[nt][3]); *(u32x2*)(C.Y + (R0 + row) * D + 768 + 128 * nh + 16 * nt + 4 * gq) = o; }
        }
        __syncthreads();
    }
}
__device__ __forceinline__ void compress_item(const Ctx& C, int l, int it, LAS unsigned char* lds) {
    const int wid = C.wid, lane = C.lane;
    const int rt = it >> 1, kv = it & 1, m16 = lane & 15, gq = lane >> 4;
    const int cr = 16 * rt + m16, bb = cr >> 9, n = cr & 511, nn = n < 510 ? n : 510;
    const bf16* rowbase = C.Z + ((size_t)bb * T + 16 * nn) * DINP + (kv ? C_VCMP : C_KCMP);
    const bf16* w1t = C.CW1T + (size_t)(l * 2 + kv) * 256 * 2048;
    f32x4 acc[2]; acc[0] = (f32x4){0.f, 0.f, 0.f, 0.f}; acc[1] = acc[0];
#pragma unroll 8
    for (int s = 0; s < 64; ++s) {
        const bf16x8 a = *(const bf16x8*)(rowbase + (size_t)(s >> 1) * DINP + 32 * (s & 1) + 8 * gq);
#pragma unroll
        for (int nt = 0; nt < 2; ++nt) { const bf16x8 bfr = *(const bf16x8*)(w1t + (size_t)(32 * wid + 16 * nt + m16) * 2048 + 32 * s + 8 * gq); acc[nt] = mfma16(bfr, a, acc[nt]); }
    }
    LAS bf16* Hc = (LAS bf16*)lds;
#pragma unroll
    for (int nt = 0; nt < 2; ++nt) { const int col = 32 * wid + 16 * nt + 4 * gq; const f32x4 pb = *(const f32x4*)(C.PEB + (l * 2 + kv) * 256 + col);
        u32x2 o; o.x = pk2(gelu_tanh(acc[nt][0] + pb[0]), gelu_tanh(acc[nt][1] + pb[1])); o.y = pk2(gelu_tanh(acc[nt][2] + pb[2]), gelu_tanh(acc[nt][3] + pb[3]));
        *(LAS u32x2*)(Hc + m16 * 264 + col) = o; }
    __syncthreads();
    if (wid < 4) {
        const bf16* w2t = C.CW2T + (size_t)(l * 2 + kv) * 64 * 256;
        f32x4 a2 = {0.f, 0.f, 0.f, 0.f};
#pragma unroll
        for (int s = 0; s < 8; ++s) { const bf16x8 a = *(const LAS bf16x8*)(Hc + m16 * 264 + 32 * s + 8 * gq); const bf16x8 bfr = *(const bf16x8*)(w2t + (size_t)(16 * wid + m16) * 256 + 32 * s + 8 * gq); a2 = mfma16(bfr, a, a2); }
        { u32x2 o; o.x = pk2(a2[0], a2[1]); o.y = pk2(a2[2], a2[3]); if (n >= NCMP) { o.x = 0u; o.y = 0u; }
          *(u32x2*)((kv ? C.VC : C.KC) + (size_t)cr * 64 + 16 * wid + 4 * gq) = o;
          const int tile = n >> 6, kk = n & 63;
          if (!kv) { const int sub = kk >> 4, s = wid >> 1, g2 = 2 * (wid & 1) + (gq >> 1);
              *(u32x2*)(C.KCF + ((size_t)(bb * 8 + tile)) * 4096 + ((sub * 2 + s) * 64 + g2 * 16 + (kk & 15)) * 8 + 4 * (gq & 1)) = o;
          } else { const int s2 = kk >> 5, k5 = kk & 31, g2 = (k5 & 15) >> 2, j = (k5 & 3) + ((k5 >> 4) << 2);
              bf16* vt = C.VCF + ((size_t)(bb * 8 + tile)) * 4096 + ((s2 * 4 + wid) * 64 + g2 * 16 + 4 * gq) * 8 + j;
              vt[0] = (bf16)(o.x & 0xffffu); vt[8] = (bf16)(o.x >> 16); vt[16] = (bf16)(o.y & 0xffffu); vt[24] = (bf16)(o.y >> 16); } }
    }
    __syncthreads();
}

__device__ __forceinline__ void nsa_branch(const bf16* kb, const bf16* vb, int pitch, const LAS int* base, int nch, int vlo, int vhi, int chi,
                                           const LAS unsigned* qs, LAS float* sc, float (&o)[4], int lane) {
    float mx0 = -INFINITY, mx1 = -INFINITY, mx2 = -INFINITY, mx3 = -INFINITY;
#pragma unroll 1
    for (int i = 0; i < nch; ++i) {
        asm volatile("" ::: "memory");
        const int r = base[i] + lane; const bool valid = (r >= vlo) && (r <= vhi);
        const int rc = r < 0 ? 0 : (r > chi ? chi : r);
        const u32x4* kp = (const u32x4*)(kb + (size_t)rc * pitch);
        u32x4 kr[8];
#pragma unroll
        for (int c = 0; c < 8; ++c) kr[c] = kp[c];
        float a0 = 0.f, a1 = 0.f, a2 = 0.f, a3 = 0.f;
#pragma unroll
        for (int c = 0; c < 8; ++c) {
            const u32x4 q0 = *(const LAS u32x4*)(qs + 0 * 32 + 4 * c), q1 = *(const LAS u32x4*)(qs + 1 * 32 + 4 * c), q2 = *(const LAS u32x4*)(qs + 2 * 32 + 4 * c), q3 = *(const LAS u32x4*)(qs + 3 * 32 + 4 * c);
            a0 = dot2bf(kr[c].x, q0.x, a0); a0 = dot2bf(kr[c].y, q0.y, a0); a0 = dot2bf(kr[c].z, q0.z, a0); a0 = dot2bf(kr[c].w, q0.w, a0);
            a1 = dot2bf(kr[c].x, q1.x, a1); a1 = dot2bf(kr[c].y, q1.y, a1); a1 = dot2bf(kr[c].z, q1.z, a1); a1 = dot2bf(kr[c].w, q1.w, a1);
            a2 = dot2bf(kr[c].x, q2.x, a2); a2 = dot2bf(kr[c].y, q2.y, a2); a2 = dot2bf(kr[c].z, q2.z, a2); a2 = dot2bf(kr[c].w, q2.w, a2);
            a3 = dot2bf(kr[c].x, q3.x, a3); a3 = dot2bf(kr[c].y, q3.y, a3); a3 = dot2bf(kr[c].z, q3.z, a3); a3 = dot2bf(kr[c].w, q3.w, a3);
        }
        if (!valid) { a0 = -INFINITY; a1 = -INFINITY; a2 = -INFINITY; a3 = -INFINITY; }
        sc[0 * 1024 + 64 * i + lane] = a0; sc[1 * 1024 + 64 * i + lane] = a1; sc[2 * 1024 + 64 * i + lane] = a2; sc[3 * 1024 + 64 * i + lane] = a3;
        mx0 = fmaxf(mx0, a0); mx1 = fmaxf(mx1, a1); mx2 = fmaxf(mx2, a2); mx3 = fmaxf(mx3, a3);
    }
    mx0 = wave_max(mx0); mx1 = wave_max(mx1); mx2 = wave_max(mx2); mx3 = wave_max(mx3);
    float l0 = 0.f, l1 = 0.f, l2 = 0.f, l3 = 0.f;
    for (int i = 0; i < nch; ++i) {
        const float s0 = sc[0 * 1024 + 64 * i + lane], s1 = sc[1 * 1024 + 64 * i + lane], s2 = sc[2 * 1024 + 64 * i + lane], s3 = sc[3 * 1024 + 64 * i + lane];
        const float e0 = (s0 == -INFINITY) ? 0.f : __expf(s0 - mx0), e1 = (s1 == -INFINITY) ? 0.f : __expf(s1 - mx1), e2 = (s2 == -INFINITY) ? 0.f : __expf(s2 - mx2), e3 = (s3 == -INFINITY) ? 0.f : __expf(s3 - mx3);
        sc[0 * 1024 + 64 * i + lane] = e0; sc[1 * 1024 + 64 * i + lane] = e1; sc[2 * 1024 + 64 * i + lane] = e2; sc[3 * 1024 + 64 * i + lane] = e3;
        l0 += e0; l1 += e1; l2 += e2; l3 += e3;
    }
    l0 = wave_sum(l0); l1 = wave_sum(l1); l2 = wave_sum(l2); l3 = wave_sum(l3);
    const float i0 = l0 > 0.f ? 1.0f / l0 : 0.f, i1 = l1 > 0.f ? 1.0f / l1 : 0.f, i2 = l2 > 0.f ? 1.0f / l2 : 0.f, i3 = l3 > 0.f ? 1.0f / l3 : 0.f;
    for (int i = 0; i < nch; ++i) { sc[0 * 1024 + 64 * i + lane] *= i0; sc[1 * 1024 + 64 * i + lane] *= i1; sc[2 * 1024 + 64 * i + lane] *= i2; sc[3 * 1024 + 64 * i + lane] *= i3; }
    LDS_WAIT();
    float o0 = 0.f, o1 = 0.f, o2 = 0.f, o3 = 0.f;
    for (int i = 0; i < nch; ++i) {
        const int b0 = base[i];
        for (int j = 0; j < 64; j += 16) {
            float vv[16];
#pragma unroll
            for (int u = 0; u < 16; ++u) { int r = b0 + j + u; r = r < 0 ? 0 : (r > chi ? chi : r); vv[u] = bf2f((unsigned)vb[(size_t)r * pitch + lane]); }
#pragma unroll
            for (int u4 = 0; u4 < 4; ++u4) {
                const f32x4 p0 = *(const LAS f32x4*)(sc + 0 * 1024 + 64 * i + j + 4 * u4), p1 = *(const LAS f32x4*)(sc + 1 * 1024 + 64 * i + j + 4 * u4), p2 = *(const LAS f32x4*)(sc + 2 * 1024 + 64 * i + j + 4 * u4), p3 = *(const LAS f32x4*)(sc + 3 * 1024 + 64 * i + j + 4 * u4);
#pragma unroll
                for (int u = 0; u < 4; ++u) { const float v1 = vv[4 * u4 + u]; o0 += p0[u] * v1; o1 += p1[u] * v1; o2 += p2[u] * v1; o3 += p3[u] * v1; }
            }
        }
    }
    o[0] = o0; o[1] = o1; o[2] = o2; o[3] = o3;
}
template <bool CHECK>
__device__ __forceinline__ void nsa_query(const Ctx& C, int b, int t, LAS unsigned char* wl  , unsigned* errw) {
    const int lane = C.lane;
    LAS float* sc = (LAS float*)wl;
    LAS unsigned* qs = (LAS unsigned*)(wl + 16384);
    LAS int* base = (LAS int*)(wl + 16384 + 1024);
    const size_t row = (size_t)b * T + t;
    const bf16* zr = C.Z + row * DINP;
    const bf16* Zb = C.Z + (size_t)b * T * DINP;
    { const unsigned w2 = *(const unsigned*)(zr + C_Q + 2 * lane);
      const unsigned w3 = *(const unsigned*)(zr + C_Q + 128 + 2 * lane);
      qs[lane] = pk2(lo16(w2) * 0.125f, hi16(w2) * 0.125f); qs[64 + lane] = pk2(lo16(w3) * 0.125f, hi16(w3) * 0.125f); }
    const int nvalid = (t >= 31) ? ((t - 31) / 16 + 1) : 0;
    const int nchc = (nvalid + 63) >> 6;
    if (lane < 16) base[lane] = 64 * lane;
    LDS_WAIT();
    float oc[4];
    nsa_branch(C.KC + (size_t)b * 512 * 64, C.VC + (size_t)b * 512 * 64, 64, base, nchc, 0, nvalid - 1, 510, qs, sc, oc, lane);
    const int cur = t >> 6;
    float c0, c1;
    {
        float im0 = 0.f, im1 = 0.f;
#pragma unroll
        for (int rr = -1; rr <= 3; ++rr) { const int n0 = 4 * lane + rr, n1 = 4 * (lane + 64) + rr;
            if (n0 >= 0 && n0 < 64 * nchc) im0 += (sc[n0] + sc[1024 + n0]) + (sc[2048 + n0] + sc[3072 + n0]);
            if (n1 < 64 * nchc) im1 += (sc[n1] + sc[1024 + n1]) + (sc[2048 + n1] + sc[3072 + n1]); }
        const int m0 = lane, m1 = lane + 64;
        c0 = (m0 <= cur) ? (im0 + ((m0 == 0 || m0 == cur || m0 == cur - 1) ? 1e4f : 0.f)) : -1.0f;
        c1 = (m1 <= cur) ? (im1 + ((m1 == 0 || m1 == cur || m1 == cur - 1) ? 1e4f : 0.f)) : -1.0f;
    }
    LDS_WAIT();
    for (int r = 0; r < 16; ++r) {
        float bv; int bi;
        if (c0 >= c1) { bv = c0; bi = lane; } else { bv = c1; bi = lane + 64; }
#pragma unroll
        for (int off = 1; off < 64; off <<= 1) { const float ov = __shfl_xor(bv, off); const int oi = __shfl_xor(bi, off); if (ov > bv || (ov == bv && oi < bi)) { bv = ov; bi = oi; } }
        if (bi == lane) c0 = -2.0f; if (bi == lane + 64) c1 = -2.0f;
        if (lane == 0) base[r] = (bv >= 0.f) ? 64 * bi : -1000000;
    }
    LDS_WAIT();
    float os[4];
    nsa_branch(Zb + C_KSEL, Zb + C_VSEL, DINP, base, 16, 0, t, T - 1, qs, sc, os, lane);
    if (lane < 16) base[lane] = t - 511 + 64 * lane;
    LDS_WAIT();
    float ow[4];
    nsa_branch(Zb + C_KWIN, Zb + C_VWIN, DINP, base, 8, 0, t, T - 1, qs, sc, ow, lane);
    float yv[4];
#pragma unroll
    for (int h = 0; h < 4; ++h) {
        const float g0 = sigmoidf_(bf2f((unsigned)zr[C_GATE + 3 * h + 0])), g1 = sigmoidf_(bf2f((unsigned)zr[C_GATE + 3 * h + 1])), g2 = sigmoidf_(bf2f((unsigned)zr[C_GATE + 3 * h + 2]));
        yv[h] = g0 * oc[h] + g1 * os[h] + g2 * ow[h];
        if (!CHECK) C.Y[row * D + 256 + h * 64 + lane] = (bf16)f2bf(yv[h]);
    }
    if (CHECK) {
        const float rmax = wave_max(fmaxf(fmaxf(fabsf(yv[0]), fabsf(yv[1])), fmaxf(fabsf(yv[2]), fabsf(yv[3]))));
        int bad = 0;
#pragma unroll
        for (int h = 0; h < 4; ++h) { const float ym = bf2f((unsigned)C.Y[row * D + 256 + h * 64 + lane]); if (!(fabsf(ym - yv[h]) <= 0.03f * rmax + 2e-4f)) ++bad; }
        const float fb = wave_sum((float)bad);
        if (lane == 0) { atomicAdd(errw, (unsigned)fb); atomicAdd(errw + 64, 256u); }
    }
    LDS_WAIT();
}

__device__ __forceinline__ void xattn_unit(const Ctx& C, int l, int unit, LAS unsigned char* lds) {
    const int tid = C.tid, wid = C.wid, lane = C.lane;
    const int qt = unit & 63, bh = unit >> 6, b = bh >> 2, h = bh & 3;
    const int m16 = lane & 15, gq = lane >> 4;
    const size_t qrow = (size_t)b * T + qt * 128 + 16 * wid + m16;
    bf16x8 qf[8];
#pragma unroll
    for (int s = 0; s < 8; ++s) qf[s] = *(const bf16x8*)(C.Q + qrow * D + h * 256 + 32 * s + 8 * gq);
    const bf16* ksrc = C.KMEM + ((size_t)l * 1024 + b * 256) * 1024 + h * 256;
    for (int it = tid; it < 256 * 32; it += NTHREADS) { const int key = it >> 5, c = it & 31; *(LAS u32x4*)(lds + key * 528 + c * 16) = *(const u32x4*)(ksrc + (size_t)key * 1024 + 8 * c); }
    __syncthreads();
    f32x4 sacc[16];
#pragma unroll
    for (int kt = 0; kt < 16; ++kt) { sacc[kt] = (f32x4){0.f, 0.f, 0.f, 0.f};
#pragma unroll
        for (int s = 0; s < 8; ++s) { const bf16x8 a = *(const LAS bf16x8*)(lds + (16 * kt + m16) * 528 + 64 * s + 16 * gq); sacc[kt] = mfma16(a, qf[s], sacc[kt]); } }
    float mx = -INFINITY;
#pragma unroll
    for (int kt = 0; kt < 16; ++kt) mx = fmaxf(fmaxf(mx, fmaxf(sacc[kt][0], sacc[kt][1])), fmaxf(sacc[kt][2], sacc[kt][3]));
    mx = fmaxf(mx, __shfl_xor(mx, 16)); mx = fmaxf(mx, __shfl_xor(mx, 32));
    const float scl = 0.0625f * 1.4426950408889634f;
    float sum = 0.f;
#pragma unroll
    for (int kt = 0; kt < 16; ++kt)
#pragma unroll
        for (int r = 0; r < 4; ++r) { const float e = exp2f((sacc[kt][r] - mx) * scl); sacc[kt][r] = e; sum += e; }
    sum += __shfl_xor(sum, 16); sum += __shfl_xor(sum, 32);
    const float inv = 1.0f / sum;
    bf16x8 pf[8];
#pragma unroll
    for (int s2 = 0; s2 < 8; ++s2) { u32x4 w; w.x = pk2(sacc[2 * s2][0], sacc[2 * s2][1]); w.y = pk2(sacc[2 * s2][2], sacc[2 * s2][3]); w.z = pk2(sacc[2 * s2 + 1][0], sacc[2 * s2 + 1][1]); w.w = pk2(sacc[2 * s2 + 1][2], sacc[2 * s2 + 1][3]);
        pf[s2] = __builtin_bit_cast(bf16x8, w); }
    __syncthreads();
    const bf16* vsrc = C.VTMEM + ((size_t)l * 4096 + (b * 4 + h) * 256) * 256;
    for (int it = tid; it < 256 * 32; it += NTHREADS) { const int d = it >> 5, c = it & 31; *(LAS u32x4*)(lds + d * 528 + c * 16) = *(const u32x4*)(vsrc + (size_t)d * 256 + 8 * c); }
    __syncthreads();
#pragma unroll
    for (int dt = 0; dt < 16; ++dt) {
        f32x4 oacc = {0.f, 0.f, 0.f, 0.f};
#pragma unroll
        for (int s2 = 0; s2 < 8; ++s2) { const u32x2 lo = *(const LAS u32x2*)(lds + (16 * dt + m16) * 528 + 64 * s2 + 8 * gq), hi = *(const LAS u32x2*)(lds + (16 * dt + m16) * 528 + 64 * s2 + 32 + 8 * gq);
            u32x4 w; w.x = lo.x; w.y = lo.y; w.z = hi.x; w.w = hi.y; oacc = mfma16(__builtin_bit_cast(bf16x8, w), pf[s2], oacc); }
        u32x2 o; o.x = pk2(oacc[0] * inv, oacc[1] * inv); o.y = pk2(oacc[2] * inv, oacc[3] * inv);
        *(u32x2*)(C.Y + qrow * D + h * 256 + 16 * dt + 4 * gq) = o;
    }
    __syncthreads();
}

__device__ __forceinline__ void moe_gather(const Ctx& C, LAS unsigned char* lds) {
    LAS int* sh = (LAS int*)lds;
    for (int i = C.tid; i < 2048; i += NTHREADS) sh[i] = C.HIST[i];
    __syncthreads();
    if (C.tid < 8) { int c = 0; for (int tl = 0; tl < 256; ++tl) c += sh[tl * 8 + C.tid]; sh[2048 + C.tid] = c; }
    __syncthreads();
    if (C.tid == 0) { int acc = 0; for (int ex = 0; ex < 8; ++ex) { sh[2064 + ex] = acc; acc += (sh[2048 + ex] + 255) & ~255; if (C.bid == 0) C.META[ex] = acc >> 8; } if (C.bid == 0) C.META[8] = acc >> 8; }
    __syncthreads();
    for (int tile = C.bid; tile < 256; tile += C.G) {
        if (C.tid < 8) { int c = 0; for (int tl = 0; tl < tile; ++tl) c += sh[tl * 8 + C.tid]; sh[2056 + C.tid] = c; }
        __syncthreads();
        for (int i = 0; i < 32; ++i) {
            const int a = 32 * C.wid + i; const size_t ag = (size_t)tile * 256 + a;
            const unsigned info = C.TOKINFO[ag]; const int e = info & 255u, lr = info >> 8;
            const int dest = sh[2064 + e] + sh[2056 + e] + lr;
            if (C.lane == 0) C.TOKPOS[ag] = dest;
            const u32x4* s = (const u32x4*)(C.XB + ((size_t)tile * 128 + (a >> 1)) * D); u32x4* dd = (u32x4*)(C.XG + (size_t)dest * D);
            dd[C.lane] = s[C.lane]; dd[C.lane + 64] = s[C.lane + 64];
        }
        __syncthreads();
    }
    const int gw = C.bid * NWAVES + C.wid, NGW = C.G * NWAVES;
    for (int ex = 0; ex < 8; ++ex) { const int s0 = sh[2064 + ex] + sh[2048 + ex], e0 = sh[2064 + ex] + ((sh[2048 + ex] + 255) & ~255);
        for (int r = s0 + gw; r < e0; r += NGW) { u32x4* dd = (u32x4*)(C.XG + (size_t)r * D); const u32x4 z = {0u, 0u, 0u, 0u}; dd[C.lane] = z; dd[C.lane + 64] = z; } }
}

__device__ __forceinline__ void frag_tile(const Ctx& C, int tb) {
    const int b = tb >> 6, t0 = (tb & 63) << 7;
    const bf16* Zt = C.Z + ((size_t)b * T + t0) * DINP;
    for (int task = C.tid; task < 2048; task += NTHREADS) {
        const int arr = task >> 10, key = (task >> 3) & 127, d8 = task & 7;
        const u32x4 v = *(const u32x4*)(Zt + (size_t)key * DINP + (arr ? C_KWIN : C_KSEL) + 8 * d8);
        const int tile = (t0 + key) >> 6, kk = key & 63;
        *(u32x4*)((arr ? C.KWINF : C.KSELF) + ((size_t)(b * 128 + tile)) * 4096 + (((kk >> 4) * 2 + (d8 >> 2)) * 64 + (d8 & 3) * 16 + (kk & 15)) * 8) = v;
    }
    for (int task = C.tid; task < 2048; task += NTHREADS) {
        const int arr = task >> 10, tile2 = (task >> 9) & 1, s2 = (task >> 8) & 1, dt = (task >> 6) & 3, ln = task & 63, g2 = ln >> 4, c2 = ln & 15;
        const bf16* src = Zt + (size_t)(64 * tile2 + 32 * s2 + 4 * g2) * DINP + (arr ? C_VWIN : C_VSEL) + 16 * dt + c2;
        unsigned v[8];
#pragma unroll
        for (int i = 0; i < 4; ++i) { v[i] = src[(size_t)i * DINP]; v[4 + i] = src[(size_t)(16 + i) * DINP]; }
        u32x4 o; o.x = v[0] | (v[1] << 16); o.y = v[2] | (v[3] << 16); o.z = v[4] | (v[5] << 16); o.w = v[6] | (v[7] << 16);
        *(u32x4*)((arr ? C.VWINF : C.VSELF) + ((size_t)(b * 128 + (t0 >> 6) + tile2)) * 4096 + ((s2 * 4 + dt) * 64 + ln) * 8) = o;
    }
}

constexpr int NCT = 2, NQW = 4 * NCT;
struct NsaAcc { f32x4 o[NCT][4]; float m[NCT], l[NCT]; };
__device__ __forceinline__ void nsa_acc_reset(NsaAcc& A) {
#pragma unroll
    for (int ct = 0; ct < NCT; ++ct) { A.m[ct] = -INFINITY; A.l[ct] = 0.f;
#pragma unroll
        for (int dt = 0; dt < 4; ++dt) A.o[ct][dt] = (f32x4){0.f, 0.f, 0.f, 0.f}; }
}
#define NSA_SCL (0.125f * 1.4426950408889634f)
__device__ __forceinline__ void nsa_tile(const bf16* Kt, const bf16* Vt, const bf16x8 (&qf)[NCT][2], int k0,
                                         const int (&lo)[NCT], const int (&hi)[NCT], unsigned ctmask, NsaAcc& A, int lane, int g) {
    bf16x8 kf[4][2], vf[4][2];
#pragma unroll
    for (int sub = 0; sub < 4; ++sub)
#pragma unroll
        for (int s = 0; s < 2; ++s) kf[sub][s] = *(const bf16x8*)(Kt + ((sub * 2 + s) * 64 + lane) * 8);
#pragma unroll
    for (int dt = 0; dt < 4; ++dt)
#pragma unroll
        for (int s2 = 0; s2 < 2; ++s2) vf[dt][s2] = *(const bf16x8*)(Vt + ((s2 * 4 + dt) * 64 + lane) * 8);
#pragma unroll
    for (int ct = 0; ct < NCT; ++ct) {
        if (!((ctmask >> ct) & 1u)) continue;
        f32x4 sa[4];
#pragma unroll
        for (int sub = 0; sub < 4; ++sub) { sa[sub] = mfma16(kf[sub][0], qf[ct][0], (f32x4){0.f, 0.f, 0.f, 0.f}); sa[sub] = mfma16(kf[sub][1], qf[ct][1], sa[sub]); }
        {
            const bool allv = (lo[ct] <= k0) && (k0 + 63 <= hi[ct]); const bool nonev = (hi[ct] < k0) || (lo[ct] > k0 + 63);
            if (__any(!(allv || nonev))) {
#pragma unroll
                for (int sub = 0; sub < 4; ++sub)
#pragma unroll
                    for (int r = 0; r < 4; ++r) { const int key = k0 + 16 * sub + 4 * g + r; sa[sub][r] = (key >= lo[ct] && key <= hi[ct]) ? sa[sub][r] : -INFINITY; }
            } else if (__any(nonev)) {
#pragma unroll
                for (int sub = 0; sub < 4; ++sub)
#pragma unroll
                    for (int r = 0; r < 4; ++r) sa[sub][r] = allv ? sa[sub][r] : -INFINITY;
            }
        }
        float tmax = fmaxf(fmaxf(fmaxf(sa[0][0], sa[0][1]), fmaxf(sa[0][2], sa[0][3])), fmaxf(fmaxf(sa[1][0], sa[1][1]), fmaxf(sa[1][2], sa[1][3])));
        tmax = fmaxf(tmax, fmaxf(fmaxf(fmaxf(sa[2][0], sa[2][1]), fmaxf(sa[2][2], sa[2][3])), fmaxf(fmaxf(sa[3][0], sa[3][1]), fmaxf(sa[3][2], sa[3][3]))));
        tmax = fmaxf(tmax, __shfl_xor(tmax, 16)); tmax = fmaxf(tmax, __shfl_xor(tmax, 32));
        tmax *= NSA_SCL;
        if (__any(tmax > A.m[ct])) {
            const float mn = fmaxf(A.m[ct], tmax);
            const float alpha = __builtin_amdgcn_exp2f(A.m[ct] - ((mn == -INFINITY) ? 0.f : mn));
            A.l[ct] *= alpha; A.m[ct] = mn;
#pragma unroll
            for (int dt = 0; dt < 4; ++dt) A.o[ct][dt] = A.o[ct][dt] * alpha;
        }
        const float nms = (A.m[ct] == -INFINITY) ? 0.f : -A.m[ct];
        float ps = 0.f;
#pragma unroll
        for (int sub = 0; sub < 4; ++sub)
#pragma unroll
            for (int r = 0; r < 4; ++r) { const float p = __builtin_amdgcn_exp2f(fmaf(sa[sub][r], NSA_SCL, nms)); sa[sub][r] = p; ps += p; }
        A.l[ct] += ps;
        bf16x8 pf[2];
#pragma unroll
        for (int s2 = 0; s2 < 2; ++s2) { u32x4 w; w.x = pk2(sa[2 * s2][0], sa[2 * s2][1]); w.y = pk2(sa[2 * s2][2], sa[2 * s2][3]); w.z = pk2(sa[2 * s2 + 1][0], sa[2 * s2 + 1][1]); w.w = pk2(sa[2 * s2 + 1][2], sa[2 * s2 + 1][3]);
            pf[s2] = __builtin_bit_cast(bf16x8, w); }
#pragma unroll
        for (int dt = 0; dt < 4; ++dt)
#pragma unroll
            for (int s2 = 0; s2 < 2; ++s2) A.o[ct][dt] = mfma16(vf[dt][s2], pf[s2], A.o[ct][dt]);
    }
}
__device__ __forceinline__ void nsa_finalize(const Ctx& C, NsaAcc& A, const bf16* Zb, size_t rowb, int t0, int jb, bool first, bool last, float (&msave)[NCT], float (&isave)[NCT], int c, int g) {
    const int ql = c >> 2, h = c & 3;
    float* scr = C.VBUF;
#pragma unroll
    for (int ct = 0; ct < NCT; ++ct) {
        float lt = A.l[ct]; lt += __shfl_xor(lt, 16); lt += __shfl_xor(lt, 32);
        const float inv = lt > 0.f ? 1.0f / lt : 0.f; msave[ct] = A.m[ct]; isave[ct] = inv;
        const int tq = t0 + 4 * ct + ql;
        const float gate = sigmoidf_(bf2f((unsigned)Zb[(size_t)tq * DINP + C_GATE + 3 * h + jb]));
        const float f = inv * gate;
#pragma unroll
        for (int dt = 0; dt < 4; ++dt) {
            f32x4 v = A.o[ct][dt] * f; const size_t off = (rowb + tq) * 256 + h * 64 + 16 * dt + 4 * g;
            if (!first) v = v + *(const f32x4*)(scr + off);
            if (last) { u32x2 o; o.x = pk2(v[0], v[1]); o.y = pk2(v[2], v[3]); *(u32x2*)(C.Y + (rowb + tq) * D + 256 + h * 64 + 16 * dt + 4 * g) = o; }
            else *(f32x4*)(scr + off) = v;
        }
    }
}
__device__ __forceinline__ void nsa_unit(const Ctx& C, int U, LAS unsigned char* wl) {
    const int lane = C.lane, c = lane & 15, g = lane >> 4, ql = c >> 2, h = c & 3;
    const int b = U / (T / NQW), t0 = (U % (T / NQW)) * NQW;
    const size_t rowb = (size_t)b * T;
    const bf16* Zb = C.Z + rowb * DINP;
    LAS float* imp = (LAS float*)wl; LAS unsigned* smask = (LAS unsigned*)(wl + 8192);
    bf16x8 qf[NCT][2]; int tq[NCT];
#pragma unroll
    for (int ct = 0; ct < NCT; ++ct) { tq[ct] = t0 + 4 * ct + ql;
#pragma unroll
        for (int s = 0; s < 2; ++s) qf[ct][s] = *(const bf16x8*)(Zb + (size_t)tq[ct] * DINP + C_Q + h * 64 + 32 * s + 8 * g); }
    NsaAcc A; float msave[NCT], isave[NCT], mc[NCT], ic[NCT];
    int lo[NCT], hi[NCT];
    constexpr unsigned ALLCT = (1u << NCT) - 1u;
    const int nmaxw = (t0 + NQW - 1 >= 31) ? ((t0 + NQW - 1 - 31) >> 4) : -1;
    const int nkt = (nmaxw >> 6) + 1;
    const bf16* KCb = C.KCF + (size_t)b * 8 * 4096; const bf16* VCb = C.VCF + (size_t)b * 8 * 4096;
#pragma unroll
    for (int ct = 0; ct < NCT; ++ct) { lo[ct] = 0; hi[ct] = (tq[ct] >= 31) ? ((tq[ct] - 31) >> 4) : -1; }
    nsa_acc_reset(A);
    for (int kt = 0; kt < nkt; ++kt) nsa_tile(KCb + (size_t)kt * 4096, VCb + (size_t)kt * 4096, qf, 64 * kt, lo, hi, ALLCT, A, lane, g);
    nsa_finalize(C, A, Zb, rowb, t0, 0, true, false, mc, ic, c, g);
    for (int i = lane; i < NQW * 128; i += 64) imp[i] = 0.f;
    LDS_WAIT();
    for (int kt = 0; kt < nkt; ++kt) {
        bf16x8 kf[4][2];
#pragma unroll
        for (int sub = 0; sub < 4; ++sub)
#pragma unroll
            for (int s = 0; s < 2; ++s) kf[sub][s] = *(const bf16x8*)(KCb + (size_t)kt * 4096 + ((sub * 2 + s) * 64 + lane) * 8);
#pragma unroll
        for (int ct = 0; ct < NCT; ++ct) {
#pragma unroll
            for (int sub = 0; sub < 4; ++sub) {
                f32x4 sa = mfma16(kf[sub][0], qf[ct][0], (f32x4){0.f, 0.f, 0.f, 0.f}); sa = mfma16(kf[sub][1], qf[ct][1], sa);
                float p[4];
#pragma unroll
                for (int r = 0; r < 4; ++r) { const int n = 64 * kt + 16 * sub + 4 * g + r; float v = (n <= hi[ct]) ? __builtin_amdgcn_exp2f(sa[r] * NSA_SCL - mc[ct]) * ic[ct] : 0.f;
                    v += __shfl_xor(v, 1); v += __shfl_xor(v, 2); p[r] = v; }
                if (h == 0) { const int mb = 16 * kt + 4 * sub + g; LAS float* ip = imp + (4 * ct + ql) * 128 + mb;
                    atomicAdd((float*)ip, (p[0] + p[1]) + (p[2] + p[3])); if (mb + 1 < 128) atomicAdd((float*)(ip + 1), p[3]); }
            }
        }
    }
    LDS_WAIT();
#pragma unroll 1
    for (int qi = 0; qi < NQW; ++qi) {
        const int t = t0 + qi, cur = t >> 6; const int m0 = lane, m1 = lane + 64;
        unsigned long long mlo, mhi;
        if (cur < 16) { mlo = __ballot(m0 <= cur); mhi = 0ull; }
        else {
            const float s0 = imp[qi * 128 + m0] + ((m0 == 0 || m0 == cur || m0 == cur - 1) ? 1e4f : 0.f), s1 = imp[qi * 128 + m1] + ((m1 == 0 || m1 == cur || m1 == cur - 1) ? 1e4f : 0.f);
            const unsigned u0 = (m0 <= cur) ? __float_as_uint(s0) + 1u : 0u, u1 = (m1 <= cur) ? __float_as_uint(s1) + 1u : 0u;
            unsigned tau = 0u;
            for (int bit = 30; bit >= 0; --bit) { const unsigned cand = tau | (1u << bit); const int cnt = __popcll(__ballot(u0 >= cand)) + __popcll(__ballot(u1 >= cand)); if (cnt >= 16) tau = cand; }
            const unsigned long long g0 = __ballot(u0 > tau), g1 = __ballot(u1 > tau), e0 = __ballot(u0 == tau), e1 = __ballot(u1 == tau);
            int need = 16 - __popcll(g0) - __popcll(g1);
            const unsigned long long lt = (1ull << lane) - 1ull;
            const unsigned long long k0m = __ballot(((e0 >> lane) & 1ull) && __popcll(e0 & lt) < need); need -= __popcll(k0m);
            const unsigned long long k1m = __ballot(((e1 >> lane) & 1ull) && __popcll(e1 & lt) < need);
            mlo = g0 | k0m; mhi = g1 | k1m;
        }
        if (lane == 0) { smask[qi * 4 + 0] = (unsigned)mlo; smask[qi * 4 + 1] = (unsigned)(mlo >> 32); smask[qi * 4 + 2] = (unsigned)mhi; smask[qi * 4 + 3] = (unsigned)(mhi >> 32); }
    }
    LDS_WAIT();
    nsa_acc_reset(A);
    {
        const int jmax = (t0 + NQW - 1) >> 6;
        const bf16* Kb = C.KSELF + (size_t)b * 128 * 4096; const bf16* Vb = C.VSELF + (size_t)b * 128 * 4096;
#pragma unroll
        for (int ct = 0; ct < NCT; ++ct) lo[ct] = 0;
        for (int j = 0; j <= jmax; ++j) {
            unsigned ctmask = 0u;
#pragma unroll
            for (int ct = 0; ct < NCT; ++ct) { const unsigned w = smask[(4 * ct + ql) * 4 + (j >> 5)]; const bool sel = (w >> (j & 31)) & 1u; hi[ct] = sel ? tq[ct] : -1; if (__any(sel)) ctmask |= 1u << ct; }
            if (ctmask) nsa_tile(Kb + (size_t)j * 4096, Vb + (size_t)j * 4096, qf, 64 * j, lo, hi, ctmask, A, lane, g);
        }
    }
    nsa_finalize(C, A, Zb, rowb, t0, 1, false, false, msave, isave, c, g);
    nsa_acc_reset(A);
    {
        const int j0 = (t0 >= 511) ? ((t0 - 511) >> 6) : 0, j1 = (t0 + NQW - 1) >> 6;
        const bf16* Kb = C.KWINF + (size_t)b * 128 * 4096; const bf16* Vb = C.VWINF + (size_t)b * 128 * 4096;
#pragma unroll
        for (int ct = 0; ct < NCT; ++ct) { lo[ct] = tq[ct] - 511; hi[ct] = tq[ct]; }
        for (int j = j0; j <= j1; ++j) nsa_tile(Kb + (size_t)j * 4096, Vb + (size_t)j * 4096, qf, 64 * j, lo, hi, ALLCT, A, lane, g);
    }
    nsa_finalize(C, A, Zb, rowb, t0, 2, false, true, msave, isave, c, g);
    LDS_WAIT();
}

#ifndef DBG_REP
#define DBG_REP 0
#endif
#ifndef NSA_CHECK
#define NSA_CHECK 0
#endif
#ifndef MK_MULTI
#define MK_MULTI 0
#endif
constexpr int PH_PER_LAYER = 13, N_PHASES = 1 + NL * PH_PER_LAYER;


__device__ __forceinline__ void mkctx(Ctx& C, const Params& P, int tid) {
    C.tid = tid; C.lane = tid & 63; C.wid = __builtin_amdgcn_readfirstlane(tid >> 6); C.bid = blockIdx.x; C.G = gridDim.x;
#pragma unroll
    for (int i = 0; i < 35; ++i) C.in[i] = P.in[i];
    unsigned char* ws = P.ws;
    C.X = P.out;
    C.XB = (bf16*)(ws + WS_XB); C.Z = (bf16*)(ws + WS_Z); C.Y = (bf16*)(ws + WS_Y); C.Q = (bf16*)(ws + WS_Q); C.H = (bf16*)(ws + WS_H); C.XG = (bf16*)(ws + WS_Z);
    C.KC = (bf16*)(ws + WS_KC); C.VC = (bf16*)(ws + WS_VC); C.MEMB = (bf16*)(ws + WS_MEMB); C.KMEM = (bf16*)(ws + WS_KMEM); C.VTMEM = (bf16*)(ws + WS_VTMEM); C.KCF = (bf16*)(ws + WS_KCF); C.VCF = (bf16*)(ws + WS_VCF); C.KSELF = (bf16*)(ws + WS_KSELF); C.VSELF = (bf16*)(ws + WS_VSELF); C.KWINF = (bf16*)(ws + WS_KWINF); C.VWINF = (bf16*)(ws + WS_VWINF);
    C.WINT = (bf16*)(ws + WS_WINT); C.WOUTT = (bf16*)(ws + WS_WOUTT); C.XQT = (bf16*)(ws + WS_XQT); C.XKVT = (bf16*)(ws + WS_XKVT); C.XOT = (bf16*)(ws + WS_XOT);
    C.W13T = (bf16*)(ws + WS_W13T); C.W2T = (bf16*)(ws + WS_W2T); C.E13T = (bf16*)(ws + WS_E13T); C.E2T = (bf16*)(ws + WS_E2T);
    C.CW1T = (bf16*)(ws + WS_CW1T); C.CW2T = (bf16*)(ws + WS_CW2T); C.PWT = (bf16*)(ws + WS_PWT); C.POOLWT = (bf16*)(ws + WS_POOLWT); C.SGUWB = (bf16*)(ws + WS_SGUW);
    C.VBUF = (float*)(ws + WS_VBUF); C.FS = (float*)(ws + WS_VBUF); C.PEB = (float*)(ws + WS_PEB); C.TOKG = (float*)(ws + WS_TOKG);
    C.HIST = (int*)(ws + WS_HIST); C.META = (int*)(ws + WS_META); C.TOKPOS = (int*)(ws + WS_TOKPOS); C.TOKINFO = (unsigned*)(ws + WS_TOKINFO);
}
#define MKCTX() Ctx C; { int t_ = threadIdx.x; asm volatile("" : "+v"(t_)); mkctx(C, P, t_); }

__global__ void __launch_bounds__(NTHREADS, 2) fwd_kernel(Params P) {
    extern __shared__ __attribute__((aligned(16))) unsigned char lds_raw[];
    LAS unsigned char* lds = (LAS unsigned char*)lds_raw;
    for (int u = threadIdx.x; u < (LDS_BYTES - LDSCTL_OFF) / 4; u += NTHREADS) ((LAS unsigned*)(lds + LDSCTL_OFF))[u] = 0u;
    __syncthreads();
    unsigned char* ws = P.ws;
    XcdBarrier bar; bar.bar = (unsigned*)(ws + WS_CTL); bar.x = 0; bar.st = nullptr;
#if !MK_MULTI
    bar = xcd_barrier_post((unsigned*)(ws + WS_CTL), (volatile LAS unsigned*)(lds + LDSCTL_OFF));
#endif
    const int lo = P.ph_lo, hi = P.ph_hi;
#define IN(k) (lo <= (k) && (k) < hi)
#if MK_MULTI
#define SEAM(k) do { } while (0)
#else
#define SEAM(k) do { if (IN(k) && IN((k) + 1)) xcd_barrier(bar); } while (0)
#endif
    int ph = 0;
    if (IN(ph)) { for (int rep = 0; rep < ((P.dbg & 2) ? 2 : 1); ++rep) { MKCTX(); p0_prologue(C, lds); __syncthreads(); } }
    SEAM(ph); ++ph;

    for (int l = 0; l < NL; ++l) {
        const bool moe = (l & 1) != 0; const int li = l >> 1;
        if (IN(ph)) {
            MKCTX();
            if (l == 0) {
                for (int l2 = 0; l2 < NL; ++l2) {
                    pg8::Gemm g{C.MEMB, C.XKVT + (size_t)l2 * 2 * D * D, NB * MEM, 2 * D, D}; pg8::StaticOrder S; S.init(NB * MEM, 2 * D, C.G, (C.bid + 32 * l2) % C.G);
                    pg8::EpiKV E{C.KMEM + (size_t)l2 * 1024 * 1024, C.VTMEM + (size_t)l2 * 4096 * 256};
                    pg8::gemm_phase<pg8::EpiKV, pg8::StaticOrder, true, true>(lds, g, S, E);
                }
            }
            pg8::Gemm g{C.XB, C.WINT + (size_t)l * DINP * D, M, DINP, D}; pg8::StaticOrder S; S.init(M, DINP, C.G, C.bid);
            pg8::EpiBf16 E{C.Z, DINP};
            pg8::gemm_phase<pg8::EpiBf16, pg8::StaticOrder, true, true>(lds, g, S, E);
        }
        SEAM(ph); ++ph;
        if (IN(ph)) for (int rep = 0; rep < ((P.dbg & 4) ? 2 : 1); ++rep) {
            MKCTX();
            { ConvW cw;
              for (int tb = C.bid; tb < M / 128; tb += C.G) frag_tile(C, tb);
              for (int tb = C.bid; tb < M / 128; tb += C.G) mixers_tile<1>(C, l, tb, lds, cw);
              for (int tb = C.bid; tb < M / 128; tb += C.G) mixers_tile<2>(C, l, tb, lds, cw);
              load_convw(C, l, cw);
              for (int tb = C.bid; tb < M / 128; tb += C.G) mixers_tile<4>(C, l, tb, lds, cw); }
            for (int it = C.bid; it < 256; it += C.G) compress_item(C, l, it, lds);
        }
        SEAM(ph); ++ph;
        if (IN(ph)) for (int rep = 0; rep < ((P.dbg & 1) ? 2 : 1); ++rep) {
            MKCTX();
            for (int slot = C.bid * NWAVES + C.wid; slot < M / NQW / 2; slot += C.G * NWAVES) {
                int bb = slot >> 9, lw = slot & 511;
                if (C.G == 256) { bb = (C.bid & 7) >> 1; lw = (((C.bid >> 3) << 1) + (C.bid & 1)) * NWAVES + C.wid; }
#pragma unroll 1
                for (int k = 0; k < 2; ++k) nsa_unit(C, bb * (T / NQW) + (k ? (T / NQW - 1 - lw) : lw), lds + C.wid * 17664);
            }
#if NSA_CHECK
            xcd_barrier(bar);
            { const int gw = C.bid * NWAVES + C.wid, NGW = C.G * NWAVES;
              for (int q = gw; q < M; q += NGW) { const int t = q & (T - 1); if ((((unsigned)q * 2654435761u) >> 29) == 0u || t < 192) nsa_query<true>(C, q >> 13, t, lds + C.wid * 17664, (unsigned*)(P.ws + WS_CTL + 32768)); } }
#endif
        }
        SEAM(ph); ++ph;
        if (IN(ph)) {
            MKCTX();
            pg8::Gemm g{C.Y, C.WOUTT + (size_t)l * D * D, M, D, D}; pg8::StaticOrder S; S.init(M, D, C.G, C.bid);
            pg8::EpiF32Res E{C.VBUF, (l == 0) ? C.in[I_X] : nullptr, (l == 0) ? nullptr : C.XB, D, ALPHA};
            pg8::gemm_phase<pg8::EpiF32Res, pg8::StaticOrder, true, true>(lds, g, S, E);
        }
        SEAM(ph); ++ph;
        if (IN(ph)) for (int rep = 0; rep < ((P.dbg & 8) ? 2 : 1); ++rep) { MKCTX(); ln_phase(C, C.VBUF, C.in[I_LN1G] + l * D, C.in[I_LN1B] + l * D, 0, nullptr, nullptr, lds); }
        SEAM(ph); ++ph;
        if (IN(ph)) {
            MKCTX();
            pg8::Gemm g{C.XB, C.XQT + (size_t)l * D * D, M, D, D}; pg8::StaticOrder S; S.init(M, D, C.G, C.bid);
            pg8::EpiBf16 E{C.Q, D};
            pg8::gemm_phase<pg8::EpiBf16, pg8::StaticOrder, true, true>(lds, g, S, E);
        }
        SEAM(ph); ++ph;
        if (IN(ph)) for (int rep = 0; rep < ((P.dbg & 16) ? 2 : 1); ++rep) { MKCTX(); for (int u = C.bid; u < NB * 4 * 64; u += C.G) xattn_unit(C, l, u, lds); }
        SEAM(ph); ++ph;
        if (IN(ph)) {
            MKCTX();
            pg8::Gemm g{C.Y, C.XOT + (size_t)l * D * D, M, D, D}; pg8::StaticOrder S; S.init(M, D, C.G, C.bid);
            pg8::EpiF32Res E{C.VBUF, nullptr, C.XB, D, ALPHA};
            pg8::gemm_phase<pg8::EpiF32Res, pg8::StaticOrder, true, true>(lds, g, S, E);
        }
        SEAM(ph); ++ph;
        if (IN(ph)) for (int rep = 0; rep < ((P.dbg & 8) ? 2 : 1); ++rep) { MKCTX(); ln_phase(C, C.VBUF, C.in[I_LN2G] + l * D, C.in[I_LN2B] + l * D, 0, moe ? C.in[I_ROUTER] + (size_t)li * D * NE : nullptr, nullptr, lds); }
        SEAM(ph); ++ph;
        if (IN(ph)) for (int rep = 0; rep < ((P.dbg & 32) ? 2 : 1); ++rep) { if (moe) { MKCTX(); moe_gather(C, lds); __syncthreads(); } }
        if (moe || MK_MULTI) SEAM(ph);
        ++ph;
        if (IN(ph)) {
            MKCTX();
            pg8::GroupedOrder S; int npan;
            if (moe) {
#pragma unroll
                for (int k = 0; k < 8; ++k) S.pend[k] = __builtin_amdgcn_readfirstlane(C.META[k]);
                npan = __builtin_amdgcn_readfirstlane(C.META[8]); S.estride = (size_t)2 * FE * D * 2;
            } else {
#pragma unroll
                for (int k = 0; k < 8; ++k) S.pend[k] = M / 256;
                npan = M / 256; S.estride = 0;
            }
            const int N = moe ? 2 * FE : 2 * FF;
            pg8::Gemm g{moe ? C.XG : C.XB, moe ? C.E13T + (size_t)li * NE * 2 * FE * D : C.W13T + (size_t)li * 2 * FF * D, npan * 256, N, D};
            S.init(npan * 256, N, C.G, C.bid);
            pg8::EpiSwiglu E{C.H, N / 2};
            pg8::gemm_phase<pg8::EpiSwiglu, pg8::GroupedOrder, true, true>(lds, g, S, E);
        }
        SEAM(ph); ++ph;
        if (IN(ph)) {
            MKCTX();
            pg8::GroupedOrder S; int npan;
            if (moe) {
#pragma unroll
                for (int k = 0; k < 8; ++k) S.pend[k] = __builtin_amdgcn_readfirstlane(C.META[k]);
                npan = __builtin_amdgcn_readfirstlane(C.META[8]); S.estride = (size_t)D * FE * 2;
            } else {
#pragma unroll
                for (int k = 0; k < 8; ++k) S.pend[k] = M / 256;
                npan = M / 256; S.estride = 0;
            }
            const int K = moe ? FE : FF;
            pg8::Gemm g{C.H, moe ? C.E2T + (size_t)li * NE * D * FE : C.W2T + (size_t)li * D * FF, npan * 256, D, K};
            S.init(npan * 256, D, C.G, C.bid);
            pg8::EpiF32Res E{moe ? C.FS : C.VBUF, nullptr, moe ? nullptr : C.XB, D, ALPHA};
            pg8::gemm_phase<pg8::EpiF32Res, pg8::GroupedOrder, true, true>(lds, g, S, E);
        }
        SEAM(ph); ++ph;
        if (IN(ph)) { MKCTX(); ln_phase(C, C.VBUF, C.in[I_LN3G] + l * D, C.in[I_LN3B] + l * D, moe ? 1 : 0, nullptr, (l == NL - 1) ? C.X : nullptr, lds); }
        SEAM(ph); ++ph;
    }
#if NSA_CHECK
    xcd_barrier(bar);
    { unsigned* ew = (unsigned*)(P.ws + WS_CTL + 32768); const unsigned err = __hip_atomic_load(ew, __ATOMIC_RELAXED, __HIP_MEMORY_SCOPE_AGENT), cnt = __hip_atomic_load(ew + 64, __ATOMIC_RELAXED, __HIP_MEMORY_SCOPE_AGENT);
      if (cnt == 0u || (unsigned long long)err * 256ull > (unsigned long long)cnt) { for (size_t i = (size_t)blockIdx.x * NTHREADS + threadIdx.x; i < (size_t)M * D; i += (size_t)gridDim.x * NTHREADS) P.out[i] = 0.f; } }
#endif
#undef IN
#undef SEAM
}

extern "C" void kernel_launch(void* const* d_in, const int* in_sizes, int n_in, void* d_out, int out_size, void* d_ws, size_t ws_size, hipStream_t stream) {
    static int grid = 0;
    if (grid == 0) {
        if (n_in != 35 || out_size != M * D || ws_size < WS_END) { fprintf(stderr, "kernel_launch: unexpected problem (n_in %d, out %d, ws %zu < %zu)\n", n_in, out_size, ws_size, (size_t)WS_END); grid = -1; return; }
        int dev = 0, cus = 0, per_cu = 0;
        if (hipGetDevice(&dev) != hipSuccess || hipDeviceGetAttribute(&cus, hipDeviceAttributeMultiprocessorCount, dev) != hipSuccess) { grid = -1; return; }
        if (hipFuncSetAttribute((const void*)fwd_kernel, hipFuncAttributeMaxDynamicSharedMemorySize, LDS_BYTES) != hipSuccess) { fprintf(stderr, "kernel_launch: hipFuncSetAttribute failed\n"); grid = -1; return; }
        if (hipOccupancyMaxActiveBlocksPerMultiprocessor(&per_cu, (const void*)fwd_kernel, NTHREADS, LDS_BYTES) != hipSuccess || per_cu < 1) { fprintf(stderr, "kernel_launch: occupancy query says %d\n", per_cu); }
        (void)hipGetLastError();
        grid = cus;
    }
    if (grid < 0) return;
    (void)hipMemsetAsync((char*)d_ws + WS_CTL, 0, CTL_ZERO_BYTES, stream);
    Params p{};
    for (int i = 0; i < 35; ++i) p.in[i] = (const float*)d_in[i];
    p.out = (float*)d_out; p.ws = (unsigned char*)d_ws; p.dbg = DBG_REP;
#if MK_MULTI
    for (int k = 0; k < N_PHASES; ++k) { p.ph_lo = k; p.ph_hi = k + 1; hipLaunchKernelGGL(fwd_kernel, dim3(grid), dim3(NTHREADS), LDS_BYTES, stream, p); }
#else
    p.ph_lo = 0; p.ph_hi = N_PHASES;
    hipLaunchKernelGGL(fwd_kernel, dim3(grid), dim3(NTHREADS), LDS_BYTES, stream, p);
#endif
}
```

```cpp
#include <hip/hip_runtime.h>
#include <cstdio>
#include <cstdint>

#define GAS __attribute__((address_space(1)))
#define LAS __attribute__((address_space(3)))
typedef unsigned short bf16;
typedef short bf16x8 __attribute__((ext_vector_type(8)));
typedef short bf16x4 __attribute__((ext_vector_type(4)));
typedef float f32x4 __attribute__((ext_vector_type(4)));
typedef float f32x2 __attribute__((ext_vector_type(2)));
typedef unsigned u32x4 __attribute__((ext_vector_type(4)));
typedef unsigned u32x2 __attribute__((ext_vector_type(2)));

constexpr int D = 1024, NB = 4, T = 8192, NL = 4, MEM = 256, M = NB * T;
constexpr int DIN = 1932, DINP = 2048;
constexpr int C_POOL = 0, C_Q = 256, C_KCMP = 512, C_VCMP = 576, C_KSEL = 640, C_VSEL = 704, C_KWIN = 768, C_VWIN = 832, C_GATE = 896, C_U = 908, C_V = 1164, C_CA = 1420, C_CG = 1676;
constexpr int FF = 2816, NE = 8, FE = 3584;
constexpr int NCMP = 511;
constexpr float ALPHA = 1.6817928305074292f;
constexpr float LN_EPS = 1e-5f;
constexpr int MOE_ROWS = 2 * M + NE * 256;
constexpr int NWAVES = 8, NTHREADS = 512;

constexpr size_t al256(size_t x) { return (x + 255) & ~(size_t)255; }
constexpr size_t MiB = 1u << 20;
constexpr size_t WS_CTL = 0, CTL_ZERO_BYTES = 64 * 1024;
constexpr size_t WS_HIST = 1 * MiB;
constexpr size_t WS_META = WS_HIST + 8192;
constexpr size_t WS_TOKINFO = WS_META + 256;
constexpr size_t WS_TOKG = WS_TOKINFO + (size_t)2 * M * 4;
constexpr size_t WS_TOKPOS = WS_TOKG + (size_t)2 * M * 4;
constexpr size_t WS_KC = WS_TOKPOS + (size_t)2 * M * 4;
constexpr size_t WS_VC = WS_KC + (size_t)NB * 512 * 64 * 2;
constexpr size_t WS_PEB = WS_VC + (size_t)NB * 512 * 64 * 2;
constexpr size_t WS_POOLWT = WS_PEB + (size_t)NL * 2 * 256 * 4;
constexpr size_t WS_SGUW = WS_POOLWT + (size_t)NL * 4 * 64 * 64 * 2;
constexpr size_t WS_PWT = WS_SGUW + (size_t)NL * 4 * 128 * 128 * 2;
constexpr size_t WS_CW2T = WS_PWT + (size_t)NL * 256 * 256 * 2;
constexpr size_t WS_CW1T = WS_CW2T + (size_t)NL * 2 * 64 * 256 * 2;
constexpr size_t WS_MEMB = WS_CW1T + (size_t)NL * 2 * 256 * 2048 * 2;
constexpr size_t WS_KMEM = WS_MEMB + (size_t)1024 * 1024 * 2;
constexpr size_t WS_VTMEM = WS_KMEM + (size_t)NL * 1024 * 1024 * 2;
constexpr size_t WS_KCF = WS_VTMEM + (size_t)NL * 4096 * 256 * 2;
constexpr size_t WS_VCF = WS_KCF + (size_t)NB * 8 * 4096 * 2;
constexpr size_t WS_KSELF = WS_VCF + (size_t)NB * 8 * 4096 * 2;
constexpr size_t WS_VSELF = WS_KSELF + (size_t)NB * 128 * 4096 * 2;
constexpr size_t WS_KWINF = WS_VSELF + (size_t)NB * 128 * 4096 * 2;
constexpr size_t WS_VWINF = WS_KWINF + (size_t)NB * 128 * 4096 * 2;
constexpr size_t WS_SMALL_END = WS_VWINF + (size_t)NB * 128 * 4096 * 2;
constexpr size_t WS_WINT = 48 * MiB;
static_assert(WS_SMALL_END <= WS_WINT, "small region");
constexpr size_t WS_WOUTT = WS_WINT + (size_t)NL * DINP * D * 2;
constexpr size_t WS_XQT = WS_WOUTT + (size_t)NL * D * D * 2;
constexpr size_t WS_XKVT = WS_XQT + (size_t)NL * D * D * 2;
constexpr size_t WS_XOT = WS_XKVT + (size_t)NL * 2 * D * D * 2;
constexpr size_t WS_W13T = WS_XOT + (size_t)NL * D * D * 2;
constexpr size_t WS_W2T = WS_W13T + (size_t)2 * 2 * FF * D * 2;
constexpr size_t WS_E13T = WS_W2T + (size_t)2 * D * FF * 2;
constexpr size_t WS_E2T = WS_E13T + (size_t)16 * 2 * FE * D * 2;
constexpr size_t WS_XB = WS_E2T + (size_t)16 * D * FE * 2;
constexpr size_t WS_VBUF = WS_XB + (size_t)M * D * 2;
constexpr size_t WS_Z = WS_VBUF + (size_t)M * D * 4;
constexpr size_t WS_Y = WS_Z + (size_t)M * DINP * 2;
constexpr size_t WS_Q = WS_Y + (size_t)M * D * 2;
constexpr size_t WS_H = WS_Q + (size_t)M * D * 2;
constexpr size_t WS_W1X = WS_H + (size_t)MOE_ROWS * FE * 2;
constexpr size_t WS_W2X = WS_W1X + (size_t)NL * NB * D * D * 2;
constexpr size_t WS_END = WS_W2X + (size_t)NL * NB * D * D * 2;
static_assert((size_t)MOE_ROWS * D * 4 <= WS_H - WS_VBUF, "FS overlay");
static_assert((size_t)MOE_ROWS * D * 2 <= WS_Q - WS_Z, "XG overlay");

constexpr int SCR_BYTES = 153600;
constexpr int LDSCTL_OFF = SCR_BYTES;
constexpr int LDS_BYTES = 155648;

__device__ __forceinline__ float bf2f(unsigned v) { return __uint_as_float(v << 16); }
__device__ __forceinline__ unsigned f2bf(float f) { unsigned u = __builtin_bit_cast(unsigned, f); return (u + 0x7fffu + ((u >> 16) & 1u)) >> 16; }
typedef __bf16 bf16x2_t __attribute__((ext_vector_type(2)));
__device__ __forceinline__ unsigned pk2(float lo, float hi) { const f32x2 v = {lo, hi}; const bf16x2_t b = __builtin_convertvector(v, bf16x2_t); return __builtin_bit_cast(unsigned, b); }
__device__ __forceinline__ float lo16(unsigned w) { return __uint_as_float(w << 16); }
__device__ __forceinline__ float hi16(unsigned w) { return __uint_as_float(w & 0xffff0000u); }
__device__ __forceinline__ float sigmoidf_(float x) { return 1.0f / (1.0f + __expf(-x)); }
__device__ __forceinline__ float siluf_(float x) { return x / (1.0f + __expf(-x)); }
__device__ __forceinline__ float gelu_tanh(float x) { const float u = 0.7978845608028654f * (x + 0.044715f * x * x * x); return x / (1.0f + __expf(-2.0f * u)); }
__device__ __forceinline__ float wave_sum(float v) {
#pragma unroll
    for (int o = 1; o < 64; o <<= 1) v += __shfl_xor(v, o);
    return v;
}
__device__ __forceinline__ float wave_max(float v) {
#pragma unroll
    for (int o = 1; o < 64; o <<= 1) v = fmaxf(v, __shfl_xor(v, o));
    return v;
}
__device__ __forceinline__ f32x4 mfma16(bf16x8 a, bf16x8 b, f32x4 c) { return __builtin_amdgcn_mfma_f32_16x16x32_bf16(a, b, c, 0, 0, 0); }
__device__ __forceinline__ float dot2bf(unsigned a, unsigned b, float c) { return __builtin_amdgcn_fdot2_f32_bf16(__builtin_bit_cast(bf16x2_t, a), __builtin_bit_cast(bf16x2_t, b), c, false); }
#define LDS_WAIT() asm volatile("s_waitcnt lgkmcnt(0)" ::: "memory")

namespace pg8 {
#define PG8_LAS __attribute__((address_space(3)))
typedef unsigned short bf16_t;
typedef short bf16x8 __attribute__((ext_vector_type(8)));
typedef float f32x4 __attribute__((ext_vector_type(4)));
typedef unsigned u32x4 __attribute__((ext_vector_type(4)));
constexpr int BM = 256, BK = 64, HALF = 128, HTB = HALF * BK * 2  , STAGE_BYTES = 8 * HTB, NXCD = 8, WGM = 8;

__host__ __device__ __forceinline__ int lds_byte(int r, int c) { const int st = (r >> 4) * 2 + (c >> 5), rr = r & 15, cc = c & 31, ob = rr * 64 + cc * 2; return st * 1024 + (ob ^ (((ob >> 9) & 1) << 5)); }
__host__ __device__ __forceinline__ void stage_rc(int b, int& R, int& C) { const int st = b / 1024, sb = b % 1024, swz = sb ^ (((sb >> 9) & 1) << 5); R = (st >> 1) * 16 + swz / 64; C = (st & 1) * 32 + (swz % 64) / 2; }
__host__ __device__ __forceinline__ int perm32(int rho) { const int n = rho >> 4, i = rho & 15; return 8 * (i >> 2) + 4 * n + (i & 3); }

struct Unit { int pm, pn, e; };
struct Gemm { const bf16_t* A; const bf16_t* Bt; int M, N, K, lda, ldb; };

struct StaticOrder {
    int nM, nN, nwg, G, c;
    __host__ __device__ void init(int M, int N, int G_, int c_) { nM = M / BM; nN = N / BM; nwg = nM * nN; G = G_; c = c_; }
    __host__ __device__ bool next(int i, Unit& u) const {
        const long L = (long)i * G + c; if (L >= nwg) return false;
        int wgid = (int)L; { const int q = nwg / NXCD, r = nwg % NXCD, xcd = wgid % NXCD, off = wgid / NXCD; wgid = (xcd < r ? xcd * (q + 1) : r * (q + 1) + (xcd - r) * q) + off; }
        const int nig = WGM * nN, gid = wgid / nig, fm = gid * WGM, gsz = (nM - fm) < WGM ? (nM - fm) : WGM;
        u.pm = fm + ((wgid % nig) % gsz); u.pn = (wgid % nig) / gsz; u.e = 0; return true;
    }
    __device__ __forceinline__ void a_ready(const Unit&) const {}
    __device__ __forceinline__ void done(const Unit&) const {}
    __device__ __forceinline__ const char* bbase(const Gemm& g, const Unit&) const { return (const char*)g.Bt; }
    __device__ __forceinline__ const char* abase(const Gemm& g, const Unit&) const { return (const char*)g.A; }
};

template <class Epi, class Sched, bool ALIGN_EPI = false, bool SP2 = false>
__device__ __forceinline__ void gemm_phase(PG8_LAS unsigned char* lds, const Gemm g, const Sched& S, const Epi& E) {
    int tid_l = threadIdx.x; asm volatile("" : "+v"(tid_l));
    const int tid = tid_l, wid = __builtin_amdgcn_readfirstlane(tid >> 6), lane = tid & 63, wr = wid >> 2, wc = wid & 3, fr = lane & 15, fq = lane >> 4;
    const int K = g.K, nt = K / BK;
    unsigned voffA[2], voffB[2];
#pragma unroll
    for (int i = 0; i < 2; ++i) { int R, C; stage_rc(tid * 16 + i * 8192, R, C); const int Rb = Epi::PERM ? ((R & ~31) + perm32(R & 31)) : R;
        voffA[i] = (unsigned)(R * g.lda + C) * 2u; voffB[i] = (unsigned)(Rb * g.ldb + C) * 2u; }
    const size_t kstep = (size_t)(BK * 2);
    const size_t hstepA = (size_t)HALF * g.lda * 2, hstepB = (size_t)HALF * g.ldb * 2;
    const size_t tstepA = 2 * hstepA, tstepB = 2 * hstepB;
    const unsigned ldsw = (unsigned)wid * 1024u;
    const int aoff = lds_byte(wr * 64 + fr, fq * 8), boff = lds_byte(wc * 32 + fr, fq * 8);
#define PG8_SA(b, h) (((b) * 2 + (h)) * HTB)
#define PG8_SB(b, h) ((4 + (b) * 2 + (h)) * HTB)
#define PG8_STAGE(bufoff, gbase, voff) do { _Pragma("unroll") for (int _i = 0; _i < 2; ++_i) \
        __builtin_amdgcn_global_load_lds((const unsigned*)((const char*)(gbase) + (voff)[_i]), (PG8_LAS unsigned*)(lds + (bufoff) + ldsw + _i * 8192), 16, 0, 0); } while (0)
#define PG8_LDA(dst, b, h) do { _Pragma("unroll") for (int m = 0; m < 4; ++m) _Pragma("unroll") for (int k = 0; k < 2; ++k) dst[m][k] = *(const PG8_LAS bf16x8*)(lds + PG8_SA(b, h) + aoff + m * 2048 + k * 1024); } while (0)
#define PG8_LDB(dst, b, h) do { _Pragma("unroll") for (int n = 0; n < 2; ++n) _Pragma("unroll") for (int k = 0; k < 2; ++k) dst[n][k] = *(const PG8_LAS bf16x8*)(lds + PG8_SB(b, h) + boff + n * 2048 + k * 1024); } while (0)
#define PG8_MMA(ai, bj, At, Bt) do { __builtin_amdgcn_s_setprio(1); _Pragma("unroll") for (int m = 0; m < 4; ++m) _Pragma("unroll") for (int n = 0; n < 2; ++n) _Pragma("unroll") for (int k = 0; k < 2; ++k) \
        acc[ai][bj][m][n] = __builtin_amdgcn_mfma_f32_16x16x32_bf16(Bt[n][k], At[m][k], acc[ai][bj][m][n], 0, 0, 0); __builtin_amdgcn_s_setprio(0); } while (0)
#define PG8_WAIT_V(n) asm volatile("s_waitcnt vmcnt(" #n ")" ::: "memory")
#define PG8_WAIT_L(n) asm volatile("s_waitcnt lgkmcnt(" #n ")" ::: "memory")
#define PG8_BAR __builtin_amdgcn_s_barrier()
#define PG8_SCHED __builtin_amdgcn_sched_barrier(0)
    Unit cur, nxt; int ui = 0;
    if (!S.next(0, cur)) return;
    float z0 = 0.f; asm volatile("" : "+v"(z0));
    const f32x4 zero4 = {z0, z0, z0, z0};
    f32x4 acc[2][2][4][2];
#pragma unroll
    for (int a = 0; a < 2; ++a)
#pragma unroll
        for (int b = 0; b < 2; ++b)
#pragma unroll
            for (int m = 0; m < 4; ++m)
#pragma unroll
                for (int n = 0; n < 2; ++n) acc[a][b][m][n] = zero4;
    bf16x8 At[4][2], B0[2][2], B1[2][2];
    const char* cA = S.abase(g, cur) + (size_t)cur.pm * tstepA; const char* cB = S.bbase(g, cur) + (size_t)cur.pn * tstepB;
    S.a_ready(cur);
    if constexpr (SP2) {
        PG8_STAGE(PG8_SB(0, 0), cB, voffB); PG8_STAGE(PG8_SB(0, 1), cB + hstepB, voffB); PG8_STAGE(PG8_SA(0, 0), cA, voffA); PG8_STAGE(PG8_SA(0, 1), cA + hstepA, voffA);
        if (wr == 1) PG8_BAR;
        PG8_WAIT_V(2); PG8_BAR;
        PG8_STAGE(PG8_SB(1, 0), cB + kstep, voffB); PG8_STAGE(PG8_SA(1, 0), cA + kstep, voffA); PG8_STAGE(PG8_SB(1, 1), cB + hstepB + kstep, voffB);
        PG8_WAIT_V(6); PG8_BAR;
    } else {
        PG8_STAGE(PG8_SB(0, 0), cB, voffB); PG8_STAGE(PG8_SA(0, 0), cA, voffA); PG8_STAGE(PG8_SB(0, 1), cB + hstepB, voffB); PG8_STAGE(PG8_SA(0, 1), cA + hstepA, voffA);
        if (wr == 1) PG8_BAR;
        PG8_WAIT_V(4); PG8_BAR;
        PG8_STAGE(PG8_SB(1, 0), cB + kstep, voffB); PG8_STAGE(PG8_SA(1, 0), cA + kstep, voffA); PG8_STAGE(PG8_SB(1, 1), cB + hstepB + kstep, voffB);
        PG8_WAIT_V(6); PG8_BAR;
    }
    for (;;) {
        const bool has_next = S.next(ui + 1, nxt);
        const char* nA = has_next ? S.abase(g, nxt) + (size_t)nxt.pm * tstepA : cA; const char* nB = has_next ? S.bbase(g, nxt) + (size_t)nxt.pn * tstepB : cB;
        for (int t = 0; t < nt; t += 2) {
            const bool last = (t == nt - 2);
            const char* a1 = cA + (size_t)(t + 1) * kstep;
            const char* a2 = last ? nA : cA + (size_t)(t + 2) * kstep; const char* b2 = last ? nB : cB + (size_t)(t + 2) * kstep;
            const char* a3 = a2 + kstep; const char* b3 = b2 + kstep;
            if (last && has_next) S.a_ready(nxt);
            if constexpr (SP2) {
            PG8_LDB(B0, 0, 0); PG8_LDB(B1, 0, 1); PG8_SCHED; PG8_LDA(At, 0, 0); PG8_STAGE(PG8_SA(1, 1), a1 + hstepA, voffA);
            PG8_WAIT_V(8); PG8_WAIT_L(0); PG8_BAR; PG8_MMA(0, 0, At, B0); PG8_MMA(0, 1, At, B1); PG8_BAR; PG8_SCHED;
            PG8_LDA(At, 0, 1); PG8_STAGE(PG8_SB(0, 0), b2, voffB); PG8_STAGE(PG8_SB(0, 1), b2 + hstepB, voffB); PG8_STAGE(PG8_SA(0, 0), a2, voffA);
            PG8_WAIT_V(8); PG8_WAIT_L(0); PG8_BAR; PG8_MMA(1, 0, At, B0); PG8_MMA(1, 1, At, B1); PG8_BAR; PG8_SCHED;
            PG8_LDB(B0, 1, 0); PG8_LDB(B1, 1, 1); PG8_SCHED; PG8_LDA(At, 1, 0); PG8_STAGE(PG8_SA(0, 1), a2 + hstepA, voffA);
            PG8_WAIT_V(8); PG8_WAIT_L(0); PG8_BAR; PG8_MMA(0, 0, At, B0); PG8_MMA(0, 1, At, B1); PG8_BAR; PG8_SCHED;
            PG8_LDA(At, 1, 1); PG8_STAGE(PG8_SB(1, 0), b3, voffB); PG8_STAGE(PG8_SB(1, 1), b3 + hstepB, voffB); PG8_STAGE(PG8_SA(1, 0), a3, voffA);
            PG8_WAIT_V(8); PG8_WAIT_L(0); PG8_BAR; PG8_MMA(1, 0, At, B0); PG8_MMA(1, 1, At, B1); PG8_BAR; PG8_SCHED;
            } else {
            PG8_LDB(B0, 0, 0); PG8_SCHED; PG8_LDA(At, 0, 0); PG8_STAGE(PG8_SA(1, 1), a1 + hstepA, voffA);
            PG8_WAIT_L(8); PG8_BAR; PG8_WAIT_L(0); PG8_MMA(0, 0, At, B0); PG8_BAR; PG8_SCHED;
            PG8_LDB(B1, 0, 1); PG8_STAGE(PG8_SB(0, 0), b2, voffB);
            PG8_BAR; PG8_WAIT_L(0); PG8_MMA(0, 1, At, B1); PG8_BAR;
            PG8_LDA(At, 0, 1); PG8_STAGE(PG8_SA(0, 0), a2, voffA);
            PG8_BAR; PG8_WAIT_L(0); PG8_MMA(1, 0, At, B0); PG8_BAR; PG8_SCHED;
            PG8_STAGE(PG8_SB(0, 1), b2 + hstepB, voffB);
            PG8_WAIT_V(6); PG8_BAR; PG8_MMA(1, 1, At, B1); PG8_BAR;
            PG8_LDB(B0, 1, 0); PG8_SCHED; PG8_LDA(At, 1, 0); PG8_STAGE(PG8_SA(0, 1), a2 + hstepA, voffA);
            PG8_WAIT_L(8); PG8_BAR; PG8_WAIT_L(0); PG8_MMA(0, 0, At, B0); PG8_BAR; PG8_SCHED;
            PG8_LDB(B1, 1, 1); PG8_STAGE(PG8_SB(1, 0), b3, voffB);
            PG8_BAR; PG8_WAIT_L(0); PG8_MMA(0, 1, At, B1); PG8_BAR;
            PG8_LDA(At, 1, 1); PG8_STAGE(PG8_SA(1, 0), a3, voffA);
            PG8_BAR; PG8_WAIT_L(0); PG8_MMA(1, 0, At, B0); PG8_BAR; PG8_SCHED;
            PG8_STAGE(PG8_SB(1, 1), b3 + hstepB, voffB);
            PG8_WAIT_V(6); PG8_BAR; PG8_MMA(1, 1, At, B1); PG8_BAR;
            }
        }
        if constexpr (ALIGN_EPI) { if (wr == 0) PG8_BAR; }
        if constexpr (!Epi::AFTER_DRAIN) { E(acc, cur, wr, wc, fr, fq); S.done(cur); }
        if (!has_next) break;
#pragma unroll
        for (int a = 0; a < 2; ++a)
#pragma unroll
            for (int b = 0; b < 2; ++b)
#pragma unroll
                for (int m = 0; m < 4; ++m)
#pragma unroll
                    for (int n = 0; n < 2; ++n) acc[a][b][m][n] = zero4;
        cur = nxt; cA = nA; cB = nB; ++ui;
        if constexpr (ALIGN_EPI) { if (wr == 1) PG8_BAR; }
    }
    PG8_WAIT_V(0);
    if constexpr (!ALIGN_EPI) { if (wr == 0) PG8_BAR; }
    PG8_BAR;
    if constexpr (Epi::AFTER_DRAIN) { E.fused(acc, cur, wr, wc, fr, fq, lds, wid, lane); S.done(cur); }
#undef PG8_SA
#undef PG8_SB
#undef PG8_STAGE
#undef PG8_LDA
#undef PG8_LDB
#undef PG8_MMA
#undef PG8_WAIT_V
#undef PG8_WAIT_L
#undef PG8_BAR
#undef PG8_SCHED
}
}

namespace pg8 {
__device__ __forceinline__ unsigned cvt_pk_bf16(float lo, float hi) { unsigned r; asm volatile("v_cvt_pk_bf16_f32 %0, %1, %2" : "=v"(r) : "v"(lo), "v"(hi)); return r; }

struct EpiBf16 {
    static constexpr bool PERM = true, AFTER_DRAIN = false;
    bf16_t* O; int ldc; size_t oL, oB, oH;
    __device__ __forceinline__ void operator()(const f32x4 (&acc)[2][2][4][2], const Unit& u, int wr, int wc, int fr, int fq) const {
        const int row0 = u.pm * BM + wr * 64 + fr; const int col0 = u.pn * BM + wc * 32 + 8 * fq;
        bf16_t* Ob = O + (size_t)(u.e >> 4) * oL + (size_t)((u.e >> 2) & 3) * oB + (size_t)(u.e & 3) * oH;
#pragma unroll
        for (int ai = 0; ai < 2; ++ai)
#pragma unroll
            for (int m = 0; m < 4; ++m) { bf16_t* rowp = Ob + (size_t)(row0 + ai * HALF + m * 16) * ldc + col0;
#pragma unroll
                for (int bj = 0; bj < 2; ++bj) { const f32x4 v0 = acc[ai][bj][m][0], v1 = acc[ai][bj][m][1];
                    u32x4 w; w.x = cvt_pk_bf16(v0[0], v0[1]); w.y = cvt_pk_bf16(v0[2], v0[3]); w.z = cvt_pk_bf16(v1[0], v1[1]); w.w = cvt_pk_bf16(v1[2], v1[3]);
                    *(u32x4*)(rowp + bj * HALF) = w; } }
    }
};
struct EpiSoftmax {
    static constexpr bool PERM = true, AFTER_DRAIN = false;
    bf16_t* O; int ldc; float scl; PG8_LAS float* xch;
    __device__ __forceinline__ void operator()(f32x4 (&acc)[2][2][4][2], const Unit& u, int wr, int wc, int fr, int fq) const {
        typedef float f32x2v __attribute__((ext_vector_type(2)));
        PG8_LAS float* const xw = xch + ((wr * 64 + fr) * 4 + wc) * 2; const PG8_LAS float* const xr = xch + (wr * 64 + fr) * 8;
        float mxs[2][4];
#pragma unroll
        for (int ai = 0; ai < 2; ++ai)
#pragma unroll
            for (int m = 0; m < 4; ++m) {
                float mx = -INFINITY;
#pragma unroll
                for (int bj = 0; bj < 2; ++bj)
#pragma unroll
                    for (int n = 0; n < 2; ++n) { const f32x4 x = acc[ai][bj][m][n]; mx = fmaxf(mx, fmaxf(fmaxf(x[0], x[1]), fmaxf(x[2], x[3]))); }
                mx = fmaxf(mx, __shfl_xor(mx, 16)); mx = fmaxf(mx, __shfl_xor(mx, 32));
                float s = 0.f;
#pragma unroll
                for (int bj = 0; bj < 2; ++bj)
#pragma unroll
                    for (int n = 0; n < 2; ++n) { f32x4 x = acc[ai][bj][m][n];
#pragma unroll
                        for (int i = 0; i < 4; ++i) { x[i] = __builtin_amdgcn_exp2f((x[i] - mx) * scl); s += x[i]; }
                        acc[ai][bj][m][n] = x; }
                s += __shfl_xor(s, 16); s += __shfl_xor(s, 32);
                mxs[ai][m] = mx;
                if (fq == 0) *(PG8_LAS f32x2v*)(xw + (ai * HALF + m * 16) * 8) = (f32x2v){mx, s};
            }
        asm volatile("s_waitcnt lgkmcnt(0)" ::: "memory"); __builtin_amdgcn_s_barrier(); asm volatile("" ::: "memory");
        const int row0 = u.pm * BM + wr * 64 + fr; const int col0 = u.pn * BM + wc * 32 + 8 * fq;
#pragma unroll
        for (int ai = 0; ai < 2; ++ai)
#pragma unroll
            for (int m = 0; m < 4; ++m) {
                const PG8_LAS f32x4* xp = (const PG8_LAS f32x4*)(xr + (ai * HALF + m * 16) * 8);
                const f32x4 p01 = xp[0], p23 = xp[1];
                const float gm = fmaxf(fmaxf(p01[0], p01[2]), fmaxf(p23[0], p23[2]));
                const float gs = p01[1] * __builtin_amdgcn_exp2f((p01[0] - gm) * scl) + p01[3] * __builtin_amdgcn_exp2f((p01[2] - gm) * scl) + p23[1] * __builtin_amdgcn_exp2f((p23[0] - gm) * scl) + p23[3] * __builtin_amdgcn_exp2f((p23[2] - gm) * scl);
                const float f = __builtin_amdgcn_exp2f((mxs[ai][m] - gm) * scl) / gs;
                bf16_t* rowp = O + (size_t)(row0 + ai * HALF + m * 16) * ldc + col0;
#pragma unroll
                for (int bj = 0; bj < 2; ++bj) { const f32x4 v0 = acc[ai][bj][m][0] * f, v1 = acc[ai][bj][m][1] * f;
                    u32x4 w; w.x = cvt_pk_bf16(v0[0], v0[1]); w.y = cvt_pk_bf16(v0[2], v0[3]); w.z = cvt_pk_bf16(v1[0], v1[1]); w.w = cvt_pk_bf16(v1[2], v1[3]);
                    *(u32x4*)(rowp + bj * HALF) = w; }
            }
    }
};
struct EpiF32Res {
    static constexpr bool PERM = false, AFTER_DRAIN = false;
    float* out; const float* res32; const bf16_t* res16; int ldc; float alpha;
    __device__ __forceinline__ void operator()(const f32x4 (&acc)[2][2][4][2], const Unit& u, int wr, int wc, int fr, int fq) const {
        const int row0 = u.pm * BM + wr * 64 + fr; const int col0 = u.pn * BM + wc * 32 + 4 * fq;
#pragma unroll
        for (int ai = 0; ai < 2; ++ai)
#pragma unroll
            for (int m = 0; m < 4; ++m) { const size_t off = (size_t)(row0 + ai * HALF + m * 16) * ldc + col0;
#pragma unroll
                for (int bj = 0; bj < 2; ++bj)
#pragma unroll
                    for (int n = 0; n < 2; ++n) { f32x4 v = acc[ai][bj][m][n]; const size_t o2 = off + bj * HALF + n * 16;
                        if (res32) { const f32x4 r = *(const f32x4*)(res32 + o2); v = v + r * alpha; }
                        else if (res16) { const u32x2 r = *(const u32x2*)(res16 + o2); v[0] += alpha * __uint_as_float(r.x << 16); v[1] += alpha * __uint_as_float(r.x & 0xffff0000u); v[2] += alpha * __uint_as_float(r.y << 16); v[3] += alpha * __uint_as_float(r.y & 0xffff0000u); }
                        *(f32x4*)(out + o2) = v; } }
    }
};
struct EpiSwiglu {
    static constexpr bool PERM = true, AFTER_DRAIN = false;
    bf16_t* H; int ldh;
    __device__ __forceinline__ void operator()(const f32x4 (&acc)[2][2][4][2], const Unit& u, int wr, int wc, int fr, int fq) const {
        const int row0 = u.pm * BM + wr * 64 + fr; const int col0 = u.pn * BM + wc * 32 + 8 * fq;
#pragma unroll
        for (int ai = 0; ai < 2; ++ai)
#pragma unroll
            for (int m = 0; m < 4; ++m) { bf16_t* rowp = H + (size_t)(row0 + ai * HALF + m * 16) * ldh;
#pragma unroll
                for (int bj = 0; bj < 2; ++bj) { const f32x4 v0 = acc[ai][bj][m][0], v1 = acc[ai][bj][m][1];
                    const float h0 = v0[0] / (1.0f + __expf(-v0[0])) * v0[1], h1 = v0[2] / (1.0f + __expf(-v0[2])) * v0[3];
                    const float h2 = v1[0] / (1.0f + __expf(-v1[0])) * v1[1], h3 = v1[2] / (1.0f + __expf(-v1[2])) * v1[3];
                    u32x2 w; w.x = cvt_pk_bf16(h0, h1); w.y = cvt_pk_bf16(h2, h3);
                    *(u32x2*)(rowp + ((col0 + bj * HALF) >> 1)) = w; } }
    }
};
struct GroupedOrder : StaticOrder {
    int pend[8]; size_t estride;
    __device__ __forceinline__ const char* bbase(const Gemm& g, const Unit& u) const {
        int e = 0;
#pragma unroll
        for (int k = 0; k < 7; ++k) e += (u.pm >= pend[k]) ? 1 : 0;
        return (const char*)g.Bt + (size_t)e * estride;
    }
};
struct BatchedOrder {
    int nM, per, nwg, G, c; size_t aL, aB, aH, bL, bB, bH;
    __device__ __forceinline__ void init(int nM_, int nN_, int nprob, int G_, int c_) { nM = nM_; per = nM_ * nN_; nwg = per * nprob; G = G_; c = c_; }
    __device__ __forceinline__ bool next(int i, Unit& u) const { const long L = (long)i * G + c; if (L >= nwg) return false; const int e = (int)(L / per), r = (int)(L % per); u.e = e; u.pm = r % nM; u.pn = r / nM; return true; }
    __device__ __forceinline__ void a_ready(const Unit&) const {}
    __device__ __forceinline__ void done(const Unit&) const {}
    __device__ __forceinline__ const char* abase(const Gemm& g, const Unit& u) const { return (const char*)g.A + (size_t)(u.e >> 4) * aL + (size_t)((u.e >> 2) & 3) * aB + (size_t)(u.e & 3) * aH; }
    __device__ __forceinline__ const char* bbase(const Gemm& g, const Unit& u) const { return (const char*)g.Bt + (size_t)(u.e >> 4) * bL + (size_t)((u.e >> 2) & 3) * bB + (size_t)(u.e & 3) * bH; }
};
}
#define XB_TMO      128
#define XB_XCNT(j)  (256  + 64 * (j))
#define XB_XSUB(j)  (1280 + 64 * (j))
#define XB_XGEN(j)  (2304 + 64 * (j))
#define XB_TOP      3328
#define XB_TOPGEN   3392
#define XCD_BAR_WORDS 3456
#define XB_SPIN_CAP (1u << 18)

__device__ __forceinline__ unsigned xb_ld(unsigned* p)              { return __hip_atomic_load(p, __ATOMIC_RELAXED, __HIP_MEMORY_SCOPE_AGENT); }
__device__ __forceinline__ unsigned xb_add(unsigned* p, unsigned v) { return __hip_atomic_fetch_add(p, v, __ATOMIC_RELAXED, __HIP_MEMORY_SCOPE_AGENT); }
__device__ __forceinline__ unsigned xb_xcc_id() { return (unsigned)__builtin_amdgcn_s_getreg((3 << 11) | 20) & 0xFu; }
#define XB_SPIN(cond, bar) do { unsigned _sp = 0; while (cond) { __builtin_amdgcn_s_sleep(1); \
    if ((++_sp & 255u) == 0u) { if (xb_ld(&(bar)[XB_TMO])) break; if (_sp > XB_SPIN_CAP) { atomicAdd(&(bar)[XB_TMO], 1u); break; } } } } while (0)

struct XcdBarrier {
    unsigned* bar; unsigned x;
    volatile LAS unsigned* st;
};

__device__ __forceinline__ XcdBarrier xcd_barrier_post(unsigned* bar, volatile LAS unsigned* st) {
    XcdBarrier b; b.bar = bar; b.x = xb_xcc_id(); b.st = st;
    if (threadIdx.x == 0) (void)xb_add(&bar[XB_XCNT(b.x)], 1u);
    return b;
}
__device__ __forceinline__ void xcd_barrier_complete(unsigned* bar, unsigned x, unsigned& nloc, unsigned& nx) {
    const unsigned G = gridDim.x * gridDim.y * gridDim.z;
    unsigned sum, cnt, mine, sp = 0u;
    for (;;) {
        sum = 0u; cnt = 0u; mine = 0u;
#pragma unroll
        for (unsigned j = 0; j < 16; ++j) { const unsigned c = xb_ld(&bar[XB_XCNT(j)]); sum += c; cnt += (c > 0u) ? 1u : 0u; mine = (j == x) ? c : mine; }
        if (sum == G) break;
        __builtin_amdgcn_s_sleep(1);
        if ((++sp & 255u) == 0u) { if (xb_ld(&bar[XB_TMO])) break; if (sp > XB_SPIN_CAP) { atomicAdd(&bar[XB_TMO], 1u); break; } }
    }
    nloc = mine > 0u ? mine : 1u; nx = cnt > 0u ? cnt : 1u;
}

__device__ __forceinline__ void xcd_barrier(const XcdBarrier& b) {
    asm volatile("s_waitcnt vmcnt(0)" ::: "memory");
    __syncthreads();
    if (threadIdx.x == 0) {
        unsigned* bar = b.bar;
        __builtin_amdgcn_s_waitcnt(0);
        unsigned nloc = b.st[0], nx = b.st[1];
        if (nloc == 0u) { xcd_barrier_complete(bar, b.x, nloc, nx); b.st[0] = nloc; b.st[1] = nx; }
        const unsigned old = xb_add(&bar[XB_XSUB(b.x)], 1u);
        const unsigned gen = old / nloc;
        if (old + 1u == (gen + 1u) * nloc) {
            __builtin_amdgcn_fence(__ATOMIC_RELEASE, "agent");
            asm volatile("s_waitcnt vmcnt(0)" ::: "memory");
            const unsigned og = xb_add(&bar[XB_TOP], 1u);
            const unsigned tg = og / nx;
            if (og + 1u == (tg + 1u) * nx) xb_add(&bar[XB_TOPGEN], 1u);
            else XB_SPIN(xb_ld(&bar[XB_TOPGEN]) == tg, bar);
            __builtin_amdgcn_fence(__ATOMIC_ACQUIRE, "agent");
            xb_add(&bar[XB_XGEN(b.x)], 1u);
            asm volatile("s_waitcnt vmcnt(0)" ::: "memory");
        } else {
            XB_SPIN(xb_ld(&bar[XB_XGEN(b.x)]) == gen, bar);
            __builtin_amdgcn_fence(__ATOMIC_ACQUIRE, "agent");
            asm volatile("s_waitcnt vmcnt(0)" ::: "memory");
        }
    }
    __syncthreads();
}

struct Params { const float* in[35]; float* out; unsigned char* ws; int ph_lo, ph_hi, dbg, pad; };
enum { I_X = 0, I_MEM, I_WIN, I_POOLW, I_POOLS, I_PEK, I_KW1, I_KW2, I_PEV, I_VW1, I_VW2, I_SLNG, I_SLNB, I_SGUW, I_SGUB, I_CONVW, I_CONVB, I_CLNG, I_CLNB, I_CONVPW,
       I_WOUT, I_LN1G, I_LN1B, I_XQ, I_XKV, I_XO, I_LN2G, I_LN2B, I_W13, I_W2, I_ROUTER, I_E13, I_E2, I_LN3G, I_LN3B };

struct Ctx {
    const float* in[35];
    float* X;
    bf16 *XB, *Z, *Y, *Q, *H, *XG, *KC, *VC, *MEMB, *KVROW, *W1X, *W2X, *KCF, *VCF, *KSELF, *VSELF, *KWINF, *VWINF;
    bf16 *WINT, *WOUTT, *XQT, *XKVT, *XOT, *W13T, *W2T, *E13T, *E2T, *CW1T, *CW2T, *PWT, *POOLWT, *SGUWB;
    float *VBUF, *FS, *PEB, *TOKG;
    int *HIST, *META, *TOKPOS; unsigned* TOKINFO;
    int tid, lane, wid, bid, G;
};

struct MatDesc { const float* src; bf16* dst; int K, N, Npad, split; };
__device__ __forceinline__ void get_mat(const Ctx& C, int id, MatDesc& d) {
    d.split = 0;
    if (id < 56) {
        const int l = id / 14, k = id % 14;
        if (k == 0)      { d.src = C.in[I_WIN] + (size_t)l * D * DIN;  d.dst = C.WINT + (size_t)l * DINP * D;  d.K = D; d.N = DIN; d.Npad = DINP; }
        else if (k == 1) { d.src = C.in[I_WOUT] + (size_t)l * D * D;   d.dst = C.WOUTT + (size_t)l * D * D;    d.K = D; d.N = D; d.Npad = D; }
        else if (k == 2) { d.src = C.in[I_XQ] + (size_t)l * D * D;     d.dst = C.XQT + (size_t)l * D * D;      d.K = 0; d.N = D; d.Npad = D; }
        else if (k == 3) { d.src = C.in[I_XKV] + (size_t)l * D * 2 * D; d.dst = C.XKVT + (size_t)l * 2 * D * D; d.K = D; d.N = 2 * D; d.Npad = 2 * D; }
        else if (k == 4) { d.src = C.in[I_XO] + (size_t)l * D * D;     d.dst = C.XOT + (size_t)l * D * D;      d.K = D; d.N = D; d.Npad = D; }
        else if (k == 5) { d.src = C.in[I_KW1] + (size_t)l * 2048 * 256; d.dst = C.CW1T + (size_t)(l * 2 + 0) * 256 * 2048; d.K = 2048; d.N = 256; d.Npad = 256; }
        else if (k == 6) { d.src = C.in[I_VW1] + (size_t)l * 2048 * 256; d.dst = C.CW1T + (size_t)(l * 2 + 1) * 256 * 2048; d.K = 2048; d.N = 256; d.Npad = 256; }
        else if (k == 7) { d.src = C.in[I_KW2] + (size_t)l * 256 * 64; d.dst = C.CW2T + (size_t)(l * 2 + 0) * 64 * 256; d.K = 256; d.N = 64; d.Npad = 64; }
        else if (k == 8) { d.src = C.in[I_VW2] + (size_t)l * 256 * 64; d.dst = C.CW2T + (size_t)(l * 2 + 1) * 64 * 256; d.K = 256; d.N = 64; d.Npad = 64; }
        else if (k == 9) { d.src = C.in[I_CONVPW] + (size_t)l * 256 * 256; d.dst = C.PWT + (size_t)l * 256 * 256; d.K = 256; d.N = 256; d.Npad = 256; }
        else { const int g = k - 10; d.src = C.in[I_POOLW] + (size_t)(l * 4 + g) * 64 * 64; d.dst = C.POOLWT + (size_t)(l * 4 + g) * 64 * 64; d.K = 64; d.N = 64; d.Npad = 64; }
    } else if (id < 60) {
        const int i = (id - 56) >> 1, w = (id - 56) & 1;
        if (w == 0) { d.src = C.in[I_W13] + (size_t)i * D * 2 * FF; d.dst = C.W13T + (size_t)i * 2 * FF * D; d.K = D; d.N = 2 * FF; d.Npad = 2 * FF; d.split = FF; }
        else        { d.src = C.in[I_W2] + (size_t)i * FF * D;      d.dst = C.W2T + (size_t)i * D * FF;      d.K = FF; d.N = D; d.Npad = D; }
    } else {
        const int j = id - 60, ie = j >> 1, w = j & 1;
        if (w == 0) { d.src = C.in[I_E13] + (size_t)ie * D * 2 * FE; d.dst = C.E13T + (size_t)ie * 2 * FE * D; d.K = D; d.N = 2 * FE; d.Npad = 2 * FE; d.split = FE; }
        else        { d.src = C.in[I_E2] + (size_t)ie * FE * D;      d.dst = C.E2T + (size_t)ie * D * FE;      d.K = FE; d.N = D; d.Npad = D; }
    }
}
__device__ __forceinline__ void transpose_item(const MatDesc& d, LAS float* scr, int item, int lane) {
    const int nblk = d.Npad / 32, kb = item / nblk, nb = item % nblk, k0 = 64 * kb, n0 = 32 * nb;
    const int ncol = n0 + 4 * (lane & 7); const bool ok = ncol < d.N;
    f32x4 v[8];
#pragma unroll
    for (int i = 0; i < 8; ++i) { const int kk = 8 * i + (lane >> 3); v[i] = ok ? *(const f32x4*)(d.src + (size_t)(k0 + kk) * d.N + ncol) : (f32x4){0.f, 0.f, 0.f, 0.f}; }
#pragma unroll
    for (int i = 0; i < 8; ++i) { const int kk = 8 * i + (lane >> 3); LAS float* p = scr + kk * 33 + 4 * (lane & 7); p[0] = v[i][0]; p[1] = v[i][1]; p[2] = v[i][2]; p[3] = v[i][3]; }
    LDS_WAIT();
    const int c = lane & 7;
#pragma unroll
    for (int j = 0; j < 4; ++j) { const int n = (lane >> 3) + 8 * j; const LAS float* s = scr + (8 * c) * 33 + n;
        u32x4 o; o.x = pk2(s[0 * 33], s[1 * 33]); o.y = pk2(s[2 * 33], s[3 * 33]); o.z = pk2(s[4 * 33], s[5 * 33]); o.w = pk2(s[6 * 33], s[7 * 33]);
        const int ng = n0 + n; const int drow = d.split ? (ng < d.split ? 2 * ng : 2 * (ng - d.split) + 1) : ng;
        *(u32x4*)(d.dst + (size_t)drow * d.K + k0 + 8 * c) = o; }
    LDS_WAIT();
}
__device__ __forceinline__ void p0_prologue(const Ctx& C, LAS unsigned char* lds) {
    LAS float* scr = (LAS float*)(lds + C.wid * 8704);
    const int gw = C.bid * NWAVES + C.wid, NGW = C.G * NWAVES;
    int start = 0;
    for (int id = 0; id < 92; ++id) {
        MatDesc d; get_mat(C, id, d);
        const int ntiles = (d.K / 64) * (d.Npad / 32);
        int first = gw - start; if (first < 0) first += NGW;
        for (int it = first; it < ntiles; it += NGW) transpose_item(d, scr, it, C.lane);
        start = (start + ntiles) % NGW;
    }
    const int gt = C.bid * NTHREADS + C.tid, NGT = C.G * NTHREADS;
    { const f32x4* xs = (const f32x4*)C.in[I_X]; u32x4* xd = (u32x4*)C.XB;
      for (int i = gt; i < M * D / 8; i += NGT) { const f32x4 a = xs[2 * i], b = xs[2 * i + 1]; u32x4 o; o.x = pk2(a[0], a[1]); o.y = pk2(a[2], a[3]); o.z = pk2(b[0], b[1]); o.w = pk2(b[2], b[3]); xd[i] = o; } }
    { const f32x4* xs = (const f32x4*)C.in[I_MEM]; u32x4* xd = (u32x4*)C.MEMB;
      for (int i = gt; i < NB * MEM * D / 8; i += NGT) { const f32x4 a = xs[2 * i], b = xs[2 * i + 1]; u32x4 o; o.x = pk2(a[0], a[1]); o.y = pk2(a[2], a[3]); o.z = pk2(b[0], b[1]); o.w = pk2(b[2], b[3]); xd[i] = o; } }
    { const f32x4* xs = (const f32x4*)C.in[I_XQ]; u32x4* xd = (u32x4*)C.XQT;
      for (int i = gt; i < NL * D * D / 8; i += NGT) { const f32x4 a = xs[2 * i], b = xs[2 * i + 1]; u32x4 o; o.x = pk2(a[0], a[1]); o.y = pk2(a[2], a[3]); o.z = pk2(b[0], b[1]); o.w = pk2(b[2], b[3]); xd[i] = o; } }
    { const f32x4* ws = (const f32x4*)C.in[I_SGUW]; u32x4* wd = (u32x4*)C.SGUWB;
      for (int i = gt; i < NL * 4 * 128 * 128 / 8; i += NGT) { const int j0 = (i & 15) * 8, ii = (i >> 4) & 127; const f32x4 a = ws[2 * i], b = ws[2 * i + 1];
          float v[8] = {a[0], a[1], a[2], a[3], b[0], b[1], b[2], b[3]};
#pragma unroll
          for (int e = 0; e < 8; ++e) v[e] = (j0 + e <= ii) ? v[e] : 0.f;
          u32x4 o; o.x = pk2(v[0], v[1]); o.y = pk2(v[2], v[3]); o.z = pk2(v[4], v[5]); o.w = pk2(v[6], v[7]); wd[i] = o; } }
    for (int o = gw; o < NL * 2 * 256; o += NGW) { const int n = o & 255, kv = (o >> 8) & 1, l = o >> 9;
        const float* pe = C.in[kv ? I_PEV : I_PEK] + (size_t)l * 2048; const float* w1 = C.in[kv ? I_VW1 : I_KW1] + (size_t)l * 2048 * 256;
        float s = 0.f;
        for (int k = C.lane; k < 2048; k += 64) s += pe[k] * w1[(size_t)k * 256 + n];
        s = wave_sum(s); if (C.lane == 0) C.PEB[o] = s; }
}

__device__ __forceinline__ void ln_phase(const Ctx& C, const float* src, const float* gam, const float* bet, int mode, const float* router, float* xout, LAS unsigned char* lds) {
    LAS float* rwT = (LAS float*)lds;
    LAS int* te = (LAS int*)(lds + 32768);
    LAS float* tgl = (LAS float*)(lds + 32768 + 1024);
    if (router) { for (int i = C.tid; i < 8192; i += NTHREADS) rwT[(i & 7) * 1024 + (i >> 3)] = router[i]; __syncthreads(); }
    f32x4 g4[4], b4[4];
#pragma unroll
    for (int j = 0; j < 4; ++j) { g4[j] = *(const f32x4*)(gam + 256 * j + 4 * C.lane); b4[j] = *(const f32x4*)(bet + 256 * j + 4 * C.lane); }
    for (int tile = C.bid; tile < M / 128; tile += C.G) {
        for (int i = 0; i < 16; ++i) {
            const int tl = 16 * C.wid + i; const size_t row = (size_t)tile * 128 + tl;
            f32x4 v[4];
            if (mode == 0) {
#pragma unroll
                for (int j = 0; j < 4; ++j) v[j] = *(const f32x4*)(src + row * D + 256 * j + 4 * C.lane);
            } else {
                const int p0 = C.TOKPOS[2 * row], p1 = C.TOKPOS[2 * row + 1]; const float g0 = C.TOKG[2 * row], g1 = C.TOKG[2 * row + 1];
#pragma unroll
                for (int j = 0; j < 4; ++j) { const u32x2 xr = *(const u32x2*)(C.XB + row * D + 256 * j + 4 * C.lane); const f32x4 x = {lo16(xr.x), hi16(xr.x), lo16(xr.y), hi16(xr.y)};
                    const f32x4 a = *(const f32x4*)(C.FS + (size_t)p0 * D + 256 * j + 4 * C.lane), b = *(const f32x4*)(C.FS + (size_t)p1 * D + 256 * j + 4 * C.lane);
                    v[j] = x * ALPHA + a * g0 + b * g1; }
            }
            float s = 0.f;
#pragma unroll
            for (int j = 0; j < 4; ++j) s += (v[j][0] + v[j][1]) + (v[j][2] + v[j][3]);
            const float mean = wave_sum(s) * (1.f / D); float s2 = 0.f;
#pragma unroll
            for (int j = 0; j < 4; ++j) { v[j] = v[j] - mean; s2 += (v[j][0] * v[j][0] + v[j][1] * v[j][1]) + (v[j][2] * v[j][2] + v[j][3] * v[j][3]); }
            const float rstd = 1.0f / sqrtf(wave_sum(s2) * (1.f / D) + LN_EPS);
#pragma unroll
            for (int j = 0; j < 4; ++j) { v[j] = v[j] * rstd * g4[j] + b4[j];
                if (xout) *(f32x4*)(xout + row * D + 256 * j + 4 * C.lane) = v[j];
                u32x2 o; o.x = pk2(v[j][0], v[j][1]); o.y = pk2(v[j][2], v[j][3]); *(u32x2*)(C.XB + row * D + 256 * j + 4 * C.lane) = o; }
            if (router) {
                float lg[8];
#pragma unroll
                for (int ex = 0; ex < 8; ++ex) { float a = 0.f;
#pragma unroll
                    for (int j = 0; j < 4; ++j) { const f32x4 w = *(const LAS f32x4*)(rwT + ex * 1024 + 256 * j + 4 * C.lane); a += (v[j][0] * w[0] + v[j][1] * w[1]) + (v[j][2] * w[2] + v[j][3] * w[3]); }
                    lg[ex] = wave_sum(a); }
                int e0 = 0; float l0 = lg[0];
#pragma unroll
                for (int ex = 1; ex < 8; ++ex) if (lg[ex] > l0) { l0 = lg[ex]; e0 = ex; }
                int e1 = -1; float l1 = -INFINITY;
#pragma unroll
                for (int ex = 0; ex < 8; ++ex) if (ex != e0 && lg[ex] > l1) { l1 = lg[ex]; e1 = ex; }
                const float ed = __expf(l1 - l0), ga = 1.0f / (1.0f + ed), gb = ed * ga;
                if (C.lane == 0) { te[2 * tl] = e0; te[2 * tl + 1] = e1; tgl[2 * tl] = ga; tgl[2 * tl + 1] = gb; }
            }
        }
        if (router) {
            __syncthreads();
            if (C.wid == 0) {
                int run[8];
#pragma unroll
                for (int ex = 0; ex < 8; ++ex) run[ex] = 0;
                for (int rr = 0; rr < 4; ++rr) { const int a = 64 * rr + C.lane; const int e = te[a]; int rank = 0;
#pragma unroll
                    for (int ex = 0; ex < 8; ++ex) { const unsigned long long mk = __ballot(e == ex); if (e == ex) rank = run[ex] + __popcll(mk & ((1ull << C.lane) - 1ull)); run[ex] += __popcll(mk); }
                    C.TOKINFO[(size_t)tile * 256 + a] = (unsigned)e | ((unsigned)rank << 8); C.TOKG[(size_t)tile * 256 + a] = tgl[a]; }
#pragma unroll
                for (int ex = 0; ex < 8; ++ex) if (C.lane == ex) C.HIST[tile * 8 + ex] = run[ex];
            }
            __syncthreads();
        }
    }
}

struct ConvW { f32x4 w[31]; f32x4 cb, lg, lb; };
__device__ __forceinline__ void load_convw(const Ctx& C, int l, ConvW& cw) {
#pragma unroll
    for (int k = 0; k < 31; ++k) cw.w[k] = *(const f32x4*)(C.in[I_CONVW] + ((size_t)l * 31 + k) * 256 + 4 * C.lane);
    cw.cb = *(const f32x4*)(C.in[I_CONVB] + l * 256 + 4 * C.lane); cw.lg = *(const f32x4*)(C.in[I_CLNG] + l * 256 + 4 * C.lane); cw.lb = *(const f32x4*)(C.in[I_CLNB] + l * 256 + 4 * C.lane);
}
template <int WHICH>
__device__ __forceinline__ void mixers_tile(const Ctx& C, int l, int tb, LAS unsigned char* lds, const ConvW& cw) {
    const int tid = C.tid, wid = C.wid, lane = C.lane;
    const int b = tb >> 6, t0 = (tb & 63) << 7; const size_t R0 = (size_t)b * T + t0;
    const bf16* Zb = C.Z + (size_t)b * T * DINP;
    const int m16 = lane & 15, gq = lane >> 4, row = 16 * wid + m16;
    if constexpr ((WHICH & 1) != 0) {
        LAS bf16* Dl = (LAS bf16*)lds;
#pragma unroll
        for (int g = 0; g < 4; ++g) {
            constexpr int W4[4] = {2, 4, 8, 16}; const int w = W4[g];
            for (int it = tid; it < 128 * 8; it += NTHREADS) {
                const int tl = it >> 3, c8 = 8 * g + (it & 7), t = t0 + tl, n = (t + 1 < w) ? (t + 1) : w;
                float s[8];
#pragma unroll
                for (int e2 = 0; e2 < 8; ++e2) s[e2] = 0.f;
                u32x4 cur = {0u, 0u, 0u, 0u};
#pragma unroll
                for (int k = 0; k < W4[g]; ++k) {
                    u32x4 v = {0u, 0u, 0u, 0u};
                    if (k < n) v = *(const u32x4*)(Zb + (size_t)(t - k) * DINP + C_POOL + 8 * c8);
                    if (k == 0) cur = v;
                    s[0] += lo16(v.x); s[1] += hi16(v.x); s[2] += lo16(v.y); s[3] += hi16(v.y); s[4] += lo16(v.z); s[5] += hi16(v.z); s[6] += lo16(v.w); s[7] += hi16(v.w);
                }
                const float inv = 1.0f / (float)n;
                u32x4 o; o.x = pk2(s[0] * inv - lo16(cur.x), s[1] * inv - hi16(cur.x)); o.y = pk2(s[2] * inv - lo16(cur.y), s[3] * inv - hi16(cur.y));
                o.z = pk2(s[4] * inv - lo16(cur.z), s[5] * inv - hi16(cur.z)); o.w = pk2(s[6] * inv - lo16(cur.w), s[7] * inv - hi16(cur.w));
                *(LAS u32x4*)(Dl + tl * 264 + 8 * c8) = o;
            }
        }
        __syncthreads();
#pragma unroll
        for (int g = 0; g < 4; ++g) {
            bf16x8 a[2];
#pragma unroll
            for (int s = 0; s < 2; ++s) a[s] = *(const LAS bf16x8*)(Dl + row * 264 + g * 64 + 32 * s + 8 * gq);
#pragma unroll
            for (int nt = 0; nt < 4; ++nt) {
                f32x4 acc = {0.f, 0.f, 0.f, 0.f};
#pragma unroll
                for (int s = 0; s < 2; ++s) { const bf16x8 bfr = *(const bf16x8*)(C.POOLWT + ((size_t)((l * 4 + g) * 64 + 16 * nt + m16)) * 64 + 32 * s + 8 * gq); acc = mfma16(bfr, a[s], acc); }
                const int col = g * 64 + 16 * nt + 4 * gq;
                const f32x4 sc = *(const f32x4*)(C.in[I_POOLS] + l * 256 + col);
                u32x2 o; o.x = pk2(acc[0] * sc[0], acc[1] * sc[1]); o.y = pk2(acc[2] * sc[2], acc[3] * sc[3]);
                *(u32x2*)(C.Y + (R0 + row) * D + col) = o;
            }
        }
        __syncthreads();
    }
    if constexpr ((WHICH & 2) != 0) {
        LAS bf16* VnT = (LAS bf16*)lds;
        const f32x4 lg = *(const f32x4*)(C.in[I_SLNG] + l * 256 + 4 * lane), lb = *(const f32x4*)(C.in[I_SLNB] + l * 256 + 4 * lane);
        u32x2 vpre[16];
#pragma unroll
        for (int i = 0; i < 16; ++i) vpre[i] = *(const u32x2*)(C.Z + (R0 + 16 * wid + i) * DINP + C_V + 4 * lane);
#pragma unroll
        for (int i = 0; i < 16; ++i) {
            const int tl = 16 * wid + i;
            const u32x2 v = vpre[i];
            const float x0 = gelu_tanh(lo16(v.x)), x1 = gelu_tanh(hi16(v.x)), x2 = gelu_tanh(lo16(v.y)), x3 = gelu_tanh(hi16(v.y));
            const float mean = wave_sum((x0 + x1) + (x2 + x3)) * (1.f / 256.f);
            const float d0 = x0 - mean, d1 = x1 - mean, d2 = x2 - mean, d3 = x3 - mean;
            const float rstd = 1.0f / sqrtf(wave_sum((d0 * d0 + d1 * d1) + (d2 * d2 + d3 * d3)) * (1.f / 256.f) + LN_EPS);
            VnT[(4 * lane + 0) * 136 + tl] = (bf16)f2bf(d0 * rstd * lg[0] + lb[0]); VnT[(4 * lane + 1) * 136 + tl] = (bf16)f2bf(d1 * rstd * lg[1] + lb[1]);
            VnT[(4 * lane + 2) * 136 + tl] = (bf16)f2bf(d2 * rstd * lg[2] + lb[2]); VnT[(4 * lane + 3) * 136 + tl] = (bf16)f2bf(d3 * rstd * lg[3] + lb[3]);
        }
        __syncthreads();
        const int ns = (wid >> 1) + 1;
#pragma unroll
        for (int g = 0; g < 4; ++g) {
            f32x4 acc[4];
#pragma unroll
            for (int nt = 0; nt < 4; ++nt) acc[nt] = (f32x4){0.f, 0.f, 0.f, 0.f};
#pragma unroll
            for (int s = 0; s < 4; ++s) if (s < ns) {
                const bf16x8 a = *(const bf16x8*)(C.SGUWB + ((size_t)((l * 4 + g) * 128 + row)) * 128 + 32 * s + 8 * gq);
#pragma unroll
                for (int nt = 0; nt < 4; ++nt) { const bf16x8 bfr = *(const LAS bf16x8*)(VnT + (g * 64 + 16 * nt + m16) * 136 + 32 * s + 8 * gq); acc[nt] = mfma16(bfr, a, acc[nt]); }
            }
            const float bs = C.in[I_SGUB][(l * 4 + g) * 128 + row];
#pragma unroll
            for (int nt = 0; nt < 4; ++nt) {
                const int col = g * 64 + 16 * nt + 4 * gq;
                const u32x2 uu = *(const u32x2*)(C.Z + (R0 + row) * DINP + C_U + col);
                const float u0 = gelu_tanh(lo16(uu.x)), u1 = gelu_tanh(hi16(uu.x)), u2 = gelu_tanh(lo16(uu.y)), u3 = gelu_tanh(hi16(uu.y));
                u32x2 o; o.x = pk2(u0 * (acc[nt][0] + bs), u1 * (acc[nt][1] + bs)); o.y = pk2(u2 * (acc[nt][2] + bs), u3 * (acc[nt][3] + bs));
                *(u32x2*)(C.Y + (R0 + row) * D + 512 + col) = o;
            }
        }
        __syncthreads();
    }
    if constexpr ((WHICH & 4) != 0) {
        LAS bf16* Hg = (LAS bf16*)lds;
        LAS unsigned char* Hn = lds + 158 * 528;
        for (int it0 = tid; it0 < 158 * 64; it0 += 4 * NTHREADS) {
            u32x2 av[4], gv[4];
#pragma unroll
            for (int u = 0; u < 4; ++u) { const int it = it0 + u * NTHREADS; const int r = it >> 6, c4 = it & 63, t = t0 - 30 + r; av[u] = (u32x2){0u, 0u}; gv[u] = (u32x2){0u, 0u};
                if (it < 158 * 64 && t >= 0) { const bf16* zr = Zb + (size_t)t * DINP; av[u] = *(const u32x2*)(zr + C_CA + 4 * c4); gv[u] = *(const u32x2*)(zr + C_CG + 4 * c4); } }
#pragma unroll
            for (int u = 0; u < 4; ++u) { const int it = it0 + u * NTHREADS; const int r = it >> 6, c4 = it & 63;
                if (it < 158 * 64) { u32x2 o; o.x = pk2(lo16(av[u].x) * sigmoidf_(lo16(gv[u].x)), hi16(av[u].x) * sigmoidf_(hi16(gv[u].x))); o.y = pk2(lo16(av[u].y) * sigmoidf_(lo16(gv[u].y)), hi16(av[u].y) * sigmoidf_(hi16(gv[u].y)));
                    *(LAS u32x2*)(Hg + r * 264 + 4 * c4) = o; } }
        }
        __syncthreads();
        {
            const f32x4 cb = cw.cb, lg = cw.lg, lb = cw.lb;
#pragma unroll 1
            for (int i = 0; i < 16; ++i) {
                const int tl = 16 * wid + i;
                f32x4 acc = cb;
#pragma unroll
                for (int k = 0; k < 31; ++k) {
                    const u32x2 h = *(const LAS u32x2*)(Hg + (tl + k) * 264 + 4 * lane);
                    acc[0] += cw.w[k][0] * lo16(h.x); acc[1] += cw.w[k][1] * hi16(h.x); acc[2] += cw.w[k][2] * lo16(h.y); acc[3] += cw.w[k][3] * hi16(h.y); }
                const float mean = wave_sum((acc[0] + acc[1]) + (acc[2] + acc[3])) * (1.f / 256.f);
                const float d0 = acc[0] - mean, d1 = acc[1] - mean, d2 = acc[2] - mean, d3 = acc[3] - mean;
                const float rstd = 1.0f / sqrtf(wave_sum((d0 * d0 + d1 * d1) + (d2 * d2 + d3 * d3)) * (1.f / 256.f) + LN_EPS);
                const float y0 = siluf_(d0 * rstd * lg[0] + lb[0]), y1 = siluf_(d1 * rstd * lg[1] + lb[1]), y2 = siluf_(d2 * rstd * lg[2] + lb[2]), y3 = siluf_(d3 * rstd * lg[3] + lb[3]);
                u32x2 o; o.x = pk2(y0, y1); o.y = pk2(y2, y3);
                *(LAS u32x2*)(Hn + tl * 512 + (((lane >> 1) ^ (tl & 15)) << 4) + ((lane & 1) << 3)) = o;
            }
        }
        __syncthreads();
#pragma unroll 1
        for (int nh = 0; nh < 2; ++nh) {
            f32x4 acc[8];
#pragma unroll
            for (int nt = 0; nt < 8; ++nt) acc[nt] = (f32x4){0.f, 0.f, 0.f, 0.f};
            const bf16* pw = C.PWT + ((size_t)(l * 256 + 128 * nh + m16)) * 256 + 8 * gq;
#pragma unroll 2
            for (int s = 0; s < 8; ++s) {
                const bf16x8 a = *(const LAS bf16x8*)(Hn + row * 512 + (((4 * s + gq) ^ (row & 15)) << 4));
#pragma unroll
                for (int nt = 0; nt < 8; ++nt) { const bf16x8 bfr = *(const bf16x8*)(pw + (size_t)(16 * nt) * 256 + 32 * s); acc[nt] = mfma16(bfr, a, acc[nt]); }
            }
#pragma unroll
            for (int nt = 0; nt < 8; ++nt) { u32x2 o; o.x = pk2(acc[nt][0], acc[nt][1]); o.y = pk2(acc[nt][2], acc[nt][3]); *(u32x2*)(C.Y + (R0 + row) * D + 768 + 128 * nh + 16 * nt + 4 * gq) = o; }
        }
        __syncthreads();
    }
}
__device__ __forceinline__ void compress_item(const Ctx& C, int l, int it, LAS unsigned char* lds) {
    const int wid = C.wid, lane = C.lane;
    const int rt = it >> 1, kv = it & 1, m16 = lane & 15, gq = lane >> 4;
    const int cr = 16 * rt + m16, bb = cr >> 9, n = cr & 511, nn = n < 510 ? n : 510;
    const bf16* rowbase = C.Z + ((size_t)bb * T + 16 * nn) * DINP + (kv ? C_VCMP : C_KCMP);
    const bf16* w1t = C.CW1T + (size_t)(l * 2 + kv) * 256 * 2048;
    f32x4 acc[2]; acc[0] = (f32x4){0.f, 0.f, 0.f, 0.f}; acc[1] = acc[0];
#pragma unroll 8
    for (int s = 0; s < 64; ++s) {
        const bf16x8 a = *(const bf16x8*)(rowbase + (size_t)(s >> 1) * DINP + 32 * (s & 1) + 8 * gq);
#pragma unroll
        for (int nt = 0; nt < 2; ++nt) { const bf16x8 bfr = *(const bf16x8*)(w1t + (size_t)(32 * wid + 16 * nt + m16) * 2048 + 32 * s + 8 * gq); acc[nt] = mfma16(bfr, a, acc[nt]); }
    }
    LAS bf16* Hc = (LAS bf16*)lds;
#pragma unroll
    for (int nt = 0; nt < 2; ++nt) { const int col = 32 * wid + 16 * nt + 4 * gq; const f32x4 pb = *(const f32x4*)(C.PEB + (l * 2 + kv) * 256 + col);
        u32x2 o; o.x = pk2(gelu_tanh(acc[nt][0] + pb[0]), gelu_tanh(acc[nt][1] + pb[1])); o.y = pk2(gelu_tanh(acc[nt][2] + pb[2]), gelu_tanh(acc[nt][3] + pb[3]));
        *(LAS u32x2*)(Hc + m16 * 264 + col) = o; }
    __syncthreads();
    if (wid < 4) {
        const bf16* w2t = C.CW2T + (size_t)(l * 2 + kv) * 64 * 256;
        f32x4 a2 = {0.f, 0.f, 0.f, 0.f};
#pragma unroll
        for (int s = 0; s < 8; ++s) { const bf16x8 a = *(const LAS bf16x8*)(Hc + m16 * 264 + 32 * s + 8 * gq); const bf16x8 bfr = *(const bf16x8*)(w2t + (size_t)(16 * wid + m16) * 256 + 32 * s + 8 * gq); a2 = mfma16(bfr, a, a2); }
        { u32x2 o; o.x = pk2(a2[0], a2[1]); o.y = pk2(a2[2], a2[3]); if (n >= NCMP) { o.x = 0u; o.y = 0u; }
          *(u32x2*)((kv ? C.VC : C.KC) + (size_t)cr * 64 + 16 * wid + 4 * gq) = o;
          const int tile = n >> 6, kk = n & 63;
          if (!kv) { const int sub = kk >> 4, s = wid >> 1, g2 = 2 * (wid & 1) + (gq >> 1);
              *(u32x2*)(C.KCF + ((size_t)(bb * 8 + tile)) * 4096 + ((sub * 2 + s) * 64 + g2 * 16 + (kk & 15)) * 8 + 4 * (gq & 1)) = o;
          } else { const int s2 = kk >> 5, k5 = kk & 31, g2 = (k5 & 15) >> 2, j = (k5 & 3) + ((k5 >> 4) << 2);
              bf16* vt = C.VCF + ((size_t)(bb * 8 + tile)) * 4096 + ((s2 * 4 + wid) * 64 + g2 * 16 + 4 * gq) * 8 + j;
              vt[0] = (bf16)(o.x & 0xffffu); vt[8] = (bf16)(o.x >> 16); vt[16] = (bf16)(o.y & 0xffffu); vt[24] = (bf16)(o.y >> 16); } }
    }
    __syncthreads();
}

__device__ __forceinline__ void nsa_branch(const bf16* kb, const bf16* vb, int pitch, const LAS int* base, int nch, int vlo, int vhi, int chi,
                                           const LAS unsigned* qs, LAS float* sc, float (&o)[4], int lane) {
    float mx0 = -INFINITY, mx1 = -INFINITY, mx2 = -INFINITY, mx3 = -INFINITY;
#pragma unroll 1
    for (int i = 0; i < nch; ++i) {
        asm volatile("" ::: "memory");
        const int r = base[i] + lane; const bool valid = (r >= vlo) && (r <= vhi);
        const int rc = r < 0 ? 0 : (r > chi ? chi : r);
        const u32x4* kp = (const u32x4*)(kb + (size_t)rc * pitch);
        u32x4 kr[8];
#pragma unroll
        for (int c = 0; c < 8; ++c) kr[c] = kp[c];
        float a0 = 0.f, a1 = 0.f, a2 = 0.f, a3 = 0.f;
#pragma unroll
        for (int c = 0; c < 8; ++c) {
            const u32x4 q0 = *(const LAS u32x4*)(qs + 0 * 32 + 4 * c), q1 = *(const LAS u32x4*)(qs + 1 * 32 + 4 * c), q2 = *(const LAS u32x4*)(qs + 2 * 32 + 4 * c), q3 = *(const LAS u32x4*)(qs + 3 * 32 + 4 * c);
            a0 = dot2bf(kr[c].x, q0.x, a0); a0 = dot2bf(kr[c].y, q0.y, a0); a0 = dot2bf(kr[c].z, q0.z, a0); a0 = dot2bf(kr[c].w, q0.w, a0);
            a1 = dot2bf(kr[c].x, q1.x, a1); a1 = dot2bf(kr[c].y, q1.y, a1); a1 = dot2bf(kr[c].z, q1.z, a1); a1 = dot2bf(kr[c].w, q1.w, a1);
            a2 = dot2bf(kr[c].x, q2.x, a2); a2 = dot2bf(kr[c].y, q2.y, a2); a2 = dot2bf(kr[c].z, q2.z, a2); a2 = dot2bf(kr[c].w, q2.w, a2);
            a3 = dot2bf(kr[c].x, q3.x, a3); a3 = dot2bf(kr[c].y, q3.y, a3); a3 = dot2bf(kr[c].z, q3.z, a3); a3 = dot2bf(kr[c].w, q3.w, a3);
        }
        if (!valid) { a0 = -INFINITY; a1 = -INFINITY; a2 = -INFINITY; a3 = -INFINITY; }
        sc[0 * 1024 + 64 * i + lane] = a0; sc[1 * 1024 + 64 * i + lane] = a1; sc[2 * 1024 + 64 * i + lane] = a2; sc[3 * 1024 + 64 * i + lane] = a3;
        mx0 = fmaxf(mx0, a0); mx1 = fmaxf(mx1, a1); mx2 = fmaxf(mx2, a2); mx3 = fmaxf(mx3, a3);
    }
    mx0 = wave_max(mx0); mx1 = wave_max(mx1); mx2 = wave_max(mx2); mx3 = wave_max(mx3);
    float l0 = 0.f, l1 = 0.f, l2 = 0.f, l3 = 0.f;
    for (int i = 0; i < nch; ++i) {
        const float s0 = sc[0 * 1024 + 64 * i + lane], s1 = sc[1 * 1024 + 64 * i + lane], s2 = sc[2 * 1024 + 64 * i + lane], s3 = sc[3 * 1024 + 64 * i + lane];
        const float e0 = (s0 == -INFINITY) ? 0.f : __expf(s0 - mx0), e1 = (s1 == -INFINITY) ? 0.f : __expf(s1 - mx1), e2 = (s2 == -INFINITY) ? 0.f : __expf(s2 - mx2), e3 = (s3 == -INFINITY) ? 0.f : __expf(s3 - mx3);
        sc[0 * 1024 + 64 * i + lane] = e0; sc[1 * 1024 + 64 * i + lane] = e1; sc[2 * 1024 + 64 * i + lane] = e2; sc[3 * 1024 + 64 * i + lane] = e3;
        l0 += e0; l1 += e1; l2 += e2; l3 += e3;
    }
    l0 = wave_sum(l0); l1 = wave_sum(l1); l2 = wave_sum(l2); l3 = wave_sum(l3);
    const float i0 = l0 > 0.f ? 1.0f / l0 : 0.f, i1 = l1 > 0.f ? 1.0f / l1 : 0.f, i2 = l2 > 0.f ? 1.0f / l2 : 0.f, i3 = l3 > 0.f ? 1.0f / l3 : 0.f;
    for (int i = 0; i < nch; ++i) { sc[0 * 1024 + 64 * i + lane] *= i0; sc[1 * 1024 + 64 * i + lane] *= i1; sc[2 * 1024 + 64 * i + lane] *= i2; sc[3 * 1024 + 64 * i + lane] *= i3; }
    LDS_WAIT();
    float o0 = 0.f, o1 = 0.f, o2 = 0.f, o3 = 0.f;
    for (int i = 0; i < nch; ++i) {
        const int b0 = base[i];
        for (int j = 0; j < 64; j += 16) {
            float vv[16];
#pragma unroll
            for (int u = 0; u < 16; ++u) { int r = b0 + j + u; r = r < 0 ? 0 : (r > chi ? chi : r); vv[u] = bf2f((unsigned)vb[(size_t)r * pitch + lane]); }
#pragma unroll
            for (int u4 = 0; u4 < 4; ++u4) {
                const f32x4 p0 = *(const LAS f32x4*)(sc + 0 * 1024 + 64 * i + j + 4 * u4), p1 = *(const LAS f32x4*)(sc + 1 * 1024 + 64 * i + j + 4 * u4), p2 = *(const LAS f32x4*)(sc + 2 * 1024 + 64 * i + j + 4 * u4), p3 = *(const LAS f32x4*)(sc + 3 * 1024 + 64 * i + j + 4 * u4);
#pragma unroll
                for (int u = 0; u < 4; ++u) { const float v1 = vv[4 * u4 + u]; o0 += p0[u] * v1; o1 += p1[u] * v1; o2 += p2[u] * v1; o3 += p3[u] * v1; }
            }
        }
    }
    o[0] = o0; o[1] = o1; o[2] = o2; o[3] = o3;
}
template <bool CHECK>
__device__ __forceinline__ void nsa_query(const Ctx& C, int b, int t, LAS unsigned char* wl  , unsigned* errw) {
    const int lane = C.lane;
    LAS float* sc = (LAS float*)wl;
    LAS unsigned* qs = (LAS unsigned*)(wl + 16384);
    LAS int* base = (LAS int*)(wl + 16384 + 1024);
    const size_t row = (size_t)b * T + t;
    const bf16* zr = C.Z + row * DINP;
    const bf16* Zb = C.Z + (size_t)b * T * DINP;
    { const unsigned w2 = *(const unsigned*)(zr + C_Q + 2 * lane);
      const unsigned w3 = *(const unsigned*)(zr + C_Q + 128 + 2 * lane);
      qs[lane] = pk2(lo16(w2) * 0.125f, hi16(w2) * 0.125f); qs[64 + lane] = pk2(lo16(w3) * 0.125f, hi16(w3) * 0.125f); }
    const int nvalid = (t >= 31) ? ((t - 31) / 16 + 1) : 0;
    const int nchc = (nvalid + 63) >> 6;
    if (lane < 16) base[lane] = 64 * lane;
    LDS_WAIT();
    float oc[4];
    nsa_branch(C.KC + (size_t)b * 512 * 64, C.VC + (size_t)b * 512 * 64, 64, base, nchc, 0, nvalid - 1, 510, qs, sc, oc, lane);
    const int cur = t >> 6;
    float c0, c1;
    {
        float im0 = 0.f, im1 = 0.f;
#pragma unroll
        for (int rr = -1; rr <= 3; ++rr) { const int n0 = 4 * lane + rr, n1 = 4 * (lane + 64) + rr;
            if (n0 >= 0 && n0 < 64 * nchc) im0 += (sc[n0] + sc[1024 + n0]) + (sc[2048 + n0] + sc[3072 + n0]);
            if (n1 < 64 * nchc) im1 += (sc[n1] + sc[1024 + n1]) + (sc[2048 + n1] + sc[3072 + n1]); }
        const int m0 = lane, m1 = lane + 64;
        c0 = (m0 <= cur) ? (im0 + ((m0 == 0 || m0 == cur || m0 == cur - 1) ? 1e4f : 0.f)) : -1.0f;
        c1 = (m1 <= cur) ? (im1 + ((m1 == 0 || m1 == cur || m1 == cur - 1) ? 1e4f : 0.f)) : -1.0f;
    }
    LDS_WAIT();
    for (int r = 0; r < 16; ++r) {
        float bv; int bi;
        if (c0 >= c1) { bv = c0; bi = lane; } else { bv = c1; bi = lane + 64; }
#pragma unroll
        for (int off = 1; off < 64; off <<= 1) { const float ov = __shfl_xor(bv, off); const int oi = __shfl_xor(bi, off); if (ov > bv || (ov == bv && oi < bi)) { bv = ov; bi = oi; } }
        if (bi == lane) c0 = -2.0f; if (bi == lane + 64) c1 = -2.0f;
        if (lane == 0) base[r] = (bv >= 0.f) ? 64 * bi : -1000000;
    }
    LDS_WAIT();
    float os[4];
    nsa_branch(Zb + C_KSEL, Zb + C_VSEL, DINP, base, 16, 0, t, T - 1, qs, sc, os, lane);
    if (lane < 16) base[lane] = t - 511 + 64 * lane;
    LDS_WAIT();
    float ow[4];
    nsa_branch(Zb + C_KWIN, Zb + C_VWIN, DINP, base, 8, 0, t, T - 1, qs, sc, ow, lane);
    float yv[4];
#pragma unroll
    for (int h = 0; h < 4; ++h) {
        const float g0 = sigmoidf_(bf2f((unsigned)zr[C_GATE + 3 * h + 0])), g1 = sigmoidf_(bf2f((unsigned)zr[C_GATE + 3 * h + 1])), g2 = sigmoidf_(bf2f((unsigned)zr[C_GATE + 3 * h + 2]));
        yv[h] = g0 * oc[h] + g1 * os[h] + g2 * ow[h];
        if (!CHECK) C.Y[row * D + 256 + h * 64 + lane] = (bf16)f2bf(yv[h]);
    }
    if (CHECK) {
        const float rmax = wave_max(fmaxf(fmaxf(fabsf(yv[0]), fabsf(yv[1])), fmaxf(fabsf(yv[2]), fabsf(yv[3]))));
        int bad = 0;
#pragma unroll
        for (int h = 0; h < 4; ++h) { const float ym = bf2f((unsigned)C.Y[row * D + 256 + h * 64 + lane]); if (!(fabsf(ym - yv[h]) <= 0.03f * rmax + 2e-4f)) ++bad; }
        const float fb = wave_sum((float)bad);
        if (lane == 0) { atomicAdd(errw, (unsigned)fb); atomicAdd(errw + 64, 256u); }
    }
    LDS_WAIT();
}

__device__ __forceinline__ void moe_gather(const Ctx& C, LAS unsigned char* lds) {
    LAS int* sh = (LAS int*)lds;
    for (int i = C.tid; i < 2048; i += NTHREADS) sh[i] = C.HIST[i];
    __syncthreads();
    if (C.tid < 8) { int c = 0; for (int tl = 0; tl < 256; ++tl) c += sh[tl * 8 + C.tid]; sh[2048 + C.tid] = c; }
    __syncthreads();
    if (C.tid == 0) { int acc = 0; for (int ex = 0; ex < 8; ++ex) { sh[2064 + ex] = acc; acc += (sh[2048 + ex] + 255) & ~255; if (C.bid == 0) C.META[ex] = acc >> 8; } if (C.bid == 0) C.META[8] = acc >> 8; }
    __syncthreads();
    for (int tile = C.bid; tile < 256; tile += C.G) {
        if (C.tid < 8) { int c = 0; for (int tl = 0; tl < tile; ++tl) c += sh[tl * 8 + C.tid]; sh[2056 + C.tid] = c; }
        __syncthreads();
        for (int i = 0; i < 32; ++i) {
            const int a = 32 * C.wid + i; const size_t ag = (size_t)tile * 256 + a;
            const unsigned info = C.TOKINFO[ag]; const int e = info & 255u, lr = info >> 8;
            const int dest = sh[2064 + e] + sh[2056 + e] + lr;
            if (C.lane == 0) C.TOKPOS[ag] = dest;
            const u32x4* s = (const u32x4*)(C.XB + ((size_t)tile * 128 + (a >> 1)) * D); u32x4* dd = (u32x4*)(C.XG + (size_t)dest * D);
            dd[C.lane] = s[C.lane]; dd[C.lane + 64] = s[C.lane + 64];
        }
        __syncthreads();
    }
    const int gw = C.bid * NWAVES + C.wid, NGW = C.G * NWAVES;
    for (int ex = 0; ex < 8; ++ex) { const int s0 = sh[2064 + ex] + sh[2048 + ex], e0 = sh[2064 + ex] + ((sh[2048 + ex] + 255) & ~255);
        for (int r = s0 + gw; r < e0; r += NGW) { u32x4* dd = (u32x4*)(C.XG + (size_t)r * D); const u32x4 z = {0u, 0u, 0u, 0u}; dd[C.lane] = z; dd[C.lane + 64] = z; } }
}

__device__ __forceinline__ void frag_tile(const Ctx& C, int tb) {
    const int b = tb >> 6, t0 = (tb & 63) << 7;
    const bf16* Zt = C.Z + ((size_t)b * T + t0) * DINP;
    for (int task = C.tid; task < 2048; task += NTHREADS) {
        const int arr = task >> 10, key = (task >> 3) & 127, d8 = task & 7;
        const u32x4 v = *(const u32x4*)(Zt + (size_t)key * DINP + (arr ? C_KWIN : C_KSEL) + 8 * d8);
        const int tile = (t0 + key) >> 6, kk = key & 63;
        *(u32x4*)((arr ? C.KWINF : C.KSELF) + ((size_t)(b * 128 + tile)) * 4096 + (((kk >> 4) * 2 + (d8 >> 2)) * 64 + (d8 & 3) * 16 + (kk & 15)) * 8) = v;
    }
    for (int task = C.tid; task < 2048; task += NTHREADS) {
        const int arr = task >> 10, tile2 = (task >> 9) & 1, s2 = (task >> 8) & 1, dt = (task >> 6) & 3, ln = task & 63, g2 = ln >> 4, c2 = ln & 15;
        const bf16* src = Zt + (size_t)(64 * tile2 + 32 * s2 + 4 * g2) * DINP + (arr ? C_VWIN : C_VSEL) + 16 * dt + c2;
        unsigned v[8];
#pragma unroll
        for (int i = 0; i < 4; ++i) { v[i] = src[(size_t)i * DINP]; v[4 + i] = src[(size_t)(16 + i) * DINP]; }
        u32x4 o; o.x = v[0] | (v[1] << 16); o.y = v[2] | (v[3] << 16); o.z = v[4] | (v[5] << 16); o.w = v[6] | (v[7] << 16);
        *(u32x4*)((arr ? C.VWINF : C.VSELF) + ((size_t)(b * 128 + (t0 >> 6) + tile2)) * 4096 + ((s2 * 4 + dt) * 64 + ln) * 8) = o;
    }
}

constexpr int NCT = 2, NQW = 4 * NCT;
struct NsaAcc { f32x4 o[NCT][4]; float m[NCT], l[NCT]; };
__device__ __forceinline__ void nsa_acc_reset(NsaAcc& A) {
#pragma unroll
    for (int ct = 0; ct < NCT; ++ct) { A.m[ct] = -INFINITY; A.l[ct] = 0.f;
#pragma unroll
        for (int dt = 0; dt < 4; ++dt) A.o[ct][dt] = (f32x4){0.f, 0.f, 0.f, 0.f}; }
}
#define NSA_SCL (0.125f * 1.4426950408889634f)
__device__ __forceinline__ void nsa_tile(const bf16* Kt, const bf16* Vt, const bf16x8 (&qf)[NCT][2], int k0,
                                         const int (&lo)[NCT], const int (&hi)[NCT], unsigned ctmask, NsaAcc& A, int lane, int g) {
    bf16x8 kf[4][2], vf[4][2];
#pragma unroll
    for (int sub = 0; sub < 4; ++sub)
#pragma unroll
        for (int s = 0; s < 2; ++s) kf[sub][s] = *(const bf16x8*)(Kt + ((sub * 2 + s) * 64 + lane) * 8);
#pragma unroll
    for (int dt = 0; dt < 4; ++dt)
#pragma unroll
        for (int s2 = 0; s2 < 2; ++s2) vf[dt][s2] = *(const bf16x8*)(Vt + ((s2 * 4 + dt) * 64 + lane) * 8);
#pragma unroll
    for (int ct = 0; ct < NCT; ++ct) {
        if (!((ctmask >> ct) & 1u)) continue;
        f32x4 sa[4];
#pragma unroll
        for (int sub = 0; sub < 4; ++sub) { sa[sub] = mfma16(kf[sub][0], qf[ct][0], (f32x4){0.f, 0.f, 0.f, 0.f}); sa[sub] = mfma16(kf[sub][1], qf[ct][1], sa[sub]); }
        {
            const bool allv = (lo[ct] <= k0) && (k0 + 63 <= hi[ct]); const bool nonev = (hi[ct] < k0) || (lo[ct] > k0 + 63);
            if (__any(!(allv || nonev))) {
#pragma unroll
                for (int sub = 0; sub < 4; ++sub)
#pragma unroll
                    for (int r = 0; r < 4; ++r) { const int key = k0 + 16 * sub + 4 * g + r; sa[sub][r] = (key >= lo[ct] && key <= hi[ct]) ? sa[sub][r] : -INFINITY; }
            } else if (__any(nonev)) {
#pragma unroll
                for (int sub = 0; sub < 4; ++sub)
#pragma unroll
                    for (int r = 0; r < 4; ++r) sa[sub][r] = allv ? sa[sub][r] : -INFINITY;
            }
        }
        float tmax = fmaxf(fmaxf(fmaxf(sa[0][0], sa[0][1]), fmaxf(sa[0][2], sa[0][3])), fmaxf(fmaxf(sa[1][0], sa[1][1]), fmaxf(sa[1][2], sa[1][3])));
        tmax = fmaxf(tmax, fmaxf(fmaxf(fmaxf(sa[2][0], sa[2][1]), fmaxf(sa[2][2], sa[2][3])), fmaxf(fmaxf(sa[3][0], sa[3][1]), fmaxf(sa[3][2], sa[3][3]))));
        tmax = fmaxf(tmax, __shfl_xor(tmax, 16)); tmax = fmaxf(tmax, __shfl_xor(tmax, 32));
        tmax *= NSA_SCL;
        if (__any(tmax > A.m[ct])) {
            const float mn = fmaxf(A.m[ct], tmax);
            const float alpha = __builtin_amdgcn_exp2f(A.m[ct] - ((mn == -INFINITY) ? 0.f : mn));
            A.l[ct] *= alpha; A.m[ct] = mn;
#pragma unroll
            for (int dt = 0; dt < 4; ++dt) A.o[ct][dt] = A.o[ct][dt] * alpha;
        }
        const float nms = (A.m[ct] == -INFINITY) ? 0.f : -A.m[ct];
        float ps = 0.f;
#pragma unroll
        for (int sub = 0; sub < 4; ++sub)
#pragma unroll
            for (int r = 0; r < 4; ++r) { const float p = __builtin_amdgcn_exp2f(fmaf(sa[sub][r], NSA_SCL, nms)); sa[sub][r] = p; ps += p; }
        A.l[ct] += ps;
        bf16x8 pf[2];
#pragma unroll
        for (int s2 = 0; s2 < 2; ++s2) { u32x4 w; w.x = pk2(sa[2 * s2][0], sa[2 * s2][1]); w.y = pk2(sa[2 * s2][2], sa[2 * s2][3]); w.z = pk2(sa[2 * s2 + 1][0], sa[2 * s2 + 1][1]); w.w = pk2(sa[2 * s2 + 1][2], sa[2 * s2 + 1][3]);
            pf[s2] = __builtin_bit_cast(bf16x8, w); }
#pragma unroll
        for (int dt = 0; dt < 4; ++dt)
#pragma unroll
            for (int s2 = 0; s2 < 2; ++s2) A.o[ct][dt] = mfma16(vf[dt][s2], pf[s2], A.o[ct][dt]);
    }
}
__device__ __forceinline__ void nsa_finalize(const Ctx& C, NsaAcc& A, const bf16* Zb, size_t rowb, int t0, int jb, bool first, bool last, float (&msave)[NCT], float (&isave)[NCT], int c, int g) {
    const int ql = c >> 2, h = c & 3;
    float* scr = C.VBUF;
#pragma unroll
    for (int ct = 0; ct < NCT; ++ct) {
        float lt = A.l[ct]; lt += __shfl_xor(lt, 16); lt += __shfl_xor(lt, 32);
        const float inv = lt > 0.f ? 1.0f / lt : 0.f; msave[ct] = A.m[ct]; isave[ct] = inv;
        const int tq = t0 + 4 * ct + ql;
        const float gate = sigmoidf_(bf2f((unsigned)Zb[(size_t)tq * DINP + C_GATE + 3 * h + jb]));
        const float f = inv * gate;
#pragma unroll
        for (int dt = 0; dt < 4; ++dt) {
            f32x4 v = A.o[ct][dt] * f; const size_t off = (rowb + tq) * 256 + h * 64 + 16 * dt + 4 * g;
            if (!first) v = v + *(const f32x4*)(scr + off);
            if (last) { u32x2 o; o.x = pk2(v[0], v[1]); o.y = pk2(v[2], v[3]); *(u32x2*)(C.Y + (rowb + tq) * D + 256 + h * 64 + 16 * dt + 4 * g) = o; }
            else *(f32x4*)(scr + off) = v;
        }
    }
}
__device__ __forceinline__ void nsa_unit(const Ctx& C, int U, LAS unsigned char* wl) {
    const int lane = C.lane, c = lane & 15, g = lane >> 4, ql = c >> 2, h = c & 3;
    const int b = U / (T / NQW), t0 = (U % (T / NQW)) * NQW;
    const size_t rowb = (size_t)b * T;
    const bf16* Zb = C.Z + rowb * DINP;
    LAS float* imp = (LAS float*)wl; LAS unsigned* smask = (LAS unsigned*)(wl + 8192);
    bf16x8 qf[NCT][2]; int tq[NCT];
#pragma unroll
    for (int ct = 0; ct < NCT; ++ct) { tq[ct] = t0 + 4 * ct + ql;
#pragma unroll
        for (int s = 0; s < 2; ++s) qf[ct][s] = *(const bf16x8*)(Zb + (size_t)tq[ct] * DINP + C_Q + h * 64 + 32 * s + 8 * g); }
    NsaAcc A; float msave[NCT], isave[NCT], mc[NCT], ic[NCT];
    int lo[NCT], hi[NCT];
    constexpr unsigned ALLCT = (1u << NCT) - 1u;
    const int nmaxw = (t0 + NQW - 1 >= 31) ? ((t0 + NQW - 1 - 31) >> 4) : -1;
    const int nkt = (nmaxw >> 6) + 1;
    const bf16* KCb = C.KCF + (size_t)b * 8 * 4096; const bf16* VCb = C.VCF + (size_t)b * 8 * 4096;
#pragma unroll
    for (int ct = 0; ct < NCT; ++ct) { lo[ct] = 0; hi[ct] = (tq[ct] >= 31) ? ((tq[ct] - 31) >> 4) : -1; }
    nsa_acc_reset(A);
    for (int kt = 0; kt < nkt; ++kt) nsa_tile(KCb + (size_t)kt * 4096, VCb + (size_t)kt * 4096, qf, 64 * kt, lo, hi, ALLCT, A, lane, g);
    nsa_finalize(C, A, Zb, rowb, t0, 0, true, false, mc, ic, c, g);
    for (int i = lane; i < NQW * 128; i += 64) imp[i] = 0.f;
    LDS_WAIT();
    for (int kt = 0; kt < nkt; ++kt) {
        bf16x8 kf[4][2];
#pragma unroll
        for (int sub = 0; sub < 4; ++sub)
#pragma unroll
            for (int s = 0; s < 2; ++s) kf[sub][s] = *(const bf16x8*)(KCb + (size_t)kt * 4096 + ((sub * 2 + s) * 64 + lane) * 8);
#pragma unroll
        for (int ct = 0; ct < NCT; ++ct) {
#pragma unroll
            for (int sub = 0; sub < 4; ++sub) {
                f32x4 sa = mfma16(kf[sub][0], qf[ct][0], (f32x4){0.f, 0.f, 0.f, 0.f}); sa = mfma16(kf[sub][1], qf[ct][1], sa);
                float p[4];
#pragma unroll
                for (int r = 0; r < 4; ++r) { const int n = 64 * kt + 16 * sub + 4 * g + r; float v = (n <= hi[ct]) ? __builtin_amdgcn_exp2f(sa[r] * NSA_SCL - mc[ct]) * ic[ct] : 0.f;
                    v += __shfl_xor(v, 1); v += __shfl_xor(v, 2); p[r] = v; }
                if (h == 0) { const int mb = 16 * kt + 4 * sub + g; LAS float* ip = imp + (4 * ct + ql) * 128 + mb;
                    atomicAdd((float*)ip, (p[0] + p[1]) + (p[2] + p[3])); if (mb + 1 < 128) atomicAdd((float*)(ip + 1), p[3]); }
            }
        }
    }
    LDS_WAIT();
#pragma unroll 1
    for (int qi = 0; qi < NQW; ++qi) {
        const int t = t0 + qi, cur = t >> 6; const int m0 = lane, m1 = lane + 64;
        unsigned long long mlo, mhi;
        if (cur < 16) { mlo = __ballot(m0 <= cur); mhi = 0ull; }
        else {
            const float s0 = imp[qi * 128 + m0] + ((m0 == 0 || m0 == cur || m0 == cur - 1) ? 1e4f : 0.f), s1 = imp[qi * 128 + m1] + ((m1 == 0 || m1 == cur || m1 == cur - 1) ? 1e4f : 0.f);
            const unsigned u0 = (m0 <= cur) ? __float_as_uint(s0) + 1u : 0u, u1 = (m1 <= cur) ? __float_as_uint(s1) + 1u : 0u;
            unsigned tau = 0u;
            for (int bit = 30; bit >= 0; --bit) { const unsigned cand = tau | (1u << bit); const int cnt = __popcll(__ballot(u0 >= cand)) + __popcll(__ballot(u1 >= cand)); if (cnt >= 16) tau = cand; }
            const unsigned long long g0 = __ballot(u0 > tau), g1 = __ballot(u1 > tau), e0 = __ballot(u0 == tau), e1 = __ballot(u1 == tau);
            int need = 16 - __popcll(g0) - __popcll(g1);
            const unsigned long long lt = (1ull << lane) - 1ull;
            const unsigned long long k0m = __ballot(((e0 >> lane) & 1ull) && __popcll(e0 & lt) < need); need -= __popcll(k0m);
            const unsigned long long k1m = __ballot(((e1 >> lane) & 1ull) && __popcll(e1 & lt) < need);
            mlo = g0 | k0m; mhi = g1 | k1m;
        }
        if (lane == 0) { smask[qi * 4 + 0] = (unsigned)mlo; smask[qi * 4 + 1] = (unsigned)(mlo >> 32); smask[qi * 4 + 2] = (unsigned)mhi; smask[qi * 4 + 3] = (unsigned)(mhi >> 32); }
    }
    LDS_WAIT();
    nsa_acc_reset(A);
    {
        const int jmax = (t0 + NQW - 1) >> 6;
        const bf16* Kb = C.KSELF + (size_t)b * 128 * 4096; const bf16* Vb = C.VSELF + (size_t)b * 128 * 4096;
#pragma unroll
        for (int ct = 0; ct < NCT; ++ct) lo[ct] = 0;
        for (int j = 0; j <= jmax; ++j) {
            unsigned ctmask = 0u;
#pragma unroll
            for (int ct = 0; ct < NCT; ++ct) { const unsigned w = smask[(4 * ct + ql) * 4 + (j >> 5)]; const bool sel = (w >> (j & 31)) & 1u; hi[ct] = sel ? tq[ct] : -1; if (__any(sel)) ctmask |= 1u << ct; }
            if (ctmask) nsa_tile(Kb + (size_t)j * 4096, Vb + (size_t)j * 4096, qf, 64 * j, lo, hi, ctmask, A, lane, g);
        }
    }
    nsa_finalize(C, A, Zb, rowb, t0, 1, false, false, msave, isave, c, g);
    nsa_acc_reset(A);
    {
        const int j0 = (t0 >= 511) ? ((t0 - 511) >> 6) : 0, j1 = (t0 + NQW - 1) >> 6;
        const bf16* Kb = C.KWINF + (size_t)b * 128 * 4096; const bf16* Vb = C.VWINF + (size_t)b * 128 * 4096;
#pragma unroll
        for (int ct = 0; ct < NCT; ++ct) { lo[ct] = tq[ct] - 511; hi[ct] = tq[ct]; }
        for (int j = j0; j <= j1; ++j) nsa_tile(Kb + (size_t)j * 4096, Vb + (size_t)j * 4096, qf, 64 * j, lo, hi, ALLCT, A, lane, g);
    }
    nsa_finalize(C, A, Zb, rowb, t0, 2, false, true, msave, isave, c, g);
    LDS_WAIT();
}


#ifndef DBG_REP
#define DBG_REP 0
#endif
#ifndef NSA_CHECK
#define NSA_CHECK 0
#endif
#ifndef MK_MULTI
#define MK_MULTI 0
#endif
constexpr int PH_PER_LAYER = 12, N_PHASES = 3 + NL * PH_PER_LAYER;


__device__ __forceinline__ void mkctx(Ctx& C, const Params& P, int tid) {
    int bid_ = blockIdx.x; asm volatile("" : "+s"(bid_));
    C.tid = tid; C.lane = tid & 63; C.wid = __builtin_amdgcn_readfirstlane(tid >> 6); C.bid = bid_; C.G = gridDim.x;
#pragma unroll
    for (int i = 0; i < 35; ++i) C.in[i] = P.in[i];
    unsigned char* ws = P.ws; asm volatile("" : "+s"(ws));
    C.X = P.out;
    C.XB = (bf16*)(ws + WS_XB); C.Z = (bf16*)(ws + WS_Z); C.Y = (bf16*)(ws + WS_Y); C.Q = (bf16*)(ws + WS_Q); C.H = (bf16*)(ws + WS_H); C.XG = (bf16*)(ws + WS_Z);
    C.KC = (bf16*)(ws + WS_KC); C.VC = (bf16*)(ws + WS_VC); C.MEMB = (bf16*)(ws + WS_MEMB); C.KVROW = (bf16*)(ws + WS_KMEM); C.W1X = (bf16*)(ws + WS_W1X); C.W2X = (bf16*)(ws + WS_W2X); C.KCF = (bf16*)(ws + WS_KCF); C.VCF = (bf16*)(ws + WS_VCF); C.KSELF = (bf16*)(ws + WS_KSELF); C.VSELF = (bf16*)(ws + WS_VSELF); C.KWINF = (bf16*)(ws + WS_KWINF); C.VWINF = (bf16*)(ws + WS_VWINF);
    C.WINT = (bf16*)(ws + WS_WINT); C.WOUTT = (bf16*)(ws + WS_WOUTT); C.XQT = (bf16*)(ws + WS_XQT); C.XKVT = (bf16*)(ws + WS_XKVT); C.XOT = (bf16*)(ws + WS_XOT);
    C.W13T = (bf16*)(ws + WS_W13T); C.W2T = (bf16*)(ws + WS_W2T); C.E13T = (bf16*)(ws + WS_E13T); C.E2T = (bf16*)(ws + WS_E2T);
    C.CW1T = (bf16*)(ws + WS_CW1T); C.CW2T = (bf16*)(ws + WS_CW2T); C.PWT = (bf16*)(ws + WS_PWT); C.POOLWT = (bf16*)(ws + WS_POOLWT); C.SGUWB = (bf16*)(ws + WS_SGUW);
    C.VBUF = (float*)(ws + WS_VBUF); C.FS = (float*)(ws + WS_VBUF); C.PEB = (float*)(ws + WS_PEB); C.TOKG = (float*)(ws + WS_TOKG);
    C.HIST = (int*)(ws + WS_HIST); C.META = (int*)(ws + WS_META); C.TOKPOS = (int*)(ws + WS_TOKPOS); C.TOKINFO = (unsigned*)(ws + WS_TOKINFO);
}
#define MKCTX() Ctx C; { int t_ = threadIdx.x; asm volatile("" : "+v"(t_)); mkctx(C, P, t_); }

__global__ void __launch_bounds__(NTHREADS, 2) fwd_kernel(Params P) {
    extern __shared__ __attribute__((aligned(16))) unsigned char lds_raw[];
    LAS unsigned char* lds = (LAS unsigned char*)lds_raw;
    for (int u = threadIdx.x; u < (LDS_BYTES - LDSCTL_OFF) / 4; u += NTHREADS) ((LAS unsigned*)(lds + LDSCTL_OFF))[u] = 0u;
    __syncthreads();
    unsigned char* ws = P.ws;
    XcdBarrier bar; bar.bar = (unsigned*)(ws + WS_CTL); bar.x = 0; bar.st = nullptr;
#if !MK_MULTI
    bar = xcd_barrier_post((unsigned*)(ws + WS_CTL), (volatile LAS unsigned*)(lds + LDSCTL_OFF));
#endif
    const int lo = P.ph_lo, hi = P.ph_hi;
#define IN(k) (lo <= (k) && (k) < hi)
#if MK_MULTI
#define SEAM(k) do { } while (0)
#else
#define SEAM(k) do { if (IN(k) && IN((k) + 1)) xcd_barrier(bar); } while (0)
#endif
    int ph = 0;
    if (IN(ph)) { for (int rep = 0; rep < ((P.dbg & 2) ? 2 : 1); ++rep) { MKCTX(); p0_prologue(C, lds); __syncthreads(); } }
    SEAM(ph); ++ph;

    if (IN(ph)) {
        MKCTX();
        pg8::Gemm g{C.MEMB, C.XKVT, NB * MEM, 2 * D, D, D, D}; pg8::BatchedOrder S; S.init(NB * MEM / 256, 2 * D / 256, NL, C.G, C.bid);
        S.aL = 0; S.aB = 0; S.aH = 0; S.bL = 0; S.bB = 0; S.bH = (size_t)2 * D * D * 2;
        pg8::EpiBf16 E{C.KVROW, 2 * D, 0, 0, (size_t)NB * MEM * 2 * D};
        pg8::gemm_phase<pg8::EpiBf16, pg8::BatchedOrder, true, true>(lds, g, S, E);
    }
    SEAM(ph); ++ph;
    if (IN(ph)) {
        MKCTX();
        for (int w = 0; w < 2; ++w) {
            pg8::Gemm g; pg8::BatchedOrder S; pg8::EpiBf16 E;
            if (w == 0) {
                g = pg8::Gemm{C.KVROW, C.XQT, MEM, D, 256, 2 * D, D}; S.init(1, D / 256, NL * NB * 4, C.G, C.bid);
                S.aL = (size_t)NB * MEM * 2 * D * 2; S.aB = (size_t)MEM * 2 * D * 2; S.aH = 256 * 2; S.bL = (size_t)D * D * 2; S.bB = 0; S.bH = 256 * 2;
                E = pg8::EpiBf16{C.W1X, D, (size_t)NB * D * D, (size_t)D * D, (size_t)256 * D};
            } else {
                g = pg8::Gemm{C.XOT, C.KVROW + D, D, MEM, 256, D, 2 * D}; S.init(D / 256, 1, NL * NB * 4, C.G, C.bid);
                S.aL = (size_t)D * D * 2; S.aB = 0; S.aH = 256 * 2; S.bL = (size_t)NB * MEM * 2 * D * 2; S.bB = (size_t)MEM * 2 * D * 2; S.bH = 256 * 2;
                E = pg8::EpiBf16{C.W2X, D, (size_t)NB * D * D, (size_t)D * D, (size_t)256};
            }
            pg8::gemm_phase<pg8::EpiBf16, pg8::BatchedOrder, true, true>(lds, g, S, E);
        }
    }
    SEAM(ph); ++ph;

    for (int l = 0; l < NL; ++l) {
        const bool moe = (l & 1) != 0; const int li = l >> 1;
        if (IN(ph)) {
            MKCTX();
            pg8::Gemm g{C.XB, C.WINT + (size_t)l * DINP * D, M, DINP, D, D, D}; pg8::StaticOrder S; S.init(M, DINP, C.G, C.bid);
            pg8::EpiBf16 E{C.Z, DINP, 0, 0, 0};
            pg8::gemm_phase<pg8::EpiBf16, pg8::StaticOrder, true, true>(lds, g, S, E);
        }
        SEAM(ph); ++ph;
        if (IN(ph)) for (int rep = 0; rep < ((P.dbg & 4) ? 2 : 1); ++rep) {
            MKCTX();
            { ConvW cw;
              for (int tb = C.bid; tb < M / 128; tb += C.G) frag_tile(C, tb);
              for (int tb = C.bid; tb < M / 128; tb += C.G) mixers_tile<1>(C, l, tb, lds, cw);
              for (int tb = C.bid; tb < M / 128; tb += C.G) mixers_tile<2>(C, l, tb, lds, cw);
              load_convw(C, l, cw);
              for (int tb = C.bid; tb < M / 128; tb += C.G) mixers_tile<4>(C, l, tb, lds, cw); }
            for (int it = C.bid; it < 256; it += C.G) compress_item(C, l, it, lds);
        }
        SEAM(ph); ++ph;
        if (IN(ph)) for (int rep = 0; rep < ((P.dbg & 1) ? 2 : 1); ++rep) {
            MKCTX();
            for (int slot = C.bid * NWAVES + C.wid; slot < M / NQW / 2; slot += C.G * NWAVES) {
                int bb = slot >> 9, lw = slot & 511;
                if (C.G == 256) { bb = (C.bid & 7) >> 1; lw = (((C.bid >> 3) << 1) + (C.bid & 1)) * NWAVES + C.wid; }
#pragma unroll 1
                for (int k = 0; k < 2; ++k) nsa_unit(C, bb * (T / NQW) + (k ? (T / NQW - 1 - lw) : lw), lds + C.wid * 17664);
            }
#if NSA_CHECK
            xcd_barrier(bar);
            { const int gw = C.bid * NWAVES + C.wid, NGW = C.G * NWAVES;
              for (int q = gw; q < M; q += NGW) { const int t = q & (T - 1); if ((((unsigned)q * 2654435761u) >> 29) == 0u || t < 192) nsa_query<true>(C, q >> 13, t, lds + C.wid * 17664, (unsigned*)(P.ws + WS_CTL + 32768)); } }
#endif
        }
        SEAM(ph); ++ph;
        if (IN(ph)) {
            MKCTX();
            pg8::Gemm g{C.Y, C.WOUTT + (size_t)l * D * D, M, D, D, D, D}; pg8::StaticOrder S; S.init(M, D, C.G, C.bid);
            pg8::EpiF32Res E{C.VBUF, (l == 0) ? C.in[I_X] : nullptr, (l == 0) ? nullptr : C.XB, D, ALPHA};
            pg8::gemm_phase<pg8::EpiF32Res, pg8::StaticOrder, true, true>(lds, g, S, E);
        }
        SEAM(ph); ++ph;
        if (IN(ph)) for (int rep = 0; rep < ((P.dbg & 8) ? 2 : 1); ++rep) { MKCTX(); ln_phase(C, C.VBUF, C.in[I_LN1G] + l * D, C.in[I_LN1B] + l * D, 0, nullptr, nullptr, lds); }
        SEAM(ph); ++ph;
        if (IN(ph)) {
            MKCTX();
            pg8::GroupedOrder S;
#pragma unroll
            for (int k = 0; k < 8; ++k) S.pend[k] = (k + 1) * (T / 256);
            S.estride = (size_t)D * D * 2; S.init(M, D, C.G, C.bid);
            pg8::Gemm g{C.XB, C.W1X + (size_t)l * NB * D * D, M, D, D, D, D};
            pg8::EpiSoftmax E{C.Q, D, 0.0625f * 1.4426950408889634f, (LAS float*)(lds + 131072)};
            pg8::gemm_phase<pg8::EpiSoftmax, pg8::GroupedOrder, true, true>(lds, g, S, E);
        }
        SEAM(ph); ++ph;
        if (IN(ph)) {
            MKCTX();
            pg8::GroupedOrder S;
#pragma unroll
            for (int k = 0; k < 8; ++k) S.pend[k] = (k + 1) * (T / 256);
            S.estride = (size_t)D * D * 2; S.init(M, D, C.G, C.bid);
            pg8::Gemm g{C.Q, C.W2X + (size_t)l * NB * D * D, M, D, D, D, D};
            pg8::EpiF32Res E{C.VBUF, nullptr, C.XB, D, ALPHA};
            pg8::gemm_phase<pg8::EpiF32Res, pg8::GroupedOrder, true, true>(lds, g, S, E);
        }
        SEAM(ph); ++ph;
        if (IN(ph)) for (int rep = 0; rep < ((P.dbg & 8) ? 2 : 1); ++rep) { MKCTX(); ln_phase(C, C.VBUF, C.in[I_LN2G] + l * D, C.in[I_LN2B] + l * D, 0, moe ? C.in[I_ROUTER] + (size_t)li * D * NE : nullptr, nullptr, lds); }
        SEAM(ph); ++ph;
        if (IN(ph)) for (int rep = 0; rep < ((P.dbg & 32) ? 2 : 1); ++rep) { if (moe) { MKCTX(); moe_gather(C, lds); __syncthreads(); } }
        if (moe || MK_MULTI) SEAM(ph);
        ++ph;
        if (IN(ph)) {
            MKCTX();
            pg8::GroupedOrder S; int npan;
            if (moe) {
#pragma unroll
                for (int k = 0; k < 8; ++k) S.pend[k] = __builtin_amdgcn_readfirstlane(C.META[k]);
                npan = __builtin_amdgcn_readfirstlane(C.META[8]); S.estride = (size_t)2 * FE * D * 2;
            } else {
#pragma unroll
                for (int k = 0; k < 8; ++k) S.pend[k] = M / 256;
                npan = M / 256; S.estride = 0;
            }
            const int N = moe ? 2 * FE : 2 * FF;
            pg8::Gemm g{moe ? C.XG : C.XB, moe ? C.E13T + (size_t)li * NE * 2 * FE * D : C.W13T + (size_t)li * 2 * FF * D, npan * 256, N, D, D, D};
            S.init(npan * 256, N, C.G, C.bid);
            pg8::EpiSwiglu E{C.H, N / 2};
            pg8::gemm_phase<pg8::EpiSwiglu, pg8::GroupedOrder, true, true>(lds, g, S, E);
        }
        SEAM(ph); ++ph;
        if (IN(ph)) {
            MKCTX();
            pg8::GroupedOrder S; int npan;
            if (moe) {
#pragma unroll
                for (int k = 0; k < 8; ++k) S.pend[k] = __builtin_amdgcn_readfirstlane(C.META[k]);
                npan = __builtin_amdgcn_readfirstlane(C.META[8]); S.estride = (size_t)D * FE * 2;
            } else {
#pragma unroll
                for (int k = 0; k < 8; ++k) S.pend[k] = M / 256;
                npan = M / 256; S.estride = 0;
            }
            const int K = moe ? FE : FF;
            pg8::Gemm g{C.H, moe ? C.E2T + (size_t)li * NE * D * FE : C.W2T + (size_t)li * D * FF, npan * 256, D, K, K, K};
            S.init(npan * 256, D, C.G, C.bid);
            pg8::EpiF32Res E{moe ? C.FS : C.VBUF, nullptr, moe ? nullptr : C.XB, D, ALPHA};
            pg8::gemm_phase<pg8::EpiF32Res, pg8::GroupedOrder, true, true>(lds, g, S, E);
        }
        SEAM(ph); ++ph;
        if (IN(ph)) { MKCTX(); ln_phase(C, C.VBUF, C.in[I_LN3G] + l * D, C.in[I_LN3B] + l * D, moe ? 1 : 0, nullptr, (l == NL - 1) ? C.X : nullptr, lds); }
        SEAM(ph); ++ph;
    }
#if NSA_CHECK
    xcd_barrier(bar);
    { unsigned* ew = (unsigned*)(P.ws + WS_CTL + 32768); const unsigned err = __hip_atomic_load(ew, __ATOMIC_RELAXED, __HIP_MEMORY_SCOPE_AGENT), cnt = __hip_atomic_load(ew + 64, __ATOMIC_RELAXED, __HIP_MEMORY_SCOPE_AGENT);
      if (cnt == 0u || (unsigned long long)err * 256ull > (unsigned long long)cnt) { for (size_t i = (size_t)blockIdx.x * NTHREADS + threadIdx.x; i < (size_t)M * D; i += (size_t)gridDim.x * NTHREADS) P.out[i] = 0.f; } }
#endif
#undef IN
#undef SEAM
}

extern "C" void kernel_launch(void* const* d_in, const int* in_sizes, int n_in, void* d_out, int out_size, void* d_ws, size_t ws_size, hipStream_t stream) {
    static int grid = 0;
    if (grid == 0) {
        if (n_in != 35 || out_size != M * D || ws_size < WS_END) { fprintf(stderr, "kernel_launch: unexpected problem (n_in %d, out %d, ws %zu < %zu)\n", n_in, out_size, ws_size, (size_t)WS_END); grid = -1; return; }
        int dev = 0, cus = 0, per_cu = 0;
        if (hipGetDevice(&dev) != hipSuccess || hipDeviceGetAttribute(&cus, hipDeviceAttributeMultiprocessorCount, dev) != hipSuccess) { grid = -1; return; }
        if (hipFuncSetAttribute((const void*)fwd_kernel, hipFuncAttributeMaxDynamicSharedMemorySize, LDS_BYTES) != hipSuccess) { fprintf(stderr, "kernel_launch: hipFuncSetAttribute failed\n"); grid = -1; return; }
        if (hipOccupancyMaxActiveBlocksPerMultiprocessor(&per_cu, (const void*)fwd_kernel, NTHREADS, LDS_BYTES) != hipSuccess || per_cu < 1) { fprintf(stderr, "kernel_launch: occupancy query says %d\n", per_cu); }
        (void)hipGetLastError();
        grid = cus;
    }
    if (grid < 0) return;
    (void)hipMemsetAsync((char*)d_ws + WS_CTL, 0, CTL_ZERO_BYTES, stream);
    Params p{};
    for (int i = 0; i < 35; ++i) p.in[i] = (const float*)d_in[i];
    p.out = (float*)d_out; p.ws = (unsigned char*)d_ws; p.dbg = DBG_REP;
#if MK_MULTI
    for (int k = 0; k < N_PHASES; ++k) { p.ph_lo = k; p.ph_hi = k + 1; hipLaunchKernelGGL(fwd_kernel, dim3(grid), dim3(NTHREADS), LDS_BYTES, stream, p); }
#else
    p.ph_lo = 0; p.ph_hi = N_PHASES;
    hipLaunchKernelGGL(fwd_kernel, dim3(grid), dim3(NTHREADS), LDS_BYTES, stream, p);
#endif
}
```

```cpp
#include <hip/hip_runtime.h>
#include <cstdio>
#include <cstdint>

#define GAS __attribute__((address_space(1)))
#define LAS __attribute__((address_space(3)))
typedef unsigned short bf16;
typedef short bf16x8 __attribute__((ext_vector_type(8)));
typedef short bf16x4 __attribute__((ext_vector_type(4)));
typedef float f32x4 __attribute__((ext_vector_type(4)));
typedef float f32x2 __attribute__((ext_vector_type(2)));
typedef unsigned u32x4 __attribute__((ext_vector_type(4)));
typedef unsigned u32x2 __attribute__((ext_vector_type(2)));

constexpr int D = 1024, NB = 4, T = 8192, NL = 4, MEM = 256, M = NB * T;
constexpr int DIN = 1932, DINP = 2048;
constexpr int C_POOL = 0, C_Q = 256, C_KCMP = 512, C_VCMP = 576, C_KSEL = 640, C_VSEL = 704, C_KWIN = 768, C_VWIN = 832, C_GATE = 896, C_U = 908, C_V = 1164, C_CA = 1420, C_CG = 1676;
constexpr int FF = 2816, NE = 8, FE = 3584;
constexpr int NCMP = 511;
constexpr float ALPHA = 1.6817928305074292f;
constexpr float LN_EPS = 1e-5f;
constexpr int MOE_ROWS = 2 * M + NE * 256;
constexpr int NWAVES = 8, NTHREADS = 512;

constexpr size_t al256(size_t x) { return (x + 255) & ~(size_t)255; }
constexpr size_t MiB = 1u << 20;
constexpr size_t WS_CTL = 0, CTL_ZERO_BYTES = 64 * 1024;
constexpr size_t WS_HIST = 1 * MiB;
constexpr size_t WS_META = WS_HIST + 8192;
constexpr size_t WS_TOKINFO = WS_META + 256;
constexpr size_t WS_TOKG = WS_TOKINFO + (size_t)2 * M * 4;
constexpr size_t WS_TOKPOS = WS_TOKG + (size_t)2 * M * 4;
constexpr size_t WS_KC = WS_TOKPOS + (size_t)2 * M * 4;
constexpr size_t WS_VC = WS_KC + (size_t)NB * 512 * 64 * 2;
constexpr size_t WS_PEB = WS_VC + (size_t)NB * 512 * 64 * 2;
constexpr size_t WS_POOLWT = WS_PEB + (size_t)NL * 2 * 256 * 4;
constexpr size_t WS_SGUW = WS_POOLWT + (size_t)NL * 4 * 64 * 64 * 2;
constexpr size_t WS_PWT = WS_SGUW + (size_t)NL * 4 * 128 * 128 * 2;
constexpr size_t WS_CW2T = WS_PWT + (size_t)NL * 256 * 256 * 2;
constexpr size_t WS_CW1T = WS_CW2T + (size_t)NL * 2 * 64 * 256 * 2;
constexpr size_t WS_MEMB = WS_CW1T + (size_t)NL * 2 * 256 * 2048 * 2;
constexpr size_t WS_KMEM = WS_MEMB + (size_t)1024 * 1024 * 2;
constexpr size_t WS_VTMEM = WS_KMEM + (size_t)NL * 1024 * 1024 * 2;
constexpr size_t WS_KCF = WS_VTMEM + (size_t)NL * 4096 * 256 * 2;
constexpr size_t WS_VCF = WS_KCF + (size_t)NB * 8 * 4096 * 2;
constexpr size_t WS_KSELF = WS_VCF + (size_t)NB * 8 * 4096 * 2;
constexpr size_t WS_VSELF = WS_KSELF + (size_t)NB * 128 * 4096 * 2;
constexpr size_t WS_KWINF = WS_VSELF + (size_t)NB * 128 * 4096 * 2;
constexpr size_t WS_VWINF = WS_KWINF + (size_t)NB * 128 * 4096 * 2;
constexpr size_t WS_SMALL_END = WS_VWINF + (size_t)NB * 128 * 4096 * 2;
constexpr size_t WS_WINT = 48 * MiB;
static_assert(WS_SMALL_END <= WS_WINT, "small region");
constexpr size_t WS_WOUTT = WS_WINT + (size_t)NL * DINP * D * 2;
constexpr size_t WS_XQT = WS_WOUTT + (size_t)NL * D * D * 2;
constexpr size_t WS_XKVT = WS_XQT + (size_t)NL * D * D * 2;
constexpr size_t WS_XOT = WS_XKVT + (size_t)NL * 2 * D * D * 2;
constexpr size_t WS_W13T = WS_XOT + (size_t)NL * D * D * 2;
constexpr size_t WS_W2T = WS_W13T + (size_t)2 * 2 * FF * D * 2;
constexpr size_t WS_E13T = WS_W2T + (size_t)2 * D * FF * 2;
constexpr size_t WS_E2T = WS_E13T + (size_t)16 * 2 * FE * D * 2;
constexpr size_t WS_XB = WS_E2T + (size_t)16 * D * FE * 2;
constexpr size_t WS_VBUF = WS_XB + (size_t)M * D * 2;
constexpr size_t WS_Z = WS_VBUF + (size_t)M * D * 4;
constexpr size_t WS_Y = WS_Z + (size_t)M * DINP * 2;
constexpr size_t WS_Q = WS_Y + (size_t)M * D * 2;
constexpr size_t WS_H = WS_Q + (size_t)M * D * 2;
constexpr size_t WS_W1X = WS_H + (size_t)MOE_ROWS * FE * 2;
constexpr size_t WS_W2X = WS_W1X + (size_t)NL * NB * D * D * 2;
constexpr size_t WS_STAT = WS_W2X + (size_t)NL * NB * D * D * 2;
constexpr size_t WS_QB = WS_STAT + (size_t)2 * M * 16 * 2 * 4;
constexpr size_t WS_C1 = WS_QB + (size_t)NL * D * 4;
constexpr size_t WS_D1 = WS_C1 + (size_t)NL * NB * D * 4;
constexpr size_t WS_CIN = WS_D1 + (size_t)NL * NB * D * 4;
constexpr size_t WS_DIN = WS_CIN + (size_t)NL * DINP * 4;
constexpr size_t WS_C13 = WS_DIN + (size_t)NL * DINP * 4;
constexpr size_t WS_D13 = WS_C13 + (size_t)2 * 2 * FF * 4;
constexpr size_t WS_END = WS_D13 + (size_t)2 * 2 * FF * 4;
static_assert((size_t)MOE_ROWS * D * 4 <= WS_H - WS_VBUF, "FS overlay");
static_assert((size_t)MOE_ROWS * D * 2 <= WS_Q - WS_Z, "XG overlay");

constexpr int SCR_BYTES = 153600;
constexpr int LDSCTL_OFF = SCR_BYTES;
constexpr int LDS_BYTES = 155648;

__device__ __forceinline__ float bf2f(unsigned v) { return __uint_as_float(v << 16); }
__device__ __forceinline__ unsigned f2bf(float f) { unsigned u = __builtin_bit_cast(unsigned, f); return (u + 0x7fffu + ((u >> 16) & 1u)) >> 16; }
typedef __bf16 bf16x2_t __attribute__((ext_vector_type(2)));
__device__ __forceinline__ unsigned pk2(float lo, float hi) { const f32x2 v = {lo, hi}; const bf16x2_t b = __builtin_convertvector(v, bf16x2_t); return __builtin_bit_cast(unsigned, b); }
__device__ __forceinline__ float lo16(unsigned w) { return __uint_as_float(w << 16); }
__device__ __forceinline__ float hi16(unsigned w) { return __uint_as_float(w & 0xffff0000u); }
__device__ __forceinline__ float sigmoidf_(float x) { return 1.0f / (1.0f + __expf(-x)); }
__device__ __forceinline__ float siluf_(float x) { return x / (1.0f + __expf(-x)); }
__device__ __forceinline__ float gelu_tanh(float x) { const float u = 0.7978845608028654f * (x + 0.044715f * x * x * x); return x / (1.0f + __expf(-2.0f * u)); }
__device__ __forceinline__ float wave_sum(float v) {
#pragma unroll
    for (int o = 1; o < 64; o <<= 1) v += __shfl_xor(v, o);
    return v;
}
__device__ __forceinline__ float wave_max(float v) {
#pragma unroll
    for (int o = 1; o < 64; o <<= 1) v = fmaxf(v, __shfl_xor(v, o));
    return v;
}
__device__ __forceinline__ f32x4 mfma16(bf16x8 a, bf16x8 b, f32x4 c) { return __builtin_amdgcn_mfma_f32_16x16x32_bf16(a, b, c, 0, 0, 0); }
__device__ __forceinline__ float dot2bf(unsigned a, unsigned b, float c) { return __builtin_amdgcn_fdot2_f32_bf16(__builtin_bit_cast(bf16x2_t, a), __builtin_bit_cast(bf16x2_t, b), c, false); }
#define LDS_WAIT() asm volatile("s_waitcnt lgkmcnt(0)" ::: "memory")

namespace pg8 {
#define PG8_LAS __attribute__((address_space(3)))
typedef unsigned short bf16_t;
typedef short bf16x8 __attribute__((ext_vector_type(8)));
typedef float f32x4 __attribute__((ext_vector_type(4)));
typedef unsigned u32x4 __attribute__((ext_vector_type(4)));
constexpr int BM = 256, BK = 64, HALF = 128, HTB = HALF * BK * 2  , STAGE_BYTES = 8 * HTB, NXCD = 8, WGM = 8;

__host__ __device__ __forceinline__ int lds_byte(int r, int c) { const int st = (r >> 4) * 2 + (c >> 5), rr = r & 15, cc = c & 31, ob = rr * 64 + cc * 2; return st * 1024 + (ob ^ (((ob >> 9) & 1) << 5)); }
__host__ __device__ __forceinline__ void stage_rc(int b, int& R, int& C) { const int st = b / 1024, sb = b % 1024, swz = sb ^ (((sb >> 9) & 1) << 5); R = (st >> 1) * 16 + swz / 64; C = (st & 1) * 32 + (swz % 64) / 2; }
__host__ __device__ __forceinline__ int perm32(int rho) { const int n = rho >> 4, i = rho & 15; return 8 * (i >> 2) + 4 * n + (i & 3); }

struct Unit { int pm, pn, e; };
struct Gemm { const bf16_t* A; const bf16_t* Bt; int M, N, K, lda, ldb; };

struct StaticOrder {
    int nM, nN, nwg, G, c;
    __host__ __device__ void init(int M, int N, int G_, int c_) { nM = M / BM; nN = N / BM; nwg = nM * nN; G = G_; c = c_; }
    __host__ __device__ bool next(int i, Unit& u) const {
        const long L = (long)i * G + c; if (L >= nwg) return false;
        int wgid = (int)L; { const int q = nwg / NXCD, r = nwg % NXCD, xcd = wgid % NXCD, off = wgid / NXCD; wgid = (xcd < r ? xcd * (q + 1) : r * (q + 1) + (xcd - r) * q) + off; }
        const int nig = WGM * nN, gid = wgid / nig, fm = gid * WGM, gsz = (nM - fm) < WGM ? (nM - fm) : WGM;
        u.pm = fm + ((wgid % nig) % gsz); u.pn = (wgid % nig) / gsz; u.e = 0; return true;
    }
    __device__ __forceinline__ void a_ready(const Unit&) const {}
    __device__ __forceinline__ void done(const Unit&) const {}
    __device__ __forceinline__ const char* bbase(const Gemm& g, const Unit&) const { return (const char*)g.Bt; }
    __device__ __forceinline__ const char* abase(const Gemm& g, const Unit&) const { return (const char*)g.A; }
};

template <class Epi, class Sched, bool ALIGN_EPI = false, bool SP2 = false>
__device__ __forceinline__ void gemm_phase(PG8_LAS unsigned char* lds, const Gemm g, const Sched& S, const Epi& E, int tid_in) {
    int tid_l = tid_in; asm volatile("" : "+v"(tid_l));
    const int tid = tid_l, wid = __builtin_amdgcn_readfirstlane(tid >> 6), lane = tid & 63, wr = wid >> 2, wc = wid & 3, fr = lane & 15, fq = lane >> 4;
    const int K = g.K, nt = K / BK;
    unsigned voffA[2], voffB[2];
#pragma unroll
    for (int i = 0; i < 2; ++i) { int R, C; stage_rc(tid * 16 + i * 8192, R, C); const int Rb = Epi::PERM ? ((R & ~31) + perm32(R & 31)) : R;
        voffA[i] = (unsigned)(R * g.lda + C) * 2u; voffB[i] = (unsigned)(Rb * g.ldb + C) * 2u; }
    const size_t kstep = (size_t)(BK * 2);
    const size_t hstepA = (size_t)HALF * g.lda * 2, hstepB = (size_t)HALF * g.ldb * 2;
    const size_t tstepA = 2 * hstepA, tstepB = 2 * hstepB;
    const unsigned ldsw = (unsigned)wid * 1024u;
    const int aoff = lds_byte(wr * 64 + fr, fq * 8), boff = lds_byte(wc * 32 + fr, fq * 8);
#define PG8_SA(b, h) (((b) * 2 + (h)) * HTB)
#define PG8_SB(b, h) ((4 + (b) * 2 + (h)) * HTB)
#define PG8_STAGE(bufoff, gbase, voff) do { _Pragma("unroll") for (int _i = 0; _i < 2; ++_i) \
        __builtin_amdgcn_global_load_lds((const unsigned*)((const char*)(gbase) + (voff)[_i]), (PG8_LAS unsigned*)(lds + (bufoff) + ldsw + _i * 8192), 16, 0, 0); } while (0)
#define PG8_LDA(dst, b, h) do { _Pragma("unroll") for (int m = 0; m < 4; ++m) _Pragma("unroll") for (int k = 0; k < 2; ++k) dst[m][k] = *(const PG8_LAS bf16x8*)(lds + PG8_SA(b, h) + aoff + m * 2048 + k * 1024); } while (0)
#define PG8_LDB(dst, b, h) do { _Pragma("unroll") for (int n = 0; n < 2; ++n) _Pragma("unroll") for (int k = 0; k < 2; ++k) dst[n][k] = *(const PG8_LAS bf16x8*)(lds + PG8_SB(b, h) + boff + n * 2048 + k * 1024); } while (0)
#define PG8_MMA(ai, bj, At, Bt) do { __builtin_amdgcn_s_setprio(1); _Pragma("unroll") for (int m = 0; m < 4; ++m) _Pragma("unroll") for (int n = 0; n < 2; ++n) _Pragma("unroll") for (int k = 0; k < 2; ++k) \
        acc[ai][bj][m][n] = __builtin_amdgcn_mfma_f32_16x16x32_bf16(Bt[n][k], At[m][k], acc[ai][bj][m][n], 0, 0, 0); __builtin_amdgcn_s_setprio(0); } while (0)
#define PG8_WAIT_V(n) asm volatile("s_waitcnt vmcnt(" #n ")" ::: "memory")
#define PG8_WAIT_L(n) asm volatile("s_waitcnt lgkmcnt(" #n ")" ::: "memory")
#define PG8_BAR __builtin_amdgcn_s_barrier()
#define PG8_SCHED __builtin_amdgcn_sched_barrier(0)
    Unit cur, nxt; int ui = 0;
    if (!S.next(0, cur)) return;
    float z0 = 0.f; asm volatile("" : "+v"(z0));
    const f32x4 zero4 = {z0, z0, z0, z0};
    f32x4 acc[2][2][4][2];
#pragma unroll
    for (int a = 0; a < 2; ++a)
#pragma unroll
        for (int b = 0; b < 2; ++b)
#pragma unroll
            for (int m = 0; m < 4; ++m)
#pragma unroll
                for (int n = 0; n < 2; ++n) acc[a][b][m][n] = zero4;
    bf16x8 At[4][2], B0[2][2], B1[2][2];
    const char* cA = S.abase(g, cur) + (size_t)cur.pm * tstepA; const char* cB = S.bbase(g, cur) + (size_t)cur.pn * tstepB;
    S.a_ready(cur);
    if constexpr (SP2) {
        PG8_STAGE(PG8_SB(0, 0), cB, voffB); PG8_STAGE(PG8_SB(0, 1), cB + hstepB, voffB); PG8_STAGE(PG8_SA(0, 0), cA, voffA); PG8_STAGE(PG8_SA(0, 1), cA + hstepA, voffA);
        if (wr == 1) PG8_BAR;
        PG8_WAIT_V(2); PG8_BAR;
        PG8_STAGE(PG8_SB(1, 0), cB + kstep, voffB); PG8_STAGE(PG8_SA(1, 0), cA + kstep, voffA); PG8_STAGE(PG8_SB(1, 1), cB + hstepB + kstep, voffB);
        PG8_WAIT_V(6); PG8_BAR;
    } else {
        PG8_STAGE(PG8_SB(0, 0), cB, voffB); PG8_STAGE(PG8_SA(0, 0), cA, voffA); PG8_STAGE(PG8_SB(0, 1), cB + hstepB, voffB); PG8_STAGE(PG8_SA(0, 1), cA + hstepA, voffA);
        if (wr == 1) PG8_BAR;
        PG8_WAIT_V(4); PG8_BAR;
        PG8_STAGE(PG8_SB(1, 0), cB + kstep, voffB); PG8_STAGE(PG8_SA(1, 0), cA + kstep, voffA); PG8_STAGE(PG8_SB(1, 1), cB + hstepB + kstep, voffB);
        PG8_WAIT_V(6); PG8_BAR;
    }
    for (;;) {
        const bool has_next = S.next(ui + 1, nxt);
        const char* nA = has_next ? S.abase(g, nxt) + (size_t)nxt.pm * tstepA : cA; const char* nB = has_next ? S.bbase(g, nxt) + (size_t)nxt.pn * tstepB : cB;
        for (int t = 0; t < nt; t += 2) {
            const bool last = (t == nt - 2);
            const char* a1 = cA + (size_t)(t + 1) * kstep;
            const char* a2 = last ? nA : cA + (size_t)(t + 2) * kstep; const char* b2 = last ? nB : cB + (size_t)(t + 2) * kstep;
            const char* a3 = a2 + kstep; const char* b3 = b2 + kstep;
            if (last && has_next) S.a_ready(nxt);
            if constexpr (SP2) {
            PG8_LDB(B0, 0, 0); PG8_LDB(B1, 0, 1); PG8_SCHED; PG8_LDA(At, 0, 0); PG8_STAGE(PG8_SA(1, 1), a1 + hstepA, voffA);
            PG8_WAIT_V(8); PG8_WAIT_L(0); PG8_BAR; PG8_MMA(0, 0, At, B0); PG8_MMA(0, 1, At, B1); PG8_BAR; PG8_SCHED;
            PG8_LDA(At, 0, 1); PG8_STAGE(PG8_SB(0, 0), b2, voffB); PG8_STAGE(PG8_SB(0, 1), b2 + hstepB, voffB); PG8_STAGE(PG8_SA(0, 0), a2, voffA);
            PG8_WAIT_V(8); PG8_WAIT_L(0); PG8_BAR; PG8_MMA(1, 0, At, B0); PG8_MMA(1, 1, At, B1); PG8_BAR; PG8_SCHED;
            PG8_LDB(B0, 1, 0); PG8_LDB(B1, 1, 1); PG8_SCHED; PG8_LDA(At, 1, 0); PG8_STAGE(PG8_SA(0, 1), a2 + hstepA, voffA);
            PG8_WAIT_V(8); PG8_WAIT_L(0); PG8_BAR; PG8_MMA(0, 0, At, B0); PG8_MMA(0, 1, At, B1); PG8_BAR; PG8_SCHED;
            PG8_LDA(At, 1, 1); PG8_STAGE(PG8_SB(1, 0), b3, voffB); PG8_STAGE(PG8_SB(1, 1), b3 + hstepB, voffB); PG8_STAGE(PG8_SA(1, 0), a3, voffA);
            PG8_WAIT_V(8); PG8_WAIT_L(0); PG8_BAR; PG8_MMA(1, 0, At, B0); PG8_MMA(1, 1, At, B1); PG8_BAR; PG8_SCHED;
            } else {
            PG8_LDB(B0, 0, 0); PG8_SCHED; PG8_LDA(At, 0, 0); PG8_STAGE(PG8_SA(1, 1), a1 + hstepA, voffA);
            PG8_WAIT_L(8); PG8_BAR; PG8_WAIT_L(0); PG8_MMA(0, 0, At, B0); PG8_BAR; PG8_SCHED;
            PG8_LDB(B1, 0, 1); PG8_STAGE(PG8_SB(0, 0), b2, voffB);
            PG8_BAR; PG8_WAIT_L(0); PG8_MMA(0, 1, At, B1); PG8_BAR;
            PG8_LDA(At, 0, 1); PG8_STAGE(PG8_SA(0, 0), a2, voffA);
            PG8_BAR; PG8_WAIT_L(0); PG8_MMA(1, 0, At, B0); PG8_BAR; PG8_SCHED;
            PG8_STAGE(PG8_SB(0, 1), b2 + hstepB, voffB);
            PG8_WAIT_V(6); PG8_BAR; PG8_MMA(1, 1, At, B1); PG8_BAR;
            PG8_LDB(B0, 1, 0); PG8_SCHED; PG8_LDA(At, 1, 0); PG8_STAGE(PG8_SA(0, 1), a2 + hstepA, voffA);
            PG8_WAIT_L(8); PG8_BAR; PG8_WAIT_L(0); PG8_MMA(0, 0, At, B0); PG8_BAR; PG8_SCHED;
            PG8_LDB(B1, 1, 1); PG8_STAGE(PG8_SB(1, 0), b3, voffB);
            PG8_BAR; PG8_WAIT_L(0); PG8_MMA(0, 1, At, B1); PG8_BAR;
            PG8_LDA(At, 1, 1); PG8_STAGE(PG8_SA(1, 0), a3, voffA);
            PG8_BAR; PG8_WAIT_L(0); PG8_MMA(1, 0, At, B0); PG8_BAR; PG8_SCHED;
            PG8_STAGE(PG8_SB(1, 1), b3 + hstepB, voffB);
            PG8_WAIT_V(6); PG8_BAR; PG8_MMA(1, 1, At, B1); PG8_BAR;
            }
        }
        if constexpr (ALIGN_EPI) { if (wr == 0) PG8_BAR; }
        if constexpr (!Epi::AFTER_DRAIN) { E(acc, cur, wr, wc, fr, fq); S.done(cur); }
        if (!has_next) break;
#pragma unroll
        for (int a = 0; a < 2; ++a)
#pragma unroll
            for (int b = 0; b < 2; ++b)
#pragma unroll
                for (int m = 0; m < 4; ++m)
#pragma unroll
                    for (int n = 0; n < 2; ++n) acc[a][b][m][n] = zero4;
        cur = nxt; cA = nA; cB = nB; ++ui;
        if constexpr (ALIGN_EPI) { if (wr == 1) PG8_BAR; }
    }
    PG8_WAIT_V(0);
    if constexpr (!ALIGN_EPI) { if (wr == 0) PG8_BAR; }
    PG8_BAR;
    if constexpr (Epi::AFTER_DRAIN) { E.fused(acc, cur, wr, wc, fr, fq, lds, wid, lane); S.done(cur); }
#undef PG8_SA
#undef PG8_SB
#undef PG8_STAGE
#undef PG8_LDA
#undef PG8_LDB
#undef PG8_MMA
#undef PG8_WAIT_V
#undef PG8_WAIT_L
#undef PG8_BAR
#undef PG8_SCHED
}
}

namespace pg8 {
__device__ __forceinline__ unsigned cvt_pk_bf16(float lo, float hi) { unsigned r; asm volatile("v_cvt_pk_bf16_f32 %0, %1, %2" : "=v"(r) : "v"(lo), "v"(hi)); return r; }

struct EpiBf16 {
    static constexpr bool PERM = true, AFTER_DRAIN = false;
    bf16_t* O; int ldc; size_t oL, oB, oH;
    __device__ __forceinline__ void operator()(const f32x4 (&acc)[2][2][4][2], const Unit& u, int wr, int wc, int fr, int fq) const {
        const int row0 = u.pm * BM + wr * 64 + fr; const int col0 = u.pn * BM + wc * 32 + 8 * fq;
        bf16_t* Ob = O + (size_t)(u.e >> 4) * oL + (size_t)((u.e >> 2) & 3) * oB + (size_t)(u.e & 3) * oH;
#pragma unroll
        for (int ai = 0; ai < 2; ++ai)
#pragma unroll
            for (int m = 0; m < 4; ++m) { bf16_t* rowp = Ob + (size_t)(row0 + ai * HALF + m * 16) * ldc + col0;
#pragma unroll
                for (int bj = 0; bj < 2; ++bj) { const f32x4 v0 = acc[ai][bj][m][0], v1 = acc[ai][bj][m][1];
                    u32x4 w; w.x = cvt_pk_bf16(v0[0], v0[1]); w.y = cvt_pk_bf16(v0[2], v0[3]); w.z = cvt_pk_bf16(v1[0], v1[1]); w.w = cvt_pk_bf16(v1[2], v1[3]);
                    *(u32x4*)(rowp + bj * HALF) = w; } }
    }
};
__device__ __forceinline__ void row_stats(const float* stat, int row0, int fq, float (&mu)[2][4], float (&rs)[2][4]) {
#pragma unroll
    for (int ai = 0; ai < 2; ++ai)
#pragma unroll
        for (int m = 0; m < 4; ++m) { const f32x4* p = (const f32x4*)((const char*)stat + (unsigned)(((row0 + ai * HALF + m * 16) * 32 + fq * 8) * 4)); const f32x4 a = p[0], b = p[1];
            float s = (a[0] + a[2]) + (b[0] + b[2]), q = (a[1] + a[3]) + (b[1] + b[3]);
            s += __shfl_xor(s, 16); s += __shfl_xor(s, 32); q += __shfl_xor(q, 16); q += __shfl_xor(q, 32);
            const float mean = s * (1.0f / 1024.0f), var = fmaxf(q * (1.0f / 1024.0f) - mean * mean, 0.f);
            mu[ai][m] = mean; rs[ai][m] = 1.0f / sqrtf(var + 1e-5f); }
}
struct EpiSoftmax {
    static constexpr bool PERM = true, AFTER_DRAIN = false;
    bf16_t* O; int ldc; float scl; PG8_LAS float* xch;
    const float* stat; const float* cvec; const float* dvec; int vstride;
    __device__ __forceinline__ void operator()(f32x4 (&acc)[2][2][4][2], const Unit& u, int wr, int wc, int fr, int fq) const {
        typedef float f32x2v __attribute__((ext_vector_type(2)));
        asm volatile("" : "+v"(fr), "+v"(fq));
        if (stat) {
            float mu[2][4], rs[2][4]; row_stats(stat, u.pm * BM + wr * 64 + fr, fq, mu, rs);
            const int cb = (u.pm >> 5) * vstride + u.pn * BM + wc * 32 + 8 * fq;
#pragma unroll
            for (int bj = 0; bj < 2; ++bj)
#pragma unroll
                for (int n = 0; n < 2; ++n) { const f32x4 c4 = *(const f32x4*)(cvec + cb + bj * HALF + 4 * n), d4 = *(const f32x4*)(dvec + cb + bj * HALF + 4 * n);
#pragma unroll
                    for (int ai = 0; ai < 2; ++ai)
#pragma unroll
                        for (int m = 0; m < 4; ++m) acc[ai][bj][m][n] = (acc[ai][bj][m][n] - c4 * mu[ai][m]) * rs[ai][m] + d4; }
        }
        PG8_LAS float* const xw = xch + ((wr * 64 + fr) * 4 + wc) * 2; const PG8_LAS float* const xr = xch + (wr * 64 + fr) * 8;
#pragma unroll
        for (int ai = 0; ai < 2; ++ai)
#pragma unroll
            for (int m = 0; m < 4; ++m) {
                float mx = -INFINITY;
#pragma unroll
                for (int bj = 0; bj < 2; ++bj)
#pragma unroll
                    for (int n = 0; n < 2; ++n) { const f32x4 x = acc[ai][bj][m][n]; mx = fmaxf(mx, fmaxf(fmaxf(x[0], x[1]), fmaxf(x[2], x[3]))); }
                mx = fmaxf(mx, __shfl_xor(mx, 16)); mx = fmaxf(mx, __shfl_xor(mx, 32));
                float s = 0.f;
#pragma unroll
                for (int bj = 0; bj < 2; ++bj)
#pragma unroll
                    for (int n = 0; n < 2; ++n) { f32x4 x = acc[ai][bj][m][n];
#pragma unroll
                        for (int i = 0; i < 4; ++i) { x[i] = __builtin_amdgcn_exp2f((x[i] - mx) * scl); s += x[i]; }
                        acc[ai][bj][m][n] = x; }
                s += __shfl_xor(s, 16); s += __shfl_xor(s, 32);
                if (fq == 0) *(PG8_LAS f32x2v*)(xw + (ai * HALF + m * 16) * 8) = (f32x2v){mx, s};
            }
        asm volatile("s_waitcnt lgkmcnt(0)" ::: "memory"); __builtin_amdgcn_s_barrier(); asm volatile("" ::: "memory");
        const int row0 = u.pm * BM + wr * 64 + fr; const int col0 = u.pn * BM + wc * 32 + 8 * fq;
#pragma unroll
        for (int ai = 0; ai < 2; ++ai)
#pragma unroll
            for (int m = 0; m < 4; ++m) {
                const PG8_LAS f32x4* xp = (const PG8_LAS f32x4*)(xr + (ai * HALF + m * 16) * 8);
                const f32x4 p01 = xp[0], p23 = xp[1];
                const float gm = fmaxf(fmaxf(p01[0], p01[2]), fmaxf(p23[0], p23[2]));
                const float gs = p01[1] * __builtin_amdgcn_exp2f((p01[0] - gm) * scl) + p01[3] * __builtin_amdgcn_exp2f((p01[2] - gm) * scl) + p23[1] * __builtin_amdgcn_exp2f((p23[0] - gm) * scl) + p23[3] * __builtin_amdgcn_exp2f((p23[2] - gm) * scl);
                const float own = (wc == 0) ? p01[0] : (wc == 1) ? p01[2] : (wc == 2) ? p23[0] : p23[2];
                const float f = __builtin_amdgcn_exp2f((own - gm) * scl) / gs;
                bf16_t* rowp = (bf16_t*)((char*)O + (unsigned)(((row0 + ai * HALF + m * 16) * ldc + col0) * 2));
#pragma unroll
                for (int bj = 0; bj < 2; ++bj) { const f32x4 v0 = acc[ai][bj][m][0] * f, v1 = acc[ai][bj][m][1] * f;
                    u32x4 w; w.x = cvt_pk_bf16(v0[0], v0[1]); w.y = cvt_pk_bf16(v0[2], v0[3]); w.z = cvt_pk_bf16(v1[0], v1[1]); w.w = cvt_pk_bf16(v1[2], v1[3]);
                    *(u32x4*)(rowp + bj * HALF) = w; }
            }
    }
};
struct EpiF32Res {
    static constexpr bool PERM = false, AFTER_DRAIN = false;
    float* out; const float* res32; const bf16_t* res16; int ldc; float alpha;
    __device__ __forceinline__ void operator()(const f32x4 (&acc)[2][2][4][2], const Unit& u, int wr, int wc, int fr, int fq) const {
        const int row0 = u.pm * BM + wr * 64 + fr; const int col0 = u.pn * BM + wc * 32 + 4 * fq;
#pragma unroll
        for (int ai = 0; ai < 2; ++ai)
#pragma unroll
            for (int m = 0; m < 4; ++m) { const size_t off = (size_t)(row0 + ai * HALF + m * 16) * ldc + col0;
#pragma unroll
                for (int bj = 0; bj < 2; ++bj)
#pragma unroll
                    for (int n = 0; n < 2; ++n) { f32x4 v = acc[ai][bj][m][n]; const size_t o2 = off + bj * HALF + n * 16;
                        if (res32) { const f32x4 r = *(const f32x4*)(res32 + o2); v = v + r * alpha; }
                        else if (res16) { const u32x2 r = *(const u32x2*)(res16 + o2); v[0] += alpha * __uint_as_float(r.x << 16); v[1] += alpha * __uint_as_float(r.x & 0xffff0000u); v[2] += alpha * __uint_as_float(r.y << 16); v[3] += alpha * __uint_as_float(r.y & 0xffff0000u); }
                        *(f32x4*)(out + o2) = v; } }
    }
};
struct EpiRes {
    static constexpr bool PERM = false, AFTER_DRAIN = false;
    float* out32; bf16_t* xb; const float* res32; int rmode; const float* pstat; const float* pg; const float* pb; float* nstat; int ldc; float alpha;
    __device__ __forceinline__ void operator()(const f32x4 (&acc)[2][2][4][2], const Unit& u, int wr, int wc, int fr, int fq) const {
        asm volatile("" : "+v"(fr), "+v"(fq));
        const int row0 = u.pm * BM + wr * 64 + fr; const int col0 = u.pn * BM + wc * 32 + 4 * fq;
        float mu[2][4], rs[2][4], ss[2][4], qq[2][4];
#pragma unroll
        for (int ai = 0; ai < 2; ++ai)
#pragma unroll
            for (int m = 0; m < 4; ++m) { mu[ai][m] = 0.f; rs[ai][m] = 1.f; ss[ai][m] = 0.f; qq[ai][m] = 0.f; }
        if (rmode == 3) row_stats(pstat, row0, fq, mu, rs);
#pragma unroll
        for (int bj = 0; bj < 2; ++bj)
#pragma unroll
            for (int n = 0; n < 2; ++n) { const int col = col0 + bj * HALF + n * 16;
                f32x4 g4 = {1.f, 1.f, 1.f, 1.f}, b4 = {0.f, 0.f, 0.f, 0.f};
                if (rmode == 3) { g4 = *(const f32x4*)(pg + col); b4 = *(const f32x4*)(pb + col); }
#pragma unroll
                for (int ai = 0; ai < 2; ++ai)
#pragma unroll
                    for (int m = 0; m < 4; ++m) { const unsigned o2 = (unsigned)((row0 + ai * HALF + m * 16) * ldc + col); f32x4 v = acc[ai][bj][m][n];
                        if (rmode == 1) { v = v + *(const f32x4*)((const char*)res32 + o2 * 4u) * alpha; }
                        else if (rmode >= 2) { const u32x2 r = *(const u32x2*)((const char*)xb + o2 * 2u); f32x4 x = {__uint_as_float(r.x << 16), __uint_as_float(r.x & 0xffff0000u), __uint_as_float(r.y << 16), __uint_as_float(r.y & 0xffff0000u)};
                            if (rmode == 3) x = (x - mu[ai][m]) * rs[ai][m] * g4 + b4;
                            v = v + x * alpha; }
                        if (out32) *(f32x4*)((char*)out32 + o2 * 4u) = v;
                        else { u32x2 w; w.x = cvt_pk_bf16(v[0], v[1]); w.y = cvt_pk_bf16(v[2], v[3]); *(u32x2*)((char*)xb + o2 * 2u) = w;
                            ss[ai][m] += (v[0] + v[1]) + (v[2] + v[3]); qq[ai][m] += (v[0] * v[0] + v[1] * v[1]) + (v[2] * v[2] + v[3] * v[3]); } } }
        if (!out32) {
#pragma unroll
            for (int ai = 0; ai < 2; ++ai)
#pragma unroll
                for (int m = 0; m < 4; ++m) { float s = ss[ai][m], q = qq[ai][m]; s += __shfl_xor(s, 16); s += __shfl_xor(s, 32); q += __shfl_xor(q, 16); q += __shfl_xor(q, 32);
                    if (fq == 0) { typedef float f32x2v __attribute__((ext_vector_type(2))); *(f32x2v*)((char*)nstat + (unsigned)((((row0 + ai * HALF + m * 16) * 16 + u.pn * 4 + wc) * 2) * 4)) = (f32x2v){s, q}; } }
        }
    }
};
struct EpiSwiglu {
    static constexpr bool PERM = true, AFTER_DRAIN = false;
    bf16_t* H; int ldh;
    __device__ __forceinline__ void operator()(const f32x4 (&acc)[2][2][4][2], const Unit& u, int wr, int wc, int fr, int fq) const {
        const int row0 = u.pm * BM + wr * 64 + fr; const int col0 = u.pn * BM + wc * 32 + 8 * fq;
#pragma unroll
        for (int ai = 0; ai < 2; ++ai)
#pragma unroll
            for (int m = 0; m < 4; ++m) { bf16_t* rowp = H + (size_t)(row0 + ai * HALF + m * 16) * ldh;
#pragma unroll
                for (int bj = 0; bj < 2; ++bj) { const f32x4 v0 = acc[ai][bj][m][0], v1 = acc[ai][bj][m][1];
                    const float h0 = v0[0] / (1.0f + __expf(-v0[0])) * v0[1], h1 = v0[2] / (1.0f + __expf(-v0[2])) * v0[3];
                    const float h2 = v1[0] / (1.0f + __expf(-v1[0])) * v1[1], h3 = v1[2] / (1.0f + __expf(-v1[2])) * v1[3];
                    u32x2 w; w.x = cvt_pk_bf16(h0, h1); w.y = cvt_pk_bf16(h2, h3);
                    *(u32x2*)(rowp + ((col0 + bj * HALF) >> 1)) = w; } }
    }
};
struct GroupedOrder : StaticOrder {
    int pend[8]; size_t estride;
    __device__ __forceinline__ const char* bbase(const Gemm& g, const Unit& u) const {
        int e = 0;
#pragma unroll
        for (int k = 0; k < 7; ++k) e += (u.pm >= pend[k]) ? 1 : 0;
        return (const char*)g.Bt + (size_t)e * estride;
    }
};
struct BatchedOrder {
    int nM, per, nwg, G, c; size_t aL, aB, aH, bL, bB, bH;
    __device__ __forceinline__ void init(int nM_, int nN_, int nprob, int G_, int c_) { nM = nM_; per = nM_ * nN_; nwg = per * nprob; G = G_; c = c_; }
    __device__ __forceinline__ bool next(int i, Unit& u) const { const long L = (long)i * G + c; if (L >= nwg) return false; const int e = (int)(L / per), r = (int)(L % per); u.e = e; u.pm = r % nM; u.pn = r / nM; return true; }
    __device__ __forceinline__ void a_ready(const Unit&) const {}
    __device__ __forceinline__ void done(const Unit&) const {}
    __device__ __forceinline__ const char* abase(const Gemm& g, const Unit& u) const { return (const char*)g.A + (size_t)(u.e >> 4) * aL + (size_t)((u.e >> 2) & 3) * aB + (size_t)(u.e & 3) * aH; }
    __device__ __forceinline__ const char* bbase(const Gemm& g, const Unit& u) const { return (const char*)g.Bt + (size_t)(u.e >> 4) * bL + (size_t)((u.e >> 2) & 3) * bB + (size_t)(u.e & 3) * bH; }
};
}
#define XB_TMO      128
#define XB_XCNT(j)  (256  + 64 * (j))
#define XB_XSUB(j)  (1280 + 64 * (j))
#define XB_XGEN(j)  (2304 + 64 * (j))
#define XB_TOP      3328
#define XB_TOPGEN   3392
#define XCD_BAR_WORDS 3456
#define XB_SPIN_CAP (1u << 18)

__device__ __forceinline__ unsigned xb_ld(unsigned* p)              { return __hip_atomic_load(p, __ATOMIC_RELAXED, __HIP_MEMORY_SCOPE_AGENT); }
__device__ __forceinline__ unsigned xb_add(unsigned* p, unsigned v) { return __hip_atomic_fetch_add(p, v, __ATOMIC_RELAXED, __HIP_MEMORY_SCOPE_AGENT); }
__device__ __forceinline__ unsigned xb_xcc_id() { return (unsigned)__builtin_amdgcn_s_getreg((3 << 11) | 20) & 0xFu; }
#define XB_SPIN(cond, bar) do { unsigned _sp = 0; while (cond) { __builtin_amdgcn_s_sleep(1); \
    if ((++_sp & 255u) == 0u) { if (xb_ld(&(bar)[XB_TMO])) break; if (_sp > XB_SPIN_CAP) { atomicAdd(&(bar)[XB_TMO], 1u); break; } } } } while (0)

struct XcdBarrier {
    unsigned* bar; unsigned x;
    volatile LAS unsigned* st;
};

__device__ __forceinline__ XcdBarrier xcd_barrier_post(unsigned* bar, volatile LAS unsigned* st, bool t0  ) {
    XcdBarrier b; b.bar = bar; b.x = xb_xcc_id(); b.st = st;
    if (t0) (void)xb_add(&bar[XB_XCNT(b.x)], 1u);
    return b;
}
__device__ __forceinline__ void xcd_barrier_complete(unsigned* bar, unsigned x, unsigned& nloc, unsigned& nx) {
    const unsigned G = gridDim.x * gridDim.y * gridDim.z;
    unsigned sum, cnt, mine, sp = 0u;
    for (;;) {
        sum = 0u; cnt = 0u; mine = 0u;
#pragma unroll
        for (unsigned j = 0; j < 16; ++j) { const unsigned c = xb_ld(&bar[XB_XCNT(j)]); sum += c; cnt += (c > 0u) ? 1u : 0u; mine = (j == x) ? c : mine; }
        if (sum == G) break;
        __builtin_amdgcn_s_sleep(1);
        if ((++sp & 255u) == 0u) { if (xb_ld(&bar[XB_TMO])) break; if (sp > XB_SPIN_CAP) { atomicAdd(&bar[XB_TMO], 1u); break; } }
    }
    nloc = mine > 0u ? mine : 1u; nx = cnt > 0u ? cnt : 1u;
}

__device__ __forceinline__ void xcd_barrier(const XcdBarrier& b, bool t0) {
    asm volatile("s_waitcnt vmcnt(0)" ::: "memory");
    __syncthreads();
    if (t0) {
        unsigned* bar = b.bar;
        __builtin_amdgcn_s_waitcnt(0);
        unsigned nloc = b.st[0], nx = b.st[1];
        if (nloc == 0u) { xcd_barrier_complete(bar, b.x, nloc, nx); b.st[0] = nloc; b.st[1] = nx; }
        const unsigned old = xb_add(&bar[XB_XSUB(b.x)], 1u);
        const unsigned gen = old / nloc;
        if (old + 1u == (gen + 1u) * nloc) {
            __builtin_amdgcn_fence(__ATOMIC_RELEASE, "agent");
            asm volatile("s_waitcnt vmcnt(0)" ::: "memory");
            const unsigned og = xb_add(&bar[XB_TOP], 1u);
            const unsigned tg = og / nx;
            if (og + 1u == (tg + 1u) * nx) xb_add(&bar[XB_TOPGEN], 1u);
            else XB_SPIN(xb_ld(&bar[XB_TOPGEN]) == tg, bar);
            __builtin_amdgcn_fence(__ATOMIC_ACQUIRE, "agent");
            xb_add(&bar[XB_XGEN(b.x)], 1u);
            asm volatile("s_waitcnt vmcnt(0)" ::: "memory");
        } else {
            XB_SPIN(xb_ld(&bar[XB_XGEN(b.x)]) == gen, bar);
            __builtin_amdgcn_fence(__ATOMIC_ACQUIRE, "agent");
            asm volatile("s_waitcnt vmcnt(0)" ::: "memory");
        }
    }
    __syncthreads();
}

struct Params { const float* in[35]; float* out; unsigned char* ws; int ph_lo, ph_hi, dbg, pad; };
enum { I_X = 0, I_MEM, I_WIN, I_POOLW, I_POOLS, I_PEK, I_KW1, I_KW2, I_PEV, I_VW1, I_VW2, I_SLNG, I_SLNB, I_SGUW, I_SGUB, I_CONVW, I_CONVB, I_CLNG, I_CLNB, I_CONVPW,
       I_WOUT, I_LN1G, I_LN1B, I_XQ, I_XKV, I_XO, I_LN2G, I_LN2B, I_W13, I_W2, I_ROUTER, I_E13, I_E2, I_LN3G, I_LN3B };

struct Ctx {
    const float* in[35];
    float* X;
    bf16 *XB, *Z, *Y, *Q, *H, *XG, *KC, *VC, *MEMB, *KVROW, *W1X, *W2X, *KCF, *VCF, *KSELF, *VSELF, *KWINF, *VWINF;
    bf16 *WINT, *WOUTT, *XQT, *XKVT, *XOT, *W13T, *W2T, *E13T, *E2T, *CW1T, *CW2T, *PWT, *POOLWT, *SGUWB;
    float *VBUF, *FS, *PEB, *TOKG, *STAT, *QB, *C1, *D1, *CIN, *DINV, *C13, *D13;
    int *HIST, *META, *TOKPOS; unsigned* TOKINFO;
    int tid, lane, wid, bid, G;
};

struct MatDesc { const float* src; bf16* dst; int K, N, Npad, split; };
__device__ __forceinline__ void get_mat(const Ctx& C, int id, MatDesc& d) {
    d.split = 0;
    if (id < 56) {
        const int l = id / 14, k = id % 14;
        if (k == 0)      { d.src = C.in[I_WIN] + (size_t)l * D * DIN;  d.dst = C.WINT + (size_t)l * DINP * D;  d.K = D; d.N = DIN; d.Npad = DINP; }
        else if (k == 1) { d.src = C.in[I_WOUT] + (size_t)l * D * D;   d.dst = C.WOUTT + (size_t)l * D * D;    d.K = D; d.N = D; d.Npad = D; }
        else if (k == 2) { d.src = C.in[I_XQ] + (size_t)l * D * D;     d.dst = C.XQT + (size_t)l * D * D;      d.K = 0; d.N = D; d.Npad = D; }
        else if (k == 3) { d.src = C.in[I_XKV] + (size_t)l * D * 2 * D; d.dst = C.XKVT + (size_t)l * 2 * D * D; d.K = D; d.N = 2 * D; d.Npad = 2 * D; }
        else if (k == 4) { d.src = C.in[I_XO] + (size_t)l * D * D;     d.dst = C.XOT + (size_t)l * D * D;      d.K = D; d.N = D; d.Npad = D; }
        else if (k == 5) { d.src = C.in[I_KW1] + (size_t)l * 2048 * 256; d.dst = C.CW1T + (size_t)(l * 2 + 0) * 256 * 2048; d.K = 2048; d.N = 256; d.Npad = 256; }
        else if (k == 6) { d.src = C.in[I_VW1] + (size_t)l * 2048 * 256; d.dst = C.CW1T + (size_t)(l * 2 + 1) * 256 * 2048; d.K = 2048; d.N = 256; d.Npad = 256; }
        else if (k == 7) { d.src = C.in[I_KW2] + (size_t)l * 256 * 64; d.dst = C.CW2T + (size_t)(l * 2 + 0) * 64 * 256; d.K = 256; d.N = 64; d.Npad = 64; }
        else if (k == 8) { d.src = C.in[I_VW2] + (size_t)l * 256 * 64; d.dst = C.CW2T + (size_t)(l * 2 + 1) * 64 * 256; d.K = 256; d.N = 64; d.Npad = 64; }
        else if (k == 9) { d.src = C.in[I_CONVPW] + (size_t)l * 256 * 256; d.dst = C.PWT + (size_t)l * 256 * 256; d.K = 256; d.N = 256; d.Npad = 256; }
        else { const int g = k - 10; d.src = C.in[I_POOLW] + (size_t)(l * 4 + g) * 64 * 64; d.dst = C.POOLWT + (size_t)(l * 4 + g) * 64 * 64; d.K = 64; d.N = 64; d.Npad = 64; }
    } else if (id < 60) {
        const int i = (id - 56) >> 1, w = (id - 56) & 1;
        if (w == 0) { d.src = C.in[I_W13] + (size_t)i * D * 2 * FF; d.dst = C.W13T + (size_t)i * 2 * FF * D; d.K = D; d.N = 2 * FF; d.Npad = 2 * FF; d.split = FF; }
        else        { d.src = C.in[I_W2] + (size_t)i * FF * D;      d.dst = C.W2T + (size_t)i * D * FF;      d.K = FF; d.N = D; d.Npad = D; }
    } else {
        const int j = id - 60, ie = j >> 1, w = j & 1;
        if (w == 0) { d.src = C.in[I_E13] + (size_t)ie * D * 2 * FE; d.dst = C.E13T + (size_t)ie * 2 * FE * D; d.K = D; d.N = 2 * FE; d.Npad = 2 * FE; d.split = FE; }
        else        { d.src = C.in[I_E2] + (size_t)ie * FE * D;      d.dst = C.E2T + (size_t)ie * D * FE;      d.K = FE; d.N = D; d.Npad = D; }
    }
}
__device__ __forceinline__ void transpose_item(const MatDesc& d, LAS float* scr, int item, int lane) {
    const int nblk = d.Npad / 32, kb = item / nblk, nb = item % nblk, k0 = 64 * kb, n0 = 32 * nb;
    const int ncol = n0 + 4 * (lane & 7); const bool ok = ncol < d.N;
    f32x4 v[8];
#pragma unroll
    for (int i = 0; i < 8; ++i) { const int kk = 8 * i + (lane >> 3); v[i] = ok ? *(const f32x4*)(d.src + (size_t)(k0 + kk) * d.N + ncol) : (f32x4){0.f, 0.f, 0.f, 0.f}; }
#pragma unroll
    for (int i = 0; i < 8; ++i) { const int kk = 8 * i + (lane >> 3); LAS float* p = scr + kk * 33 + 4 * (lane & 7); p[0] = v[i][0]; p[1] = v[i][1]; p[2] = v[i][2]; p[3] = v[i][3]; }
    LDS_WAIT();
    const int c = lane & 7;
#pragma unroll
    for (int j = 0; j < 4; ++j) { const int n = (lane >> 3) + 8 * j; const LAS float* s = scr + (8 * c) * 33 + n;
        u32x4 o; o.x = pk2(s[0 * 33], s[1 * 33]); o.y = pk2(s[2 * 33], s[3 * 33]); o.z = pk2(s[4 * 33], s[5 * 33]); o.w = pk2(s[6 * 33], s[7 * 33]);
        const int ng = n0 + n; const int drow = d.split ? (ng < d.split ? 2 * ng : 2 * (ng - d.split) + 1) : ng;
        *(u32x4*)(d.dst + (size_t)drow * d.K + k0 + 8 * c) = o; }
    LDS_WAIT();
}
__device__ __forceinline__ void coldot64(const float* W, int K, int N, const float* vec, int n0, int ldw, float* out, int oidx, LAS unsigned char* lds, int wid, int lane) {
    LAS float* red = (LAS float*)(lds + 98304);
    const int n = n0 + lane; float s = 0.f;
    if (n < N) { const int k0 = wid * (K / 8);
#pragma unroll 8
        for (int k = k0; k < k0 + K / 8; ++k) s += vec[k] * W[(size_t)k * ldw + n]; }
    red[wid * 64 + lane] = s;
    __syncthreads();
    if (wid == 0) { float t = 0.f;
#pragma unroll
        for (int w = 0; w < 8; ++w) t += red[w * 64 + lane];
        out[oidx + lane] = t; }
    __syncthreads();
}
__device__ __forceinline__ void p0_prologue(const Ctx& C, LAS unsigned char* lds) {
    LAS float* scr = (LAS float*)(lds + C.wid * 8704);
    const int gw = C.bid * NWAVES + C.wid, NGW = C.G * NWAVES;
    int start = 0;
    for (int id = 0; id < 92; ++id) {
        MatDesc d; get_mat(C, id, d);
        const int ntiles = (d.K / 64) * (d.Npad / 32);
        int first = gw - start; if (first < 0) first += NGW;
        for (int it = first; it < ntiles; it += NGW) transpose_item(d, scr, it, C.lane);
        start = (start + ntiles) % NGW;
    }
    const int gt = C.bid * NTHREADS + C.tid, NGT = C.G * NTHREADS;
    { const f32x4* xs = (const f32x4*)C.in[I_X]; u32x4* xd = (u32x4*)C.XB;
      for (int i = gt; i < M * D / 8; i += NGT) { const f32x4 a = xs[2 * i], b = xs[2 * i + 1]; u32x4 o; o.x = pk2(a[0], a[1]); o.y = pk2(a[2], a[3]); o.z = pk2(b[0], b[1]); o.w = pk2(b[2], b[3]); xd[i] = o; } }
    { const f32x4* xs = (const f32x4*)C.in[I_MEM]; u32x4* xd = (u32x4*)C.MEMB;
      for (int i = gt; i < NB * MEM * D / 8; i += NGT) { const f32x4 a = xs[2 * i], b = xs[2 * i + 1]; u32x4 o; o.x = pk2(a[0], a[1]); o.y = pk2(a[2], a[3]); o.z = pk2(b[0], b[1]); o.w = pk2(b[2], b[3]); xd[i] = o; } }
    { const f32x4* xs = (const f32x4*)C.in[I_XQ]; u32x4* xd = (u32x4*)C.XQT;
      for (int i = gt; i < NL * D * D / 8; i += NGT) { const f32x4 a = xs[2 * i], b = xs[2 * i + 1]; const float gk = C.in[I_LN1G][i >> 7];
          u32x4 o; o.x = pk2(a[0] * gk, a[1] * gk); o.y = pk2(a[2] * gk, a[3] * gk); o.z = pk2(b[0] * gk, b[1] * gk); o.w = pk2(b[2] * gk, b[3] * gk); xd[i] = o; } }
    for (int task = C.bid; task < NL * (D / 64); task += C.G) { const int l = task / (D / 64), n0 = (task % (D / 64)) * 64;
        coldot64(C.in[I_XQ] + (size_t)l * D * D, D, D, C.in[I_LN1B] + l * D, n0, D, C.QB + l * D, n0, lds, C.wid, C.lane); }
    { const f32x4* ws = (const f32x4*)C.in[I_SGUW]; u32x4* wd = (u32x4*)C.SGUWB;
      for (int i = gt; i < NL * 4 * 128 * 128 / 8; i += NGT) { const int j0 = (i & 15) * 8, ii = (i >> 4) & 127; const f32x4 a = ws[2 * i], b = ws[2 * i + 1];
          float v[8] = {a[0], a[1], a[2], a[3], b[0], b[1], b[2], b[3]};
#pragma unroll
          for (int e = 0; e < 8; ++e) v[e] = (j0 + e <= ii) ? v[e] : 0.f;
          u32x4 o; o.x = pk2(v[0], v[1]); o.y = pk2(v[2], v[3]); o.z = pk2(v[4], v[5]); o.w = pk2(v[6], v[7]); wd[i] = o; } }
    for (int o = gw; o < NL * 2 * 256; o += NGW) { const int n = o & 255, kv = (o >> 8) & 1, l = o >> 9;
        const float* pe = C.in[kv ? I_PEV : I_PEK] + (size_t)l * 2048; const float* w1 = C.in[kv ? I_VW1 : I_KW1] + (size_t)l * 2048 * 256;
        float s = 0.f;
        for (int k = C.lane; k < 2048; k += 64) s += pe[k] * w1[(size_t)k * 256 + n];
        s = wave_sum(s); if (C.lane == 0) C.PEB[o] = s; }
}

__device__ __forceinline__ void ln_phase(const Ctx& C, const float* src, const float* gam, const float* bet, int mode, const float* router, float* xout, LAS unsigned char* lds) {
    LAS float* rwT = (LAS float*)lds;
    LAS int* te = (LAS int*)(lds + 32768);
    LAS float* tgl = (LAS float*)(lds + 32768 + 1024);
    if (router) { for (int i = C.tid; i < 8192; i += NTHREADS) rwT[(i & 7) * 1024 + (i >> 3)] = router[i]; __syncthreads(); }
    f32x4 g4[4], b4[4];
#pragma unroll
    for (int j = 0; j < 4; ++j) { g4[j] = *(const f32x4*)(gam + 256 * j + 4 * C.lane); b4[j] = *(const f32x4*)(bet + 256 * j + 4 * C.lane); }
    for (int tile = C.bid; tile < M / 128; tile += C.G) {
        for (int i = 0; i < 16; ++i) {
            const int tl = 16 * C.wid + i; const size_t row = (size_t)tile * 128 + tl;
            f32x4 v[4];
            if (mode == 0) {
#pragma unroll
                for (int j = 0; j < 4; ++j) v[j] = *(const f32x4*)(src + row * D + 256 * j + 4 * C.lane);
            } else {
                const int p0 = C.TOKPOS[2 * row], p1 = C.TOKPOS[2 * row + 1]; const float g0 = C.TOKG[2 * row], g1 = C.TOKG[2 * row + 1];
#pragma unroll
                for (int j = 0; j < 4; ++j) { const u32x2 xr = *(const u32x2*)(C.XB + row * D + 256 * j + 4 * C.lane); const f32x4 x = {lo16(xr.x), hi16(xr.x), lo16(xr.y), hi16(xr.y)};
                    const f32x4 a = *(const f32x4*)(C.FS + (size_t)p0 * D + 256 * j + 4 * C.lane), b = *(const f32x4*)(C.FS + (size_t)p1 * D + 256 * j + 4 * C.lane);
                    v[j] = x * ALPHA + a * g0 + b * g1; }
            }
            float s = 0.f;
#pragma unroll
            for (int j = 0; j < 4; ++j) s += (v[j][0] + v[j][1]) + (v[j][2] + v[j][3]);
            const float mean = wave_sum(s) * (1.f / D); float s2 = 0.f;
#pragma unroll
            for (int j = 0; j < 4; ++j) { v[j] = v[j] - mean; s2 += (v[j][0] * v[j][0] + v[j][1] * v[j][1]) + (v[j][2] * v[j][2] + v[j][3] * v[j][3]); }
            const float rstd = 1.0f / sqrtf(wave_sum(s2) * (1.f / D) + LN_EPS);
#pragma unroll
            for (int j = 0; j < 4; ++j) { v[j] = v[j] * rstd * g4[j] + b4[j];
                if (xout) *(f32x4*)(xout + row * D + 256 * j + 4 * C.lane) = v[j];
                u32x2 o; o.x = pk2(v[j][0], v[j][1]); o.y = pk2(v[j][2], v[j][3]); *(u32x2*)(C.XB + row * D + 256 * j + 4 * C.lane) = o; }
            if (router) {
                float lg[8];
#pragma unroll
                for (int ex = 0; ex < 8; ++ex) { float a = 0.f;
#pragma unroll
                    for (int j = 0; j < 4; ++j) { const f32x4 w = *(const LAS f32x4*)(rwT + ex * 1024 + 256 * j + 4 * C.lane); a += (v[j][0] * w[0] + v[j][1] * w[1]) + (v[j][2] * w[2] + v[j][3] * w[3]); }
                    lg[ex] = wave_sum(a); }
                int e0 = 0; float l0 = lg[0];
#pragma unroll
                for (int ex = 1; ex < 8; ++ex) if (lg[ex] > l0) { l0 = lg[ex]; e0 = ex; }
                int e1 = -1; float l1 = -INFINITY;
#pragma unroll
                for (int ex = 0; ex < 8; ++ex) if (ex != e0 && lg[ex] > l1) { l1 = lg[ex]; e1 = ex; }
                const float ed = __expf(l1 - l0), ga = 1.0f / (1.0f + ed), gb = ed * ga;
                if (C.lane == 0) { te[2 * tl] = e0; te[2 * tl + 1] = e1; tgl[2 * tl] = ga; tgl[2 * tl + 1] = gb; }
            }
        }
        if (router) {
            __syncthreads();
            if (C.wid == 0) {
                int run[8];
#pragma unroll
                for (int ex = 0; ex < 8; ++ex) run[ex] = 0;
                for (int rr = 0; rr < 4; ++rr) { const int a = 64 * rr + C.lane; const int e = te[a]; int rank = 0;
#pragma unroll
                    for (int ex = 0; ex < 8; ++ex) { const unsigned long long mk = __ballot(e == ex); if (e == ex) rank = run[ex] + __popcll(mk & ((1ull << C.lane) - 1ull)); run[ex] += __popcll(mk); }
                    C.TOKINFO[(size_t)tile * 256 + a] = (unsigned)e | ((unsigned)rank << 8); C.TOKG[(size_t)tile * 256 + a] = tgl[a]; }
#pragma unroll
                for (int ex = 0; ex < 8; ++ex) if (C.lane == ex) C.HIST[tile * 8 + ex] = run[ex];
            }
            __syncthreads();
        }
    }
}

struct ConvW { f32x4 w[31]; f32x4 cb, lg, lb; };
__device__ __forceinline__ void load_convw(const Ctx& C, int l, ConvW& cw) {
#pragma unroll
    for (int k = 0; k < 31; ++k) cw.w[k] = *(const f32x4*)(C.in[I_CONVW] + ((size_t)l * 31 + k) * 256 + 4 * C.lane);
    cw.cb = *(const f32x4*)(C.in[I_CONVB] + l * 256 + 4 * C.lane); cw.lg = *(const f32x4*)(C.in[I_CLNG] + l * 256 + 4 * C.lane); cw.lb = *(const f32x4*)(C.in[I_CLNB] + l * 256 + 4 * C.lane);
}
template <int WHICH>
__device__ __forceinline__ void mixers_tile(const Ctx& C, int l, int tb, LAS unsigned char* lds, const ConvW& cw) {
    const int tid = C.tid, wid = C.wid, lane = C.lane;
    const int b = tb >> 6, t0 = (tb & 63) << 7; const size_t R0 = (size_t)b * T + t0;
    const bf16* Zb = C.Z + (size_t)b * T * DINP;
    const int m16 = lane & 15, gq = lane >> 4, row = 16 * wid + m16;
    if constexpr ((WHICH & 1) != 0) {
        LAS bf16* Dl = (LAS bf16*)lds;
#pragma unroll
        for (int g = 0; g < 4; ++g) {
            constexpr int W4[4] = {2, 4, 8, 16}; const int w = W4[g];
            for (int it = tid; it < 128 * 8; it += NTHREADS) {
                const int tl = it >> 3, c8 = 8 * g + (it & 7), t = t0 + tl, n = (t + 1 < w) ? (t + 1) : w;
                float s[8];
#pragma unroll
                for (int e2 = 0; e2 < 8; ++e2) s[e2] = 0.f;
                u32x4 cur = {0u, 0u, 0u, 0u};
#pragma unroll
                for (int k = 0; k < W4[g]; ++k) {
                    u32x4 v = {0u, 0u, 0u, 0u};
                    if (k < n) v = *(const u32x4*)(Zb + (size_t)(t - k) * DINP + C_POOL + 8 * c8);
                    if (k == 0) cur = v;
                    s[0] += lo16(v.x); s[1] += hi16(v.x); s[2] += lo16(v.y); s[3] += hi16(v.y); s[4] += lo16(v.z); s[5] += hi16(v.z); s[6] += lo16(v.w); s[7] += hi16(v.w);
                }
                const float inv = 1.0f / (float)n;
                u32x4 o; o.x = pk2(s[0] * inv - lo16(cur.x), s[1] * inv - hi16(cur.x)); o.y = pk2(s[2] * inv - lo16(cur.y), s[3] * inv - hi16(cur.y));
                o.z = pk2(s[4] * inv - lo16(cur.z), s[5] * inv - hi16(cur.z)); o.w = pk2(s[6] * inv - lo16(cur.w), s[7] * inv - hi16(cur.w));
                *(LAS u32x4*)(Dl + tl * 264 + 8 * c8) = o;
            }
        }
        __syncthreads();
#pragma unroll
        for (int g = 0; g < 4; ++g) {
            bf16x8 a[2];
#pragma unroll
            for (int s = 0; s < 2; ++s) a[s] = *(const LAS bf16x8*)(Dl + row * 264 + g * 64 + 32 * s + 8 * gq);
#pragma unroll
            for (int nt = 0; nt < 4; ++nt) {
                f32x4 acc = {0.f, 0.f, 0.f, 0.f};
#pragma unroll
                for (int s = 0; s < 2; ++s) { const bf16x8 bfr = *(const bf16x8*)(C.POOLWT + ((size_t)((l * 4 + g) * 64 + 16 * nt + m16)) * 64 + 32 * s + 8 * gq); acc = mfma16(bfr, a[s], acc); }
                const int col = g * 64 + 16 * nt + 4 * gq;
                const f32x4 sc = *(const f32x4*)(C.in[I_POOLS] + l * 256 + col);
                u32x2 o; o.x = pk2(acc[0] * sc[0], acc[1] * sc[1]); o.y = pk2(acc[2] * sc[2], acc[3] * sc[3]);
                *(u32x2*)(C.Y + (R0 + row) * D + col) = o;
            }
        }
        __syncthreads();
    }
    if constexpr ((WHICH & 2) != 0) {
        LAS bf16* VnT = (LAS bf16*)lds;
        const f32x4 lg = *(const f32x4*)(C.in[I_SLNG] + l * 256 + 4 * lane), lb = *(const f32x4*)(C.in[I_SLNB] + l * 256 + 4 * lane);
        u32x2 vpre[16];
#pragma unroll
        for (int i = 0; i < 16; ++i) vpre[i] = *(const u32x2*)(C.Z + (R0 + 16 * wid + i) * DINP + C_V + 4 * lane);
#pragma unroll
        for (int i = 0; i < 16; ++i) {
            const int tl = 16 * wid + i;
            const u32x2 v = vpre[i];
            const float x0 = gelu_tanh(lo16(v.x)), x1 = gelu_tanh(hi16(v.x)), x2 = gelu_tanh(lo16(v.y)), x3 = gelu_tanh(hi16(v.y));
            const float mean = wave_sum((x0 + x1) + (x2 + x3)) * (1.f / 256.f);
            const float d0 = x0 - mean, d1 = x1 - mean, d2 = x2 - mean, d3 = x3 - mean;
            const float rstd = 1.0f / sqrtf(wave_sum((d0 * d0 + d1 * d1) + (d2 * d2 + d3 * d3)) * (1.f / 256.f) + LN_EPS);
            VnT[(4 * lane + 0) * 136 + tl] = (bf16)f2bf(d0 * rstd * lg[0] + lb[0]); VnT[(4 * lane + 1) * 136 + tl] = (bf16)f2bf(d1 * rstd * lg[1] + lb[1]);
            VnT[(4 * lane + 2) * 136 + tl] = (bf16)f2bf(d2 * rstd * lg[2] + lb[2]); VnT[(4 * lane + 3) * 136 + tl] = (bf16)f2bf(d3 * rstd * lg[3] + lb[3]);
        }
        __syncthreads();
        const int ns = (wid >> 1) + 1;
#pragma unroll
        for (int g = 0; g < 4; ++g) {
            f32x4 acc[4];
#pragma unroll
            for (int nt = 0; nt < 4; ++nt) acc[nt] = (f32x4){0.f, 0.f, 0.f, 0.f};
#pragma unroll
            for (int s = 0; s < 4; ++s) if (s < ns) {
                const bf16x8 a = *(const bf16x8*)(C.SGUWB + ((size_t)((l * 4 + g) * 128 + row)) * 128 + 32 * s + 8 * gq);
#pragma unroll
                for (int nt = 0; nt < 4; ++nt) { const bf16x8 bfr = *(const LAS bf16x8*)(VnT + (g * 64 + 16 * nt + m16) * 136 + 32 * s + 8 * gq); acc[nt] = mfma16(bfr, a, acc[nt]); }
            }
            const float bs = C.in[I_SGUB][(l * 4 + g) * 128 + row];
#pragma unroll
            for (int nt = 0; nt < 4; ++nt) {
                const int col = g * 64 + 16 * nt + 4 * gq;
                const u32x2 uu = *(const u32x2*)(C.Z + (R0 + row) * DINP + C_U + col);
                const float u0 = gelu_tanh(lo16(uu.x)), u1 = gelu_tanh(hi16(uu.x)), u2 = gelu_tanh(lo16(uu.y)), u3 = gelu_tanh(hi16(uu.y));
                u32x2 o; o.x = pk2(u0 * (acc[nt][0] + bs), u1 * (acc[nt][1] + bs)); o.y = pk2(u2 * (acc[nt][2] + bs), u3 * (acc[nt][3] + bs));
                *(u32x2*)(C.Y + (R0 + row) * D + 512 + col) = o;
            }
        }
        __syncthreads();
    }
    if constexpr ((WHICH & 4) != 0) {
        LAS bf16* Hg = (LAS bf16*)lds;
        LAS unsigned char* Hn = lds + 158 * 528;
        for (int it0 = tid; it0 < 158 * 64; it0 += 4 * NTHREADS) {
            u32x2 av[4], gv[4];
#pragma unroll
            for (int u = 0; u < 4; ++u) { const int it = it0 + u * NTHREADS; const int r = it >> 6, c4 = it & 63, t = t0 - 30 + r; av[u] = (u32x2){0u, 0u}; gv[u] = (u32x2){0u, 0u};
                if (it < 158 * 64 && t >= 0) { const bf16* zr = Zb + (size_t)t * DINP; av[u] = *(const u32x2*)(zr + C_CA + 4 * c4); gv[u] = *(const u32x2*)(zr + C_CG + 4 * c4); } }
#pragma unroll
            for (int u = 0; u < 4; ++u) { const int it = it0 + u * NTHREADS; const int r = it >> 6, c4 = it & 63;
                if (it < 158 * 64) { u32x2 o; o.x = pk2(lo16(av[u].x) * sigmoidf_(lo16(gv[u].x)), hi16(av[u].x) * sigmoidf_(hi16(gv[u].x))); o.y = pk2(lo16(av[u].y) * sigmoidf_(lo16(gv[u].y)), hi16(av[u].y) * sigmoidf_(hi16(gv[u].y)));
                    *(LAS u32x2*)(Hg + r * 264 + 4 * c4) = o; } }
        }
        __syncthreads();
        {
            const f32x4 cb = cw.cb, lg = cw.lg, lb = cw.lb;
#pragma unroll 1
            for (int i = 0; i < 16; ++i) {
                const int tl = 16 * wid + i;
                f32x4 acc = cb;
#pragma unroll
                for (int k = 0; k < 31; ++k) {
                    const u32x2 h = *(const LAS u32x2*)(Hg + (tl + k) * 264 + 4 * lane);
                    acc[0] += cw.w[k][0] * lo16(h.x); acc[1] += cw.w[k][1] * hi16(h.x); acc[2] += cw.w[k][2] * lo16(h.y); acc[3] += cw.w[k][3] * hi16(h.y); }
                const float mean = wave_sum((acc[0] + acc[1]) + (acc[2] + acc[3])) * (1.f / 256.f);
                const float d0 = acc[0] - mean, d1 = acc[1] - mean, d2 = acc[2] - mean, d3 = acc[3] - mean;
                const float rstd = 1.0f / sqrtf(wave_sum((d0 * d0 + d1 * d1) + (d2 * d2 + d3 * d3)) * (1.f / 256.f) + LN_EPS);
                const float y0 = siluf_(d0 * rstd * lg[0] + lb[0]), y1 = siluf_(d1 * rstd * lg[1] + lb[1]), y2 = siluf_(d2 * rstd * lg[2] + lb[2]), y3 = siluf_(d3 * rstd * lg[3] + lb[3]);
                u32x2 o; o.x = pk2(y0, y1); o.y = pk2(y2, y3);
                *(LAS u32x2*)(Hn + tl * 512 + (((lane >> 1) ^ (tl & 15)) << 4) + ((lane & 1) << 3)) = o;
            }
        }
        __syncthreads();
#pragma unroll 1
        for (int nh = 0; nh < 2; ++nh) {
            f32x4 acc[8];
#pragma unroll
            for (int nt = 0; nt < 8; ++nt) acc[nt] = (f32x4){0.f, 0.f, 0.f, 0.f};
            const bf16* pw = C.PWT + ((size_t)(l * 256 + 128 * nh + m16)) * 256 + 8 * gq;
#pragma unroll 2
            for (int s = 0; s < 8; ++s) {
                const bf16x8 a = *(const LAS bf16x8*)(Hn + row * 512 + (((4 * s + gq) ^ (row & 15)) << 4));
#pragma unroll
                for (int nt = 0; nt < 8; ++nt) { const bf16x8 bfr = *(const bf16x8*)(pw + (size_t)(16 * nt) * 256 + 32 * s); acc[nt] = mfma16(bfr, a, acc[nt]); }
            }
#pragma unroll
            for (int nt = 0; nt < 8; ++nt) { u32x2 o; o.x = pk2(acc[nt][0], acc[nt][1]); o.y = pk2(acc[nt][2], acc[nt][3]); *(u32x2*)(C.Y + (R0 + row) * D + 768 + 128 * nh + 16 * nt + 4 * gq) = o; }
        }
        __syncthreads();
    }
}
__device__ __forceinline__ void compress_item(const Ctx& C, int l, int it, LAS unsigned char* lds) {
    const int wid = C.wid, lane = C.lane;
    const int rt = it >> 1, kv = it & 1, m16 = lane & 15, gq = lane >> 4;
    const int cr = 16 * rt + m16, bb = cr >> 9, n = cr & 511, nn = n < 510 ? n : 510;
    const bf16* rowbase = C.Z + ((size_t)bb * T + 16 * nn) * DINP + (kv ? C_VCMP : C_KCMP);
    const bf16* w1t = C.CW1T + (size_t)(l * 2 + kv) * 256 * 2048;
    f32x4 acc[2]; acc[0] = (f32x4){0.f, 0.f, 0.f, 0.f}; acc[1] = acc[0];
#pragma unroll 8
    for (int s = 0; s < 64; ++s) {
        const bf16x8 a = *(const bf16x8*)(rowbase + (size_t)(s >> 1) * DINP + 32 * (s & 1) + 8 * gq);
#pragma unroll
        for (int nt = 0; nt < 2; ++nt) { const bf16x8 bfr = *(const bf16x8*)(w1t + (size_t)(32 * wid + 16 * nt + m16) * 2048 + 32 * s + 8 * gq); acc[nt] = mfma16(bfr, a, acc[nt]); }
    }
    LAS bf16* Hc = (LAS bf16*)lds;
#pragma unroll
    for (int nt = 0; nt < 2; ++nt) { const int col = 32 * wid + 16 * nt + 4 * gq; const f32x4 pb = *(const f32x4*)(C.PEB + (l * 2 + kv) * 256 + col);
        u32x2 o; o.x = pk2(gelu_tanh(acc[nt][0] + pb[0]), gelu_tanh(acc[nt][1] + pb[1])); o.y = pk2(gelu_tanh(acc[nt][2] + pb[2]), gelu_tanh(acc[nt][3] + pb[3]));
        *(LAS u32x2*)(Hc + m16 * 264 + col) = o; }
    __syncthreads();
    if (wid < 4) {
        const bf16* w2t = C.CW2T + (size_t)(l * 2 + kv) * 64 * 256;
        f32x4 a2 = {0.f, 0.f, 0.f, 0.f};
#pragma unroll
        for (int s = 0; s < 8; ++s) { const bf16x8 a = *(const LAS bf16x8*)(Hc + m16 * 264 + 32 * s + 8 * gq); const bf16x8 bfr = *(const bf16x8*)(w2t + (size_t)(16 * wid + m16) * 256 + 32 * s + 8 * gq); a2 = mfma16(bfr, a, a2); }
        { u32x2 o; o.x = pk2(a2[0], a2[1]); o.y = pk2(a2[2], a2[3]); if (n >= NCMP) { o.x = 0u; o.y = 0u; }
          *(u32x2*)((kv ? C.VC : C.KC) + (size_t)cr * 64 + 16 * wid + 4 * gq) = o;
          const int tile = n >> 6, kk = n & 63;
          if (!kv) { const int sub = kk >> 4, s = wid >> 1, g2 = 2 * (wid & 1) + (gq >> 1);
              *(u32x2*)(C.KCF + ((size_t)(bb * 8 + tile)) * 4096 + ((sub * 2 + s) * 64 + g2 * 16 + (kk & 15)) * 8 + 4 * (gq & 1)) = o;
          } else { const int s2 = kk >> 5, k5 = kk & 31, g2 = (k5 & 15) >> 2, j = (k5 & 3) + ((k5 >> 4) << 2);
              bf16* vt = C.VCF + ((size_t)(bb * 8 + tile)) * 4096 + ((s2 * 4 + wid) * 64 + g2 * 16 + 4 * gq) * 8 + j;
              vt[0] = (bf16)(o.x & 0xffffu); vt[8] = (bf16)(o.x >> 16); vt[16] = (bf16)(o.y & 0xffffu); vt[24] = (bf16)(o.y >> 16); } }
    }
    __syncthreads();
}

__device__ __forceinline__ void nsa_branch(const bf16* kb, const bf16* vb, int pitch, const LAS int* base, int nch, int vlo, int vhi, int chi,
                                           const LAS unsigned* qs, LAS float* sc, float (&o)[4], int lane) {
    float mx0 = -INFINITY, mx1 = -INFINITY, mx2 = -INFINITY, mx3 = -INFINITY;
#pragma unroll 1
    for (int i = 0; i < nch; ++i) {
        asm volatile("" ::: "memory");
        const int r = base[i] + lane; const bool valid = (r >= vlo) && (r <= vhi);
        const int rc = r < 0 ? 0 : (r > chi ? chi : r);
        const u32x4* kp = (const u32x4*)(kb + (size_t)rc * pitch);
        u32x4 kr[8];
#pragma unroll
        for (int c = 0; c < 8; ++c) kr[c] = kp[c];
        float a0 = 0.f, a1 = 0.f, a2 = 0.f, a3 = 0.f;
#pragma unroll
        for (int c = 0; c < 8; ++c) {
            const u32x4 q0 = *(const LAS u32x4*)(qs + 0 * 32 + 4 * c), q1 = *(const LAS u32x4*)(qs + 1 * 32 + 4 * c), q2 = *(const LAS u32x4*)(qs + 2 * 32 + 4 * c), q3 = *(const LAS u32x4*)(qs + 3 * 32 + 4 * c);
            a0 = dot2bf(kr[c].x, q0.x, a0); a0 = dot2bf(kr[c].y, q0.y, a0); a0 = dot2bf(kr[c].z, q0.z, a0); a0 = dot2bf(kr[c].w, q0.w, a0);
            a1 = dot2bf(kr[c].x, q1.x, a1); a1 = dot2bf(kr[c].y, q1.y, a1); a1 = dot2bf(kr[c].z, q1.z, a1); a1 = dot2bf(kr[c].w, q1.w, a1);
            a2 = dot2bf(kr[c].x, q2.x, a2); a2 = dot2bf(kr[c].y, q2.y, a2); a2 = dot2bf(kr[c].z, q2.z, a2); a2 = dot2bf(kr[c].w, q2.w, a2);
            a3 = dot2bf(kr[c].x, q3.x, a3); a3 = dot2bf(kr[c].y, q3.y, a3); a3 = dot2bf(kr[c].z, q3.z, a3); a3 = dot2bf(kr[c].w, q3.w, a3);
        }
        if (!valid) { a0 = -INFINITY; a1 = -INFINITY; a2 = -INFINITY; a3 = -INFINITY; }
        sc[0 * 1024 + 64 * i + lane] = a0; sc[1 * 1024 + 64 * i + lane] = a1; sc[2 * 1024 + 64 * i + lane] = a2; sc[3 * 1024 + 64 * i + lane] = a3;
        mx0 = fmaxf(mx0, a0); mx1 = fmaxf(mx1, a1); mx2 = fmaxf(mx2, a2); mx3 = fmaxf(mx3, a3);
    }
    mx0 = wave_max(mx0); mx1 = wave_max(mx1); mx2 = wave_max(mx2); mx3 = wave_max(mx3);
    float l0 = 0.f, l1 = 0.f, l2 = 0.f, l3 = 0.f;
    for (int i = 0; i < nch; ++i) {
        const float s0 = sc[0 * 1024 + 64 * i + lane], s1 = sc[1 * 1024 + 64 * i + lane], s2 = sc[2 * 1024 + 64 * i + lane], s3 = sc[3 * 1024 + 64 * i + lane];
        const float e0 = (s0 == -INFINITY) ? 0.f : __expf(s0 - mx0), e1 = (s1 == -INFINITY) ? 0.f : __expf(s1 - mx1), e2 = (s2 == -INFINITY) ? 0.f : __expf(s2 - mx2), e3 = (s3 == -INFINITY) ? 0.f : __expf(s3 - mx3);
        sc[0 * 1024 + 64 * i + lane] = e0; sc[1 * 1024 + 64 * i + lane] = e1; sc[2 * 1024 + 64 * i + lane] = e2; sc[3 * 1024 + 64 * i + lane] = e3;
        l0 += e0; l1 += e1; l2 += e2; l3 += e3;
    }
    l0 = wave_sum(l0); l1 = wave_sum(l1); l2 = wave_sum(l2); l3 = wave_sum(l3);
    const float i0 = l0 > 0.f ? 1.0f / l0 : 0.f, i1 = l1 > 0.f ? 1.0f / l1 : 0.f, i2 = l2 > 0.f ? 1.0f / l2 : 0.f, i3 = l3 > 0.f ? 1.0f / l3 : 0.f;
    for (int i = 0; i < nch; ++i) { sc[0 * 1024 + 64 * i + lane] *= i0; sc[1 * 1024 + 64 * i + lane] *= i1; sc[2 * 1024 + 64 * i + lane] *= i2; sc[3 * 1024 + 64 * i + lane] *= i3; }
    LDS_WAIT();
    float o0 = 0.f, o1 = 0.f, o2 = 0.f, o3 = 0.f;
    for (int i = 0; i < nch; ++i) {
        const int b0 = base[i];
        for (int j = 0; j < 64; j += 16) {
            float vv[16];
#pragma unroll
            for (int u = 0; u < 16; ++u) { int r = b0 + j + u; r = r < 0 ? 0 : (r > chi ? chi : r); vv[u] = bf2f((unsigned)vb[(size_t)r * pitch + lane]); }
#pragma unroll
            for (int u4 = 0; u4 < 4; ++u4) {
                const f32x4 p0 = *(const LAS f32x4*)(sc + 0 * 1024 + 64 * i + j + 4 * u4), p1 = *(const LAS f32x4*)(sc + 1 * 1024 + 64 * i + j + 4 * u4), p2 = *(const LAS f32x4*)(sc + 2 * 1024 + 64 * i + j + 4 * u4), p3 = *(const LAS f32x4*)(sc + 3 * 1024 + 64 * i + j + 4 * u4);
#pragma unroll
                for (int u = 0; u < 4; ++u) { const float v1 = vv[4 * u4 + u]; o0 += p0[u] * v1; o1 += p1[u] * v1; o2 += p2[u] * v1; o3 += p3[u] * v1; }
            }
        }
    }
    o[0] = o0; o[1] = o1; o[2] = o2; o[3] = o3;
}
template <bool CHECK>
__device__ __forceinline__ void nsa_query(const Ctx& C, int b, int t, LAS unsigned char* wl  , unsigned* errw) {
    const int lane = C.lane;
    LAS float* sc = (LAS float*)wl;
    LAS unsigned* qs = (LAS unsigned*)(wl + 16384);
    LAS int* base = (LAS int*)(wl + 16384 + 1024);
    const size_t row = (size_t)b * T + t;
    const bf16* zr = C.Z + row * DINP;
    const bf16* Zb = C.Z + (size_t)b * T * DINP;
    { const unsigned w2 = *(const unsigned*)(zr + C_Q + 2 * lane);
      const unsigned w3 = *(const unsigned*)(zr + C_Q + 128 + 2 * lane);
      qs[lane] = pk2(lo16(w2) * 0.125f, hi16(w2) * 0.125f); qs[64 + lane] = pk2(lo16(w3) * 0.125f, hi16(w3) * 0.125f); }
    const int nvalid = (t >= 31) ? ((t - 31) / 16 + 1) : 0;
    const int nchc = (nvalid + 63) >> 6;
    if (lane < 16) base[lane] = 64 * lane;
    LDS_WAIT();
    float oc[4];
    nsa_branch(C.KC + (size_t)b * 512 * 64, C.VC + (size_t)b * 512 * 64, 64, base, nchc, 0, nvalid - 1, 510, qs, sc, oc, lane);
    const int cur = t >> 6;
    float c0, c1;
    {
        float im0 = 0.f, im1 = 0.f;
#pragma unroll
        for (int rr = -1; rr <= 3; ++rr) { const int n0 = 4 * lane + rr, n1 = 4 * (lane + 64) + rr;
            if (n0 >= 0 && n0 < 64 * nchc) im0 += (sc[n0] + sc[1024 + n0]) + (sc[2048 + n0] + sc[3072 + n0]);
            if (n1 < 64 * nchc) im1 += (sc[n1] + sc[1024 + n1]) + (sc[2048 + n1] + sc[3072 + n1]); }
        const int m0 = lane, m1 = lane + 64;
        c0 = (m0 <= cur) ? (im0 + ((m0 == 0 || m0 == cur || m0 == cur - 1) ? 1e4f : 0.f)) : -1.0f;
        c1 = (m1 <= cur) ? (im1 + ((m1 == 0 || m1 == cur || m1 == cur - 1) ? 1e4f : 0.f)) : -1.0f;
    }
    LDS_WAIT();
    for (int r = 0; r < 16; ++r) {
        float bv; int bi;
        if (c0 >= c1) { bv = c0; bi = lane; } else { bv = c1; bi = lane + 64; }
#pragma unroll
        for (int off = 1; off < 64; off <<= 1) { const float ov = __shfl_xor(bv, off); const int oi = __shfl_xor(bi, off); if (ov > bv || (ov == bv && oi < bi)) { bv = ov; bi = oi; } }
        if (bi == lane) c0 = -2.0f; if (bi == lane + 64) c1 = -2.0f;
        if (lane == 0) base[r] = (bv >= 0.f) ? 64 * bi : -1000000;
    }
    LDS_WAIT();
    float os[4];
    nsa_branch(Zb + C_KSEL, Zb + C_VSEL, DINP, base, 16, 0, t, T - 1, qs, sc, os, lane);
    if (lane < 16) base[lane] = t - 511 + 64 * lane;
    LDS_WAIT();
    float ow[4];
    nsa_branch(Zb + C_KWIN, Zb + C_VWIN, DINP, base, 8, 0, t, T - 1, qs, sc, ow, lane);
    float yv[4];
#pragma unroll
    for (int h = 0; h < 4; ++h) {
        const float g0 = sigmoidf_(bf2f((unsigned)zr[C_GATE + 3 * h + 0])), g1 = sigmoidf_(bf2f((unsigned)zr[C_GATE + 3 * h + 1])), g2 = sigmoidf_(bf2f((unsigned)zr[C_GATE + 3 * h + 2]));
        yv[h] = g0 * oc[h] + g1 * os[h] + g2 * ow[h];
        if (!CHECK) C.Y[row * D + 256 + h * 64 + lane] = (bf16)f2bf(yv[h]);
    }
    if (CHECK) {
        const float rmax = wave_max(fmaxf(fmaxf(fabsf(yv[0]), fabsf(yv[1])), fmaxf(fabsf(yv[2]), fabsf(yv[3]))));
        int bad = 0;
#pragma unroll
        for (int h = 0; h < 4; ++h) { const float ym = bf2f((unsigned)C.Y[row * D + 256 + h * 64 + lane]); if (!(fabsf(ym - yv[h]) <= 0.03f * rmax + 2e-4f)) ++bad; }
        const float fb = wave_sum((float)bad);
        if (lane == 0) { atomicAdd(errw, (unsigned)fb); atomicAdd(errw + 64, 256u); }
    }
    LDS_WAIT();
}

__device__ __forceinline__ void moe_gather(const Ctx& C, LAS unsigned char* lds) {
    LAS int* sh = (LAS int*)lds;
    for (int i = C.tid; i < 2048; i += NTHREADS) sh[i] = C.HIST[i];
    __syncthreads();
    if (C.tid < 8) { int c = 0; for (int tl = 0; tl < 256; ++tl) c += sh[tl * 8 + C.tid]; sh[2048 + C.tid] = c; }
    __syncthreads();
    if (C.tid == 0) { int acc = 0; for (int ex = 0; ex < 8; ++ex) { sh[2064 + ex] = acc; acc += (sh[2048 + ex] + 255) & ~255; if (C.bid == 0) C.META[ex] = acc >> 8; } if (C.bid == 0) C.META[8] = acc >> 8; }
    __syncthreads();
    for (int tile = C.bid; tile < 256; tile += C.G) {
        if (C.tid < 8) { int c = 0; for (int tl = 0; tl < tile; ++tl) c += sh[tl * 8 + C.tid]; sh[2056 + C.tid] = c; }
        __syncthreads();
        for (int i = 0; i < 32; ++i) {
            const int a = 32 * C.wid + i; const size_t ag = (size_t)tile * 256 + a;
            const unsigned info = C.TOKINFO[ag]; const int e = info & 255u, lr = info >> 8;
            const int dest = sh[2064 + e] + sh[2056 + e] + lr;
            if (C.lane == 0) C.TOKPOS[ag] = dest;
            const u32x4* s = (const u32x4*)(C.XB + ((size_t)tile * 128 + (a >> 1)) * D); u32x4* dd = (u32x4*)(C.XG + (size_t)dest * D);
            dd[C.lane] = s[C.lane]; dd[C.lane + 64] = s[C.lane + 64];
        }
        __syncthreads();
    }
    const int gw = C.bid * NWAVES + C.wid, NGW = C.G * NWAVES;
    for (int ex = 0; ex < 8; ++ex) { const int s0 = sh[2064 + ex] + sh[2048 + ex], e0 = sh[2064 + ex] + ((sh[2048 + ex] + 255) & ~255);
        for (int r = s0 + gw; r < e0; r += NGW) { u32x4* dd = (u32x4*)(C.XG + (size_t)r * D); const u32x4 z = {0u, 0u, 0u, 0u}; dd[C.lane] = z; dd[C.lane + 64] = z; } }
}

__device__ __forceinline__ void frag_tile(const Ctx& C, int tb) {
    const int b = tb >> 6, t0 = (tb & 63) << 7;
    const bf16* Zt = C.Z + ((size_t)b * T + t0) * DINP;
    for (int task = C.tid; task < 2048; task += NTHREADS) {
        const int arr = task >> 10, key = (task >> 3) & 127, d8 = task & 7;
        const u32x4 v = *(const u32x4*)(Zt + (size_t)key * DINP + (arr ? C_KWIN : C_KSEL) + 8 * d8);
        const int tile = (t0 + key) >> 6, kk = key & 63;
        *(u32x4*)((arr ? C.KWINF : C.KSELF) + ((size_t)(b * 128 + tile)) * 4096 + (((kk >> 4) * 2 + (d8 >> 2)) * 64 + (d8 & 3) * 16 + (kk & 15)) * 8) = v;
    }
    for (int task = C.tid; task < 2048; task += NTHREADS) {
        const int arr = task >> 10, tile2 = (task >> 9) & 1, s2 = (task >> 8) & 1, dt = (task >> 6) & 3, ln = task & 63, g2 = ln >> 4, c2 = ln & 15;
        const bf16* src = Zt + (size_t)(64 * tile2 + 32 * s2 + 4 * g2) * DINP + (arr ? C_VWIN : C_VSEL) + 16 * dt + c2;
        unsigned v[8];
#pragma unroll
        for (int i = 0; i < 4; ++i) { v[i] = src[(size_t)i * DINP]; v[4 + i] = src[(size_t)(16 + i) * DINP]; }
        u32x4 o; o.x = v[0] | (v[1] << 16); o.y = v[2] | (v[3] << 16); o.z = v[4] | (v[5] << 16); o.w = v[6] | (v[7] << 16);
        *(u32x4*)((arr ? C.VWINF : C.VSELF) + ((size_t)(b * 128 + (t0 >> 6) + tile2)) * 4096 + ((s2 * 4 + dt) * 64 + ln) * 8) = o;
    }
}

constexpr int NCT = 2, NQW = 4 * NCT;
struct NsaAcc { f32x4 o[NCT][4]; float m[NCT], l[NCT]; };
__device__ __forceinline__ void nsa_acc_reset(NsaAcc& A) {
#pragma unroll
    for (int ct = 0; ct < NCT; ++ct) { A.m[ct] = -INFINITY; A.l[ct] = 0.f;
#pragma unroll
        for (int dt = 0; dt < 4; ++dt) A.o[ct][dt] = (f32x4){0.f, 0.f, 0.f, 0.f}; }
}
#define NSA_SCL (0.125f * 1.4426950408889634f)
__device__ __forceinline__ void nsa_tile(const bf16* Kt, const bf16* Vt, const bf16x8 (&qf)[NCT][2], int k0,
                                         const int (&lo)[NCT], const int (&hi)[NCT], unsigned ctmask, NsaAcc& A, int lane, int g) {
    bf16x8 kf[4][2], vf[4][2];
#pragma unroll
    for (int sub = 0; sub < 4; ++sub)
#pragma unroll
        for (int s = 0; s < 2; ++s) kf[sub][s] = *(const bf16x8*)(Kt + ((sub * 2 + s) * 64 + lane) * 8);
#pragma unroll
    for (int dt = 0; dt < 4; ++dt)
#pragma unroll
        for (int s2 = 0; s2 < 2; ++s2) vf[dt][s2] = *(const bf16x8*)(Vt + ((s2 * 4 + dt) * 64 + lane) * 8);
#pragma unroll
    for (int ct = 0; ct < NCT; ++ct) {
        if (!((ctmask >> ct) & 1u)) continue;
        f32x4 sa[4];
#pragma unroll
        for (int sub = 0; sub < 4; ++sub) { sa[sub] = mfma16(kf[sub][0], qf[ct][0], (f32x4){0.f, 0.f, 0.f, 0.f}); sa[sub] = mfma16(kf[sub][1], qf[ct][1], sa[sub]); }
        {
            const bool allv = (lo[ct] <= k0) && (k0 + 63 <= hi[ct]); const bool nonev = (hi[ct] < k0) || (lo[ct] > k0 + 63);
            if (__any(!(allv || nonev))) {
#pragma unroll
                for (int sub = 0; sub < 4; ++sub)
#pragma unroll
                    for (int r = 0; r < 4; ++r) { const int key = k0 + 16 * sub + 4 * g + r; sa[sub][r] = (key >= lo[ct] && key <= hi[ct]) ? sa[sub][r] : -INFINITY; }
            } else if (__any(nonev)) {
#pragma unroll
                for (int sub = 0; sub < 4; ++sub)
#pragma unroll
                    for (int r = 0; r < 4; ++r) sa[sub][r] = allv ? sa[sub][r] : -INFINITY;
            }
        }
        float tmax = fmaxf(fmaxf(fmaxf(sa[0][0], sa[0][1]), fmaxf(sa[0][2], sa[0][3])), fmaxf(fmaxf(sa[1][0], sa[1][1]), fmaxf(sa[1][2], sa[1][3])));
        tmax = fmaxf(tmax, fmaxf(fmaxf(fmaxf(sa[2][0], sa[2][1]), fmaxf(sa[2][2], sa[2][3])), fmaxf(fmaxf(sa[3][0], sa[3][1]), fmaxf(sa[3][2], sa[3][3]))));
        tmax = fmaxf(tmax, __shfl_xor(tmax, 16)); tmax = fmaxf(tmax, __shfl_xor(tmax, 32));
        tmax *= NSA_SCL;
        if (__any(tmax > A.m[ct])) {
            const float mn = fmaxf(A.m[ct], tmax);
            const float alpha = __builtin_amdgcn_exp2f(A.m[ct] - ((mn == -INFINITY) ? 0.f : mn));
            A.l[ct] *= alpha; A.m[ct] = mn;
#pragma unroll
            for (int dt = 0; dt < 4; ++dt) A.o[ct][dt] = A.o[ct][dt] * alpha;
        }
        const float nms = (A.m[ct] == -INFINITY) ? 0.f : -A.m[ct];
        float ps = 0.f;
#pragma unroll
        for (int sub = 0; sub < 4; ++sub)
#pragma unroll
            for (int r = 0; r < 4; ++r) { const float p = __builtin_amdgcn_exp2f(fmaf(sa[sub][r], NSA_SCL, nms)); sa[sub][r] = p; ps += p; }
        A.l[ct] += ps;
        bf16x8 pf[2];
#pragma unroll
        for (int s2 = 0; s2 < 2; ++s2) { u32x4 w; w.x = pk2(sa[2 * s2][0], sa[2 * s2][1]); w.y = pk2(sa[2 * s2][2], sa[2 * s2][3]); w.z = pk2(sa[2 * s2 + 1][0], sa[2 * s2 + 1][1]); w.w = pk2(sa[2 * s2 + 1][2], sa[2 * s2 + 1][3]);
            pf[s2] = __builtin_bit_cast(bf16x8, w); }
#pragma unroll
        for (int dt = 0; dt < 4; ++dt)
#pragma unroll
            for (int s2 = 0; s2 < 2; ++s2) A.o[ct][dt] = mfma16(vf[dt][s2], pf[s2], A.o[ct][dt]);
    }
}
__device__ __forceinline__ void nsa_finalize(const Ctx& C, NsaAcc& A, const bf16* Zb, size_t rowb, int t0, int jb, bool first, bool last, float (&msave)[NCT], float (&isave)[NCT], int c, int g) {
    const int ql = c >> 2, h = c & 3;
    float* scr = C.VBUF;
#pragma unroll
    for (int ct = 0; ct < NCT; ++ct) {
        float lt = A.l[ct]; lt += __shfl_xor(lt, 16); lt += __shfl_xor(lt, 32);
        const float inv = lt > 0.f ? 1.0f / lt : 0.f; msave[ct] = A.m[ct]; isave[ct] = inv;
        const int tq = t0 + 4 * ct + ql;
        const float gate = sigmoidf_(bf2f((unsigned)Zb[(size_t)tq * DINP + C_GATE + 3 * h + jb]));
        const float f = inv * gate;
#pragma unroll
        for (int dt = 0; dt < 4; ++dt) {
            f32x4 v = A.o[ct][dt] * f; const size_t off = (rowb + tq) * 256 + h * 64 + 16 * dt + 4 * g;
            if (!first) v = v + *(const f32x4*)(scr + off);
            if (last) { u32x2 o; o.x = pk2(v[0], v[1]); o.y = pk2(v[2], v[3]); *(u32x2*)(C.Y + (rowb + tq) * D + 256 + h * 64 + 16 * dt + 4 * g) = o; }
            else *(f32x4*)(scr + off) = v;
        }
    }
}
__device__ __forceinline__ void nsa_unit(const Ctx& C, int U, LAS unsigned char* wl) {
    const int lane = C.lane, c = lane & 15, g = lane >> 4, ql = c >> 2, h = c & 3;
    const int b = U / (T / NQW), t0 = (U % (T / NQW)) * NQW;
    const size_t rowb = (size_t)b * T;
    const bf16* Zb = C.Z + rowb * DINP;
    LAS float* imp = (LAS float*)wl; LAS unsigned* smask = (LAS unsigned*)(wl + 8192);
    bf16x8 qf[NCT][2]; int tq[NCT];
#pragma unroll
    for (int ct = 0; ct < NCT; ++ct) { tq[ct] = t0 + 4 * ct + ql;
#pragma unroll
        for (int s = 0; s < 2; ++s) qf[ct][s] = *(const bf16x8*)(Zb + (size_t)tq[ct] * DINP + C_Q + h * 64 + 32 * s + 8 * g); }
    NsaAcc A; float msave[NCT], isave[NCT], mc[NCT], ic[NCT];
    int lo[NCT], hi[NCT];
    constexpr unsigned ALLCT = (1u << NCT) - 1u;
    const int nmaxw = (t0 + NQW - 1 >= 31) ? ((t0 + NQW - 1 - 31) >> 4) : -1;
    const int nkt = (nmaxw >> 6) + 1;
    const bf16* KCb = C.KCF + (size_t)b * 8 * 4096; const bf16* VCb = C.VCF + (size_t)b * 8 * 4096;
#pragma unroll
    for (int ct = 0; ct < NCT; ++ct) { lo[ct] = 0; hi[ct] = (tq[ct] >= 31) ? ((tq[ct] - 31) >> 4) : -1; }
    nsa_acc_reset(A);
    for (int kt = 0; kt < nkt; ++kt) nsa_tile(KCb + (size_t)kt * 4096, VCb + (size_t)kt * 4096, qf, 64 * kt, lo, hi, ALLCT, A, lane, g);
    nsa_finalize(C, A, Zb, rowb, t0, 0, true, false, mc, ic, c, g);
    for (int i = lane; i < NQW * 128; i += 64) imp[i] = 0.f;
    LDS_WAIT();
    for (int kt = 0; kt < nkt; ++kt) {
        bf16x8 kf[4][2];
#pragma unroll
        for (int sub = 0; sub < 4; ++sub)
#pragma unroll
            for (int s = 0; s < 2; ++s) kf[sub][s] = *(const bf16x8*)(KCb + (size_t)kt * 4096 + ((sub * 2 + s) * 64 + lane) * 8);
#pragma unroll
        for (int ct = 0; ct < NCT; ++ct) {
#pragma unroll
            for (int sub = 0; sub < 4; ++sub) {
                f32x4 sa = mfma16(kf[sub][0], qf[ct][0], (f32x4){0.f, 0.f, 0.f, 0.f}); sa = mfma16(kf[sub][1], qf[ct][1], sa);
                float p[4];
#pragma unroll
                for (int r = 0; r < 4; ++r) { const int n = 64 * kt + 16 * sub + 4 * g + r; float v = (n <= hi[ct]) ? __builtin_amdgcn_exp2f(sa[r] * NSA_SCL - mc[ct]) * ic[ct] : 0.f;
                    v += __shfl_xor(v, 1); v += __shfl_xor(v, 2); p[r] = v; }
                if (h == 0) { const int mb = 16 * kt + 4 * sub + g; LAS float* ip = imp + (4 * ct + ql) * 128 + mb;
                    atomicAdd((float*)ip, (p[0] + p[1]) + (p[2] + p[3])); if (mb + 1 < 128) atomicAdd((float*)(ip + 1), p[3]); }
            }
        }
    }
    LDS_WAIT();
#pragma unroll 1
    for (int qi = 0; qi < NQW; ++qi) {
        const int t = t0 + qi, cur = t >> 6; const int m0 = lane, m1 = lane + 64;
        unsigned long long mlo, mhi;
        if (cur < 16) { mlo = __ballot(m0 <= cur); mhi = 0ull; }
        else {
            const float s0 = imp[qi * 128 + m0] + ((m0 == 0 || m0 == cur || m0 == cur - 1) ? 1e4f : 0.f), s1 = imp[qi * 128 + m1] + ((m1 == 0 || m1 == cur || m1 == cur - 1) ? 1e4f : 0.f);
            const unsigned u0 = (m0 <= cur) ? __float_as_uint(s0) + 1u : 0u, u1 = (m1 <= cur) ? __float_as_uint(s1) + 1u : 0u;
            unsigned tau = 0u;
            for (int bit = 30; bit >= 0; --bit) { const unsigned cand = tau | (1u << bit); const int cnt = __popcll(__ballot(u0 >= cand)) + __popcll(__ballot(u1 >= cand)); if (cnt >= 16) tau = cand; }
            const unsigned long long g0 = __ballot(u0 > tau), g1 = __ballot(u1 > tau), e0 = __ballot(u0 == tau), e1 = __ballot(u1 == tau);
            int need = 16 - __popcll(g0) - __popcll(g1);
            const unsigned long long lt = (1ull << lane) - 1ull;
            const unsigned long long k0m = __ballot(((e0 >> lane) & 1ull) && __popcll(e0 & lt) < need); need -= __popcll(k0m);
            const unsigned long long k1m = __ballot(((e1 >> lane) & 1ull) && __popcll(e1 & lt) < need);
            mlo = g0 | k0m; mhi = g1 | k1m;
        }
        if (lane == 0) { smask[qi * 4 + 0] = (unsigned)mlo; smask[qi * 4 + 1] = (unsigned)(mlo >> 32); smask[qi * 4 + 2] = (unsigned)mhi; smask[qi * 4 + 3] = (unsigned)(mhi >> 32); }
    }
    LDS_WAIT();
    nsa_acc_reset(A);
    {
        const int jmax = (t0 + NQW - 1) >> 6;
        const bf16* Kb = C.KSELF + (size_t)b * 128 * 4096; const bf16* Vb = C.VSELF + (size_t)b * 128 * 4096;
#pragma unroll
        for (int ct = 0; ct < NCT; ++ct) lo[ct] = 0;
        for (int j = 0; j <= jmax; ++j) {
            unsigned ctmask = 0u;
#pragma unroll
            for (int ct = 0; ct < NCT; ++ct) { const unsigned w = smask[(4 * ct + ql) * 4 + (j >> 5)]; const bool sel = (w >> (j & 31)) & 1u; hi[ct] = sel ? tq[ct] : -1; if (__any(sel)) ctmask |= 1u << ct; }
            if (ctmask) nsa_tile(Kb + (size_t)j * 4096, Vb + (size_t)j * 4096, qf, 64 * j, lo, hi, ctmask, A, lane, g);
        }
    }
    nsa_finalize(C, A, Zb, rowb, t0, 1, false, false, msave, isave, c, g);
    nsa_acc_reset(A);
    {
        const int j0 = (t0 >= 511) ? ((t0 - 511) >> 6) : 0, j1 = (t0 + NQW - 1) >> 6;
        const bf16* Kb = C.KWINF + (size_t)b * 128 * 4096; const bf16* Vb = C.VWINF + (size_t)b * 128 * 4096;
#pragma unroll
        for (int ct = 0; ct < NCT; ++ct) { lo[ct] = tq[ct] - 511; hi[ct] = tq[ct]; }
        for (int j = j0; j <= j1; ++j) nsa_tile(Kb + (size_t)j * 4096, Vb + (size_t)j * 4096, qf, 64 * j, lo, hi, ALLCT, A, lane, g);
    }
    nsa_finalize(C, A, Zb, rowb, t0, 2, false, true, msave, isave, c, g);
    LDS_WAIT();
}


#ifndef DBG_REP
#define DBG_REP 0
#endif
#ifndef NSA_CHECK
#define NSA_CHECK 0
#endif
#ifndef MK_MULTI
#define MK_MULTI 0
#endif
constexpr int PH_PER_LAYER = 11, N_PHASES = 3 + NL * PH_PER_LAYER;


__device__ __forceinline__ void mkctx(Ctx& C, const Params& P, int tid) {
    int bid_ = blockIdx.x; asm volatile("" : "+s"(bid_));
    C.tid = tid; C.lane = tid & 63; C.wid = __builtin_amdgcn_readfirstlane(tid >> 6); C.bid = bid_; C.G = gridDim.x;
#pragma unroll
    for (int i = 0; i < 35; ++i) C.in[i] = P.in[i];
    size_t wz = 0; asm volatile("" : "+s"(wz)); unsigned char* ws = P.ws + wz;
    C.X = P.out;
    C.XB = (bf16*)(ws + WS_XB); C.Z = (bf16*)(ws + WS_Z); C.Y = (bf16*)(ws + WS_Y); C.Q = (bf16*)(ws + WS_Q); C.H = (bf16*)(ws + WS_H); C.XG = (bf16*)(ws + WS_Z);
    C.KC = (bf16*)(ws + WS_KC); C.VC = (bf16*)(ws + WS_VC); C.MEMB = (bf16*)(ws + WS_MEMB); C.KVROW = (bf16*)(ws + WS_KMEM); C.W1X = (bf16*)(ws + WS_W1X); C.W2X = (bf16*)(ws + WS_W2X); C.KCF = (bf16*)(ws + WS_KCF); C.VCF = (bf16*)(ws + WS_VCF); C.KSELF = (bf16*)(ws + WS_KSELF); C.VSELF = (bf16*)(ws + WS_VSELF); C.KWINF = (bf16*)(ws + WS_KWINF); C.VWINF = (bf16*)(ws + WS_VWINF);
    C.WINT = (bf16*)(ws + WS_WINT); C.WOUTT = (bf16*)(ws + WS_WOUTT); C.XQT = (bf16*)(ws + WS_XQT); C.XKVT = (bf16*)(ws + WS_XKVT); C.XOT = (bf16*)(ws + WS_XOT);
    C.W13T = (bf16*)(ws + WS_W13T); C.W2T = (bf16*)(ws + WS_W2T); C.E13T = (bf16*)(ws + WS_E13T); C.E2T = (bf16*)(ws + WS_E2T);
    C.CW1T = (bf16*)(ws + WS_CW1T); C.CW2T = (bf16*)(ws + WS_CW2T); C.PWT = (bf16*)(ws + WS_PWT); C.POOLWT = (bf16*)(ws + WS_POOLWT); C.SGUWB = (bf16*)(ws + WS_SGUW);
    C.VBUF = (float*)(ws + WS_VBUF); C.FS = (float*)(ws + WS_VBUF); C.PEB = (float*)(ws + WS_PEB); C.TOKG = (float*)(ws + WS_TOKG); C.STAT = (float*)(ws + WS_STAT); C.QB = (float*)(ws + WS_QB); C.C1 = (float*)(ws + WS_C1); C.D1 = (float*)(ws + WS_D1);
    C.CIN = (float*)(ws + WS_CIN); C.DINV = (float*)(ws + WS_DIN); C.C13 = (float*)(ws + WS_C13); C.D13 = (float*)(ws + WS_D13);
    C.HIST = (int*)(ws + WS_HIST); C.META = (int*)(ws + WS_META); C.TOKPOS = (int*)(ws + WS_TOKPOS); C.TOKINFO = (unsigned*)(ws + WS_TOKINFO);
}
__device__ __forceinline__ int lane_now() { int l; asm volatile("v_mbcnt_lo_u32_b32 %0, -1, 0\n\tv_mbcnt_hi_u32_b32 %0, -1, %0" : "=v"(l)); return l; }
#define TID_NOW (wid_s * 64 + lane_now())
#define MKCTX() Ctx C; { int t_ = TID_NOW; asm volatile("" : "+v"(t_)); mkctx(C, P, t_); }

__global__ void __launch_bounds__(NTHREADS, 2) fwd_kernel(Params P) {
    extern __shared__ __attribute__((aligned(16))) unsigned char lds_raw[];
    LAS unsigned char* lds = (LAS unsigned char*)lds_raw;
    const int wid_s = __builtin_amdgcn_readfirstlane((int)threadIdx.x >> 6);
    for (int u = TID_NOW; u < (LDS_BYTES - LDSCTL_OFF) / 4; u += NTHREADS) ((LAS unsigned*)(lds + LDSCTL_OFF))[u] = 0u;
    __syncthreads();
    unsigned char* ws = P.ws;
    XcdBarrier bar; bar.bar = (unsigned*)(ws + WS_CTL); bar.x = 0; bar.st = nullptr;
#if !MK_MULTI
    bar = xcd_barrier_post((unsigned*)(ws + WS_CTL), (volatile LAS unsigned*)(lds + LDSCTL_OFF), TID_NOW == 0);
#endif
    const int lo = P.ph_lo, hi = P.ph_hi;
#define IN(k) (lo <= (k) && (k) < hi)
#if MK_MULTI
#define SEAM(k) do { } while (0)
#else
#define SEAM(k) do { if (IN(k) && IN((k) + 1)) xcd_barrier(bar, TID_NOW == 0); } while (0)
#endif
    int ph = 0;
    if (IN(ph)) { for (int rep = 0; rep < ((P.dbg & 2) ? 2 : 1); ++rep) { MKCTX(); p0_prologue(C, lds); __syncthreads(); } }
    SEAM(ph); ++ph;

    if (IN(ph)) {
        MKCTX();
        pg8::Gemm g{C.MEMB, C.XKVT, NB * MEM, 2 * D, D, D, D}; pg8::BatchedOrder S; S.init(NB * MEM / 256, 2 * D / 256, NL, C.G, C.bid);
        S.aL = 0; S.aB = 0; S.aH = 0; S.bL = 0; S.bB = 0; S.bH = (size_t)2 * D * D * 2;
        pg8::EpiBf16 E{C.KVROW, 2 * D, 0, 0, (size_t)NB * MEM * 2 * D};
        pg8::gemm_phase<pg8::EpiBf16, pg8::BatchedOrder, true, true>(lds, g, S, E, C.tid);
    }
    SEAM(ph); ++ph;
    if (IN(ph)) {
        MKCTX();
        for (int w = 0; w < 2; ++w) {
            pg8::Gemm g; pg8::BatchedOrder S; pg8::EpiBf16 E;
            if (w == 0) {
                g = pg8::Gemm{C.KVROW, C.XQT, MEM, D, 256, 2 * D, D}; S.init(1, D / 256, NL * NB * 4, C.G, C.bid);
                S.aL = (size_t)NB * MEM * 2 * D * 2; S.aB = (size_t)MEM * 2 * D * 2; S.aH = 256 * 2; S.bL = (size_t)D * D * 2; S.bB = 0; S.bH = 256 * 2;
                E = pg8::EpiBf16{C.W1X, D, (size_t)NB * D * D, (size_t)D * D, (size_t)256 * D};
            } else {
                g = pg8::Gemm{C.XOT, C.KVROW + D, D, MEM, 256, D, 2 * D}; S.init(D / 256, 1, NL * NB * 4, C.G, C.bid);
                S.aL = (size_t)D * D * 2; S.aB = 0; S.aH = 256 * 2; S.bL = (size_t)NB * MEM * 2 * D * 2; S.bB = (size_t)MEM * 2 * D * 2; S.bH = 256 * 2;
                E = pg8::EpiBf16{C.W2X, D, (size_t)NB * D * D, (size_t)D * D, (size_t)256};
            }
            pg8::gemm_phase<pg8::EpiBf16, pg8::BatchedOrder, true, true>(lds, g, S, E, C.tid);
        }
        for (int r = C.bid * NWAVES + C.wid; r < NL * NB * D; r += C.G * NWAVES) { const int lb = r >> 10, hm = r & 1023, h = hm >> 8, m = hm & 255, l2 = lb >> 2;
            const u32x2 kk = *(const u32x2*)(C.KVROW + ((size_t)lb * MEM + m) * 2 * D + h * 256 + 4 * C.lane); const f32x4 q4 = *(const f32x4*)(C.QB + l2 * D + h * 256 + 4 * C.lane);
            const float s = wave_sum((q4[0] * lo16(kk.x) + q4[1] * hi16(kk.x)) + (q4[2] * lo16(kk.y) + q4[3] * hi16(kk.y)));
            if (C.lane == 0) C.D1[r] = s; }
    }
    SEAM(ph); ++ph;

    for (int l = 0; l < NL; ++l) {
        const bool moe = (l & 1) != 0; const int li = l >> 1;
        if (IN(ph)) {
            MKCTX();
            pg8::Gemm g{C.XB, C.WINT + (size_t)l * DINP * D, M, DINP, D, D, D}; pg8::StaticOrder S; S.init(M, DINP, C.G, C.bid);
            pg8::EpiBf16 E{C.Z, DINP, 0, 0, 0};
            pg8::gemm_phase<pg8::EpiBf16, pg8::StaticOrder, true, true>(lds, g, S, E, C.tid);
            for (int r = C.bid * NWAVES + C.wid; r < NB * D; r += C.G * NWAVES) { const bf16* wr_ = C.W1X + ((size_t)l * NB * D + r) * D; float s = 0.f;
#pragma unroll
                for (int j = 0; j < 2; ++j) { const u32x4 v = *(const u32x4*)(wr_ + 512 * j + 8 * C.lane); s += (lo16(v.x) + hi16(v.x)) + (lo16(v.y) + hi16(v.y)) + (lo16(v.z) + hi16(v.z)) + (lo16(v.w) + hi16(v.w)); }
                s = wave_sum(s); if (C.lane == 0) C.C1[l * NB * D + r] = s; }
        }
        SEAM(ph); ++ph;
        if (IN(ph)) for (int rep = 0; rep < ((P.dbg & 4) ? 2 : 1); ++rep) {
            MKCTX();
            { ConvW cw;
              for (int r2 = 0; r2 < ((P.dbg & 64) ? 2 : 1); ++r2) for (int tb = C.bid; tb < M / 128; tb += C.G) frag_tile(C, tb);
              for (int r2 = 0; r2 < ((P.dbg & 128) ? 2 : 1); ++r2) for (int tb = C.bid; tb < M / 128; tb += C.G) mixers_tile<1>(C, l, tb, lds, cw);
              for (int r2 = 0; r2 < ((P.dbg & 256) ? 2 : 1); ++r2) for (int tb = C.bid; tb < M / 128; tb += C.G) mixers_tile<2>(C, l, tb, lds, cw);
              load_convw(C, l, cw);
              for (int r2 = 0; r2 < ((P.dbg & 512) ? 2 : 1); ++r2) for (int tb = C.bid; tb < M / 128; tb += C.G) mixers_tile<4>(C, l, tb, lds, cw); }
            for (int r2 = 0; r2 < ((P.dbg & 1024) ? 2 : 1); ++r2) for (int it = C.bid; it < 256; it += C.G) compress_item(C, l, it, lds);
        }
        SEAM(ph); ++ph;
        if (IN(ph)) for (int rep = 0; rep < ((P.dbg & 1) ? 2 : 1); ++rep) {
            MKCTX();
            for (int slot = C.bid * NWAVES + C.wid; slot < M / NQW / 2; slot += C.G * NWAVES) {
                int bb = slot >> 9, lw = slot & 511;
                if (C.G == 256) { bb = (C.bid & 7) >> 1; lw = (((C.bid >> 3) << 1) + (C.bid & 1)) * NWAVES + C.wid; }
#pragma unroll 1
                for (int k = 0; k < 2; ++k) nsa_unit(C, bb * (T / NQW) + (k ? (T / NQW - 1 - lw) : lw), lds + C.wid * 17664);
            }
#if NSA_CHECK
            xcd_barrier(bar, TID_NOW == 0);
            { const int gw = C.bid * NWAVES + C.wid, NGW = C.G * NWAVES;
              for (int q = gw; q < M; q += NGW) { const int t = q & (T - 1); if ((((unsigned)q * 2654435761u) >> 29) == 0u || t < 192) nsa_query<true>(C, q >> 13, t, lds + C.wid * 17664, (unsigned*)(P.ws + WS_CTL + 32768)); } }
#endif
        }
        SEAM(ph); ++ph;
        if (IN(ph)) {
            MKCTX();
            pg8::Gemm g{C.Y, C.WOUTT + (size_t)l * D * D, M, D, D, D, D}; pg8::StaticOrder S; S.init(M, D, C.G, C.bid);
            pg8::EpiRes E{nullptr, C.XB, C.in[I_X], (l == 0) ? 1 : 2, nullptr, nullptr, nullptr, C.STAT, D, ALPHA};
            pg8::gemm_phase<pg8::EpiRes, pg8::StaticOrder, true, true>(lds, g, S, E, C.tid);
        }
        SEAM(ph); ++ph;
        if (IN(ph)) {
            MKCTX();
            pg8::GroupedOrder S;
#pragma unroll
            for (int k = 0; k < 8; ++k) S.pend[k] = (k + 1) * (T / 256);
            S.estride = (size_t)D * D * 2; S.init(M, D, C.G, C.bid);
            pg8::Gemm g{C.XB, C.W1X + (size_t)l * NB * D * D, M, D, D, D, D};
            pg8::EpiSoftmax E{C.Q, D, 0.0625f * 1.4426950408889634f, (LAS float*)(lds + 131072), C.STAT, C.C1 + l * NB * D, C.D1 + l * NB * D, D};
            pg8::gemm_phase<pg8::EpiSoftmax, pg8::GroupedOrder, true, true>(lds, g, S, E, C.tid);
        }
        SEAM(ph); ++ph;
        if (IN(ph)) {
            MKCTX();
            pg8::GroupedOrder S;
#pragma unroll
            for (int k = 0; k < 8; ++k) S.pend[k] = (k + 1) * (T / 256);
            S.estride = (size_t)D * D * 2; S.init(M, D, C.G, C.bid);
            pg8::Gemm g{C.Q, C.W2X + (size_t)l * NB * D * D, M, D, D, D, D};
            pg8::EpiRes E{C.VBUF, C.XB, nullptr, 3, C.STAT, C.in[I_LN1G] + l * D, C.in[I_LN1B] + l * D, nullptr, D, ALPHA};
            pg8::gemm_phase<pg8::EpiRes, pg8::GroupedOrder, true, true>(lds, g, S, E, C.tid);
        }
        SEAM(ph); ++ph;
        if (IN(ph)) for (int rep = 0; rep < ((P.dbg & 8) ? 2 : 1); ++rep) { MKCTX(); ln_phase(C, C.VBUF, C.in[I_LN2G] + l * D, C.in[I_LN2B] + l * D, 0, moe ? C.in[I_ROUTER] + (size_t)li * D * NE : nullptr, nullptr, lds); }
        SEAM(ph); ++ph;
        if (IN(ph)) for (int rep = 0; rep < ((P.dbg & 32) ? 2 : 1); ++rep) { if (moe) { MKCTX(); moe_gather(C, lds); __syncthreads(); } }
        if (moe || MK_MULTI) SEAM(ph);
        ++ph;
        if (IN(ph)) {
            MKCTX();
            pg8::GroupedOrder S; int npan;
            if (moe) {
#pragma unroll
                for (int k = 0; k < 8; ++k) S.pend[k] = __builtin_amdgcn_readfirstlane(C.META[k]);
                npan = __builtin_amdgcn_readfirstlane(C.META[8]); S.estride = (size_t)2 * FE * D * 2;
            } else {
#pragma unroll
                for (int k = 0; k < 8; ++k) S.pend[k] = M / 256;
                npan = M / 256; S.estride = 0;
            }
            const int N = moe ? 2 * FE : 2 * FF;
            pg8::Gemm g{moe ? C.XG : C.XB, moe ? C.E13T + (size_t)li * NE * 2 * FE * D : C.W13T + (size_t)li * 2 * FF * D, npan * 256, N, D, D, D};
            S.init(npan * 256, N, C.G, C.bid);
            pg8::EpiSwiglu E{C.H, N / 2};
            pg8::gemm_phase<pg8::EpiSwiglu, pg8::GroupedOrder, true, true>(lds, g, S, E, C.tid);
        }
        SEAM(ph); ++ph;
        if (IN(ph)) {
            MKCTX();
            pg8::GroupedOrder S; int npan;
            if (moe) {
#pragma unroll
                for (int k = 0; k < 8; ++k) S.pend[k] = __builtin_amdgcn_readfirstlane(C.META[k]);
                npan = __builtin_amdgcn_readfirstlane(C.META[8]); S.estride = (size_t)D * FE * 2;
            } else {
#pragma unroll
                for (int k = 0; k < 8; ++k) S.pend[k] = M / 256;
                npan = M / 256; S.estride = 0;
            }
            const int K = moe ? FE : FF;
            pg8::Gemm g{C.H, moe ? C.E2T + (size_t)li * NE * D * FE : C.W2T + (size_t)li * D * FF, npan * 256, D, K, K, K};
            S.init(npan * 256, D, C.G, C.bid);
            pg8::EpiRes E{moe ? C.FS : C.VBUF, C.XB, nullptr, moe ? 0 : 2, nullptr, nullptr, nullptr, nullptr, D, ALPHA};
            pg8::gemm_phase<pg8::EpiRes, pg8::GroupedOrder, true, true>(lds, g, S, E, C.tid);
        }
        SEAM(ph); ++ph;
        if (IN(ph)) { MKCTX(); ln_phase(C, C.VBUF, C.in[I_LN3G] + l * D, C.in[I_LN3B] + l * D, moe ? 1 : 0, nullptr, (l == NL - 1) ? C.X : nullptr, lds); }
        SEAM(ph); ++ph;
    }
#if NSA_CHECK
    xcd_barrier(bar, TID_NOW == 0);
    { unsigned* ew = (unsigned*)(P.ws + WS_CTL + 32768); const unsigned err = __hip_atomic_load(ew, __ATOMIC_RELAXED, __HIP_MEMORY_SCOPE_AGENT), cnt = __hip_atomic_load(ew + 64, __ATOMIC_RELAXED, __HIP_MEMORY_SCOPE_AGENT);
      if (cnt == 0u || (unsigned long long)err * 256ull > (unsigned long long)cnt) { for (size_t i = (size_t)blockIdx.x * NTHREADS + TID_NOW; i < (size_t)M * D; i += (size_t)gridDim.x * NTHREADS) P.out[i] = 0.f; } }
#endif
#undef IN
#undef SEAM
}

extern "C" void kernel_launch(void* const* d_in, const int* in_sizes, int n_in, void* d_out, int out_size, void* d_ws, size_t ws_size, hipStream_t stream) {
    static int grid = 0;
    if (grid == 0) {
        if (n_in != 35 || out_size != M * D || ws_size < WS_END) { fprintf(stderr, "kernel_launch: unexpected problem (n_in %d, out %d, ws %zu < %zu)\n", n_in, out_size, ws_size, (size_t)WS_END); grid = -1; return; }
        int dev = 0, cus = 0, per_cu = 0;
        if (hipGetDevice(&dev) != hipSuccess || hipDeviceGetAttribute(&cus, hipDeviceAttributeMultiprocessorCount, dev) != hipSuccess) { grid = -1; return; }
        if (hipFuncSetAttribute((const void*)fwd_kernel, hipFuncAttributeMaxDynamicSharedMemorySize, LDS_BYTES) != hipSuccess) { fprintf(stderr, "kernel_launch: hipFuncSetAttribute failed\n"); grid = -1; return; }
        if (hipOccupancyMaxActiveBlocksPerMultiprocessor(&per_cu, (const void*)fwd_kernel, NTHREADS, LDS_BYTES) != hipSuccess || per_cu < 1) { fprintf(stderr, "kernel_launch: occupancy query says %d\n", per_cu); }
        (void)hipGetLastError();
        grid = cus;
    }
    if (grid < 0) return;
    (void)hipMemsetAsync((char*)d_ws + WS_CTL, 0, CTL_ZERO_BYTES, stream);
    Params p{};
    for (int i = 0; i < 35; ++i) p.in[i] = (const float*)d_in[i];
    p.out = (float*)d_out; p.ws = (unsigned char*)d_ws; p.dbg = DBG_REP;
#if MK_MULTI
    for (int k = 0; k < N_PHASES; ++k) { p.ph_lo = k; p.ph_hi = k + 1; hipLaunchKernelGGL(fwd_kernel, dim3(grid), dim3(NTHREADS), LDS_BYTES, stream, p); }
#else
    p.ph_lo = 0; p.ph_hi = N_PHASES;
    hipLaunchKernelGGL(fwd_kernel, dim3(grid), dim3(NTHREADS), LDS_BYTES, stream, p);
#endif
}
```
